# Optimizing an MI355X kernel written in HIP

```python
import jax, jax.numpy as jnp
from jax import lax
import numpy as np

D_MODEL = 1024
BATCH = 1
SEQ = 16384
DEPTH = 4

D_MIX = D_MODEL
D_RNN = D_MIX // 2
RNN_HEADS = 8
RNN_BLOCK = D_RNN // RNN_HEADS
CONV_WIDTH = 4
CONV_PAD = (2, 1)
LRU_C = 8.0
GLA_HEADS = 4
GLA_DV_TOTAL = D_MIX - D_RNN
GLA_DK_TOTAL = GLA_DV_TOTAL // 2
GLA_DV = GLA_DV_TOTAL // GLA_HEADS
GLA_DK = GLA_DK_TOTAL // GLA_HEADS
GLA_RANK = 16
GLA_TAU = 16.0
GLA_CHUNK = 64
D_FF = ((8 * D_MODEL + 2) // 3 + 255) // 256 * 256
D_IN = 2 * D_RNN + 2 * GLA_DK_TOTAL + 2 * GLA_DV_TOTAL + 2 * GLA_RANK
RMS_EPS = 1e-6

kernel_name = 'hymba_rglru_gla_encoder'


def rms_norm(x, gain):
    xf = x.astype(jnp.float32)
    y = xf * lax.rsqrt(jnp.mean(xf * xf, axis=-1, keepdims=True) + RMS_EPS)
    return (y * gain.astype(jnp.float32)).astype(x.dtype)


def centred_depthwise_conv(x, w, b):
    y = lax.conv_general_dilated(
        x, w[:, None, :], window_strides=(1,), padding=[CONV_PAD],
        dimension_numbers=('NWC', 'WIO', 'NWC'), feature_group_count=x.shape[-1])
    return y + b


def linear_scan(a, u, reverse):
    def combine(c1, c2):
        a1, b1 = c1
        a2, b2 = c2
        return a1 * a2, a2 * b1 + b2
    _, h = lax.associative_scan(combine, (a, u), axis=1, reverse=reverse)
    return h


def rg_lru(x, w_a, b_a, w_x, b_x, lam, reverse):
    B, S, _ = x.shape
    xf = x.astype(jnp.float32)
    xh = xf.reshape(B, S, RNN_HEADS, RNN_BLOCK)
    r = jax.nn.sigmoid(jnp.einsum('bshi,hij->bshj', xh, w_a.astype(jnp.float32)).reshape(B, S, D_RNN) + b_a)
    i = jax.nn.sigmoid(jnp.einsum('bshi,hij->bshj', xh, w_x.astype(jnp.float32)).reshape(B, S, D_RNN) + b_x)
    log_a = -LRU_C * r * jax.nn.softplus(-lam.astype(jnp.float32))
    a = jnp.exp(log_a)
    u = xf * i * jnp.sqrt(-jnp.expm1(2.0 * log_a))
    return linear_scan(a, u, reverse)


def gla_chunked(q, k, v, log_a):
    B, S, H, DK = q.shape
    DV = v.shape[-1]
    N = S // GLA_CHUNK
    q = q.astype(jnp.float32).reshape(B, N, GLA_CHUNK, H, DK)
    k = k.astype(jnp.float32).reshape(B, N, GLA_CHUNK, H, DK)
    v = v.astype(jnp.float32).reshape(B, N, GLA_CHUNK, H, DV)
    b = jnp.cumsum(log_a.astype(jnp.float32).reshape(B, N, GLA_CHUNK, H, DK), axis=2)
    b_last = b[:, :, -1]
    q_e = q * jnp.exp(b)
    k_e = k * jnp.exp(-b)
    scores = jnp.einsum('bnihd,bnjhd->bnhij', q_e, k_e)
    mask = jnp.tril(jnp.ones((GLA_CHUNK, GLA_CHUNK), dtype=bool))
    scores = jnp.where(mask, scores, 0.0)
    o_intra = jnp.einsum('bnhij,bnjhv->bnihv', scores, v)
    k_dec = k * jnp.exp(b_last[:, :, None] - b)
    u = jnp.einsum('bnjhd,bnjhv->bnhdv', k_dec, v)
    decay = jnp.exp(b_last)

    def step(state, inp):
        d, u_n = inp
        return d[..., None] * state + u_n, state

    _, s_prev = lax.scan(step, jnp.zeros((B, H, DK, DV), jnp.float32),
                         (jnp.moveaxis(decay, 1, 0), jnp.moveaxis(u, 1, 0)))
    s_prev = jnp.moveaxis(s_prev, 0, 1)
    o_inter = jnp.einsum('bnihd,bnhdv->bnihv', q_e, s_prev)
    return (o_intra + o_inter).reshape(B, S, H, DV)


def hybrid_mixer(h, w_in, conv_w, conv_b, lru_w_a, lru_b_a, lru_w_x, lru_b_x, lru_lambda,
                 rnn_out_norm, gla_w_gate, gla_b_gate, gla_out_norm, w_out):
    B, S, _ = h.shape
    proj = jnp.einsum('bsd,de->bse', h, w_in)
    p1 = D_RNN
    p2 = p1 + D_RNN
    p3 = p2 + GLA_DK_TOTAL
    p4 = p3 + GLA_DK_TOTAL
    p5 = p4 + GLA_DV_TOTAL
    p6 = p5 + GLA_DV_TOTAL
    p7 = p6 + GLA_RANK
    x_r, gate_r, q, k, v, g, lr_f, lr_b = jnp.split(proj, [p1, p2, p3, p4, p5, p6, p7], axis=-1)

    xc = centred_depthwise_conv(x_r, conv_w, conv_b)
    h_f = rg_lru(xc, lru_w_a[0], lru_b_a[0], lru_w_x[0], lru_b_x[0], lru_lambda[0], False)
    h_b = rg_lru(xc, lru_w_a[1], lru_b_a[1], lru_w_x[1], lru_b_x[1], lru_lambda[1], True)
    y_rnn = (h_f + h_b) * jax.nn.gelu(gate_r.astype(jnp.float32))
    y_rnn = rms_norm(y_rnn, rnn_out_norm).astype(h.dtype)

    qh = q.reshape(B, S, GLA_HEADS, GLA_DK) * (GLA_DK ** -0.5)
    kh = k.reshape(B, S, GLA_HEADS, GLA_DK)
    vh = v.reshape(B, S, GLA_HEADS, GLA_DV)
    la_f = jax.nn.log_sigmoid((jnp.einsum('bsr,re->bse', lr_f, gla_w_gate[0]) + gla_b_gate[0]).astype(jnp.float32)) / GLA_TAU
    la_b = jax.nn.log_sigmoid((jnp.einsum('bsr,re->bse', lr_b, gla_w_gate[1]) + gla_b_gate[1]).astype(jnp.float32)) / GLA_TAU
    la_f = la_f.reshape(B, S, GLA_HEADS, GLA_DK)
    la_b = la_b.reshape(B, S, GLA_HEADS, GLA_DK)
    o_f = gla_chunked(qh, kh, vh, la_f)
    o_b = jnp.flip(gla_chunked(jnp.flip(qh, 1), jnp.flip(kh, 1), jnp.flip(vh, 1), jnp.flip(la_b, 1)), 1)
    o = rms_norm(o_f + o_b, gla_out_norm)
    o = o * jax.nn.silu(g.astype(jnp.float32).reshape(B, S, GLA_HEADS, GLA_DV))
    y_gla = o.reshape(B, S, GLA_DV_TOTAL).astype(h.dtype)

    y = jnp.concatenate([y_rnn, y_gla], axis=-1)
    return jnp.einsum('bse,ed->bsd', y, w_out)


def swiglu(h, w_gate, w_up, w_down):
    a = jnp.einsum('bsd,df->bsf', h, w_gate)
    u = jnp.einsum('bsd,df->bsf', h, w_up)
    return jnp.einsum('bsf,fd->bsd', jax.nn.silu(a) * u, w_down)


def setup_inputs(seed: int = 0) -> dict:
    key = jax.random.key(seed)
    ks = jax.random.split(key, 24)
    L = DEPTH

    def nrm(k, shape, scale):
        return jax.random.normal(k, shape, jnp.float32) * scale

    def gain(k, shape):
        return 1.0 + nrm(k, shape, 0.02)

    u = jax.random.uniform(ks[10], (L, 2, D_RNN), jnp.float32, minval=0.9, maxval=0.999)
    a = u ** (1.0 / LRU_C)
    lam = jnp.log(a) - jnp.log1p(-a)
    return {
        'x': nrm(ks[0], (BATCH, SEQ, D_MODEL), 1.0),
        'mix_norm_pre': gain(ks[1], (L, D_MODEL)),
        'mix_norm_post': gain(ks[2], (L, D_MODEL)),
        'w_in': nrm(ks[3], (L, D_MODEL, D_IN), D_MODEL ** -0.5),
        'conv_w': nrm(ks[4], (L, CONV_WIDTH, D_RNN), CONV_WIDTH ** -0.5),
        'conv_b': nrm(ks[5], (L, D_RNN), 0.01),
        'lru_w_a': nrm(ks[6], (L, 2, RNN_HEADS, RNN_BLOCK, RNN_BLOCK), RNN_BLOCK ** -0.5),
        'lru_b_a': nrm(ks[7], (L, 2, D_RNN), 0.01),
        'lru_w_x': nrm(ks[8], (L, 2, RNN_HEADS, RNN_BLOCK, RNN_BLOCK), RNN_BLOCK ** -0.5),
        'lru_b_x': nrm(ks[9], (L, 2, D_RNN), 0.01),
        'lru_lambda': lam,
        'rnn_out_norm': gain(ks[11], (L, D_RNN)),
        'gla_w_gate': nrm(ks[12], (L, 2, GLA_RANK, GLA_DK_TOTAL), GLA_RANK ** -0.5),
        'gla_b_gate': nrm(ks[13], (L, 2, GLA_DK_TOTAL), 0.1),
        'gla_out_norm': gain(ks[14], (L, GLA_DV)),
        'w_out': nrm(ks[15], (L, D_MIX, D_MODEL), D_MIX ** -0.5),
        'ffn_norm_pre': gain(ks[16], (L, D_MODEL)),
        'ffn_norm_post': gain(ks[17], (L, D_MODEL)),
        'w_ffn_gate': nrm(ks[18], (L, D_MODEL, D_FF), D_MODEL ** -0.5),
        'w_ffn_up': nrm(ks[19], (L, D_MODEL, D_FF), D_MODEL ** -0.5),
        'w_ffn_down': nrm(ks[20], (L, D_FF, D_MODEL), D_FF ** -0.5),
    }


def reference(x, mix_norm_pre, mix_norm_post, w_in, conv_w, conv_b, lru_w_a, lru_b_a,
              lru_w_x, lru_b_x, lru_lambda, rnn_out_norm, gla_w_gate, gla_b_gate,
              gla_out_norm, w_out, ffn_norm_pre, ffn_norm_post, w_ffn_gate, w_ffn_up,
              w_ffn_down):
    for l in range(DEPTH):
        h = rms_norm(x, mix_norm_pre[l])
        m = hybrid_mixer(h, w_in[l], conv_w[l], conv_b[l], lru_w_a[l], lru_b_a[l],
                         lru_w_x[l], lru_b_x[l], lru_lambda[l], rnn_out_norm[l],
                         gla_w_gate[l], gla_b_gate[l], gla_out_norm[l], w_out[l])
        x = x + rms_norm(m, mix_norm_post[l])
        h = rms_norm(x, ffn_norm_pre[l])
        f = swiglu(h, w_ffn_gate[l], w_ffn_up[l], w_ffn_down[l])
        x = x + rms_norm(f, ffn_norm_post[l])
    return x
```

```cpp
#include <hip/hip_runtime.h>
#include <hip/hip_cooperative_groups.h>
#include <cstdio>
namespace cg = cooperative_groups;

#ifndef ONE_LAUNCH
#define ONE_LAUNCH 0
#endif

#define LAS __attribute__((address_space(3)))
typedef unsigned short bf16_t;
typedef short bf16x8 __attribute__((ext_vector_type(8)));
typedef short bf16x4 __attribute__((ext_vector_type(4)));
typedef float f32x4 __attribute__((ext_vector_type(4)));
typedef unsigned u32x4 __attribute__((ext_vector_type(4)));
typedef unsigned u32x2 __attribute__((ext_vector_type(2)));

constexpr int S = 16384, D = 1024, DIN = 2592, DINP = 2816, DFF = 2816, NL = 4, NCH = 256;
constexpr int NTHR = 512;
constexpr int LDS_BYTES = 147456;
constexpr float EPS = 1e-6f;

constexpr size_t WS_CTL = 0;
constexpr size_t WS_WIN = 65536;
constexpr size_t WS_WOUT = WS_WIN + (size_t)DINP * D * 2;
constexpr size_t WS_WGU = WS_WOUT + (size_t)D * D * 2;
constexpr size_t WS_WD = WS_WGU + (size_t)2 * DFF * D * 2;
constexpr size_t WS_LRUW = WS_WD + (size_t)D * DFF * 2;
constexpr size_t WS_H = WS_LRUW + (size_t)2 * 2 * 8 * 64 * 64 * 2;
constexpr size_t WS_PROJ = WS_H + (size_t)S * D * 2;
constexpr size_t WS_M = WS_PROJ + (size_t)S * DINP * 2;
constexpr size_t WS_AP = WS_M + (size_t)S * D * 4;
constexpr size_t WS_HE = WS_AP + (size_t)2 * NCH * 512 * 4;
constexpr size_t WS_CA = WS_HE + (size_t)2 * NCH * 512 * 4;
constexpr size_t WS_DEC = WS_CA + (size_t)2 * NCH * 512 * 4;
constexpr size_t WS_END = WS_DEC + (size_t)2 * NCH * 4 * 64 * 4;

struct Params { const float* in[21]; float* out; unsigned char* ws; int ph_lo, ph_hi; };

__device__ __forceinline__ float bf2f(bf16_t b) { return __uint_as_float(((unsigned)b) << 16); }
__device__ __forceinline__ bf16_t f2bf(float f) { unsigned u = __float_as_uint(f); return (bf16_t)((u + 0x7fffu + ((u >> 16) & 1u)) >> 16); }
__device__ __forceinline__ unsigned pk2(float lo, float hi) { return (unsigned)f2bf(lo) | ((unsigned)f2bf(hi) << 16); }
__device__ __forceinline__ float sigmoidf_(float x) { return 1.0f / (1.0f + __expf(-x)); }
__device__ __forceinline__ float siluf_(float x) { return x * sigmoidf_(x); }
__device__ __forceinline__ float geluf_(float x) { const float y = 0.7978845608028654f * (x + 0.044715f * x * x * x); const float t = 1.0f - 2.0f / (__expf(2.0f * y) + 1.0f); return 0.5f * x * (1.0f + t); }
__device__ __forceinline__ f32x4 mfma16(bf16x8 a, bf16x8 b, f32x4 c) { return __builtin_amdgcn_mfma_f32_16x16x32_bf16(a, b, c, 0, 0, 0); }
__device__ __forceinline__ int otid() { int t = threadIdx.x; asm volatile("" : "+v"(t)); return t; }
__device__ __forceinline__ int obid() { int t = blockIdx.x; asm volatile("" : "+s"(t)); return t; }
#define LDS_FENCE() asm volatile("s_waitcnt lgkmcnt(0)" ::: "memory")

__device__ __forceinline__ void wtile(const float* __restrict__ src, int ldsrc, int c0, int nvalid, int k0, bf16_t* __restrict__ dst, int lddst, int r0, LAS float* T) {
    const int tid = otid();
    { const int k = tid >> 3, cg8 = (tid & 7) * 8;
      const float* sp = src + (size_t)(k0 + k) * ldsrc + c0 + cg8;
#pragma unroll
      for (int i = 0; i < 2; ++i) { f32x4 v = (f32x4){0.f, 0.f, 0.f, 0.f}; if (cg8 + 4 * i + 3 < nvalid) v = *(const f32x4*)(sp + 4 * i);
          T[k * 65 + cg8 + 4 * i + 0] = v[0]; T[k * 65 + cg8 + 4 * i + 1] = v[1]; T[k * 65 + cg8 + 4 * i + 2] = v[2]; T[k * 65 + cg8 + 4 * i + 3] = v[3]; } }
    __syncthreads();
    { const int r = tid >> 3, kg = (tid & 7) * 8; u32x4 w;
      w.x = pk2(T[(kg + 0) * 65 + r], T[(kg + 1) * 65 + r]); w.y = pk2(T[(kg + 2) * 65 + r], T[(kg + 3) * 65 + r]);
      w.z = pk2(T[(kg + 4) * 65 + r], T[(kg + 5) * 65 + r]); w.w = pk2(T[(kg + 6) * 65 + r], T[(kg + 7) * 65 + r]);
      *(u32x4*)(dst + (size_t)(r0 + r) * lddst + k0 + kg) = w; }
    __syncthreads();
}

__device__ void phase_weights(const Params& p, int l, LAS unsigned char* lds) {
    LAS float* T = (LAS float*)lds;
    unsigned char* ws = p.ws;
    bf16_t* WinT = (bf16_t*)(ws + WS_WIN); bf16_t* WoutT = (bf16_t*)(ws + WS_WOUT); bf16_t* WguT = (bf16_t*)(ws + WS_WGU); bf16_t* WdT = (bf16_t*)(ws + WS_WD); bf16_t* LW = (bf16_t*)(ws + WS_LRUW);
    const float* w_in = p.in[3] + (size_t)l * D * DIN; const float* w_out = p.in[15] + (size_t)l * D * D;
    const float* w_g = p.in[18] + (size_t)l * D * DFF; const float* w_u = p.in[19] + (size_t)l * D * DFF; const float* w_d = p.in[20] + (size_t)l * DFF * D;
    constexpr int T_IN = 44 * 16, T_OUT = 16 * 16, T_GU = 88 * 16, T_D = 16 * 44, T_L = 32;
    constexpr int TOT = T_IN + T_OUT + T_GU + T_D + T_L;
    for (int u = obid(); u < TOT; u += gridDim.x) {
        int v = u;
        if (v < T_IN) { const int rt = v / 16, kt = v % 16; int nv = DIN - rt * 64; nv = nv > 64 ? 64 : (nv < 0 ? 0 : nv); wtile(w_in, DIN, nv > 0 ? rt * 64 : 0, nv, kt * 64, WinT, D, rt * 64, T); continue; }
        v -= T_IN;
        if (v < T_OUT) { const int rt = v / 16, kt = v % 16; wtile(w_out, D, rt * 64, 64, kt * 64, WoutT, D, rt * 64, T); continue; }
        v -= T_OUT;
        if (v < T_GU) { const int rt = v / 16, kt = v % 16; const int r0 = rt * 64, j = r0 / 256, within = r0 % 256; const float* src = within < 128 ? w_g : w_u; const int col = j * 128 + (within & 127);
            wtile(src, DFF, col, 64, kt * 64, WguT, D, r0, T); continue; }
        v -= T_GU;
        if (v < T_D) { const int rt = v / 44, kt = v % 44; wtile(w_d, D, rt * 64, 64, kt * 64, WdT, DFF, rt * 64, T); continue; }
        v -= T_D;
        { const int dir = v / 16, gate = (v / 8) % 2, h = v % 8; const float* src = (gate ? p.in[8] : p.in[6]) + ((size_t)(l * 2 + dir) * 8 + h) * 4096;
          wtile(src, 64, 0, 64, 0, LW + ((size_t)(dir * 2 + gate) * 8 + h) * 4096, 64, 0, T); }
    }
}

__device__ void phase_rowprep(const float* __restrict__ xsrc, const float* __restrict__ m, const float* __restrict__ gpost, float* __restrict__ xdst, const float* __restrict__ gpre, bf16_t* __restrict__ hdst) {
    const int tid = otid(); const int lane = tid & 63, wave = tid >> 6;
    for (int row = obid() * 8 + wave; row < S; row += gridDim.x * 8) {
        f32x4 xv[4];
#pragma unroll
        for (int i = 0; i < 4; ++i) xv[i] = *(const f32x4*)(xsrc + (size_t)row * D + i * 256 + lane * 4);
        if (m) {
            f32x4 mv[4]; float ss = 0.f;
#pragma unroll
            for (int i = 0; i < 4; ++i) { mv[i] = *(const f32x4*)(m + (size_t)row * D + i * 256 + lane * 4); ss += mv[i][0] * mv[i][0] + mv[i][1] * mv[i][1] + mv[i][2] * mv[i][2] + mv[i][3] * mv[i][3]; }
#pragma unroll
            for (int o = 32; o >= 1; o >>= 1) ss += __shfl_xor(ss, o);
            const float rs = rsqrtf(ss * (1.0f / D) + EPS);
#pragma unroll
            for (int i = 0; i < 4; ++i) { const f32x4 g = *(const f32x4*)(gpost + i * 256 + lane * 4); xv[i] += mv[i] * rs * g; }
        }
        if (xdst) {
#pragma unroll
            for (int i = 0; i < 4; ++i) *(f32x4*)(xdst + (size_t)row * D + i * 256 + lane * 4) = xv[i];
        }
        if (hdst) {
            float ss = 0.f;
#pragma unroll
            for (int i = 0; i < 4; ++i) ss += xv[i][0] * xv[i][0] + xv[i][1] * xv[i][1] + xv[i][2] * xv[i][2] + xv[i][3] * xv[i][3];
#pragma unroll
            for (int o = 32; o >= 1; o >>= 1) ss += __shfl_xor(ss, o);
            const float rs = rsqrtf(ss * (1.0f / D) + EPS);
#pragma unroll
            for (int i = 0; i < 4; ++i) { const f32x4 g = *(const f32x4*)(gpre + i * 256 + lane * 4); const f32x4 hv = xv[i] * rs * g; u32x2 w; w.x = pk2(hv[0], hv[1]); w.y = pk2(hv[2], hv[3]);
                *(u32x2*)(hdst + (size_t)row * D + i * 256 + lane * 4) = w; }
        }
    }
}

template <int EPI> __device__ void gemm_simple(const bf16_t* __restrict__ A, int lda, const bf16_t* __restrict__ Bt, int K, int M, int N, void* __restrict__ Cv, int ldc) {
    const int tid = otid(), lane = tid & 63, wave = tid >> 6, wr = wave >> 2, wc = wave & 3, c = lane & 15, q = lane >> 4;
    const int nM = M / 128, nN = N / 256;
    for (int u = obid(); u < nM * nN; u += gridDim.x) {
        const int pn = u / nM, pm = u % nM; const int m0 = pm * 128 + wr * 64;
        f32x4 acc[4][4];
#pragma unroll
        for (int i = 0; i < 4; ++i)
#pragma unroll
            for (int j = 0; j < 4; ++j) acc[i][j] = (f32x4){0.f, 0.f, 0.f, 0.f};
        const bf16_t* ap = A + (size_t)(m0 + c) * lda + 8 * q;
        const bf16_t* bp = Bt + (size_t)(pn * 256 + wc * 32 + c) * K + 8 * q;
        for (int k0 = 0; k0 < K; k0 += 32) {
            bf16x8 af[4], bfr[4];
#pragma unroll
            for (int mi = 0; mi < 4; ++mi) af[mi] = *(const bf16x8*)(ap + (size_t)(16 * mi) * lda + k0);
#pragma unroll
            for (int nf = 0; nf < 4; ++nf) bfr[nf] = *(const bf16x8*)(bp + (size_t)((nf >> 1) * 128 + (nf & 1) * 16) * K + k0);
#pragma unroll
            for (int mi = 0; mi < 4; ++mi)
#pragma unroll
                for (int nf = 0; nf < 4; ++nf) acc[mi][nf] = mfma16(bfr[nf], af[mi], acc[mi][nf]);
        }
#pragma unroll
        for (int mi = 0; mi < 4; ++mi) { const int row = m0 + 16 * mi + c;
            if (EPI == 2) {
#pragma unroll
                for (int nf = 0; nf < 2; ++nf) { const f32x4 g = acc[mi][nf], uu = acc[mi][nf + 2]; const int col = pn * 128 + wc * 32 + nf * 16 + 4 * q;
                    u32x2 w; w.x = pk2(siluf_(g[0]) * uu[0], siluf_(g[1]) * uu[1]); w.y = pk2(siluf_(g[2]) * uu[2], siluf_(g[3]) * uu[3]);
                    *(u32x2*)((bf16_t*)Cv + (size_t)row * ldc + col) = w; }
            } else {
#pragma unroll
                for (int nf = 0; nf < 4; ++nf) { const int col = pn * 256 + (nf >> 1) * 128 + wc * 32 + (nf & 1) * 16 + 4 * q; const f32x4 v = acc[mi][nf];
                    if (EPI == 0) { u32x2 w; w.x = pk2(v[0], v[1]); w.y = pk2(v[2], v[3]); *(u32x2*)((bf16_t*)Cv + (size_t)row * ldc + col) = w; }
                    else *(f32x4*)((float*)Cv + (size_t)row * ldc + col) = v; }
            }
        }
    }
}

template <int MODE> __device__ void mixer_lru(const Params& p, int l, int n, LAS unsigned char* lds) {
    const int tid = otid(), lane = tid & 63, wave = tid >> 6, c = lane & 15, q = lane >> 4;
    unsigned char* ws = p.ws;
    const bf16_t* proj = (const bf16_t*)(ws + WS_PROJ); bf16_t* y = (bf16_t*)(ws + WS_H);
    const bf16_t* LW = (const bf16_t*)(ws + WS_LRUW);
    float* Aprod = (float*)(ws + WS_AP); float* Hend = (float*)(ws + WS_HE); const float* carry = (const float*)(ws + WS_CA);
    LAS bf16_t* XC = (LAS bf16_t*)lds;
    LAS float* STA = (LAS float*)(lds + 66560 + wave * 8704);
    LAS float* STU = STA + 16 * 68;
    const int t0 = n * 64;
    {
        const int ch = tid;
        const float cw0 = p.in[4][(size_t)(l * 4 + 0) * 512 + ch], cw1 = p.in[4][(size_t)(l * 4 + 1) * 512 + ch], cw2 = p.in[4][(size_t)(l * 4 + 2) * 512 + ch], cw3 = p.in[4][(size_t)(l * 4 + 3) * 512 + ch];
        const float cb = p.in[5][(size_t)l * 512 + ch];
#define LDX(s) (((s) >= 0 && (s) < S) ? bf2f(proj[(size_t)(s) * DINP + ch]) : 0.f)
        float xm2 = LDX(t0 - 2), xm1 = LDX(t0 - 1), x0 = LDX(t0);
#pragma unroll 8
        for (int t = 0; t < 64; ++t) { const float x1 = LDX(t0 + t + 1); const float xc = cb + cw0 * xm2 + cw1 * xm1 + cw2 * x0 + cw3 * x1; XC[t * 520 + ch] = f2bf(xc); xm2 = xm1; xm1 = x0; x0 = x1; }
#undef LDX
    }
    __syncthreads();
    {
        const int h = wave, j = lane;
#pragma unroll 1
        for (int dir = 0; dir < 2; ++dir) {
            const float* lam = p.in[10] + (size_t)(l * 2 + dir) * 512 + 64 * h; const float* b_a = p.in[7] + (size_t)(l * 2 + dir) * 512 + 64 * h; const float* b_x = p.in[9] + (size_t)(l * 2 + dir) * 512 + 64 * h;
            const bf16_t* LWa = LW + ((size_t)(dir * 2 + 0) * 8 + h) * 4096 + c * 64 + 8 * q; const bf16_t* LWx = LW + ((size_t)(dir * 2 + 1) * 8 + h) * 4096 + c * 64 + 8 * q;
            float hcar = 0.f, P = 1.f;
            if (MODE == 1) hcar = carry[(size_t)(dir * NCH + n) * 512 + 64 * h + j];
#pragma unroll 1
            for (int g = 0; g < 4; ++g) {
                const int mi = dir == 0 ? g : 3 - g;
                bf16x8 xf[2];
#pragma unroll
                for (int ks = 0; ks < 2; ++ks) xf[ks] = *(const LAS bf16x8*)(XC + (16 * mi + c) * 520 + 64 * h + 32 * ks + 8 * q);
#pragma unroll 1
                for (int nf = 0; nf < 4; ++nf) {
                    f32x4 za = (f32x4){0.f, 0.f, 0.f, 0.f}, zx = za;
                    za = mfma16(*(const bf16x8*)(LWa + nf * 1024), xf[0], za); za = mfma16(*(const bf16x8*)(LWa + nf * 1024 + 32), xf[1], za);
                    zx = mfma16(*(const bf16x8*)(LWx + nf * 1024), xf[0], zx); zx = mfma16(*(const bf16x8*)(LWx + nf * 1024 + 32), xf[1], zx);
                    const int jo = 16 * nf + 4 * q;
                    const f32x4 ba4 = *(const f32x4*)(b_a + jo), bx4 = *(const f32x4*)(b_x + jo), lam4 = *(const f32x4*)(lam + jo);
                    const bf16x4 xc4 = *(const LAS bf16x4*)(XC + (16 * mi + c) * 520 + 64 * h + jo);
                    f32x4 av, uv;
#pragma unroll
                    for (int r = 0; r < 4; ++r) {
                        const float ra = sigmoidf_(za[r] + ba4[r]), ix = sigmoidf_(zx[r] + bx4[r]);
                        const float sp = log1pf(__expf(-lam4[r]));
                        const float la = -8.0f * ra * sp;
                        av[r] = __expf(la);
                        uv[r] = bf2f((bf16_t)xc4[r]) * ix * sqrtf(fmaxf(-expm1f(2.0f * la), 0.f));
                    }
                    *(LAS f32x4*)(STA + c * 68 + jo) = av; *(LAS f32x4*)(STU + c * 68 + jo) = uv;
                }
                LDS_FENCE();
#pragma unroll 1
                for (int s = 0; s < 16; ++s) {
                    const int tl = dir == 0 ? s : 15 - s;
                    const float a = STA[tl * 68 + j], u = STU[tl * 68 + j];
                    hcar = a * hcar + u; P *= a;
                    if (MODE == 1) {
                        const int t = 16 * mi + tl; const size_t yi = (size_t)(t0 + t) * D + 64 * h + j;
                        if (dir == 0) y[yi] = f2bf(hcar);
                        else { const float hf = bf2f(y[yi]); const float gt = bf2f(proj[(size_t)(t0 + t) * DINP + 512 + 64 * h + j]); XC[t * 520 + 64 * h + j] = f2bf((hf + hcar) * geluf_(gt)); }
                    }
                }
                LDS_FENCE();
            }
            if (MODE == 0) { Aprod[(size_t)(dir * NCH + n) * 512 + 64 * h + j] = P; Hend[(size_t)(dir * NCH + n) * 512 + 64 * h + j] = hcar; }
        }
    }
    __syncthreads();
    if (MODE == 1) {
        const int t = tid >> 3, seg = tid & 7;
        float ss = 0.f;
#pragma unroll
        for (int i = 0; i < 8; ++i) { const bf16x8 b = *(const LAS bf16x8*)(XC + t * 520 + 64 * seg + 8 * i);
#pragma unroll
            for (int k = 0; k < 8; ++k) { const float f = bf2f((bf16_t)b[k]); ss += f * f; } }
        ss += __shfl_xor(ss, 1); ss += __shfl_xor(ss, 2); ss += __shfl_xor(ss, 4);
        const float rs = rsqrtf(ss * (1.0f / 512.0f) + EPS);
        const float* gn = p.in[11] + (size_t)l * 512 + 64 * seg;
#pragma unroll 2
        for (int i = 0; i < 8; ++i) { const bf16x8 b = *(const LAS bf16x8*)(XC + t * 520 + 64 * seg + 8 * i); const f32x4 g0 = *(const f32x4*)(gn + 8 * i), g1 = *(const f32x4*)(gn + 8 * i + 4); u32x4 w;
            w.x = pk2(bf2f((bf16_t)b[0]) * rs * g0[0], bf2f((bf16_t)b[1]) * rs * g0[1]); w.y = pk2(bf2f((bf16_t)b[2]) * rs * g0[2], bf2f((bf16_t)b[3]) * rs * g0[3]);
            w.z = pk2(bf2f((bf16_t)b[4]) * rs * g1[0], bf2f((bf16_t)b[5]) * rs * g1[1]); w.w = pk2(bf2f((bf16_t)b[6]) * rs * g1[2], bf2f((bf16_t)b[7]) * rs * g1[3]);
            *(u32x4*)(y + (size_t)(t0 + t) * D + 64 * seg + 8 * i) = w; }
        __syncthreads();
    }
}

template <int MODE> __device__ void mixer_gla(const Params& p, int l, int n, LAS unsigned char* lds) {
    const int tid = otid(), lane = tid & 63, wave = tid >> 6, c = lane & 15, q = lane >> 4;
    unsigned char* ws = p.ws;
    const bf16_t* proj = (const bf16_t*)(ws + WS_PROJ); bf16_t* y = (bf16_t*)(ws + WS_H);
    bf16_t* uT = (bf16_t*)(ws + WS_M); const bf16_t* spT = (const bf16_t*)(ws + WS_M + (size_t)S * D * 2); float* dec = (float*)(ws + WS_DEC);
    LAS float* LA0 = (LAS float*)lds;
    LAS bf16_t* QE0 = (LAS bf16_t*)(lds + 32768);
    LAS bf16_t* VT = (LAS bf16_t*)(lds + 69632);
    LAS bf16_t* P0 = (LAS bf16_t*)(lds + 88064);
    LAS float* SSQ = (LAS float*)(lds + 106496);
    const int t0 = n * 64;
#pragma unroll 1
    for (int h = 0; h < 4; ++h) {
        {
            const int de = tid & 127, dir = de >> 6, e = de & 63, tg = tid >> 7;
            const float* Wg = p.in[12] + (size_t)(l * 2 + dir) * 16 * 256 + 64 * h + e; const float bg = p.in[13][(size_t)(l * 2 + dir) * 256 + 64 * h + e];
            float w[16];
#pragma unroll
            for (int r = 0; r < 16; ++r) w[r] = Wg[(size_t)r * 256];
            LAS float* LA = LA0 + dir * 4096;
#pragma unroll 1
            for (int tt = 0; tt < 16; ++tt) { const int t = tg * 16 + tt;
                const bf16x8 l0 = *(const bf16x8*)(proj + (size_t)(t0 + t) * DINP + 2560 + dir * 16), l1 = *(const bf16x8*)(proj + (size_t)(t0 + t) * DINP + 2560 + dir * 16 + 8);
                float z = bg;
#pragma unroll
                for (int r = 0; r < 8; ++r) { z += bf2f((bf16_t)l0[r]) * w[r]; z += bf2f((bf16_t)l1[r]) * w[8 + r]; }
                LA[t * 64 + e] = (fminf(z, 0.f) - log1pf(__expf(-fabsf(z)))) * (1.0f / 16.0f); }
            const int vv = tid & 127, tq = tid >> 7;
            unsigned wv[8];
#pragma unroll
            for (int i = 0; i < 8; ++i) { const unsigned lo = proj[(size_t)(t0 + 16 * tq + 2 * i) * DINP + 1536 + 128 * h + vv], hi = proj[(size_t)(t0 + 16 * tq + 2 * i + 1) * DINP + 1536 + 128 * h + vv]; wv[i] = lo | (hi << 16); }
            *(LAS u32x4*)(VT + vv * 72 + 16 * tq) = (u32x4){wv[0], wv[1], wv[2], wv[3]}; *(LAS u32x4*)(VT + vv * 72 + 16 * tq + 8) = (u32x4){wv[4], wv[5], wv[6], wv[7]};
        }
        __syncthreads();
        if (tid < 128) {
            const int dir = tid >> 6, d = tid & 63; LAS float* LA = LA0 + dir * 4096; float acc = 0.f;
            if (MODE == 1) {
                if (dir == 0) {
#pragma unroll 8
                    for (int t = 0; t < 64; ++t) { acc += LA[t * 64 + d]; LA[t * 64 + d] = acc; } }
                else {
#pragma unroll 8
                    for (int t = 63; t >= 0; --t) { acc += LA[t * 64 + d]; LA[t * 64 + d] = acc; } }
            } else {
                if (dir == 0) {
#pragma unroll 8
                    for (int t = 63; t >= 0; --t) { const float v = LA[t * 64 + d]; LA[t * 64 + d] = acc; acc += v; } }
                else {
#pragma unroll 8
                    for (int t = 0; t < 64; ++t) { const float v = LA[t * 64 + d]; LA[t * 64 + d] = acc; acc += v; } }
                dec[((size_t)(dir * NCH + n) * 4 + h) * 64 + d] = __expf(acc);
            }
        }
        __syncthreads();
        if (MODE == 1) {
            { const int t = tid >> 3, dg = (tid & 7) * 8;
              const bf16x8 qv = *(const bf16x8*)(proj + (size_t)(t0 + t) * DINP + 1024 + 64 * h + dg), kv = *(const bf16x8*)(proj + (size_t)(t0 + t) * DINP + 1280 + 64 * h + dg);
#pragma unroll
              for (int dir = 0; dir < 2; ++dir) { float qe[8], ke[8];
#pragma unroll
                  for (int k = 0; k < 8; ++k) { const float b = LA0[dir * 4096 + t * 64 + dg + k]; qe[k] = bf2f((bf16_t)qv[k]) * 0.125f * __expf(b); ke[k] = bf2f((bf16_t)kv[k]) * __expf(-b); }
                  *(LAS u32x4*)(QE0 + dir * 9216 + t * 72 + dg) = (u32x4){pk2(qe[0], qe[1]), pk2(qe[2], qe[3]), pk2(qe[4], qe[5]), pk2(qe[6], qe[7])};
                  *(LAS u32x4*)(QE0 + dir * 9216 + 4608 + t * 72 + dg) = (u32x4){pk2(ke[0], ke[1]), pk2(ke[2], ke[3]), pk2(ke[4], ke[5]), pk2(ke[6], ke[7])}; } }
            __syncthreads();
            { const int dir = wave >> 2, ti = wave & 3; LAS bf16_t* QE = QE0 + dir * 9216; LAS bf16_t* KE = QE + 4608; LAS bf16_t* P = P0 + dir * 4608;
              bf16x8 qf[2];
#pragma unroll
              for (int ks = 0; ks < 2; ++ks) qf[ks] = *(const LAS bf16x8*)(QE + (16 * ti + c) * 72 + 32 * ks + 8 * q);
#pragma unroll
              for (int tj = 0; tj < 4; ++tj) { f32x4 sc = (f32x4){0.f, 0.f, 0.f, 0.f};
#pragma unroll
                  for (int ks = 0; ks < 2; ++ks) { const bf16x8 kf = *(const LAS bf16x8*)(KE + (16 * tj + c) * 72 + 32 * ks + 8 * q); sc = mfma16(kf, qf[ks], sc); }
                  const int i = 16 * ti + c, j0 = 16 * tj + 4 * q; float m[4];
#pragma unroll
                  for (int r = 0; r < 4; ++r) { const int j = j0 + r; const bool keep = dir == 0 ? (j <= i) : (j >= i); m[r] = keep ? sc[r] : 0.f; }
                  *(LAS u32x2*)(P + i * 72 + j0) = (u32x2){pk2(m[0], m[1]), pk2(m[2], m[3])}; } }
            __syncthreads();
            { const int ti = wave & 3, vb = (wave >> 2) * 4;
              f32x4 acc[4];
#pragma unroll
              for (int i = 0; i < 4; ++i) acc[i] = (f32x4){0.f, 0.f, 0.f, 0.f};
#pragma unroll
              for (int dir = 0; dir < 2; ++dir) {
                  LAS bf16_t* QE = QE0 + dir * 9216; LAS bf16_t* P = P0 + dir * 4608;
                  const bf16_t* SP = spT + ((size_t)(dir * NCH + n) * 4 + h) * 8192;
#pragma unroll
                  for (int ks = 0; ks < 2; ++ks) {
                      const bf16x8 pf = *(const LAS bf16x8*)(P + (16 * ti + c) * 72 + 32 * ks + 8 * q), qf = *(const LAS bf16x8*)(QE + (16 * ti + c) * 72 + 32 * ks + 8 * q);
#pragma unroll
                      for (int vl = 0; vl < 4; ++vl) { const int vf = vb + vl;
                          const bf16x8 vtf = *(const LAS bf16x8*)(VT + (16 * vf + c) * 72 + 32 * ks + 8 * q); acc[vl] = mfma16(vtf, pf, acc[vl]);
                          const bf16x8 sf = *(const bf16x8*)(SP + (16 * vf + c) * 64 + 32 * ks + 8 * q); acc[vl] = mfma16(sf, qf, acc[vl]); }
                  }
              }
              float ss = 0.f;
#pragma unroll
              for (int vl = 0; vl < 4; ++vl) ss += acc[vl][0] * acc[vl][0] + acc[vl][1] * acc[vl][1] + acc[vl][2] * acc[vl][2] + acc[vl][3] * acc[vl][3];
              ss += __shfl_xor(ss, 16); ss += __shfl_xor(ss, 32);
              const int t = 16 * ti + c;
              if (q == 0) SSQ[t * 2 + (wave >> 2)] = ss;
              __syncthreads();
              const float rs = rsqrtf((SSQ[t * 2] + SSQ[t * 2 + 1]) * (1.0f / 128.0f) + EPS);
              const float* gn = p.in[14] + (size_t)l * 128;
#pragma unroll
              for (int vl = 0; vl < 4; ++vl) { const int v = 16 * (vb + vl) + 4 * q; const f32x4 g4 = *(const f32x4*)(gn + v);
                  const bf16x4 gg = *(const bf16x4*)(proj + (size_t)(t0 + t) * DINP + 2048 + 128 * h + v); float o[4];
#pragma unroll
                  for (int r = 0; r < 4; ++r) o[r] = acc[vl][r] * rs * g4[r] * siluf_(bf2f((bf16_t)gg[r]));
                  *(u32x2*)(y + (size_t)(t0 + t) * D + 512 + 128 * h + v) = (u32x2){pk2(o[0], o[1]), pk2(o[2], o[3])}; }
            }
            __syncthreads();
        } else {
            { const int d = tid & 63, tg = tid >> 6; float kk[8];
#pragma unroll
              for (int i = 0; i < 8; ++i) kk[i] = bf2f(proj[(size_t)(t0 + 8 * tg + i) * DINP + 1280 + 64 * h + d]);
#pragma unroll
              for (int dir = 0; dir < 2; ++dir) { float kd[8];
#pragma unroll
                  for (int i = 0; i < 8; ++i) kd[i] = kk[i] * __expf(LA0[dir * 4096 + (8 * tg + i) * 64 + d]);
                  *(LAS u32x4*)(QE0 + dir * 9216 + d * 72 + 8 * tg) = (u32x4){pk2(kd[0], kd[1]), pk2(kd[2], kd[3]), pk2(kd[4], kd[5]), pk2(kd[6], kd[7])}; } }
            __syncthreads();
            { const int dir = wave >> 2, df = wave & 3; LAS bf16_t* KDT = QE0 + dir * 9216;
              bf16x8 kf[2];
#pragma unroll
              for (int ks = 0; ks < 2; ++ks) kf[ks] = *(const LAS bf16x8*)(KDT + (16 * df + c) * 72 + 32 * ks + 8 * q);
              bf16_t* U = uT + ((size_t)(dir * NCH + n) * 4 + h) * 8192;
#pragma unroll
              for (int vf = 0; vf < 8; ++vf) { f32x4 a = (f32x4){0.f, 0.f, 0.f, 0.f};
#pragma unroll
                  for (int ks = 0; ks < 2; ++ks) { const bf16x8 vtf = *(const LAS bf16x8*)(VT + (16 * vf + c) * 72 + 32 * ks + 8 * q); a = mfma16(kf[ks], vtf, a); }
                  *(u32x2*)(U + (16 * vf + c) * 64 + 16 * df + 4 * q) = (u32x2){pk2(a[0], a[1]), pk2(a[2], a[3])}; } }
            __syncthreads();
        }
    }
}

__device__ void phase_scan(const Params& p) {
    unsigned char* ws = p.ws; const int tid = otid();
    if (tid < 256) {
        const bf16_t* uT = (const bf16_t*)(ws + WS_M); bf16_t* spT = (bf16_t*)(ws + WS_M + (size_t)S * D * 2); const float* dec = (const float*)(ws + WS_DEC);
        for (int gid = obid() * 256 + tid; gid < 65536; gid += gridDim.x * 256) {
            const int dir = gid >> 15, rem = gid & 32767, h = rem >> 13, vd = rem & 8191, d = vd & 63;
            float s = 0.f;
#pragma unroll 8
            for (int st = 0; st < NCH; ++st) { const int n = dir ? (NCH - 1 - st) : st; const size_t idx = ((size_t)(dir * NCH + n) * 4 + h) * 8192 + vd;
                const float u = bf2f(uT[idx]); const float dc = dec[((size_t)(dir * NCH + n) * 4 + h) * 64 + d]; spT[idx] = f2bf(s); s = dc * s + u; }
        }
    } else if (tid < 384 && obid() < 8) {
        const float* Aprod = (const float*)(ws + WS_AP); const float* Hend = (const float*)(ws + WS_HE); float* carry = (float*)(ws + WS_CA);
        const int gid = obid() * 128 + (tid - 256); const int dir = gid >> 9, ch = gid & 511;
        float hc = 0.f;
#pragma unroll 8
        for (int st = 0; st < NCH; ++st) { const int n = dir ? (NCH - 1 - st) : st; const size_t idx = (size_t)(dir * NCH + n) * 512 + ch;
            const float a = Aprod[idx], he = Hend[idx]; carry[idx] = hc; hc = a * hc + he; }
    }
}

__global__ void __launch_bounds__(NTHR, 2) mk_fwd(Params p) {
    extern __shared__ __attribute__((aligned(16))) unsigned char lds_raw[];
    LAS unsigned char* lds = (LAS unsigned char*)lds_raw;
    unsigned char* ws = p.ws;
    bf16_t* WinT = (bf16_t*)(ws + WS_WIN); bf16_t* WoutT = (bf16_t*)(ws + WS_WOUT); bf16_t* WguT = (bf16_t*)(ws + WS_WGU); bf16_t* WdT = (bf16_t*)(ws + WS_WD);
    bf16_t* Hb = (bf16_t*)(ws + WS_H); bf16_t* PROJ = (bf16_t*)(ws + WS_PROJ); float* Mb = (float*)(ws + WS_M);
    const float* xin = p.in[0]; float* out = p.out;
    for (int ph = p.ph_lo; ph < p.ph_hi; ++ph) {
        if (ph > p.ph_lo) cg::this_grid().sync();
        if (ph == 9 * NL) { phase_rowprep(out, Mb, p.in[17] + (size_t)(NL - 1) * D, out, nullptr, nullptr); continue; }
        const int l = ph / 9, s = ph % 9;
        switch (s) {
#ifndef PHMASK
#define PHMASK 0x1ff
#endif
        case 0: if (!(PHMASK & 1)) break; phase_weights(p, l, lds);
                if (l == 0) phase_rowprep(xin, nullptr, nullptr, nullptr, p.in[1], Hb);
                else phase_rowprep(out, Mb, p.in[17] + (size_t)(l - 1) * D, out, p.in[1] + (size_t)l * D, Hb);
                break;
        case 1: if (!(PHMASK & 2)) break; gemm_simple<0>(Hb, D, WinT, D, S, DINP, PROJ, DINP); break;
        case 2: if (!(PHMASK & 4)) break; for (int n = obid(); n < NCH; n += gridDim.x) mixer_lru<0>(p, l, n, lds);
                for (int n = obid(); n < NCH; n += gridDim.x) mixer_gla<0>(p, l, n, lds); break;
        case 3: if (!(PHMASK & 8)) break; phase_scan(p); break;
        case 4: if (!(PHMASK & 16)) break; for (int n = obid(); n < NCH; n += gridDim.x) mixer_lru<1>(p, l, n, lds);
                for (int n = obid(); n < NCH; n += gridDim.x) mixer_gla<1>(p, l, n, lds); break;
        case 5: if (!(PHMASK & 32)) break; gemm_simple<1>(Hb, D, WoutT, D, S, D, Mb, D); break;
        case 6: if (!(PHMASK & 64)) break; phase_rowprep(l == 0 ? xin : out, Mb, p.in[2] + (size_t)l * D, out, p.in[16] + (size_t)l * D, Hb); break;
        case 7: if (!(PHMASK & 128)) break; gemm_simple<2>(Hb, D, WguT, D, S, 2 * DFF, PROJ, DFF); break;
        case 8: if (!(PHMASK & 256)) break; gemm_simple<1>(PROJ, DFF, WdT, DFF, S, D, Mb, D); break;
        }
    }
}

extern "C" void kernel_launch(void* const* d_in, const int* in_sizes, int n_in, void* d_out, int out_size, void* d_ws, size_t ws_size, hipStream_t stream) {
    static int grid = 0;
    if (grid == 0) {
        if (n_in != 21 || out_size != S * D || ws_size < WS_END) { fprintf(stderr, "kernel_launch: unexpected shapes: n_in %d out %d ws %zu (need %zu)\n", n_in, out_size, ws_size, (size_t)WS_END); grid = -1; return; }
        int dev = 0, cus = 0, per_cu = 0;
        (void)hipGetDevice(&dev); (void)hipDeviceGetAttribute(&cus, hipDeviceAttributeMultiprocessorCount, dev);
        if (hipFuncSetAttribute((const void*)mk_fwd, hipFuncAttributeMaxDynamicSharedMemorySize, LDS_BYTES) != hipSuccess) { fprintf(stderr, "kernel_launch: hipFuncSetAttribute failed\n"); grid = -1; return; }
        if (hipOccupancyMaxActiveBlocksPerMultiprocessor(&per_cu, (const void*)mk_fwd, NTHR, LDS_BYTES) != hipSuccess || per_cu < 1) { fprintf(stderr, "kernel_launch: occupancy query says %d\n", per_cu); per_cu = 1; }
        (void)hipGetLastError();
        grid = cus;
    }
    if (grid < 0) return;
    Params p{};
    for (int i = 0; i < 21; ++i) p.in[i] = (const float*)d_in[i];
    p.out = (float*)d_out; p.ws = (unsigned char*)d_ws;
#if ONE_LAUNCH
    p.ph_lo = 0; p.ph_hi = 9 * NL + 1;
    void* args[] = {&p};
    hipError_t e = hipLaunchCooperativeKernel((const void*)mk_fwd, dim3(grid), dim3(NTHR), args, LDS_BYTES, stream);
    if (e != hipSuccess) fprintf(stderr, "cooperative launch failed: %s (grid %d)\n", hipGetErrorString(e), grid);
#else
    for (int ph = 0; ph < 9 * NL + 1; ++ph) { p.ph_lo = ph; p.ph_hi = ph + 1; hipLaunchKernelGGL(mk_fwd, dim3(grid), dim3(NTHR), LDS_BYTES, stream, p); }
#endif
}
```

```cpp
#include <hip/hip_runtime.h>
#include <hip/hip_cooperative_groups.h>
#include <cstdio>
namespace cg = cooperative_groups;

#ifndef ONE_LAUNCH
#define ONE_LAUNCH 1
#endif

#define LAS __attribute__((address_space(3)))
typedef unsigned short bf16_t;
typedef short bf16x8 __attribute__((ext_vector_type(8)));
typedef short bf16x4 __attribute__((ext_vector_type(4)));
typedef float f32x4 __attribute__((ext_vector_type(4)));
typedef unsigned u32x4 __attribute__((ext_vector_type(4)));
typedef unsigned u32x2 __attribute__((ext_vector_type(2)));

constexpr int S = 16384, D = 1024, DIN = 2592, DINP = 2816, DFF = 2816, NL = 4, NCH = 256;
constexpr int NTHR = 512;
constexpr int LDS_BYTES = 147456;
constexpr float EPS = 1e-6f;

constexpr size_t WS_CTL = 0;
constexpr size_t WS_WIN = 65536;
constexpr size_t WS_WOUT = WS_WIN + (size_t)DINP * D * 2;
constexpr size_t WS_WGU = WS_WOUT + (size_t)D * D * 2;
constexpr size_t WS_WD = WS_WGU + (size_t)2 * DFF * D * 2;
constexpr size_t WS_LRUW = WS_WD + (size_t)D * DFF * 2;
constexpr size_t WS_H = WS_LRUW + (size_t)2 * 2 * 8 * 64 * 64 * 2;
constexpr size_t WS_PROJ = WS_H + (size_t)S * D * 2;
constexpr size_t WS_M = WS_PROJ + (size_t)S * DINP * 2;
constexpr size_t WS_AP = WS_M + (size_t)S * D * 4;
constexpr size_t WS_HE = WS_AP + (size_t)2 * NCH * 512 * 4;
constexpr size_t WS_CA = WS_HE + (size_t)2 * NCH * 512 * 4;
constexpr size_t WS_DEC = WS_CA + (size_t)2 * NCH * 512 * 4;
constexpr size_t WS_END = WS_DEC + (size_t)2 * NCH * 4 * 64 * 4;

struct Params { const float* in[21]; float* out; unsigned char* ws; int ph_lo, ph_hi; };

__device__ __forceinline__ float bf2f(bf16_t b) { return __uint_as_float(((unsigned)b) << 16); }
__device__ __forceinline__ bf16_t f2bf(float f) { unsigned u = __float_as_uint(f); return (bf16_t)((u + 0x7fffu + ((u >> 16) & 1u)) >> 16); }
__device__ __forceinline__ unsigned pk2(float lo, float hi) { return (unsigned)f2bf(lo) | ((unsigned)f2bf(hi) << 16); }
__device__ __forceinline__ float sigmoidf_(float x) { return 1.0f / (1.0f + __expf(-x)); }
__device__ __forceinline__ float siluf_(float x) { return x * sigmoidf_(x); }
__device__ __forceinline__ float geluf_(float x) { const float y = 0.7978845608028654f * (x + 0.044715f * x * x * x); const float t = 1.0f - 2.0f / (__expf(2.0f * y) + 1.0f); return 0.5f * x * (1.0f + t); }
__device__ __forceinline__ f32x4 mfma16(bf16x8 a, bf16x8 b, f32x4 c) { return __builtin_amdgcn_mfma_f32_16x16x32_bf16(a, b, c, 0, 0, 0); }
__device__ __forceinline__ int otid() { int t = threadIdx.x; asm volatile("" : "+v"(t)); return t; }
__device__ __forceinline__ int obid() { int t = blockIdx.x; asm volatile("" : "+s"(t)); return t; }
#define LDS_FENCE() asm volatile("s_waitcnt lgkmcnt(0)" ::: "memory")

__device__ __forceinline__ void wtile(const float* __restrict__ src, int ldsrc, int c0, int nvalid, int k0, bf16_t* __restrict__ dst, int lddst, int r0, LAS float* T) {
    const int tid = otid();
    { const int k = tid >> 3, cg8 = (tid & 7) * 8;
      const float* sp = src + (size_t)(k0 + k) * ldsrc + c0 + cg8;
#pragma unroll
      for (int i = 0; i < 2; ++i) { f32x4 v = (f32x4){0.f, 0.f, 0.f, 0.f}; if (cg8 + 4 * i + 3 < nvalid) v = *(const f32x4*)(sp + 4 * i);
          T[k * 65 + cg8 + 4 * i + 0] = v[0]; T[k * 65 + cg8 + 4 * i + 1] = v[1]; T[k * 65 + cg8 + 4 * i + 2] = v[2]; T[k * 65 + cg8 + 4 * i + 3] = v[3]; } }
    __syncthreads();
    { const int r = tid >> 3, kg = (tid & 7) * 8; u32x4 w;
      w.x = pk2(T[(kg + 0) * 65 + r], T[(kg + 1) * 65 + r]); w.y = pk2(T[(kg + 2) * 65 + r], T[(kg + 3) * 65 + r]);
      w.z = pk2(T[(kg + 4) * 65 + r], T[(kg + 5) * 65 + r]); w.w = pk2(T[(kg + 6) * 65 + r], T[(kg + 7) * 65 + r]);
      *(u32x4*)(dst + (size_t)(r0 + r) * lddst + k0 + kg) = w; }
    __syncthreads();
}

__device__ void phase_weights(const Params& p, int l, LAS unsigned char* lds) {
    LAS float* T = (LAS float*)lds;
    unsigned char* ws = p.ws;
    bf16_t* WinT = (bf16_t*)(ws + WS_WIN); bf16_t* WoutT = (bf16_t*)(ws + WS_WOUT); bf16_t* WguT = (bf16_t*)(ws + WS_WGU); bf16_t* WdT = (bf16_t*)(ws + WS_WD); bf16_t* LW = (bf16_t*)(ws + WS_LRUW);
    const float* w_in = p.in[3] + (size_t)l * D * DIN; const float* w_out = p.in[15] + (size_t)l * D * D;
    const float* w_g = p.in[18] + (size_t)l * D * DFF; const float* w_u = p.in[19] + (size_t)l * D * DFF; const float* w_d = p.in[20] + (size_t)l * DFF * D;
    constexpr int T_IN = 44 * 16, T_OUT = 16 * 16, T_GU = 88 * 16, T_D = 16 * 44, T_L = 32;
    constexpr int TOT = T_IN + T_OUT + T_GU + T_D + T_L;
    for (int u = obid(); u < TOT; u += gridDim.x) {
        int v = u;
        if (v < T_IN) { const int rt = v / 16, kt = v % 16; int nv = DIN - rt * 64; nv = nv > 64 ? 64 : (nv < 0 ? 0 : nv); wtile(w_in, DIN, nv > 0 ? rt * 64 : 0, nv, kt * 64, WinT, D, rt * 64, T); continue; }
        v -= T_IN;
        if (v < T_OUT) { const int rt = v / 16, kt = v % 16; wtile(w_out, D, rt * 64, 64, kt * 64, WoutT, D, rt * 64, T); continue; }
        v -= T_OUT;
        if (v < T_GU) { const int rt = v / 16, kt = v % 16; const int r0 = rt * 64, j = r0 / 256, within = r0 % 256; const float* src = within < 128 ? w_g : w_u; const int col = j * 128 + (within & 127);
            wtile(src, DFF, col, 64, kt * 64, WguT, D, r0, T); continue; }
        v -= T_GU;
        if (v < T_D) { const int rt = v / 44, kt = v % 44; wtile(w_d, D, rt * 64, 64, kt * 64, WdT, DFF, rt * 64, T); continue; }
        v -= T_D;
        { const int dir = v / 16, gate = (v / 8) % 2, h = v % 8; const float* src = (gate ? p.in[8] : p.in[6]) + ((size_t)(l * 2 + dir) * 8 + h) * 4096;
          wtile(src, 64, 0, 64, 0, LW + ((size_t)(dir * 2 + gate) * 8 + h) * 4096, 64, 0, T); }
    }
}

__device__ void phase_rowprep(const float* __restrict__ xsrc, const float* __restrict__ m, const float* __restrict__ gpost, float* __restrict__ xdst, const float* __restrict__ gpre, bf16_t* __restrict__ hdst) {
    const int tid = otid(); const int lane = tid & 63, wave = tid >> 6;
    for (int row = obid() * 8 + wave; row < S; row += gridDim.x * 8) {
        f32x4 xv[4];
#pragma unroll
        for (int i = 0; i < 4; ++i) xv[i] = *(const f32x4*)(xsrc + (size_t)row * D + i * 256 + lane * 4);
        if (m) {
            f32x4 mv[4]; float ss = 0.f;
#pragma unroll
            for (int i = 0; i < 4; ++i) { mv[i] = *(const f32x4*)(m + (size_t)row * D + i * 256 + lane * 4); ss += mv[i][0] * mv[i][0] + mv[i][1] * mv[i][1] + mv[i][2] * mv[i][2] + mv[i][3] * mv[i][3]; }
#pragma unroll
            for (int o = 32; o >= 1; o >>= 1) ss += __shfl_xor(ss, o);
            const float rs = rsqrtf(ss * (1.0f / D) + EPS);
#pragma unroll
            for (int i = 0; i < 4; ++i) { const f32x4 g = *(const f32x4*)(gpost + i * 256 + lane * 4); xv[i] += mv[i] * rs * g; }
        }
        if (xdst) {
#pragma unroll
            for (int i = 0; i < 4; ++i) *(f32x4*)(xdst + (size_t)row * D + i * 256 + lane * 4) = xv[i];
        }
        if (hdst) {
            float ss = 0.f;
#pragma unroll
            for (int i = 0; i < 4; ++i) ss += xv[i][0] * xv[i][0] + xv[i][1] * xv[i][1] + xv[i][2] * xv[i][2] + xv[i][3] * xv[i][3];
#pragma unroll
            for (int o = 32; o >= 1; o >>= 1) ss += __shfl_xor(ss, o);
            const float rs = rsqrtf(ss * (1.0f / D) + EPS);
#pragma unroll
            for (int i = 0; i < 4; ++i) { const f32x4 g = *(const f32x4*)(gpre + i * 256 + lane * 4); const f32x4 hv = xv[i] * rs * g; u32x2 w; w.x = pk2(hv[0], hv[1]); w.y = pk2(hv[2], hv[3]);
                *(u32x2*)(hdst + (size_t)row * D + i * 256 + lane * 4) = w; }
        }
    }
}

template <int EPI> __device__ void gemm_simple(const bf16_t* __restrict__ A, int lda, const bf16_t* __restrict__ Bt, int K, int M, int N, void* __restrict__ Cv, int ldc) {
    const int tid = otid(), lane = tid & 63, wave = tid >> 6, wr = wave >> 2, wc = wave & 3, c = lane & 15, q = lane >> 4;
    const int nM = M / 128, nN = N / 256;
    for (int u = obid(); u < nM * nN; u += gridDim.x) {
        const int pn = u / nM, pm = u % nM; const int m0 = pm * 128 + wr * 64;
        f32x4 acc[4][4];
#pragma unroll
        for (int i = 0; i < 4; ++i)
#pragma unroll
            for (int j = 0; j < 4; ++j) acc[i][j] = (f32x4){0.f, 0.f, 0.f, 0.f};
        const bf16_t* ap = A + (size_t)(m0 + c) * lda + 8 * q;
        const bf16_t* bp = Bt + (size_t)(pn * 256 + wc * 32 + c) * K + 8 * q;
        for (int k0 = 0; k0 < K; k0 += 32) {
            bf16x8 af[4], bfr[4];
#pragma unroll
            for (int mi = 0; mi < 4; ++mi) af[mi] = *(const bf16x8*)(ap + (size_t)(16 * mi) * lda + k0);
#pragma unroll
            for (int nf = 0; nf < 4; ++nf) bfr[nf] = *(const bf16x8*)(bp + (size_t)((nf >> 1) * 128 + (nf & 1) * 16) * K + k0);
#pragma unroll
            for (int mi = 0; mi < 4; ++mi)
#pragma unroll
                for (int nf = 0; nf < 4; ++nf) acc[mi][nf] = mfma16(bfr[nf], af[mi], acc[mi][nf]);
        }
#pragma unroll
        for (int mi = 0; mi < 4; ++mi) { const int row = m0 + 16 * mi + c;
            if (EPI == 2) {
#pragma unroll
                for (int nf = 0; nf < 2; ++nf) { const f32x4 g = acc[mi][nf], uu = acc[mi][nf + 2]; const int col = pn * 128 + wc * 32 + nf * 16 + 4 * q;
                    u32x2 w; w.x = pk2(siluf_(g[0]) * uu[0], siluf_(g[1]) * uu[1]); w.y = pk2(siluf_(g[2]) * uu[2], siluf_(g[3]) * uu[3]);
                    *(u32x2*)((bf16_t*)Cv + (size_t)row * ldc + col) = w; }
            } else {
#pragma unroll
                for (int nf = 0; nf < 4; ++nf) { const int col = pn * 256 + (nf >> 1) * 128 + wc * 32 + (nf & 1) * 16 + 4 * q; const f32x4 v = acc[mi][nf];
                    if (EPI == 0) { u32x2 w; w.x = pk2(v[0], v[1]); w.y = pk2(v[2], v[3]); *(u32x2*)((bf16_t*)Cv + (size_t)row * ldc + col) = w; }
                    else *(f32x4*)((float*)Cv + (size_t)row * ldc + col) = v; }
            }
        }
    }
}

template <int MODE> __device__ void mixer_lru(const Params& p, int l, int n, LAS unsigned char* lds) {
    const int tid = otid(), lane = tid & 63, wave = tid >> 6, c = lane & 15, q = lane >> 4;
    unsigned char* ws = p.ws;
    const bf16_t* proj = (const bf16_t*)(ws + WS_PROJ); bf16_t* y = (bf16_t*)(ws + WS_H);
    const bf16_t* LW = (const bf16_t*)(ws + WS_LRUW);
    float* Aprod = (float*)(ws + WS_AP); float* Hend = (float*)(ws + WS_HE); const float* carry = (const float*)(ws + WS_CA);
    LAS bf16_t* XC = (LAS bf16_t*)lds;
    LAS float* STA = (LAS float*)(lds + 66560 + wave * 8704);
    LAS float* STU = STA + 16 * 68;
    const int t0 = n * 64;
    {
        const int ch = tid;
        const float cw0 = p.in[4][(size_t)(l * 4 + 0) * 512 + ch], cw1 = p.in[4][(size_t)(l * 4 + 1) * 512 + ch], cw2 = p.in[4][(size_t)(l * 4 + 2) * 512 + ch], cw3 = p.in[4][(size_t)(l * 4 + 3) * 512 + ch];
        const float cb = p.in[5][(size_t)l * 512 + ch];
#define LDX(s) (((s) >= 0 && (s) < S) ? bf2f(proj[(size_t)(s) * DINP + ch]) : 0.f)
        float xm2 = LDX(t0 - 2), xm1 = LDX(t0 - 1), x0 = LDX(t0);
#pragma unroll 8
        for (int t = 0; t < 64; ++t) { const float x1 = LDX(t0 + t + 1); const float xc = cb + cw0 * xm2 + cw1 * xm1 + cw2 * x0 + cw3 * x1; XC[t * 520 + ch] = f2bf(xc); xm2 = xm1; xm1 = x0; x0 = x1; }
#undef LDX
    }
    __syncthreads();
    {
        const int h = wave, j = lane;
#pragma unroll 1
        for (int dir = 0; dir < 2; ++dir) {
            const float* lam = p.in[10] + (size_t)(l * 2 + dir) * 512 + 64 * h; const float* b_a = p.in[7] + (size_t)(l * 2 + dir) * 512 + 64 * h; const float* b_x = p.in[9] + (size_t)(l * 2 + dir) * 512 + 64 * h;
            const bf16_t* LWa = LW + ((size_t)(dir * 2 + 0) * 8 + h) * 4096 + c * 64 + 8 * q; const bf16_t* LWx = LW + ((size_t)(dir * 2 + 1) * 8 + h) * 4096 + c * 64 + 8 * q;
            float hcar = 0.f, P = 1.f;
            if (MODE == 1) hcar = carry[(size_t)(dir * NCH + n) * 512 + 64 * h + j];
#pragma unroll 1
            for (int g = 0; g < 4; ++g) {
                const int mi = dir == 0 ? g : 3 - g;
                bf16x8 xf[2];
#pragma unroll
                for (int ks = 0; ks < 2; ++ks) xf[ks] = *(const LAS bf16x8*)(XC + (16 * mi + c) * 520 + 64 * h + 32 * ks + 8 * q);
#pragma unroll 1
                for (int nf = 0; nf < 4; ++nf) {
                    f32x4 za = (f32x4){0.f, 0.f, 0.f, 0.f}, zx = za;
                    za = mfma16(*(const bf16x8*)(LWa + nf * 1024), xf[0], za); za = mfma16(*(const bf16x8*)(LWa + nf * 1024 + 32), xf[1], za);
                    zx = mfma16(*(const bf16x8*)(LWx + nf * 1024), xf[0], zx); zx = mfma16(*(const bf16x8*)(LWx + nf * 1024 + 32), xf[1], zx);
                    const int jo = 16 * nf + 4 * q;
                    const f32x4 ba4 = *(const f32x4*)(b_a + jo), bx4 = *(const f32x4*)(b_x + jo), lam4 = *(const f32x4*)(lam + jo);
                    const bf16x4 xc4 = *(const LAS bf16x4*)(XC + (16 * mi + c) * 520 + 64 * h + jo);
                    f32x4 av, uv;
#pragma unroll
                    for (int r = 0; r < 4; ++r) {
                        const float ra = sigmoidf_(za[r] + ba4[r]), ix = sigmoidf_(zx[r] + bx4[r]);
                        const float sp = log1pf(__expf(-lam4[r]));
                        const float la = -8.0f * ra * sp;
                        av[r] = __expf(la);
                        uv[r] = bf2f((bf16_t)xc4[r]) * ix * sqrtf(fmaxf(-expm1f(2.0f * la), 0.f));
                    }
                    *(LAS f32x4*)(STA + c * 68 + jo) = av; *(LAS f32x4*)(STU + c * 68 + jo) = uv;
                }
                LDS_FENCE();
#pragma unroll 1
                for (int s = 0; s < 16; ++s) {
                    const int tl = dir == 0 ? s : 15 - s;
                    const float a = STA[tl * 68 + j], u = STU[tl * 68 + j];
                    hcar = a * hcar + u; P *= a;
                    if (MODE == 1) {
                        const int t = 16 * mi + tl; const size_t yi = (size_t)(t0 + t) * D + 64 * h + j;
                        if (dir == 0) y[yi] = f2bf(hcar);
                        else { const float hf = bf2f(y[yi]); const float gt = bf2f(proj[(size_t)(t0 + t) * DINP + 512 + 64 * h + j]); XC[t * 520 + 64 * h + j] = f2bf((hf + hcar) * geluf_(gt)); }
                    }
                }
                LDS_FENCE();
            }
            if (MODE == 0) { Aprod[(size_t)(dir * NCH + n) * 512 + 64 * h + j] = P; Hend[(size_t)(dir * NCH + n) * 512 + 64 * h + j] = hcar; }
        }
    }
    __syncthreads();
    if (MODE == 1) {
        const int t = tid >> 3, seg = tid & 7;
        float ss = 0.f;
#pragma unroll
        for (int i = 0; i < 8; ++i) { const bf16x8 b = *(const LAS bf16x8*)(XC + t * 520 + 64 * seg + 8 * i);
#pragma unroll
            for (int k = 0; k < 8; ++k) { const float f = bf2f((bf16_t)b[k]); ss += f * f; } }
        ss += __shfl_xor(ss, 1); ss += __shfl_xor(ss, 2); ss += __shfl_xor(ss, 4);
        const float rs = rsqrtf(ss * (1.0f / 512.0f) + EPS);
        const float* gn = p.in[11] + (size_t)l * 512 + 64 * seg;
#pragma unroll 2
        for (int i = 0; i < 8; ++i) { const bf16x8 b = *(const LAS bf16x8*)(XC + t * 520 + 64 * seg + 8 * i); const f32x4 g0 = *(const f32x4*)(gn + 8 * i), g1 = *(const f32x4*)(gn + 8 * i + 4); u32x4 w;
            w.x = pk2(bf2f((bf16_t)b[0]) * rs * g0[0], bf2f((bf16_t)b[1]) * rs * g0[1]); w.y = pk2(bf2f((bf16_t)b[2]) * rs * g0[2], bf2f((bf16_t)b[3]) * rs * g0[3]);
            w.z = pk2(bf2f((bf16_t)b[4]) * rs * g1[0], bf2f((bf16_t)b[5]) * rs * g1[1]); w.w = pk2(bf2f((bf16_t)b[6]) * rs * g1[2], bf2f((bf16_t)b[7]) * rs * g1[3]);
            *(u32x4*)(y + (size_t)(t0 + t) * D + 64 * seg + 8 * i) = w; }
        __syncthreads();
    }
}

template <int MODE> __device__ void mixer_gla(const Params& p, int l, int n, LAS unsigned char* lds) {
    const int tid = otid(), lane = tid & 63, wave = tid >> 6, c = lane & 15, q = lane >> 4;
    unsigned char* ws = p.ws;
    const bf16_t* proj = (const bf16_t*)(ws + WS_PROJ); bf16_t* y = (bf16_t*)(ws + WS_H);
    bf16_t* uT = (bf16_t*)(ws + WS_M); const bf16_t* spT = (const bf16_t*)(ws + WS_M + (size_t)S * D * 2); float* dec = (float*)(ws + WS_DEC);
    LAS float* LA0 = (LAS float*)lds;
    LAS bf16_t* QE0 = (LAS bf16_t*)(lds + 32768);
    LAS bf16_t* VT = (LAS bf16_t*)(lds + 69632);
    LAS bf16_t* P0 = (LAS bf16_t*)(lds + 88064);
    LAS float* SSQ = (LAS float*)(lds + 106496);
    const int t0 = n * 64;
#pragma unroll 1
    for (int h = 0; h < 4; ++h) {
        {
            const int de = tid & 127, dir = de >> 6, e = de & 63, tg = tid >> 7;
            const float* Wg = p.in[12] + (size_t)(l * 2 + dir) * 16 * 256 + 64 * h + e; const float bg = p.in[13][(size_t)(l * 2 + dir) * 256 + 64 * h + e];
            float w[16];
#pragma unroll
            for (int r = 0; r < 16; ++r) w[r] = Wg[(size_t)r * 256];
            LAS float* LA = LA0 + dir * 4096;
#pragma unroll 1
            for (int tt = 0; tt < 16; ++tt) { const int t = tg * 16 + tt;
                const bf16x8 l0 = *(const bf16x8*)(proj + (size_t)(t0 + t) * DINP + 2560 + dir * 16), l1 = *(const bf16x8*)(proj + (size_t)(t0 + t) * DINP + 2560 + dir * 16 + 8);
                float z = bg;
#pragma unroll
                for (int r = 0; r < 8; ++r) { z += bf2f((bf16_t)l0[r]) * w[r]; z += bf2f((bf16_t)l1[r]) * w[8 + r]; }
                LA[t * 64 + e] = (fminf(z, 0.f) - log1pf(__expf(-fabsf(z)))) * (1.0f / 16.0f); }
            const int vv = tid & 127, tq = tid >> 7;
            unsigned wv[8];
#pragma unroll
            for (int i = 0; i < 8; ++i) { const unsigned lo = proj[(size_t)(t0 + 16 * tq + 2 * i) * DINP + 1536 + 128 * h + vv], hi = proj[(size_t)(t0 + 16 * tq + 2 * i + 1) * DINP + 1536 + 128 * h + vv]; wv[i] = lo | (hi << 16); }
            *(LAS u32x4*)(VT + vv * 72 + 16 * tq) = (u32x4){wv[0], wv[1], wv[2], wv[3]}; *(LAS u32x4*)(VT + vv * 72 + 16 * tq + 8) = (u32x4){wv[4], wv[5], wv[6], wv[7]};
        }
        __syncthreads();
        if (tid < 128) {
            const int dir = tid >> 6, d = tid & 63; LAS float* LA = LA0 + dir * 4096; float acc = 0.f;
            if (MODE == 1) {
                if (dir == 0) {
#pragma unroll 8
                    for (int t = 0; t < 64; ++t) { acc += LA[t * 64 + d]; LA[t * 64 + d] = acc; } }
                else {
#pragma unroll 8
                    for (int t = 63; t >= 0; --t) { acc += LA[t * 64 + d]; LA[t * 64 + d] = acc; } }
            } else {
                if (dir == 0) {
#pragma unroll 8
                    for (int t = 63; t >= 0; --t) { const float v = LA[t * 64 + d]; LA[t * 64 + d] = acc; acc += v; } }
                else {
#pragma unroll 8
                    for (int t = 0; t < 64; ++t) { const float v = LA[t * 64 + d]; LA[t * 64 + d] = acc; acc += v; } }
                dec[((size_t)(dir * NCH + n) * 4 + h) * 64 + d] = __expf(acc);
            }
        }
        __syncthreads();
        if (MODE == 1) {
            { const int t = tid >> 3, dg = (tid & 7) * 8;
              const bf16x8 qv = *(const bf16x8*)(proj + (size_t)(t0 + t) * DINP + 1024 + 64 * h + dg), kv = *(const bf16x8*)(proj + (size_t)(t0 + t) * DINP + 1280 + 64 * h + dg);
#pragma unroll
              for (int dir = 0; dir < 2; ++dir) { float qe[8], ke[8];
#pragma unroll
                  for (int k = 0; k < 8; ++k) { const float b = LA0[dir * 4096 + t * 64 + dg + k]; qe[k] = bf2f((bf16_t)qv[k]) * 0.125f * __expf(b); ke[k] = bf2f((bf16_t)kv[k]) * __expf(-b); }
                  *(LAS u32x4*)(QE0 + dir * 9216 + t * 72 + dg) = (u32x4){pk2(qe[0], qe[1]), pk2(qe[2], qe[3]), pk2(qe[4], qe[5]), pk2(qe[6], qe[7])};
                  *(LAS u32x4*)(QE0 + dir * 9216 + 4608 + t * 72 + dg) = (u32x4){pk2(ke[0], ke[1]), pk2(ke[2], ke[3]), pk2(ke[4], ke[5]), pk2(ke[6], ke[7])}; } }
            __syncthreads();
            { const int dir = wave >> 2, ti = wave & 3; LAS bf16_t* QE = QE0 + dir * 9216; LAS bf16_t* KE = QE + 4608; LAS bf16_t* P = P0 + dir * 4608;
              bf16x8 qf[2];
#pragma unroll
              for (int ks = 0; ks < 2; ++ks) qf[ks] = *(const LAS bf16x8*)(QE + (16 * ti + c) * 72 + 32 * ks + 8 * q);
#pragma unroll
              for (int tj = 0; tj < 4; ++tj) { f32x4 sc = (f32x4){0.f, 0.f, 0.f, 0.f};
#pragma unroll
                  for (int ks = 0; ks < 2; ++ks) { const bf16x8 kf = *(const LAS bf16x8*)(KE + (16 * tj + c) * 72 + 32 * ks + 8 * q); sc = mfma16(kf, qf[ks], sc); }
                  const int i = 16 * ti + c, j0 = 16 * tj + 4 * q; float m[4];
#pragma unroll
                  for (int r = 0; r < 4; ++r) { const int j = j0 + r; const bool keep = dir == 0 ? (j <= i) : (j >= i); m[r] = keep ? sc[r] : 0.f; }
                  *(LAS u32x2*)(P + i * 72 + j0) = (u32x2){pk2(m[0], m[1]), pk2(m[2], m[3])}; } }
            __syncthreads();
            { const int ti = wave & 3, vb = (wave >> 2) * 4;
              f32x4 acc[4];
#pragma unroll
              for (int i = 0; i < 4; ++i) acc[i] = (f32x4){0.f, 0.f, 0.f, 0.f};
#pragma unroll
              for (int dir = 0; dir < 2; ++dir) {
                  LAS bf16_t* QE = QE0 + dir * 9216; LAS bf16_t* P = P0 + dir * 4608;
                  const bf16_t* SP = spT + ((size_t)(dir * NCH + n) * 4 + h) * 8192;
#pragma unroll
                  for (int ks = 0; ks < 2; ++ks) {
                      const bf16x8 pf = *(const LAS bf16x8*)(P + (16 * ti + c) * 72 + 32 * ks + 8 * q), qf = *(const LAS bf16x8*)(QE + (16 * ti + c) * 72 + 32 * ks + 8 * q);
#pragma unroll
                      for (int vl = 0; vl < 4; ++vl) { const int vf = vb + vl;
                          const bf16x8 vtf = *(const LAS bf16x8*)(VT + (16 * vf + c) * 72 + 32 * ks + 8 * q); acc[vl] = mfma16(vtf, pf, acc[vl]);
                          const bf16x8 sf = *(const bf16x8*)(SP + (16 * vf + c) * 64 + 32 * ks + 8 * q); acc[vl] = mfma16(sf, qf, acc[vl]); }
                  }
              }
              float ss = 0.f;
#pragma unroll
              for (int vl = 0; vl < 4; ++vl) ss += acc[vl][0] * acc[vl][0] + acc[vl][1] * acc[vl][1] + acc[vl][2] * acc[vl][2] + acc[vl][3] * acc[vl][3];
              ss += __shfl_xor(ss, 16); ss += __shfl_xor(ss, 32);
              const int t = 16 * ti + c;
              if (q == 0) SSQ[t * 2 + (wave >> 2)] = ss;
              __syncthreads();
              const float rs = rsqrtf((SSQ[t * 2] + SSQ[t * 2 + 1]) * (1.0f / 128.0f) + EPS);
              const float* gn = p.in[14] + (size_t)l * 128;
#pragma unroll
              for (int vl = 0; vl < 4; ++vl) { const int v = 16 * (vb + vl) + 4 * q; const f32x4 g4 = *(const f32x4*)(gn + v);
                  const bf16x4 gg = *(const bf16x4*)(proj + (size_t)(t0 + t) * DINP + 2048 + 128 * h + v); float o[4];
#pragma unroll
                  for (int r = 0; r < 4; ++r) o[r] = acc[vl][r] * rs * g4[r] * siluf_(bf2f((bf16_t)gg[r]));
                  *(u32x2*)(y + (size_t)(t0 + t) * D + 512 + 128 * h + v) = (u32x2){pk2(o[0], o[1]), pk2(o[2], o[3])}; }
            }
            __syncthreads();
        } else {
            { const int d = tid & 63, tg = tid >> 6; float kk[8];
#pragma unroll
              for (int i = 0; i < 8; ++i) kk[i] = bf2f(proj[(size_t)(t0 + 8 * tg + i) * DINP + 1280 + 64 * h + d]);
#pragma unroll
              for (int dir = 0; dir < 2; ++dir) { float kd[8];
#pragma unroll
                  for (int i = 0; i < 8; ++i) kd[i] = kk[i] * __expf(LA0[dir * 4096 + (8 * tg + i) * 64 + d]);
                  *(LAS u32x4*)(QE0 + dir * 9216 + d * 72 + 8 * tg) = (u32x4){pk2(kd[0], kd[1]), pk2(kd[2], kd[3]), pk2(kd[4], kd[5]), pk2(kd[6], kd[7])}; } }
            __syncthreads();
            { const int dir = wave >> 2, df = wave & 3; LAS bf16_t* KDT = QE0 + dir * 9216;
              bf16x8 kf[2];
#pragma unroll
              for (int ks = 0; ks < 2; ++ks) kf[ks] = *(const LAS bf16x8*)(KDT + (16 * df + c) * 72 + 32 * ks + 8 * q);
              bf16_t* U = uT + ((size_t)(dir * NCH + n) * 4 + h) * 8192;
#pragma unroll
              for (int vf = 0; vf < 8; ++vf) { f32x4 a = (f32x4){0.f, 0.f, 0.f, 0.f};
#pragma unroll
                  for (int ks = 0; ks < 2; ++ks) { const bf16x8 vtf = *(const LAS bf16x8*)(VT + (16 * vf + c) * 72 + 32 * ks + 8 * q); a = mfma16(kf[ks], vtf, a); }
                  *(u32x2*)(U + (16 * vf + c) * 64 + 16 * df + 4 * q) = (u32x2){pk2(a[0], a[1]), pk2(a[2], a[3])}; } }
            __syncthreads();
        }
    }
}

__device__ void phase_scan(const Params& p) {
    unsigned char* ws = p.ws; const int tid = otid();
    if (tid < 256) {
        const bf16_t* uT = (const bf16_t*)(ws + WS_M); bf16_t* spT = (bf16_t*)(ws + WS_M + (size_t)S * D * 2); const float* dec = (const float*)(ws + WS_DEC);
        for (int gid = obid() * 256 + tid; gid < 65536; gid += gridDim.x * 256) {
            const int dir = gid >> 15, rem = gid & 32767, h = rem >> 13, vd = rem & 8191, d = vd & 63;
            float s = 0.f;
#pragma unroll 8
            for (int st = 0; st < NCH; ++st) { const int n = dir ? (NCH - 1 - st) : st; const size_t idx = ((size_t)(dir * NCH + n) * 4 + h) * 8192 + vd;
                const float u = bf2f(uT[idx]); const float dc = dec[((size_t)(dir * NCH + n) * 4 + h) * 64 + d]; spT[idx] = f2bf(s); s = dc * s + u; }
        }
    } else if (tid < 384 && obid() < 8) {
        const float* Aprod = (const float*)(ws + WS_AP); const float* Hend = (const float*)(ws + WS_HE); float* carry = (float*)(ws + WS_CA);
        const int gid = obid() * 128 + (tid - 256); const int dir = gid >> 9, ch = gid & 511;
        float hc = 0.f;
#pragma unroll 8
        for (int st = 0; st < NCH; ++st) { const int n = dir ? (NCH - 1 - st) : st; const size_t idx = (size_t)(dir * NCH + n) * 512 + ch;
            const float a = Aprod[idx], he = Hend[idx]; carry[idx] = hc; hc = a * hc + he; }
    }
}

__global__ void __launch_bounds__(NTHR, 2) mk_fwd(Params p) {
    extern __shared__ __attribute__((aligned(16))) unsigned char lds_raw[];
    LAS unsigned char* lds = (LAS unsigned char*)lds_raw;
    unsigned char* ws = p.ws;
    bf16_t* WinT = (bf16_t*)(ws + WS_WIN); bf16_t* WoutT = (bf16_t*)(ws + WS_WOUT); bf16_t* WguT = (bf16_t*)(ws + WS_WGU); bf16_t* WdT = (bf16_t*)(ws + WS_WD);
    bf16_t* Hb = (bf16_t*)(ws + WS_H); bf16_t* PROJ = (bf16_t*)(ws + WS_PROJ); float* Mb = (float*)(ws + WS_M);
    const float* xin = p.in[0]; float* out = p.out;
    for (int ph = p.ph_lo; ph < p.ph_hi; ++ph) {
        if (ph > p.ph_lo) cg::this_grid().sync();
        if (ph == 9 * NL) { phase_rowprep(out, Mb, p.in[17] + (size_t)(NL - 1) * D, out, nullptr, nullptr); continue; }
        const int l = ph / 9, s = ph % 9;
        switch (s) {
#ifndef PHMASK
#define PHMASK 0x1ff
#endif
        case 0: if (!(PHMASK & 1)) break; phase_weights(p, l, lds);
                if (l == 0) phase_rowprep(xin, nullptr, nullptr, nullptr, p.in[1], Hb);
                else phase_rowprep(out, Mb, p.in[17] + (size_t)(l - 1) * D, out, p.in[1] + (size_t)l * D, Hb);
                break;
        case 1: if (!(PHMASK & 2)) break; gemm_simple<0>(Hb, D, WinT, D, S, DINP, PROJ, DINP); break;
        case 2: if (!(PHMASK & 4)) break; for (int n = obid(); n < NCH; n += gridDim.x) mixer_lru<0>(p, l, n, lds);
                for (int n = obid(); n < NCH; n += gridDim.x) mixer_gla<0>(p, l, n, lds); break;
        case 3: if (!(PHMASK & 8)) break; phase_scan(p); break;
        case 4: if (!(PHMASK & 16)) break; for (int n = obid(); n < NCH; n += gridDim.x) mixer_lru<1>(p, l, n, lds);
                for (int n = obid(); n < NCH; n += gridDim.x) mixer_gla<1>(p, l, n, lds); break;
        case 5: if (!(PHMASK & 32)) break; gemm_simple<1>(Hb, D, WoutT, D, S, D, Mb, D); break;
        case 6: if (!(PHMASK & 64)) break; phase_rowprep(l == 0 ? xin : out, Mb, p.in[2] + (size_t)l * D, out, p.in[16] + (size_t)l * D, Hb); break;
        case 7: if (!(PHMASK & 128)) break; gemm_simple<2>(Hb, D, WguT, D, S, 2 * DFF, PROJ, DFF); break;
        case 8: if (!(PHMASK & 256)) break; gemm_simple<1>(PROJ, DFF, WdT, DFF, S, D, Mb, D); break;
        }
    }
}

extern "C" void kernel_launch(void* const* d_in, const int* in_sizes, int n_in, void* d_out, int out_size, void* d_ws, size_t ws_size, hipStream_t stream) {
    static int grid = 0;
    if (grid == 0) {
        if (n_in != 21 || out_size != S * D || ws_size < WS_END) { fprintf(stderr, "kernel_launch: unexpected shapes: n_in %d out %d ws %zu (need %zu)\n", n_in, out_size, ws_size, (size_t)WS_END); grid = -1; return; }
        int dev = 0, cus = 0, per_cu = 0;
        (void)hipGetDevice(&dev); (void)hipDeviceGetAttribute(&cus, hipDeviceAttributeMultiprocessorCount, dev);
        if (hipFuncSetAttribute((const void*)mk_fwd, hipFuncAttributeMaxDynamicSharedMemorySize, LDS_BYTES) != hipSuccess) { fprintf(stderr, "kernel_launch: hipFuncSetAttribute failed\n"); grid = -1; return; }
        if (hipOccupancyMaxActiveBlocksPerMultiprocessor(&per_cu, (const void*)mk_fwd, NTHR, LDS_BYTES) != hipSuccess || per_cu < 1) { fprintf(stderr, "kernel_launch: occupancy query says %d\n", per_cu); per_cu = 1; }
        (void)hipGetLastError();
        grid = cus;
    }
    if (grid < 0) return;
    Params p{};
    for (int i = 0; i < 21; ++i) p.in[i] = (const float*)d_in[i];
    p.out = (float*)d_out; p.ws = (unsigned char*)d_ws;
#if ONE_LAUNCH
    p.ph_lo = 0; p.ph_hi = 9 * NL + 1;
    void* args[] = {&p};
    hipError_t e = hipLaunchCooperativeKernel((const void*)mk_fwd, dim3(grid), dim3(NTHR), args, LDS_BYTES, stream);
    if (e != hipSuccess) fprintf(stderr, "cooperative launch failed: %s (grid %d)\n", hipGetErrorString(e), grid);
#else
    for (int ph = 0; ph < 9 * NL + 1; ++ph) { p.ph_lo = ph; p.ph_hi = ph + 1; hipLaunchKernelGGL(mk_fwd, dim3(grid), dim3(NTHR), LDS_BYTES, stream, p); }
#endif
}
```

```cpp
#include <hip/hip_runtime.h>
#include <hip/hip_cooperative_groups.h>
#include <cstdio>
namespace cg = cooperative_groups;

#ifndef ONE_LAUNCH
#define ONE_LAUNCH 1
#endif

#define LAS __attribute__((address_space(3)))
typedef unsigned short bf16_t;
typedef short bf16x8 __attribute__((ext_vector_type(8)));
typedef short bf16x4 __attribute__((ext_vector_type(4)));
typedef float f32x4 __attribute__((ext_vector_type(4)));
typedef unsigned u32x4 __attribute__((ext_vector_type(4)));
typedef unsigned u32x2 __attribute__((ext_vector_type(2)));

constexpr int S = 16384, D = 1024, DIN = 2592, DINP = 2816, DFF = 2816, NL = 4, NCH = 256;
constexpr int NTHR = 512;
constexpr int LDS_BYTES = 147456;
constexpr float EPS = 1e-6f;

constexpr size_t WS_CTL = 0;
constexpr size_t WS_WIN = 65536;
constexpr size_t WS_WOUT = WS_WIN + (size_t)DINP * D * 2;
constexpr size_t WS_WGU = WS_WOUT + (size_t)D * D * 2;
constexpr size_t WS_WD = WS_WGU + (size_t)2 * DFF * D * 2;
constexpr size_t WS_LRUW = WS_WD + (size_t)D * DFF * 2;
constexpr size_t WS_H = WS_LRUW + (size_t)2 * 2 * 8 * 64 * 64 * 2;
constexpr size_t WS_PROJ = WS_H + (size_t)S * D * 2;
constexpr size_t WS_M = WS_PROJ + (size_t)S * DINP * 2;
constexpr size_t WS_AP = WS_M + (size_t)S * D * 4;
constexpr size_t WS_HE = WS_AP + (size_t)2 * NCH * 512 * 4;
constexpr size_t WS_CA = WS_HE + (size_t)2 * NCH * 512 * 4;
constexpr size_t WS_DEC = WS_CA + (size_t)2 * NCH * 512 * 4;
constexpr size_t WS_END = WS_DEC + (size_t)2 * NCH * 4 * 64 * 4;

struct Params { const float* in[21]; float* out; unsigned char* ws; int ph_lo, ph_hi; };

__device__ __forceinline__ float bf2f(bf16_t b) { return __uint_as_float(((unsigned)b) << 16); }
__device__ __forceinline__ bf16_t f2bf(float f) { unsigned u = __float_as_uint(f); return (bf16_t)((u + 0x7fffu + ((u >> 16) & 1u)) >> 16); }
__device__ __forceinline__ unsigned pk2(float lo, float hi) { return (unsigned)f2bf(lo) | ((unsigned)f2bf(hi) << 16); }
__device__ __forceinline__ float sigmoidf_(float x) { return 1.0f / (1.0f + __expf(-x)); }
__device__ __forceinline__ float siluf_(float x) { return x * sigmoidf_(x); }
__device__ __forceinline__ float geluf_(float x) { const float y = 0.7978845608028654f * (x + 0.044715f * x * x * x); const float t = 1.0f - 2.0f / (__expf(2.0f * y) + 1.0f); return 0.5f * x * (1.0f + t); }
__device__ __forceinline__ f32x4 mfma16(bf16x8 a, bf16x8 b, f32x4 c) { return __builtin_amdgcn_mfma_f32_16x16x32_bf16(a, b, c, 0, 0, 0); }
__device__ __forceinline__ int otid() { int t = threadIdx.x; asm volatile("" : "+v"(t)); return t; }
__device__ __forceinline__ int obid() { int t = blockIdx.x; asm volatile("" : "+s"(t)); return t; }
#define LDS_FENCE() asm volatile("s_waitcnt lgkmcnt(0)" ::: "memory")

__device__ __forceinline__ void wtile(const float* __restrict__ src, int ldsrc, int c0, int nvalid, int k0, bf16_t* __restrict__ dst, int lddst, int r0, LAS float* T) {
    const int tid = otid();
    { const int k = tid >> 3, cg8 = (tid & 7) * 8;
      const float* sp = src + (size_t)(k0 + k) * ldsrc + c0 + cg8;
#pragma unroll
      for (int i = 0; i < 2; ++i) { f32x4 v = (f32x4){0.f, 0.f, 0.f, 0.f}; if (cg8 + 4 * i + 3 < nvalid) v = *(const f32x4*)(sp + 4 * i);
          T[k * 65 + cg8 + 4 * i + 0] = v[0]; T[k * 65 + cg8 + 4 * i + 1] = v[1]; T[k * 65 + cg8 + 4 * i + 2] = v[2]; T[k * 65 + cg8 + 4 * i + 3] = v[3]; } }
    __syncthreads();
    { const int r = tid >> 3, kg = (tid & 7) * 8; u32x4 w;
      w.x = pk2(T[(kg + 0) * 65 + r], T[(kg + 1) * 65 + r]); w.y = pk2(T[(kg + 2) * 65 + r], T[(kg + 3) * 65 + r]);
      w.z = pk2(T[(kg + 4) * 65 + r], T[(kg + 5) * 65 + r]); w.w = pk2(T[(kg + 6) * 65 + r], T[(kg + 7) * 65 + r]);
      *(u32x4*)(dst + (size_t)(r0 + r) * lddst + k0 + kg) = w; }
    __syncthreads();
}

__device__ void phase_weights(const Params& p, int l, LAS unsigned char* lds) {
    LAS float* T = (LAS float*)lds;
    unsigned char* ws = p.ws;
    bf16_t* WinT = (bf16_t*)(ws + WS_WIN); bf16_t* WoutT = (bf16_t*)(ws + WS_WOUT); bf16_t* WguT = (bf16_t*)(ws + WS_WGU); bf16_t* WdT = (bf16_t*)(ws + WS_WD); bf16_t* LW = (bf16_t*)(ws + WS_LRUW);
    const float* w_in = p.in[3] + (size_t)l * D * DIN; const float* w_out = p.in[15] + (size_t)l * D * D;
    const float* w_g = p.in[18] + (size_t)l * D * DFF; const float* w_u = p.in[19] + (size_t)l * D * DFF; const float* w_d = p.in[20] + (size_t)l * DFF * D;
    constexpr int T_IN = 44 * 16, T_OUT = 16 * 16, T_GU = 88 * 16, T_D = 16 * 44, T_L = 32;
    constexpr int TOT = T_IN + T_OUT + T_GU + T_D + T_L;
    for (int u = obid(); u < TOT; u += gridDim.x) {
        int v = u;
        if (v < T_IN) { const int rt = v / 16, kt = v % 16; int nv = DIN - rt * 64; nv = nv > 64 ? 64 : (nv < 0 ? 0 : nv); wtile(w_in, DIN, nv > 0 ? rt * 64 : 0, nv, kt * 64, WinT, D, rt * 64, T); continue; }
        v -= T_IN;
        if (v < T_OUT) { const int rt = v / 16, kt = v % 16; wtile(w_out, D, rt * 64, 64, kt * 64, WoutT, D, rt * 64, T); continue; }
        v -= T_OUT;
        if (v < T_GU) { const int rt = v / 16, kt = v % 16; const int r0 = rt * 64, j = r0 / 256, within = r0 % 256; const float* src = within < 128 ? w_g : w_u; const int col = j * 128 + (within & 127);
            wtile(src, DFF, col, 64, kt * 64, WguT, D, r0, T); continue; }
        v -= T_GU;
        if (v < T_D) { const int rt = v / 44, kt = v % 44; wtile(w_d, D, rt * 64, 64, kt * 64, WdT, DFF, rt * 64, T); continue; }
        v -= T_D;
        { const int dir = v / 16, gate = (v / 8) % 2, h = v % 8; const float* src = (gate ? p.in[8] : p.in[6]) + ((size_t)(l * 2 + dir) * 8 + h) * 4096;
          wtile(src, 64, 0, 64, 0, LW + ((size_t)(dir * 2 + gate) * 8 + h) * 4096, 64, 0, T); }
    }
}

__device__ void phase_rowprep(const float* __restrict__ xsrc, const float* __restrict__ m, const float* __restrict__ gpost, float* __restrict__ xdst, const float* __restrict__ gpre, bf16_t* __restrict__ hdst) {
    const int tid = otid(); const int lane = tid & 63, wave = tid >> 6;
    for (int row = obid() * 8 + wave; row < S; row += gridDim.x * 8) {
        f32x4 xv[4];
#pragma unroll
        for (int i = 0; i < 4; ++i) xv[i] = *(const f32x4*)(xsrc + (size_t)row * D + i * 256 + lane * 4);
        if (m) {
            f32x4 mv[4]; float ss = 0.f;
#pragma unroll
            for (int i = 0; i < 4; ++i) { mv[i] = *(const f32x4*)(m + (size_t)row * D + i * 256 + lane * 4); ss += mv[i][0] * mv[i][0] + mv[i][1] * mv[i][1] + mv[i][2] * mv[i][2] + mv[i][3] * mv[i][3]; }
#pragma unroll
            for (int o = 32; o >= 1; o >>= 1) ss += __shfl_xor(ss, o);
            const float rs = rsqrtf(ss * (1.0f / D) + EPS);
#pragma unroll
            for (int i = 0; i < 4; ++i) { const f32x4 g = *(const f32x4*)(gpost + i * 256 + lane * 4); xv[i] += mv[i] * rs * g; }
        }
        if (xdst) {
#pragma unroll
            for (int i = 0; i < 4; ++i) *(f32x4*)(xdst + (size_t)row * D + i * 256 + lane * 4) = xv[i];
        }
        if (hdst) {
            float ss = 0.f;
#pragma unroll
            for (int i = 0; i < 4; ++i) ss += xv[i][0] * xv[i][0] + xv[i][1] * xv[i][1] + xv[i][2] * xv[i][2] + xv[i][3] * xv[i][3];
#pragma unroll
            for (int o = 32; o >= 1; o >>= 1) ss += __shfl_xor(ss, o);
            const float rs = rsqrtf(ss * (1.0f / D) + EPS);
#pragma unroll
            for (int i = 0; i < 4; ++i) { const f32x4 g = *(const f32x4*)(gpre + i * 256 + lane * 4); const f32x4 hv = xv[i] * rs * g; u32x2 w; w.x = pk2(hv[0], hv[1]); w.y = pk2(hv[2], hv[3]);
                *(u32x2*)(hdst + (size_t)row * D + i * 256 + lane * 4) = w; }
        }
    }
}

template <int EPI> __device__ void gemm_simple(const bf16_t* __restrict__ A, int lda, const bf16_t* __restrict__ Bt, int K, int M, int N, void* __restrict__ Cv, int ldc) {
    const int tid = otid(), lane = tid & 63, wave = tid >> 6, wr = wave >> 2, wc = wave & 3, c = lane & 15, q = lane >> 4;
    const int nM = M / 128, nN = N / 256;
    for (int u = obid(); u < nM * nN; u += gridDim.x) {
        const int pn = u / nM, pm = u % nM; const int m0 = pm * 128 + wr * 64;
        f32x4 acc[4][4];
#pragma unroll
        for (int i = 0; i < 4; ++i)
#pragma unroll
            for (int j = 0; j < 4; ++j) acc[i][j] = (f32x4){0.f, 0.f, 0.f, 0.f};
        const bf16_t* ap = A + (size_t)(m0 + c) * lda + 8 * q;
        const bf16_t* bp = Bt + (size_t)(pn * 256 + wc * 32 + c) * K + 8 * q;
        for (int k0 = 0; k0 < K; k0 += 32) {
            bf16x8 af[4], bfr[4];
#pragma unroll
            for (int mi = 0; mi < 4; ++mi) af[mi] = *(const bf16x8*)(ap + (size_t)(16 * mi) * lda + k0);
#pragma unroll
            for (int nf = 0; nf < 4; ++nf) bfr[nf] = *(const bf16x8*)(bp + (size_t)((nf >> 1) * 128 + (nf & 1) * 16) * K + k0);
#pragma unroll
            for (int mi = 0; mi < 4; ++mi)
#pragma unroll
                for (int nf = 0; nf < 4; ++nf) acc[mi][nf] = mfma16(bfr[nf], af[mi], acc[mi][nf]);
        }
#pragma unroll
        for (int mi = 0; mi < 4; ++mi) { const int row = m0 + 16 * mi + c;
            if (EPI == 2) {
#pragma unroll
                for (int nf = 0; nf < 2; ++nf) { const f32x4 g = acc[mi][nf], uu = acc[mi][nf + 2]; const int col = pn * 128 + wc * 32 + nf * 16 + 4 * q;
                    u32x2 w; w.x = pk2(siluf_(g[0]) * uu[0], siluf_(g[1]) * uu[1]); w.y = pk2(siluf_(g[2]) * uu[2], siluf_(g[3]) * uu[3]);
                    *(u32x2*)((bf16_t*)Cv + (size_t)row * ldc + col) = w; }
            } else {
#pragma unroll
                for (int nf = 0; nf < 4; ++nf) { const int col = pn * 256 + (nf >> 1) * 128 + wc * 32 + (nf & 1) * 16 + 4 * q; const f32x4 v = acc[mi][nf];
                    if (EPI == 0) { u32x2 w; w.x = pk2(v[0], v[1]); w.y = pk2(v[2], v[3]); *(u32x2*)((bf16_t*)Cv + (size_t)row * ldc + col) = w; }
                    else *(f32x4*)((float*)Cv + (size_t)row * ldc + col) = v; }
            }
        }
    }
}

namespace pg8 {
#define PG8_LAS __attribute__((address_space(3)))
constexpr int BM = 256, BK = 64, HALF = 128, HTB = HALF * BK * 2  , STAGE_BYTES = 8 * HTB, NXCD = 8, WGM = 8;
__host__ __device__ __forceinline__ int lds_byte(int r, int c) { const int st = (r >> 4) * 2 + (c >> 5), rr = r & 15, cc = c & 31, ob = rr * 64 + cc * 2; return st * 1024 + (ob ^ (((ob >> 9) & 1) << 5)); }
__host__ __device__ __forceinline__ void stage_rc(int b, int& R, int& C) { const int st = b / 1024, sb = b % 1024, swz = sb ^ (((sb >> 9) & 1) << 5); R = (st >> 1) * 16 + swz / 64; C = (st & 1) * 32 + (swz % 64) / 2; }
__host__ __device__ __forceinline__ int perm32(int rho) { const int n = rho >> 4, i = rho & 15; return 8 * (i >> 2) + 4 * n + (i & 3); }
struct Unit { int pm, pn; };
struct Gemm { const bf16_t* A; const bf16_t* Bt; int M, N, K; };
struct StaticOrder {
    int nM, nN, nwg, G, c;
    __host__ __device__ void init(int M, int N, int G_, int c_) { nM = M / BM; nN = N / BM; nwg = nM * nN; G = G_; c = c_; }
    __host__ __device__ bool next(int i, Unit& u) const {
        const long L = (long)i * G + c; if (L >= nwg) return false;
        int wgid = (int)L; { const int q = nwg / NXCD, r = nwg % NXCD, xcd = wgid % NXCD, off = wgid / NXCD; wgid = (xcd < r ? xcd * (q + 1) : r * (q + 1) + (xcd - r) * q) + off; }
        const int nig = WGM * nN, gid = wgid / nig, fm = gid * WGM, gsz = (nM - fm) < WGM ? (nM - fm) : WGM;
        u.pm = fm + ((wgid % nig) % gsz); u.pn = (wgid % nig) / gsz; return true;
    }
    __device__ __forceinline__ void a_ready(const Unit&) const {}
    __device__ __forceinline__ void done(const Unit&) const {}
};
__device__ __forceinline__ unsigned cvt_pk_bf16(float lo, float hi) { unsigned r; asm volatile("v_cvt_pk_bf16_f32 %0, %1, %2" : "=v"(r) : "v"(lo), "v"(hi)); return r; }
template <class Epi, class Sched>
__device__ __forceinline__ void gemm_phase(PG8_LAS unsigned char* lds, const Gemm g, const Sched& S, const Epi& E) {
    const int tid = otid(), wid = __builtin_amdgcn_readfirstlane(tid >> 6), lane = tid & 63, wr = wid >> 2, wc = wid & 3, fr = lane & 15, fq = lane >> 4;
    const int K = g.K, nt = K / BK;
    unsigned voffA[2], voffB[2];
#pragma unroll
    for (int i = 0; i < 2; ++i) { int R, C; stage_rc(tid * 16 + i * 8192, R, C); const int Rb = Epi::PERM ? ((R & ~31) + perm32(R & 31)) : R;
        voffA[i] = (unsigned)(R * K + C) * 2u; voffB[i] = (unsigned)(Rb * K + C) * 2u; }
    const size_t kstep = (size_t)(BK * 2);
    const size_t hstep = (size_t)HALF * K * 2;
    const size_t tstep = 2 * hstep;
    const unsigned ldsw = (unsigned)wid * 1024u;
    const int aoff = lds_byte(wr * 64 + fr, fq * 8), boff = lds_byte(wc * 32 + fr, fq * 8);
#define PG8_SA(b, h) (((b) * 2 + (h)) * HTB)
#define PG8_SB(b, h) ((4 + (b) * 2 + (h)) * HTB)
#define PG8_STAGE(bufoff, gbase, voff) do { _Pragma("unroll") for (int _i = 0; _i < 2; ++_i) \
        __builtin_amdgcn_global_load_lds((const unsigned*)((const char*)(gbase) + (voff)[_i]), (PG8_LAS unsigned*)(lds + (bufoff) + ldsw + _i * 8192), 16, 0, 0); } while (0)
#define PG8_LDA(dst, b, h) do { _Pragma("unroll") for (int m = 0; m < 4; ++m) _Pragma("unroll") for (int k = 0; k < 2; ++k) dst[m][k] = *(const PG8_LAS bf16x8*)(lds + PG8_SA(b, h) + aoff + m * 2048 + k * 1024); } while (0)
#define PG8_LDB(dst, b, h) do { _Pragma("unroll") for (int n = 0; n < 2; ++n) _Pragma("unroll") for (int k = 0; k < 2; ++k) dst[n][k] = *(const PG8_LAS bf16x8*)(lds + PG8_SB(b, h) + boff + n * 2048 + k * 1024); } while (0)
#define PG8_MMA(ai, bj, At, Bt) do { __builtin_amdgcn_s_setprio(1); _Pragma("unroll") for (int m = 0; m < 4; ++m) _Pragma("unroll") for (int n = 0; n < 2; ++n) _Pragma("unroll") for (int k = 0; k < 2; ++k) \
        acc[ai][bj][m][n] = __builtin_amdgcn_mfma_f32_16x16x32_bf16(Bt[n][k], At[m][k], acc[ai][bj][m][n], 0, 0, 0); __builtin_amdgcn_s_setprio(0); } while (0)
#define PG8_WAIT_V(n) asm volatile("s_waitcnt vmcnt(" #n ")" ::: "memory")
#define PG8_WAIT_L(n) asm volatile("s_waitcnt lgkmcnt(" #n ")" ::: "memory")
#define PG8_BAR __builtin_amdgcn_s_barrier()
#define PG8_SCHED __builtin_amdgcn_sched_barrier(0)
    Unit cur, nxt; int ui = 0;
    if (!S.next(0, cur)) return;
    f32x4 acc[2][2][4][2];
#pragma unroll
    for (int a = 0; a < 2; ++a)
#pragma unroll
        for (int b = 0; b < 2; ++b)
#pragma unroll
            for (int m = 0; m < 4; ++m)
#pragma unroll
                for (int n = 0; n < 2; ++n) acc[a][b][m][n] = (f32x4){0.f, 0.f, 0.f, 0.f};
    bf16x8 At[4][2], B0[2][2], B1[2][2];
    const char* cA = (const char*)g.A + (size_t)cur.pm * tstep; const char* cB = (const char*)g.Bt + (size_t)cur.pn * tstep;
    S.a_ready(cur);
    PG8_STAGE(PG8_SB(0, 0), cB, voffB); PG8_STAGE(PG8_SA(0, 0), cA, voffA); PG8_STAGE(PG8_SB(0, 1), cB + hstep, voffB); PG8_STAGE(PG8_SA(0, 1), cA + hstep, voffA);
    if (wr == 1) PG8_BAR;
    PG8_WAIT_V(4); PG8_BAR;
    PG8_STAGE(PG8_SB(1, 0), cB + kstep, voffB); PG8_STAGE(PG8_SA(1, 0), cA + kstep, voffA); PG8_STAGE(PG8_SB(1, 1), cB + hstep + kstep, voffB);
    PG8_WAIT_V(6); PG8_BAR;
    for (;;) {
        const bool has_next = S.next(ui + 1, nxt);
        const char* nA = has_next ? (const char*)g.A + (size_t)nxt.pm * tstep : cA; const char* nB = has_next ? (const char*)g.Bt + (size_t)nxt.pn * tstep : cB;
        for (int t = 0; t < nt; t += 2) {
            const bool last = (t == nt - 2);
            const char* a1 = cA + (size_t)(t + 1) * kstep;
            const char* a2 = last ? nA : cA + (size_t)(t + 2) * kstep; const char* b2 = last ? nB : cB + (size_t)(t + 2) * kstep;
            const char* a3 = a2 + kstep; const char* b3 = b2 + kstep;
            if (last && has_next) S.a_ready(nxt);
            PG8_LDB(B0, 0, 0); PG8_SCHED; PG8_LDA(At, 0, 0); PG8_STAGE(PG8_SA(1, 1), a1 + hstep, voffA);
            PG8_WAIT_L(8); PG8_BAR; PG8_WAIT_L(0); PG8_MMA(0, 0, At, B0); PG8_BAR; PG8_SCHED;
            PG8_LDB(B1, 0, 1); PG8_STAGE(PG8_SB(0, 0), b2, voffB);
            PG8_BAR; PG8_WAIT_L(0); PG8_MMA(0, 1, At, B1); PG8_BAR;
            PG8_LDA(At, 0, 1); PG8_STAGE(PG8_SA(0, 0), a2, voffA);
            PG8_BAR; PG8_WAIT_L(0); PG8_MMA(1, 0, At, B0); PG8_BAR; PG8_SCHED;
            PG8_STAGE(PG8_SB(0, 1), b2 + hstep, voffB);
            PG8_WAIT_V(6); PG8_BAR; PG8_MMA(1, 1, At, B1); PG8_BAR;
            PG8_LDB(B0, 1, 0); PG8_SCHED; PG8_LDA(At, 1, 0); PG8_STAGE(PG8_SA(0, 1), a2 + hstep, voffA);
            PG8_WAIT_L(8); PG8_BAR; PG8_WAIT_L(0); PG8_MMA(0, 0, At, B0); PG8_BAR; PG8_SCHED;
            PG8_LDB(B1, 1, 1); PG8_STAGE(PG8_SB(1, 0), b3, voffB);
            PG8_BAR; PG8_WAIT_L(0); PG8_MMA(0, 1, At, B1); PG8_BAR;
            PG8_LDA(At, 1, 1); PG8_STAGE(PG8_SA(1, 0), a3, voffA);
            PG8_BAR; PG8_WAIT_L(0); PG8_MMA(1, 0, At, B0); PG8_BAR; PG8_SCHED;
            PG8_STAGE(PG8_SB(1, 1), b3 + hstep, voffB);
            PG8_WAIT_V(6); PG8_BAR; PG8_MMA(1, 1, At, B1); PG8_BAR;
        }
        if constexpr (!Epi::AFTER_DRAIN) { E(acc, cur, wr, wc, fr, fq); S.done(cur); }
        if (!has_next) break;
#pragma unroll
        for (int a = 0; a < 2; ++a)
#pragma unroll
            for (int b = 0; b < 2; ++b)
#pragma unroll
                for (int m = 0; m < 4; ++m)
#pragma unroll
                    for (int n = 0; n < 2; ++n) acc[a][b][m][n] = (f32x4){0.f, 0.f, 0.f, 0.f};
        cur = nxt; cA = nA; cB = nB; ++ui;
    }
    PG8_WAIT_V(0);
    if (wr == 0) PG8_BAR;
    PG8_BAR;
    if constexpr (Epi::AFTER_DRAIN) { E.fused(acc, cur, wr, wc, fr, fq, lds, wid, lane); S.done(cur); }
#undef PG8_SA
#undef PG8_SB
#undef PG8_STAGE
#undef PG8_LDA
#undef PG8_LDB
#undef PG8_MMA
#undef PG8_WAIT_V
#undef PG8_WAIT_L
#undef PG8_BAR
#undef PG8_SCHED
}
}

struct EpiF32m {
    static constexpr bool PERM = false, AFTER_DRAIN = false;
    float* C; int ldc;
    __device__ __forceinline__ void operator()(const f32x4 (&acc)[2][2][4][2], const pg8::Unit& u, int wr, int wc, int fr, int fq) const {
        const int row0 = u.pm * 256 + wr * 64 + fr, col0 = u.pn * 256 + wc * 32 + 4 * fq;
#pragma unroll
        for (int ai = 0; ai < 2; ++ai)
#pragma unroll
            for (int m = 0; m < 4; ++m) { float* rowp = C + (size_t)(row0 + ai * 128 + m * 16) * ldc + col0;
#pragma unroll
                for (int bj = 0; bj < 2; ++bj)
#pragma unroll
                    for (int n = 0; n < 2; ++n) *(f32x4*)(rowp + bj * 128 + n * 16) = acc[ai][bj][m][n]; }
    }
};
struct EpiB16 {
    static constexpr bool PERM = true, AFTER_DRAIN = false;
    bf16_t* O; int ldc;
    __device__ __forceinline__ void operator()(const f32x4 (&acc)[2][2][4][2], const pg8::Unit& u, int wr, int wc, int fr, int fq) const {
        const int row0 = u.pm * 256 + wr * 64 + fr, col0 = u.pn * 256 + wc * 32 + 8 * fq;
#pragma unroll
        for (int ai = 0; ai < 2; ++ai)
#pragma unroll
            for (int m = 0; m < 4; ++m) { bf16_t* rowp = O + (size_t)(row0 + ai * 128 + m * 16) * ldc + col0;
#pragma unroll
                for (int bj = 0; bj < 2; ++bj) { const f32x4 v0 = acc[ai][bj][m][0], v1 = acc[ai][bj][m][1];
                    u32x4 w; w.x = pg8::cvt_pk_bf16(v0[0], v0[1]); w.y = pg8::cvt_pk_bf16(v0[2], v0[3]); w.z = pg8::cvt_pk_bf16(v1[0], v1[1]); w.w = pg8::cvt_pk_bf16(v1[2], v1[3]);
                    *(u32x4*)(rowp + bj * 128) = w; } }
    }
};
struct EpiSwiglu {
    static constexpr bool PERM = true, AFTER_DRAIN = false;
    bf16_t* O; int ldc;
    __device__ __forceinline__ void operator()(const f32x4 (&acc)[2][2][4][2], const pg8::Unit& u, int wr, int wc, int fr, int fq) const {
        const int row0 = u.pm * 256 + wr * 64 + fr, col0 = u.pn * 128 + wc * 32 + 8 * fq;
#pragma unroll
        for (int ai = 0; ai < 2; ++ai)
#pragma unroll
            for (int m = 0; m < 4; ++m) { bf16_t* rowp = O + (size_t)(row0 + ai * 128 + m * 16) * ldc + col0;
                const f32x4 g0 = acc[ai][0][m][0], g1 = acc[ai][0][m][1], u0 = acc[ai][1][m][0], u1 = acc[ai][1][m][1];
                u32x4 w; w.x = pg8::cvt_pk_bf16(siluf_(g0[0]) * u0[0], siluf_(g0[1]) * u0[1]); w.y = pg8::cvt_pk_bf16(siluf_(g0[2]) * u0[2], siluf_(g0[3]) * u0[3]);
                w.z = pg8::cvt_pk_bf16(siluf_(g1[0]) * u1[0], siluf_(g1[1]) * u1[1]); w.w = pg8::cvt_pk_bf16(siluf_(g1[2]) * u1[2], siluf_(g1[3]) * u1[3]);
                *(u32x4*)rowp = w; }
    }
};
template <class Epi> __device__ __forceinline__ void gemm_fast(LAS unsigned char* lds, const bf16_t* A, const bf16_t* Bt, int M, int N, int K, const Epi& E) {
    pg8::Gemm g; g.A = A; g.Bt = Bt; g.M = M; g.N = N; g.K = K;
    pg8::StaticOrder so; so.init(M, N, (int)gridDim.x, obid());
    pg8::gemm_phase<Epi, pg8::StaticOrder>(lds, g, so, E);
    __syncthreads();
}

template <int MODE> __device__ void mixer_lru(const Params& p, int l, int n, LAS unsigned char* lds) {
    const int tid = otid(), lane = tid & 63, wave = tid >> 6, c = lane & 15, q = lane >> 4;
    unsigned char* ws = p.ws;
    const bf16_t* proj = (const bf16_t*)(ws + WS_PROJ); bf16_t* y = (bf16_t*)(ws + WS_H);
    const bf16_t* LW = (const bf16_t*)(ws + WS_LRUW);
    float* Aprod = (float*)(ws + WS_AP); float* Hend = (float*)(ws + WS_HE); const float* carry = (const float*)(ws + WS_CA);
    LAS bf16_t* XC = (LAS bf16_t*)lds;
    LAS float* STA = (LAS float*)(lds + 66560 + wave * 8704);
    LAS float* STU = STA + 16 * 68;
    const int t0 = n * 64;
    {
        const int ch = tid;
        const float cw0 = p.in[4][(size_t)(l * 4 + 0) * 512 + ch], cw1 = p.in[4][(size_t)(l * 4 + 1) * 512 + ch], cw2 = p.in[4][(size_t)(l * 4 + 2) * 512 + ch], cw3 = p.in[4][(size_t)(l * 4 + 3) * 512 + ch];
        const float cb = p.in[5][(size_t)l * 512 + ch];
#define LDX(s) (((s) >= 0 && (s) < S) ? bf2f(proj[(size_t)(s) * DINP + ch]) : 0.f)
        float xm2 = LDX(t0 - 2), xm1 = LDX(t0 - 1), x0 = LDX(t0);
#pragma unroll 8
        for (int t = 0; t < 64; ++t) { const float x1 = LDX(t0 + t + 1); const float xc = cb + cw0 * xm2 + cw1 * xm1 + cw2 * x0 + cw3 * x1; XC[t * 520 + ch] = f2bf(xc); xm2 = xm1; xm1 = x0; x0 = x1; }
#undef LDX
    }
    __syncthreads();
    {
        const int h = wave, j = lane;
#pragma unroll 1
        for (int dir = 0; dir < 2; ++dir) {
            const float* lam = p.in[10] + (size_t)(l * 2 + dir) * 512 + 64 * h; const float* b_a = p.in[7] + (size_t)(l * 2 + dir) * 512 + 64 * h; const float* b_x = p.in[9] + (size_t)(l * 2 + dir) * 512 + 64 * h;
            const bf16_t* LWa = LW + ((size_t)(dir * 2 + 0) * 8 + h) * 4096 + c * 64 + 8 * q; const bf16_t* LWx = LW + ((size_t)(dir * 2 + 1) * 8 + h) * 4096 + c * 64 + 8 * q;
            float hcar = 0.f, P = 1.f;
            if (MODE == 1) hcar = carry[(size_t)(dir * NCH + n) * 512 + 64 * h + j];
#pragma unroll 1
            for (int g = 0; g < 4; ++g) {
                const int mi = dir == 0 ? g : 3 - g;
                bf16x8 xf[2];
#pragma unroll
                for (int ks = 0; ks < 2; ++ks) xf[ks] = *(const LAS bf16x8*)(XC + (16 * mi + c) * 520 + 64 * h + 32 * ks + 8 * q);
#pragma unroll 1
                for (int nf = 0; nf < 4; ++nf) {
                    f32x4 za = (f32x4){0.f, 0.f, 0.f, 0.f}, zx = za;
                    za = mfma16(*(const bf16x8*)(LWa + nf * 1024), xf[0], za); za = mfma16(*(const bf16x8*)(LWa + nf * 1024 + 32), xf[1], za);
                    zx = mfma16(*(const bf16x8*)(LWx + nf * 1024), xf[0], zx); zx = mfma16(*(const bf16x8*)(LWx + nf * 1024 + 32), xf[1], zx);
                    const int jo = 16 * nf + 4 * q;
                    const f32x4 ba4 = *(const f32x4*)(b_a + jo), bx4 = *(const f32x4*)(b_x + jo), lam4 = *(const f32x4*)(lam + jo);
                    const bf16x4 xc4 = *(const LAS bf16x4*)(XC + (16 * mi + c) * 520 + 64 * h + jo);
                    f32x4 av, uv;
#pragma unroll
                    for (int r = 0; r < 4; ++r) {
                        const float ra = sigmoidf_(za[r] + ba4[r]), ix = sigmoidf_(zx[r] + bx4[r]);
                        const float sp = log1pf(__expf(-lam4[r]));
                        const float la = -8.0f * ra * sp;
                        av[r] = __expf(la);
                        uv[r] = bf2f((bf16_t)xc4[r]) * ix * sqrtf(fmaxf(-expm1f(2.0f * la), 0.f));
                    }
                    *(LAS f32x4*)(STA + c * 68 + jo) = av; *(LAS f32x4*)(STU + c * 68 + jo) = uv;
                }
                LDS_FENCE();
#pragma unroll 1
                for (int s = 0; s < 16; ++s) {
                    const int tl = dir == 0 ? s : 15 - s;
                    const float a = STA[tl * 68 + j], u = STU[tl * 68 + j];
                    hcar = a * hcar + u; P *= a;
                    if (MODE == 1) {
                        const int t = 16 * mi + tl; const size_t yi = (size_t)(t0 + t) * D + 64 * h + j;
                        if (dir == 0) y[yi] = f2bf(hcar);
                        else { const float hf = bf2f(y[yi]); const float gt = bf2f(proj[(size_t)(t0 + t) * DINP + 512 + 64 * h + j]); XC[t * 520 + 64 * h + j] = f2bf((hf + hcar) * geluf_(gt)); }
                    }
                }
                LDS_FENCE();
            }
            if (MODE == 0) { Aprod[(size_t)(dir * NCH + n) * 512 + 64 * h + j] = P; Hend[(size_t)(dir * NCH + n) * 512 + 64 * h + j] = hcar; }
        }
    }
    __syncthreads();
    if (MODE == 1) {
        const int t = tid >> 3, seg = tid & 7;
        float ss = 0.f;
#pragma unroll
        for (int i = 0; i < 8; ++i) { const bf16x8 b = *(const LAS bf16x8*)(XC + t * 520 + 64 * seg + 8 * i);
#pragma unroll
            for (int k = 0; k < 8; ++k) { const float f = bf2f((bf16_t)b[k]); ss += f * f; } }
        ss += __shfl_xor(ss, 1); ss += __shfl_xor(ss, 2); ss += __shfl_xor(ss, 4);
        const float rs = rsqrtf(ss * (1.0f / 512.0f) + EPS);
        const float* gn = p.in[11] + (size_t)l * 512 + 64 * seg;
#pragma unroll 2
        for (int i = 0; i < 8; ++i) { const bf16x8 b = *(const LAS bf16x8*)(XC + t * 520 + 64 * seg + 8 * i); const f32x4 g0 = *(const f32x4*)(gn + 8 * i), g1 = *(const f32x4*)(gn + 8 * i + 4); u32x4 w;
            w.x = pk2(bf2f((bf16_t)b[0]) * rs * g0[0], bf2f((bf16_t)b[1]) * rs * g0[1]); w.y = pk2(bf2f((bf16_t)b[2]) * rs * g0[2], bf2f((bf16_t)b[3]) * rs * g0[3]);
            w.z = pk2(bf2f((bf16_t)b[4]) * rs * g1[0], bf2f((bf16_t)b[5]) * rs * g1[1]); w.w = pk2(bf2f((bf16_t)b[6]) * rs * g1[2], bf2f((bf16_t)b[7]) * rs * g1[3]);
            *(u32x4*)(y + (size_t)(t0 + t) * D + 64 * seg + 8 * i) = w; }
        __syncthreads();
    }
}

template <int MODE> __device__ void mixer_gla(const Params& p, int l, int n, LAS unsigned char* lds) {
    const int tid = otid(), lane = tid & 63, wave = tid >> 6, c = lane & 15, q = lane >> 4;
    unsigned char* ws = p.ws;
    const bf16_t* proj = (const bf16_t*)(ws + WS_PROJ); bf16_t* y = (bf16_t*)(ws + WS_H);
    bf16_t* uT = (bf16_t*)(ws + WS_M); const bf16_t* spT = (const bf16_t*)(ws + WS_M + (size_t)S * D * 2); float* dec = (float*)(ws + WS_DEC);
    LAS float* LA0 = (LAS float*)lds;
    LAS bf16_t* QE0 = (LAS bf16_t*)(lds + 32768);
    LAS bf16_t* VT = (LAS bf16_t*)(lds + 69632);
    LAS bf16_t* P0 = (LAS bf16_t*)(lds + 88064);
    LAS float* SSQ = (LAS float*)(lds + 106496);
    const int t0 = n * 64;
#pragma unroll 1
    for (int h = 0; h < 4; ++h) {
        {
            const int de = tid & 127, dir = de >> 6, e = de & 63, tg = tid >> 7;
            const float* Wg = p.in[12] + (size_t)(l * 2 + dir) * 16 * 256 + 64 * h + e; const float bg = p.in[13][(size_t)(l * 2 + dir) * 256 + 64 * h + e];
            float w[16];
#pragma unroll
            for (int r = 0; r < 16; ++r) w[r] = Wg[(size_t)r * 256];
            LAS float* LA = LA0 + dir * 4096;
#pragma unroll 1
            for (int tt = 0; tt < 16; ++tt) { const int t = tg * 16 + tt;
                const bf16x8 l0 = *(const bf16x8*)(proj + (size_t)(t0 + t) * DINP + 2560 + dir * 16), l1 = *(const bf16x8*)(proj + (size_t)(t0 + t) * DINP + 2560 + dir * 16 + 8);
                float z = bg;
#pragma unroll
                for (int r = 0; r < 8; ++r) { z += bf2f((bf16_t)l0[r]) * w[r]; z += bf2f((bf16_t)l1[r]) * w[8 + r]; }
                LA[t * 64 + e] = (fminf(z, 0.f) - log1pf(__expf(-fabsf(z)))) * (1.0f / 16.0f); }
            const int vv = tid & 127, tq = tid >> 7;
            unsigned wv[8];
#pragma unroll
            for (int i = 0; i < 8; ++i) { const unsigned lo = proj[(size_t)(t0 + 16 * tq + 2 * i) * DINP + 1536 + 128 * h + vv], hi = proj[(size_t)(t0 + 16 * tq + 2 * i + 1) * DINP + 1536 + 128 * h + vv]; wv[i] = lo | (hi << 16); }
            *(LAS u32x4*)(VT + vv * 72 + 16 * tq) = (u32x4){wv[0], wv[1], wv[2], wv[3]}; *(LAS u32x4*)(VT + vv * 72 + 16 * tq + 8) = (u32x4){wv[4], wv[5], wv[6], wv[7]};
        }
        __syncthreads();
        if (tid < 128) {
            const int dir = tid >> 6, d = tid & 63; LAS float* LA = LA0 + dir * 4096; float acc = 0.f;
            if (MODE == 1) {
                if (dir == 0) {
#pragma unroll 8
                    for (int t = 0; t < 64; ++t) { acc += LA[t * 64 + d]; LA[t * 64 + d] = acc; } }
                else {
#pragma unroll 8
                    for (int t = 63; t >= 0; --t) { acc += LA[t * 64 + d]; LA[t * 64 + d] = acc; } }
            } else {
                if (dir == 0) {
#pragma unroll 8
                    for (int t = 63; t >= 0; --t) { const float v = LA[t * 64 + d]; LA[t * 64 + d] = acc; acc += v; } }
                else {
#pragma unroll 8
                    for (int t = 0; t < 64; ++t) { const float v = LA[t * 64 + d]; LA[t * 64 + d] = acc; acc += v; } }
                dec[((size_t)(dir * NCH + n) * 4 + h) * 64 + d] = __expf(acc);
            }
        }
        __syncthreads();
        if (MODE == 1) {
            { const int t = tid >> 3, dg = (tid & 7) * 8;
              const bf16x8 qv = *(const bf16x8*)(proj + (size_t)(t0 + t) * DINP + 1024 + 64 * h + dg), kv = *(const bf16x8*)(proj + (size_t)(t0 + t) * DINP + 1280 + 64 * h + dg);
#pragma unroll
              for (int dir = 0; dir < 2; ++dir) { float qe[8], ke[8];
#pragma unroll
                  for (int k = 0; k < 8; ++k) { const float b = LA0[dir * 4096 + t * 64 + dg + k]; qe[k] = bf2f((bf16_t)qv[k]) * 0.125f * __expf(b); ke[k] = bf2f((bf16_t)kv[k]) * __expf(-b); }
                  *(LAS u32x4*)(QE0 + dir * 9216 + t * 72 + dg) = (u32x4){pk2(qe[0], qe[1]), pk2(qe[2], qe[3]), pk2(qe[4], qe[5]), pk2(qe[6], qe[7])};
                  *(LAS u32x4*)(QE0 + dir * 9216 + 4608 + t * 72 + dg) = (u32x4){pk2(ke[0], ke[1]), pk2(ke[2], ke[3]), pk2(ke[4], ke[5]), pk2(ke[6], ke[7])}; } }
            __syncthreads();
            { const int dir = wave >> 2, ti = wave & 3; LAS bf16_t* QE = QE0 + dir * 9216; LAS bf16_t* KE = QE + 4608; LAS bf16_t* P = P0 + dir * 4608;
              bf16x8 qf[2];
#pragma unroll
              for (int ks = 0; ks < 2; ++ks) qf[ks] = *(const LAS bf16x8*)(QE + (16 * ti + c) * 72 + 32 * ks + 8 * q);
#pragma unroll
              for (int tj = 0; tj < 4; ++tj) { f32x4 sc = (f32x4){0.f, 0.f, 0.f, 0.f};
#pragma unroll
                  for (int ks = 0; ks < 2; ++ks) { const bf16x8 kf = *(const LAS bf16x8*)(KE + (16 * tj + c) * 72 + 32 * ks + 8 * q); sc = mfma16(kf, qf[ks], sc); }
                  const int i = 16 * ti + c, j0 = 16 * tj + 4 * q; float m[4];
#pragma unroll
                  for (int r = 0; r < 4; ++r) { const int j = j0 + r; const bool keep = dir == 0 ? (j <= i) : (j >= i); m[r] = keep ? sc[r] : 0.f; }
                  *(LAS u32x2*)(P + i * 72 + j0) = (u32x2){pk2(m[0], m[1]), pk2(m[2], m[3])}; } }
            __syncthreads();
            { const int ti = wave & 3, vb = (wave >> 2) * 4;
              f32x4 acc[4];
#pragma unroll
              for (int i = 0; i < 4; ++i) acc[i] = (f32x4){0.f, 0.f, 0.f, 0.f};
#pragma unroll
              for (int dir = 0; dir < 2; ++dir) {
                  LAS bf16_t* QE = QE0 + dir * 9216; LAS bf16_t* P = P0 + dir * 4608;
                  const bf16_t* SP = spT + ((size_t)(dir * NCH + n) * 4 + h) * 8192;
#pragma unroll
                  for (int ks = 0; ks < 2; ++ks) {
                      const bf16x8 pf = *(const LAS bf16x8*)(P + (16 * ti + c) * 72 + 32 * ks + 8 * q), qf = *(const LAS bf16x8*)(QE + (16 * ti + c) * 72 + 32 * ks + 8 * q);
#pragma unroll
                      for (int vl = 0; vl < 4; ++vl) { const int vf = vb + vl;
                          const bf16x8 vtf = *(const LAS bf16x8*)(VT + (16 * vf + c) * 72 + 32 * ks + 8 * q); acc[vl] = mfma16(vtf, pf, acc[vl]);
                          const bf16x8 sf = *(const bf16x8*)(SP + (16 * vf + c) * 64 + 32 * ks + 8 * q); acc[vl] = mfma16(sf, qf, acc[vl]); }
                  }
              }
              float ss = 0.f;
#pragma unroll
              for (int vl = 0; vl < 4; ++vl) ss += acc[vl][0] * acc[vl][0] + acc[vl][1] * acc[vl][1] + acc[vl][2] * acc[vl][2] + acc[vl][3] * acc[vl][3];
              ss += __shfl_xor(ss, 16); ss += __shfl_xor(ss, 32);
              const int t = 16 * ti + c;
              if (q == 0) SSQ[t * 2 + (wave >> 2)] = ss;
              __syncthreads();
              const float rs = rsqrtf((SSQ[t * 2] + SSQ[t * 2 + 1]) * (1.0f / 128.0f) + EPS);
              const float* gn = p.in[14] + (size_t)l * 128;
#pragma unroll
              for (int vl = 0; vl < 4; ++vl) { const int v = 16 * (vb + vl) + 4 * q; const f32x4 g4 = *(const f32x4*)(gn + v);
                  const bf16x4 gg = *(const bf16x4*)(proj + (size_t)(t0 + t) * DINP + 2048 + 128 * h + v); float o[4];
#pragma unroll
                  for (int r = 0; r < 4; ++r) o[r] = acc[vl][r] * rs * g4[r] * siluf_(bf2f((bf16_t)gg[r]));
                  *(u32x2*)(y + (size_t)(t0 + t) * D + 512 + 128 * h + v) = (u32x2){pk2(o[0], o[1]), pk2(o[2], o[3])}; }
            }
            __syncthreads();
        } else {
            { const int d = tid & 63, tg = tid >> 6; float kk[8];
#pragma unroll
              for (int i = 0; i < 8; ++i) kk[i] = bf2f(proj[(size_t)(t0 + 8 * tg + i) * DINP + 1280 + 64 * h + d]);
#pragma unroll
              for (int dir = 0; dir < 2; ++dir) { float kd[8];
#pragma unroll
                  for (int i = 0; i < 8; ++i) kd[i] = kk[i] * __expf(LA0[dir * 4096 + (8 * tg + i) * 64 + d]);
                  *(LAS u32x4*)(QE0 + dir * 9216 + d * 72 + 8 * tg) = (u32x4){pk2(kd[0], kd[1]), pk2(kd[2], kd[3]), pk2(kd[4], kd[5]), pk2(kd[6], kd[7])}; } }
            __syncthreads();
            { const int dir = wave >> 2, df = wave & 3; LAS bf16_t* KDT = QE0 + dir * 9216;
              bf16x8 kf[2];
#pragma unroll
              for (int ks = 0; ks < 2; ++ks) kf[ks] = *(const LAS bf16x8*)(KDT + (16 * df + c) * 72 + 32 * ks + 8 * q);
              bf16_t* U = uT + ((size_t)(dir * NCH + n) * 4 + h) * 8192;
#pragma unroll
              for (int vf = 0; vf < 8; ++vf) { f32x4 a = (f32x4){0.f, 0.f, 0.f, 0.f};
#pragma unroll
                  for (int ks = 0; ks < 2; ++ks) { const bf16x8 vtf = *(const LAS bf16x8*)(VT + (16 * vf + c) * 72 + 32 * ks + 8 * q); a = mfma16(kf[ks], vtf, a); }
                  *(u32x2*)(U + (16 * vf + c) * 64 + 16 * df + 4 * q) = (u32x2){pk2(a[0], a[1]), pk2(a[2], a[3])}; } }
            __syncthreads();
        }
    }
}

__device__ void phase_scan(const Params& p) {
    unsigned char* ws = p.ws; const int tid = otid();
    if (tid < 256) {
        const bf16_t* uT = (const bf16_t*)(ws + WS_M); bf16_t* spT = (bf16_t*)(ws + WS_M + (size_t)S * D * 2); const float* dec = (const float*)(ws + WS_DEC);
        for (int gid = obid() * 256 + tid; gid < 65536; gid += gridDim.x * 256) {
            const int dir = gid >> 15, rem = gid & 32767, h = rem >> 13, vd = rem & 8191, d = vd & 63;
            float s = 0.f;
#pragma unroll 8
            for (int st = 0; st < NCH; ++st) { const int n = dir ? (NCH - 1 - st) : st; const size_t idx = ((size_t)(dir * NCH + n) * 4 + h) * 8192 + vd;
                const float u = bf2f(uT[idx]); const float dc = dec[((size_t)(dir * NCH + n) * 4 + h) * 64 + d]; spT[idx] = f2bf(s); s = dc * s + u; }
        }
    } else if (tid < 384 && obid() < 8) {
        const float* Aprod = (const float*)(ws + WS_AP); const float* Hend = (const float*)(ws + WS_HE); float* carry = (float*)(ws + WS_CA);
        const int gid = obid() * 128 + (tid - 256); const int dir = gid >> 9, ch = gid & 511;
        float hc = 0.f;
#pragma unroll 8
        for (int st = 0; st < NCH; ++st) { const int n = dir ? (NCH - 1 - st) : st; const size_t idx = (size_t)(dir * NCH + n) * 512 + ch;
            const float a = Aprod[idx], he = Hend[idx]; carry[idx] = hc; hc = a * hc + he; }
    }
}

__global__ void __launch_bounds__(NTHR, 2) mk_fwd(Params p) {
    extern __shared__ __attribute__((aligned(16))) unsigned char lds_raw[];
    LAS unsigned char* lds = (LAS unsigned char*)lds_raw;
    unsigned char* ws = p.ws;
    bf16_t* WinT = (bf16_t*)(ws + WS_WIN); bf16_t* WoutT = (bf16_t*)(ws + WS_WOUT); bf16_t* WguT = (bf16_t*)(ws + WS_WGU); bf16_t* WdT = (bf16_t*)(ws + WS_WD);
    bf16_t* Hb = (bf16_t*)(ws + WS_H); bf16_t* PROJ = (bf16_t*)(ws + WS_PROJ); float* Mb = (float*)(ws + WS_M);
    const float* xin = p.in[0]; float* out = p.out;
    for (int ph = p.ph_lo; ph < p.ph_hi; ++ph) {
        if (ph > p.ph_lo) cg::this_grid().sync();
        if (ph == 9 * NL) { phase_rowprep(out, Mb, p.in[17] + (size_t)(NL - 1) * D, out, nullptr, nullptr); continue; }
        const int l = ph / 9, s = ph % 9;
        switch (s) {
#ifndef PHMASK
#define PHMASK 0x1ff
#endif
        case 0: if (!(PHMASK & 1)) break; phase_weights(p, l, lds);
                if (l == 0) phase_rowprep(xin, nullptr, nullptr, nullptr, p.in[1], Hb);
                else phase_rowprep(out, Mb, p.in[17] + (size_t)(l - 1) * D, out, p.in[1] + (size_t)l * D, Hb);
                break;
        case 1: if (!(PHMASK & 2)) break; gemm_fast(lds, Hb, WinT, S, DINP, D, EpiB16{PROJ, DINP}); break;
        case 2: if (!(PHMASK & 4)) break; for (int n = obid(); n < NCH; n += gridDim.x) mixer_lru<0>(p, l, n, lds);
                for (int n = obid(); n < NCH; n += gridDim.x) mixer_gla<0>(p, l, n, lds); break;
        case 3: if (!(PHMASK & 8)) break; phase_scan(p); break;
        case 4: if (!(PHMASK & 16)) break; for (int n = obid(); n < NCH; n += gridDim.x) mixer_lru<1>(p, l, n, lds);
                for (int n = obid(); n < NCH; n += gridDim.x) mixer_gla<1>(p, l, n, lds); break;
        case 5: if (!(PHMASK & 32)) break; gemm_fast(lds, Hb, WoutT, S, D, D, EpiF32m{Mb, D}); break;
        case 6: if (!(PHMASK & 64)) break; phase_rowprep(l == 0 ? xin : out, Mb, p.in[2] + (size_t)l * D, out, p.in[16] + (size_t)l * D, Hb); break;
        case 7: if (!(PHMASK & 128)) break; gemm_fast(lds, Hb, WguT, S, 2 * DFF, D, EpiSwiglu{PROJ, DFF}); break;
        case 8: if (!(PHMASK & 256)) break; gemm_fast(lds, PROJ, WdT, S, D, DFF, EpiF32m{Mb, D}); break;
        }
    }
}

extern "C" void kernel_launch(void* const* d_in, const int* in_sizes, int n_in, void* d_out, int out_size, void* d_ws, size_t ws_size, hipStream_t stream) {
    static int grid = 0;
    if (grid == 0) {
        if (n_in != 21 || out_size != S * D || ws_size < WS_END) { fprintf(stderr, "kernel_launch: unexpected shapes: n_in %d out %d ws %zu (need %zu)\n", n_in, out_size, ws_size, (size_t)WS_END); grid = -1; return; }
        int dev = 0, cus = 0, per_cu = 0;
        (void)hipGetDevice(&dev); (void)hipDeviceGetAttribute(&cus, hipDeviceAttributeMultiprocessorCount, dev);
        if (hipFuncSetAttribute((const void*)mk_fwd, hipFuncAttributeMaxDynamicSharedMemorySize, LDS_BYTES) != hipSuccess) { fprintf(stderr, "kernel_launch: hipFuncSetAttribute failed\n"); grid = -1; return; }
        if (hipOccupancyMaxActiveBlocksPerMultiprocessor(&per_cu, (const void*)mk_fwd, NTHR, LDS_BYTES) != hipSuccess || per_cu < 1) { fprintf(stderr, "kernel_launch: occupancy query says %d\n", per_cu); per_cu = 1; }
        (void)hipGetLastError();
        grid = cus;
    }
    if (grid < 0) return;
    Params p{};
    for (int i = 0; i < 21; ++i) p.in[i] = (const float*)d_in[i];
    p.out = (float*)d_out; p.ws = (unsigned char*)d_ws;
#if ONE_LAUNCH
    p.ph_lo = 0; p.ph_hi = 9 * NL + 1;
    void* args[] = {&p};
    hipError_t e = hipLaunchCooperativeKernel((const void*)mk_fwd, dim3(grid), dim3(NTHR), args, LDS_BYTES, stream);
    if (e != hipSuccess) fprintf(stderr, "cooperative launch failed: %s (grid %d)\n", hipGetErrorString(e), grid);
#else
    for (int ph = 0; ph < 9 * NL + 1; ++ph) { p.ph_lo = ph; p.ph_hi = ph + 1; hipLaunchKernelGGL(mk_fwd, dim3(grid), dim3(NTHR), LDS_BYTES, stream, p); }
#endif
}
```

```cpp
#include <hip/hip_runtime.h>
#include <hip/hip_cooperative_groups.h>
#include <cstdio>
namespace cg = cooperative_groups;

#ifndef ONE_LAUNCH
#define ONE_LAUNCH 1
#endif

#define LAS __attribute__((address_space(3)))
typedef unsigned short bf16_t;
typedef short bf16x8 __attribute__((ext_vector_type(8)));
typedef short bf16x4 __attribute__((ext_vector_type(4)));
typedef float f32x4 __attribute__((ext_vector_type(4)));
typedef unsigned u32x4 __attribute__((ext_vector_type(4)));
typedef unsigned u32x2 __attribute__((ext_vector_type(2)));

constexpr int S = 16384, D = 1024, DIN = 2592, DINP = 2816, DFF = 2816, NL = 4, NCH = 256;
constexpr int NTHR = 512;
constexpr int LDS_BYTES = 147456;
constexpr float EPS = 1e-6f;

constexpr size_t WS_CTL = 0;
constexpr size_t WS_WIN = 65536;
constexpr size_t WS_WOUT = WS_WIN + (size_t)DINP * D * 2;
constexpr size_t WS_WGU = WS_WOUT + (size_t)D * D * 2;
constexpr size_t WS_WD = WS_WGU + (size_t)2 * DFF * D * 2;
constexpr size_t WS_LRUW = WS_WD + (size_t)D * DFF * 2;
constexpr size_t WS_H = WS_LRUW + (size_t)2 * 2 * 8 * 64 * 64 * 2;
constexpr size_t WS_PROJ = WS_H + (size_t)S * D * 2;
constexpr size_t WS_M = WS_PROJ + (size_t)S * DINP * 2;
constexpr size_t WS_AP = WS_M + (size_t)S * D * 4;
constexpr size_t WS_HE = WS_AP + (size_t)2 * NCH * 512 * 4;
constexpr size_t WS_CA = WS_HE + (size_t)2 * NCH * 512 * 4;
constexpr size_t WS_DEC = WS_CA + (size_t)2 * NCH * 512 * 4;
constexpr size_t WS_END = WS_DEC + (size_t)2 * NCH * 4 * 64 * 4;

struct Params { const float* in[21]; float* out; unsigned char* ws; int ph_lo, ph_hi; };

__device__ __forceinline__ float bf2f(bf16_t b) { return __uint_as_float(((unsigned)b) << 16); }
__device__ __forceinline__ bf16_t f2bf(float f) { unsigned u = __float_as_uint(f); return (bf16_t)((u + 0x7fffu + ((u >> 16) & 1u)) >> 16); }
__device__ __forceinline__ unsigned pk2(float lo, float hi) { return (unsigned)f2bf(lo) | ((unsigned)f2bf(hi) << 16); }
__device__ __forceinline__ float sigmoidf_(float x) { return 1.0f / (1.0f + __expf(-x)); }
__device__ __forceinline__ float siluf_(float x) { return x * sigmoidf_(x); }
__device__ __forceinline__ float geluf_(float x) { const float y = 0.7978845608028654f * (x + 0.044715f * x * x * x); const float t = 1.0f - 2.0f / (__expf(2.0f * y) + 1.0f); return 0.5f * x * (1.0f + t); }
__device__ __forceinline__ f32x4 mfma16(bf16x8 a, bf16x8 b, f32x4 c) { return __builtin_amdgcn_mfma_f32_16x16x32_bf16(a, b, c, 0, 0, 0); }
__device__ __forceinline__ int otid() { int t = threadIdx.x; asm volatile("" : "+v"(t)); return t; }
__device__ __forceinline__ int obid() { int t = blockIdx.x; asm volatile("" : "+s"(t)); return t; }
#define LDS_FENCE() asm volatile("s_waitcnt lgkmcnt(0)" ::: "memory")

__device__ __forceinline__ void wtile(const float* __restrict__ src, int ldsrc, int c0, int nvalid, int k0, bf16_t* __restrict__ dst, int lddst, int r0, LAS float* T) {
    const int tid = otid();
    { const int k = tid >> 3, cg8 = (tid & 7) * 8;
      const float* sp = src + (size_t)(k0 + k) * ldsrc + c0 + cg8;
#pragma unroll
      for (int i = 0; i < 2; ++i) { f32x4 v = (f32x4){0.f, 0.f, 0.f, 0.f}; if (cg8 + 4 * i + 3 < nvalid) v = *(const f32x4*)(sp + 4 * i);
          T[k * 65 + cg8 + 4 * i + 0] = v[0]; T[k * 65 + cg8 + 4 * i + 1] = v[1]; T[k * 65 + cg8 + 4 * i + 2] = v[2]; T[k * 65 + cg8 + 4 * i + 3] = v[3]; } }
    __syncthreads();
    { const int r = tid >> 3, kg = (tid & 7) * 8; u32x4 w;
      w.x = pk2(T[(kg + 0) * 65 + r], T[(kg + 1) * 65 + r]); w.y = pk2(T[(kg + 2) * 65 + r], T[(kg + 3) * 65 + r]);
      w.z = pk2(T[(kg + 4) * 65 + r], T[(kg + 5) * 65 + r]); w.w = pk2(T[(kg + 6) * 65 + r], T[(kg + 7) * 65 + r]);
      *(u32x4*)(dst + (size_t)(r0 + r) * lddst + k0 + kg) = w; }
    __syncthreads();
}

__device__ void phase_weights(const Params& p, int l, LAS unsigned char* lds) {
    LAS float* T = (LAS float*)lds;
    unsigned char* ws = p.ws;
    bf16_t* WinT = (bf16_t*)(ws + WS_WIN); bf16_t* WoutT = (bf16_t*)(ws + WS_WOUT); bf16_t* WguT = (bf16_t*)(ws + WS_WGU); bf16_t* WdT = (bf16_t*)(ws + WS_WD); bf16_t* LW = (bf16_t*)(ws + WS_LRUW);
    const float* w_in = p.in[3] + (size_t)l * D * DIN; const float* w_out = p.in[15] + (size_t)l * D * D;
    const float* w_g = p.in[18] + (size_t)l * D * DFF; const float* w_u = p.in[19] + (size_t)l * D * DFF; const float* w_d = p.in[20] + (size_t)l * DFF * D;
    constexpr int T_IN = 44 * 16, T_OUT = 16 * 16, T_GU = 88 * 16, T_D = 16 * 44, T_L = 32;
    constexpr int TOT = T_IN + T_OUT + T_GU + T_D + T_L;
    for (int u = obid(); u < TOT; u += gridDim.x) {
        int v = u;
        if (v < T_IN) { const int rt = v / 16, kt = v % 16; int nv = DIN - rt * 64; nv = nv > 64 ? 64 : (nv < 0 ? 0 : nv); wtile(w_in, DIN, nv > 0 ? rt * 64 : 0, nv, kt * 64, WinT, D, rt * 64, T); continue; }
        v -= T_IN;
        if (v < T_OUT) { const int rt = v / 16, kt = v % 16; wtile(w_out, D, rt * 64, 64, kt * 64, WoutT, D, rt * 64, T); continue; }
        v -= T_OUT;
        if (v < T_GU) { const int rt = v / 16, kt = v % 16; const int r0 = rt * 64, j = r0 / 256, within = r0 % 256; const float* src = within < 128 ? w_g : w_u; const int col = j * 128 + (within & 127);
            wtile(src, DFF, col, 64, kt * 64, WguT, D, r0, T); continue; }
        v -= T_GU;
        if (v < T_D) { const int rt = v / 44, kt = v % 44; wtile(w_d, D, rt * 64, 64, kt * 64, WdT, DFF, rt * 64, T); continue; }
        v -= T_D;
        { const int dir = v / 16, gate = (v / 8) % 2, h = v % 8; const float* src = (gate ? p.in[8] : p.in[6]) + ((size_t)(l * 2 + dir) * 8 + h) * 4096;
          wtile(src, 64, 0, 64, 0, LW + ((size_t)(dir * 2 + gate) * 8 + h) * 4096, 64, 0, T); }
    }
}

__device__ void phase_rowprep(const float* __restrict__ xsrc, const float* __restrict__ m, const float* __restrict__ gpost, float* __restrict__ xdst, const float* __restrict__ gpre, bf16_t* __restrict__ hdst) {
    const int tid = otid(); const int lane = tid & 63, wave = tid >> 6;
    for (int row = obid() * 8 + wave; row < S; row += gridDim.x * 8) {
        f32x4 xv[4];
#pragma unroll
        for (int i = 0; i < 4; ++i) xv[i] = *(const f32x4*)(xsrc + (size_t)row * D + i * 256 + lane * 4);
        if (m) {
            f32x4 mv[4]; float ss = 0.f;
#pragma unroll
            for (int i = 0; i < 4; ++i) { mv[i] = *(const f32x4*)(m + (size_t)row * D + i * 256 + lane * 4); ss += mv[i][0] * mv[i][0] + mv[i][1] * mv[i][1] + mv[i][2] * mv[i][2] + mv[i][3] * mv[i][3]; }
#pragma unroll
            for (int o = 32; o >= 1; o >>= 1) ss += __shfl_xor(ss, o);
            const float rs = rsqrtf(ss * (1.0f / D) + EPS);
#pragma unroll
            for (int i = 0; i < 4; ++i) { const f32x4 g = *(const f32x4*)(gpost + i * 256 + lane * 4); xv[i] += mv[i] * rs * g; }
        }
        if (xdst) {
#pragma unroll
            for (int i = 0; i < 4; ++i) *(f32x4*)(xdst + (size_t)row * D + i * 256 + lane * 4) = xv[i];
        }
        if (hdst) {
            float ss = 0.f;
#pragma unroll
            for (int i = 0; i < 4; ++i) ss += xv[i][0] * xv[i][0] + xv[i][1] * xv[i][1] + xv[i][2] * xv[i][2] + xv[i][3] * xv[i][3];
#pragma unroll
            for (int o = 32; o >= 1; o >>= 1) ss += __shfl_xor(ss, o);
            const float rs = rsqrtf(ss * (1.0f / D) + EPS);
#pragma unroll
            for (int i = 0; i < 4; ++i) { const f32x4 g = *(const f32x4*)(gpre + i * 256 + lane * 4); const f32x4 hv = xv[i] * rs * g; u32x2 w; w.x = pk2(hv[0], hv[1]); w.y = pk2(hv[2], hv[3]);
                *(u32x2*)(hdst + (size_t)row * D + i * 256 + lane * 4) = w; }
        }
    }
}

template <int EPI> __device__ void gemm_simple(const bf16_t* __restrict__ A, int lda, const bf16_t* __restrict__ Bt, int K, int M, int N, void* __restrict__ Cv, int ldc) {
    const int tid = otid(), lane = tid & 63, wave = tid >> 6, wr = wave >> 2, wc = wave & 3, c = lane & 15, q = lane >> 4;
    const int nM = M / 128, nN = N / 256;
    for (int u = obid(); u < nM * nN; u += gridDim.x) {
        const int pn = u / nM, pm = u % nM; const int m0 = pm * 128 + wr * 64;
        f32x4 acc[4][4];
#pragma unroll
        for (int i = 0; i < 4; ++i)
#pragma unroll
            for (int j = 0; j < 4; ++j) acc[i][j] = (f32x4){0.f, 0.f, 0.f, 0.f};
        const bf16_t* ap = A + (size_t)(m0 + c) * lda + 8 * q;
        const bf16_t* bp = Bt + (size_t)(pn * 256 + wc * 32 + c) * K + 8 * q;
        for (int k0 = 0; k0 < K; k0 += 32) {
            bf16x8 af[4], bfr[4];
#pragma unroll
            for (int mi = 0; mi < 4; ++mi) af[mi] = *(const bf16x8*)(ap + (size_t)(16 * mi) * lda + k0);
#pragma unroll
            for (int nf = 0; nf < 4; ++nf) bfr[nf] = *(const bf16x8*)(bp + (size_t)((nf >> 1) * 128 + (nf & 1) * 16) * K + k0);
#pragma unroll
            for (int mi = 0; mi < 4; ++mi)
#pragma unroll
                for (int nf = 0; nf < 4; ++nf) acc[mi][nf] = mfma16(bfr[nf], af[mi], acc[mi][nf]);
        }
#pragma unroll
        for (int mi = 0; mi < 4; ++mi) { const int row = m0 + 16 * mi + c;
            if (EPI == 2) {
#pragma unroll
                for (int nf = 0; nf < 2; ++nf) { const f32x4 g = acc[mi][nf], uu = acc[mi][nf + 2]; const int col = pn * 128 + wc * 32 + nf * 16 + 4 * q;
                    u32x2 w; w.x = pk2(siluf_(g[0]) * uu[0], siluf_(g[1]) * uu[1]); w.y = pk2(siluf_(g[2]) * uu[2], siluf_(g[3]) * uu[3]);
                    *(u32x2*)((bf16_t*)Cv + (size_t)row * ldc + col) = w; }
            } else {
#pragma unroll
                for (int nf = 0; nf < 4; ++nf) { const int col = pn * 256 + (nf >> 1) * 128 + wc * 32 + (nf & 1) * 16 + 4 * q; const f32x4 v = acc[mi][nf];
                    if (EPI == 0) { u32x2 w; w.x = pk2(v[0], v[1]); w.y = pk2(v[2], v[3]); *(u32x2*)((bf16_t*)Cv + (size_t)row * ldc + col) = w; }
                    else *(f32x4*)((float*)Cv + (size_t)row * ldc + col) = v; }
            }
        }
    }
}

namespace pg8 {
#define PG8_LAS __attribute__((address_space(3)))
constexpr int BM = 256, BK = 64, HALF = 128, HTB = HALF * BK * 2  , STAGE_BYTES = 8 * HTB, NXCD = 8, WGM = 8;
__host__ __device__ __forceinline__ int lds_byte(int r, int c) { const int st = (r >> 4) * 2 + (c >> 5), rr = r & 15, cc = c & 31, ob = rr * 64 + cc * 2; return st * 1024 + (ob ^ (((ob >> 9) & 1) << 5)); }
__host__ __device__ __forceinline__ void stage_rc(int b, int& R, int& C) { const int st = b / 1024, sb = b % 1024, swz = sb ^ (((sb >> 9) & 1) << 5); R = (st >> 1) * 16 + swz / 64; C = (st & 1) * 32 + (swz % 64) / 2; }
__host__ __device__ __forceinline__ int perm32(int rho) { const int n = rho >> 4, i = rho & 15; return 8 * (i >> 2) + 4 * n + (i & 3); }
struct Unit { int pm, pn; };
struct Gemm { const bf16_t* A; const bf16_t* Bt; int M, N, K; };
struct StaticOrder {
    int nM, nN, nwg, G, c;
    __host__ __device__ void init(int M, int N, int G_, int c_) { nM = M / BM; nN = N / BM; nwg = nM * nN; G = G_; c = c_; }
    __host__ __device__ bool next(int i, Unit& u) const {
        const long L = (long)i * G + c; if (L >= nwg) return false;
        int wgid = (int)L; { const int q = nwg / NXCD, r = nwg % NXCD, xcd = wgid % NXCD, off = wgid / NXCD; wgid = (xcd < r ? xcd * (q + 1) : r * (q + 1) + (xcd - r) * q) + off; }
        const int nig = WGM * nN, gid = wgid / nig, fm = gid * WGM, gsz = (nM - fm) < WGM ? (nM - fm) : WGM;
        u.pm = fm + ((wgid % nig) % gsz); u.pn = (wgid % nig) / gsz; return true;
    }
    __device__ __forceinline__ void a_ready(const Unit&) const {}
    __device__ __forceinline__ void done(const Unit&) const {}
};
__device__ __forceinline__ unsigned cvt_pk_bf16(float lo, float hi) { unsigned r; asm volatile("v_cvt_pk_bf16_f32 %0, %1, %2" : "=v"(r) : "v"(lo), "v"(hi)); return r; }
template <class Epi, class Sched>
__device__ __forceinline__ void gemm_phase(PG8_LAS unsigned char* lds, const Gemm g, const Sched& S, const Epi& E) {
    const int tid = otid(), wid = __builtin_amdgcn_readfirstlane(tid >> 6), lane = tid & 63, wr = wid >> 2, wc = wid & 3, fr = lane & 15, fq = lane >> 4;
    const int K = g.K, nt = K / BK;
    unsigned voffA[2], voffB[2];
#pragma unroll
    for (int i = 0; i < 2; ++i) { int R, C; stage_rc(tid * 16 + i * 8192, R, C); const int Rb = Epi::PERM ? ((R & ~31) + perm32(R & 31)) : R;
        voffA[i] = (unsigned)(R * K + C) * 2u; voffB[i] = (unsigned)(Rb * K + C) * 2u; }
    const size_t kstep = (size_t)(BK * 2);
    const size_t hstep = (size_t)HALF * K * 2;
    const size_t tstep = 2 * hstep;
    const unsigned ldsw = (unsigned)wid * 1024u;
    const int aoff = lds_byte(wr * 64 + fr, fq * 8), boff = lds_byte(wc * 32 + fr, fq * 8);
#define PG8_SA(b, h) (((b) * 2 + (h)) * HTB)
#define PG8_SB(b, h) ((4 + (b) * 2 + (h)) * HTB)
#define PG8_STAGE(bufoff, gbase, voff) do { _Pragma("unroll") for (int _i = 0; _i < 2; ++_i) \
        __builtin_amdgcn_global_load_lds((const unsigned*)((const char*)(gbase) + (voff)[_i]), (PG8_LAS unsigned*)(lds + (bufoff) + ldsw + _i * 8192), 16, 0, 0); } while (0)
#define PG8_LDA(dst, b, h) do { _Pragma("unroll") for (int m = 0; m < 4; ++m) _Pragma("unroll") for (int k = 0; k < 2; ++k) dst[m][k] = *(const PG8_LAS bf16x8*)(lds + PG8_SA(b, h) + aoff + m * 2048 + k * 1024); } while (0)
#define PG8_LDB(dst, b, h) do { _Pragma("unroll") for (int n = 0; n < 2; ++n) _Pragma("unroll") for (int k = 0; k < 2; ++k) dst[n][k] = *(const PG8_LAS bf16x8*)(lds + PG8_SB(b, h) + boff + n * 2048 + k * 1024); } while (0)
#define PG8_MMA(ai, bj, At, Bt) do { __builtin_amdgcn_s_setprio(1); _Pragma("unroll") for (int m = 0; m < 4; ++m) _Pragma("unroll") for (int n = 0; n < 2; ++n) _Pragma("unroll") for (int k = 0; k < 2; ++k) \
        acc[ai][bj][m][n] = __builtin_amdgcn_mfma_f32_16x16x32_bf16(Bt[n][k], At[m][k], acc[ai][bj][m][n], 0, 0, 0); __builtin_amdgcn_s_setprio(0); } while (0)
#define PG8_WAIT_V(n) asm volatile("s_waitcnt vmcnt(" #n ")" ::: "memory")
#define PG8_WAIT_L(n) asm volatile("s_waitcnt lgkmcnt(" #n ")" ::: "memory")
#define PG8_BAR __builtin_amdgcn_s_barrier()
#define PG8_SCHED __builtin_amdgcn_sched_barrier(0)
    Unit cur, nxt; int ui = 0;
    if (!S.next(0, cur)) return;
    f32x4 acc[2][2][4][2];
#pragma unroll
    for (int a = 0; a < 2; ++a)
#pragma unroll
        for (int b = 0; b < 2; ++b)
#pragma unroll
            for (int m = 0; m < 4; ++m)
#pragma unroll
                for (int n = 0; n < 2; ++n) acc[a][b][m][n] = (f32x4){0.f, 0.f, 0.f, 0.f};
    bf16x8 At[4][2], B0[2][2], B1[2][2];
    const char* cA = (const char*)g.A + (size_t)cur.pm * tstep; const char* cB = (const char*)g.Bt + (size_t)cur.pn * tstep;
    S.a_ready(cur);
    PG8_STAGE(PG8_SB(0, 0), cB, voffB); PG8_STAGE(PG8_SA(0, 0), cA, voffA); PG8_STAGE(PG8_SB(0, 1), cB + hstep, voffB); PG8_STAGE(PG8_SA(0, 1), cA + hstep, voffA);
    if (wr == 1) PG8_BAR;
    PG8_WAIT_V(4); PG8_BAR;
    PG8_STAGE(PG8_SB(1, 0), cB + kstep, voffB); PG8_STAGE(PG8_SA(1, 0), cA + kstep, voffA); PG8_STAGE(PG8_SB(1, 1), cB + hstep + kstep, voffB);
    PG8_WAIT_V(6); PG8_BAR;
    for (;;) {
        const bool has_next = S.next(ui + 1, nxt);
        const char* nA = has_next ? (const char*)g.A + (size_t)nxt.pm * tstep : cA; const char* nB = has_next ? (const char*)g.Bt + (size_t)nxt.pn * tstep : cB;
        for (int t = 0; t < nt; t += 2) {
            const bool last = (t == nt - 2);
            const char* a1 = cA + (size_t)(t + 1) * kstep;
            const char* a2 = last ? nA : cA + (size_t)(t + 2) * kstep; const char* b2 = last ? nB : cB + (size_t)(t + 2) * kstep;
            const char* a3 = a2 + kstep; const char* b3 = b2 + kstep;
            if (last && has_next) S.a_ready(nxt);
            PG8_LDB(B0, 0, 0); PG8_SCHED; PG8_LDA(At, 0, 0); PG8_STAGE(PG8_SA(1, 1), a1 + hstep, voffA);
            PG8_WAIT_L(8); PG8_BAR; PG8_WAIT_L(0); PG8_MMA(0, 0, At, B0); PG8_BAR; PG8_SCHED;
            PG8_LDB(B1, 0, 1); PG8_STAGE(PG8_SB(0, 0), b2, voffB);
            PG8_BAR; PG8_WAIT_L(0); PG8_MMA(0, 1, At, B1); PG8_BAR;
            PG8_LDA(At, 0, 1); PG8_STAGE(PG8_SA(0, 0), a2, voffA);
            PG8_BAR; PG8_WAIT_L(0); PG8_MMA(1, 0, At, B0); PG8_BAR; PG8_SCHED;
            PG8_STAGE(PG8_SB(0, 1), b2 + hstep, voffB);
            PG8_WAIT_V(6); PG8_BAR; PG8_MMA(1, 1, At, B1); PG8_BAR;
            PG8_LDB(B0, 1, 0); PG8_SCHED; PG8_LDA(At, 1, 0); PG8_STAGE(PG8_SA(0, 1), a2 + hstep, voffA);
            PG8_WAIT_L(8); PG8_BAR; PG8_WAIT_L(0); PG8_MMA(0, 0, At, B0); PG8_BAR; PG8_SCHED;
            PG8_LDB(B1, 1, 1); PG8_STAGE(PG8_SB(1, 0), b3, voffB);
            PG8_BAR; PG8_WAIT_L(0); PG8_MMA(0, 1, At, B1); PG8_BAR;
            PG8_LDA(At, 1, 1); PG8_STAGE(PG8_SA(1, 0), a3, voffA);
            PG8_BAR; PG8_WAIT_L(0); PG8_MMA(1, 0, At, B0); PG8_BAR; PG8_SCHED;
            PG8_STAGE(PG8_SB(1, 1), b3 + hstep, voffB);
            PG8_WAIT_V(6); PG8_BAR; PG8_MMA(1, 1, At, B1); PG8_BAR;
        }
        if constexpr (!Epi::AFTER_DRAIN) { E(acc, cur, wr, wc, fr, fq); S.done(cur); }
        if (!has_next) break;
#pragma unroll
        for (int a = 0; a < 2; ++a)
#pragma unroll
            for (int b = 0; b < 2; ++b)
#pragma unroll
                for (int m = 0; m < 4; ++m)
#pragma unroll
                    for (int n = 0; n < 2; ++n) acc[a][b][m][n] = (f32x4){0.f, 0.f, 0.f, 0.f};
        cur = nxt; cA = nA; cB = nB; ++ui;
    }
    PG8_WAIT_V(0);
    if (wr == 0) PG8_BAR;
    PG8_BAR;
    if constexpr (Epi::AFTER_DRAIN) { E.fused(acc, cur, wr, wc, fr, fq, lds, wid, lane); S.done(cur); }
#undef PG8_SA
#undef PG8_SB
#undef PG8_STAGE
#undef PG8_LDA
#undef PG8_LDB
#undef PG8_MMA
#undef PG8_WAIT_V
#undef PG8_WAIT_L
#undef PG8_BAR
#undef PG8_SCHED
}
}

struct EpiF32m {
    static constexpr bool PERM = false, AFTER_DRAIN = false;
    float* C; int ldc;
    __device__ __forceinline__ void operator()(const f32x4 (&acc)[2][2][4][2], const pg8::Unit& u, int wr, int wc, int fr, int fq) const {
        const int row0 = u.pm * 256 + wr * 64 + fr, col0 = u.pn * 256 + wc * 32 + 4 * fq;
#pragma unroll
        for (int ai = 0; ai < 2; ++ai)
#pragma unroll
            for (int m = 0; m < 4; ++m) { float* rowp = C + (size_t)(row0 + ai * 128 + m * 16) * ldc + col0;
#pragma unroll
                for (int bj = 0; bj < 2; ++bj)
#pragma unroll
                    for (int n = 0; n < 2; ++n) *(f32x4*)(rowp + bj * 128 + n * 16) = acc[ai][bj][m][n]; }
    }
};
struct EpiB16 {
    static constexpr bool PERM = true, AFTER_DRAIN = false;
    bf16_t* O; int ldc;
    __device__ __forceinline__ void operator()(const f32x4 (&acc)[2][2][4][2], const pg8::Unit& u, int wr, int wc, int fr, int fq) const {
        const int row0 = u.pm * 256 + wr * 64 + fr, col0 = u.pn * 256 + wc * 32 + 8 * fq;
#pragma unroll
        for (int ai = 0; ai < 2; ++ai)
#pragma unroll
            for (int m = 0; m < 4; ++m) { bf16_t* rowp = O + (size_t)(row0 + ai * 128 + m * 16) * ldc + col0;
#pragma unroll
                for (int bj = 0; bj < 2; ++bj) { const f32x4 v0 = acc[ai][bj][m][0], v1 = acc[ai][bj][m][1];
                    u32x4 w; w.x = pg8::cvt_pk_bf16(v0[0], v0[1]); w.y = pg8::cvt_pk_bf16(v0[2], v0[3]); w.z = pg8::cvt_pk_bf16(v1[0], v1[1]); w.w = pg8::cvt_pk_bf16(v1[2], v1[3]);
                    *(u32x4*)(rowp + bj * 128) = w; } }
    }
};
struct EpiSwiglu {
    static constexpr bool PERM = true, AFTER_DRAIN = false;
    bf16_t* O; int ldc;
    __device__ __forceinline__ void operator()(const f32x4 (&acc)[2][2][4][2], const pg8::Unit& u, int wr, int wc, int fr, int fq) const {
        const int row0 = u.pm * 256 + wr * 64 + fr, col0 = u.pn * 128 + wc * 32 + 8 * fq;
#pragma unroll
        for (int ai = 0; ai < 2; ++ai)
#pragma unroll
            for (int m = 0; m < 4; ++m) { bf16_t* rowp = O + (size_t)(row0 + ai * 128 + m * 16) * ldc + col0;
                const f32x4 g0 = acc[ai][0][m][0], g1 = acc[ai][0][m][1], u0 = acc[ai][1][m][0], u1 = acc[ai][1][m][1];
                u32x4 w; w.x = pg8::cvt_pk_bf16(siluf_(g0[0]) * u0[0], siluf_(g0[1]) * u0[1]); w.y = pg8::cvt_pk_bf16(siluf_(g0[2]) * u0[2], siluf_(g0[3]) * u0[3]);
                w.z = pg8::cvt_pk_bf16(siluf_(g1[0]) * u1[0], siluf_(g1[1]) * u1[1]); w.w = pg8::cvt_pk_bf16(siluf_(g1[2]) * u1[2], siluf_(g1[3]) * u1[3]);
                *(u32x4*)rowp = w; }
    }
};
template <class Epi> __device__ __forceinline__ void gemm_fast(LAS unsigned char* lds, const bf16_t* A, const bf16_t* Bt, int M, int N, int K, const Epi& E) {
    pg8::Gemm g; g.A = A; g.Bt = Bt; g.M = M; g.N = N; g.K = K;
    pg8::StaticOrder so; so.init(M, N, (int)gridDim.x, obid());
    pg8::gemm_phase<Epi, pg8::StaticOrder>(lds, g, so, E);
    __syncthreads();
}

template <int MODE> __device__ void mixer_lru(const Params& p, int l, int n, LAS unsigned char* lds) {
    const int tid = otid(), lane = tid & 63, wave = tid >> 6, c = lane & 15, q = lane >> 4;
    unsigned char* ws = p.ws;
    const bf16_t* proj = (const bf16_t*)(ws + WS_PROJ); bf16_t* y = (bf16_t*)(ws + WS_H);
    const bf16_t* LW = (const bf16_t*)(ws + WS_LRUW);
    float* Aprod = (float*)(ws + WS_AP); float* Hend = (float*)(ws + WS_HE); const float* carry = (const float*)(ws + WS_CA);
    LAS bf16_t* XC = (LAS bf16_t*)lds;
    LAS float* STA = (LAS float*)(lds + 66560 + wave * 8704);
    LAS float* STU = STA + 16 * 68;
    const int t0 = n * 64;
    {
        const int ch = tid;
        const float cw0 = p.in[4][(size_t)(l * 4 + 0) * 512 + ch], cw1 = p.in[4][(size_t)(l * 4 + 1) * 512 + ch], cw2 = p.in[4][(size_t)(l * 4 + 2) * 512 + ch], cw3 = p.in[4][(size_t)(l * 4 + 3) * 512 + ch];
        const float cb = p.in[5][(size_t)l * 512 + ch];
#define LDX(s) (((s) >= 0 && (s) < S) ? bf2f(proj[(size_t)(s) * DINP + ch]) : 0.f)
        float xm2 = LDX(t0 - 2), xm1 = LDX(t0 - 1), x0 = LDX(t0);
#pragma unroll 8
        for (int t = 0; t < 64; ++t) { const float x1 = LDX(t0 + t + 1); const float xc = cb + cw0 * xm2 + cw1 * xm1 + cw2 * x0 + cw3 * x1; XC[t * 520 + ch] = f2bf(xc); xm2 = xm1; xm1 = x0; x0 = x1; }
#undef LDX
    }
    __syncthreads();
    {
        const int h = wave, j = lane;
#pragma unroll 1
        for (int dir = 0; dir < 2; ++dir) {
            const float* lam = p.in[10] + (size_t)(l * 2 + dir) * 512 + 64 * h; const float* b_a = p.in[7] + (size_t)(l * 2 + dir) * 512 + 64 * h; const float* b_x = p.in[9] + (size_t)(l * 2 + dir) * 512 + 64 * h;
            const bf16_t* LWa = LW + ((size_t)(dir * 2 + 0) * 8 + h) * 4096 + c * 64 + 8 * q; const bf16_t* LWx = LW + ((size_t)(dir * 2 + 1) * 8 + h) * 4096 + c * 64 + 8 * q;
            float hcar = 0.f, P = 1.f;
            if (MODE == 1) hcar = carry[(size_t)(dir * NCH + n) * 512 + 64 * h + j];
#pragma unroll 1
            for (int g = 0; g < 4; ++g) {
                const int mi = dir == 0 ? g : 3 - g;
                bf16x8 xf[2];
#pragma unroll
                for (int ks = 0; ks < 2; ++ks) xf[ks] = *(const LAS bf16x8*)(XC + (16 * mi + c) * 520 + 64 * h + 32 * ks + 8 * q);
#pragma unroll 1
                for (int nf = 0; nf < 4; ++nf) {
                    f32x4 za = (f32x4){0.f, 0.f, 0.f, 0.f}, zx = za;
                    za = mfma16(*(const bf16x8*)(LWa + nf * 1024), xf[0], za); za = mfma16(*(const bf16x8*)(LWa + nf * 1024 + 32), xf[1], za);
                    zx = mfma16(*(const bf16x8*)(LWx + nf * 1024), xf[0], zx); zx = mfma16(*(const bf16x8*)(LWx + nf * 1024 + 32), xf[1], zx);
                    const int jo = 16 * nf + 4 * q;
                    const f32x4 ba4 = *(const f32x4*)(b_a + jo), bx4 = *(const f32x4*)(b_x + jo), lam4 = *(const f32x4*)(lam + jo);
                    const bf16x4 xc4 = *(const LAS bf16x4*)(XC + (16 * mi + c) * 520 + 64 * h + jo);
                    f32x4 av, uv;
#pragma unroll
                    for (int r = 0; r < 4; ++r) {
                        const float ra = sigmoidf_(za[r] + ba4[r]), ix = sigmoidf_(zx[r] + bx4[r]);
                        const float sp = log1pf(__expf(-lam4[r]));
                        const float la = -8.0f * ra * sp;
                        av[r] = __expf(la);
                        uv[r] = bf2f((bf16_t)xc4[r]) * ix * sqrtf(fmaxf(-expm1f(2.0f * la), 0.f));
                    }
                    *(LAS f32x4*)(STA + c * 68 + jo) = av; *(LAS f32x4*)(STU + c * 68 + jo) = uv;
                }
                LDS_FENCE();
#pragma unroll 1
                for (int s = 0; s < 16; ++s) {
                    const int tl = dir == 0 ? s : 15 - s;
                    const float a = STA[tl * 68 + j], u = STU[tl * 68 + j];
                    hcar = a * hcar + u; P *= a;
                    if (MODE == 1) {
                        const int t = 16 * mi + tl; const size_t yi = (size_t)(t0 + t) * D + 64 * h + j;
                        if (dir == 0) y[yi] = f2bf(hcar);
                        else { const float hf = bf2f(y[yi]); const float gt = bf2f(proj[(size_t)(t0 + t) * DINP + 512 + 64 * h + j]); XC[t * 520 + 64 * h + j] = f2bf((hf + hcar) * geluf_(gt)); }
                    }
                }
                LDS_FENCE();
            }
            if (MODE == 0) { Aprod[(size_t)(dir * NCH + n) * 512 + 64 * h + j] = P; Hend[(size_t)(dir * NCH + n) * 512 + 64 * h + j] = hcar; }
        }
    }
    __syncthreads();
    if (MODE == 1) {
        const int t = tid >> 3, seg = tid & 7;
        float ss = 0.f;
#pragma unroll
        for (int i = 0; i < 8; ++i) { const bf16x8 b = *(const LAS bf16x8*)(XC + t * 520 + 64 * seg + 8 * i);
#pragma unroll
            for (int k = 0; k < 8; ++k) { const float f = bf2f((bf16_t)b[k]); ss += f * f; } }
        ss += __shfl_xor(ss, 1); ss += __shfl_xor(ss, 2); ss += __shfl_xor(ss, 4);
        const float rs = rsqrtf(ss * (1.0f / 512.0f) + EPS);
        const float* gn = p.in[11] + (size_t)l * 512 + 64 * seg;
#pragma unroll 2
        for (int i = 0; i < 8; ++i) { const bf16x8 b = *(const LAS bf16x8*)(XC + t * 520 + 64 * seg + 8 * i); const f32x4 g0 = *(const f32x4*)(gn + 8 * i), g1 = *(const f32x4*)(gn + 8 * i + 4); u32x4 w;
            w.x = pk2(bf2f((bf16_t)b[0]) * rs * g0[0], bf2f((bf16_t)b[1]) * rs * g0[1]); w.y = pk2(bf2f((bf16_t)b[2]) * rs * g0[2], bf2f((bf16_t)b[3]) * rs * g0[3]);
            w.z = pk2(bf2f((bf16_t)b[4]) * rs * g1[0], bf2f((bf16_t)b[5]) * rs * g1[1]); w.w = pk2(bf2f((bf16_t)b[6]) * rs * g1[2], bf2f((bf16_t)b[7]) * rs * g1[3]);
            *(u32x4*)(y + (size_t)(t0 + t) * D + 64 * seg + 8 * i) = w; }
        __syncthreads();
    }
}

template <int MODE> __device__ void mixer_gla(const Params& p, int l, int n, LAS unsigned char* lds) {
    const int tid = otid(), lane = tid & 63, wave = tid >> 6, c = lane & 15, q = lane >> 4;
    unsigned char* ws = p.ws;
    const bf16_t* proj = (const bf16_t*)(ws + WS_PROJ); bf16_t* y = (bf16_t*)(ws + WS_H);
    bf16_t* uT = (bf16_t*)(ws + WS_M); const bf16_t* spT = (const bf16_t*)(ws + WS_M + (size_t)S * D * 2); float* dec = (float*)(ws + WS_DEC);
    LAS float* LA0 = (LAS float*)lds;
    LAS bf16_t* QE0 = (LAS bf16_t*)(lds + 32768);
    LAS bf16_t* VT = (LAS bf16_t*)(lds + 69632);
    LAS bf16_t* P0 = (LAS bf16_t*)(lds + 88064);
    LAS float* SSQ = (LAS float*)(lds + 106496);
    const int t0 = n * 64;
#pragma unroll 1
    for (int h = 0; h < 4; ++h) {
        {
            const int de = tid & 127, dir = de >> 6, e = de & 63, tg = tid >> 7;
            const float* Wg = p.in[12] + (size_t)(l * 2 + dir) * 16 * 256 + 64 * h + e; const float bg = p.in[13][(size_t)(l * 2 + dir) * 256 + 64 * h + e];
            float w[16];
#pragma unroll
            for (int r = 0; r < 16; ++r) w[r] = Wg[(size_t)r * 256];
            LAS float* LA = LA0 + dir * 4096;
#pragma unroll 1
            for (int tt = 0; tt < 16; ++tt) { const int t = tg * 16 + tt;
                const bf16x8 l0 = *(const bf16x8*)(proj + (size_t)(t0 + t) * DINP + 2560 + dir * 16), l1 = *(const bf16x8*)(proj + (size_t)(t0 + t) * DINP + 2560 + dir * 16 + 8);
                float z = bg;
#pragma unroll
                for (int r = 0; r < 8; ++r) { z += bf2f((bf16_t)l0[r]) * w[r]; z += bf2f((bf16_t)l1[r]) * w[8 + r]; }
                LA[t * 64 + e] = (fminf(z, 0.f) - log1pf(__expf(-fabsf(z)))) * (1.0f / 16.0f); }
            const int vv = tid & 127, tq = tid >> 7;
            unsigned wv[8];
#pragma unroll
            for (int i = 0; i < 8; ++i) { const unsigned lo = proj[(size_t)(t0 + 16 * tq + 2 * i) * DINP + 1536 + 128 * h + vv], hi = proj[(size_t)(t0 + 16 * tq + 2 * i + 1) * DINP + 1536 + 128 * h + vv]; wv[i] = lo | (hi << 16); }
            *(LAS u32x4*)(VT + vv * 72 + 16 * tq) = (u32x4){wv[0], wv[1], wv[2], wv[3]}; *(LAS u32x4*)(VT + vv * 72 + 16 * tq + 8) = (u32x4){wv[4], wv[5], wv[6], wv[7]};
        }
        __syncthreads();
        if (tid < 128) {
            const int dir = tid >> 6, d = tid & 63; LAS float* LA = LA0 + dir * 4096; float acc = 0.f;
            if (MODE == 1) {
                if (dir == 0) {
#pragma unroll 8
                    for (int t = 0; t < 64; ++t) { acc += LA[t * 64 + d]; LA[t * 64 + d] = acc; } }
                else {
#pragma unroll 8
                    for (int t = 63; t >= 0; --t) { acc += LA[t * 64 + d]; LA[t * 64 + d] = acc; } }
            } else {
                if (dir == 0) {
#pragma unroll 8
                    for (int t = 63; t >= 0; --t) { const float v = LA[t * 64 + d]; LA[t * 64 + d] = acc; acc += v; } }
                else {
#pragma unroll 8
                    for (int t = 0; t < 64; ++t) { const float v = LA[t * 64 + d]; LA[t * 64 + d] = acc; acc += v; } }
                dec[((size_t)(dir * NCH + n) * 4 + h) * 64 + d] = __expf(acc);
            }
        }
        __syncthreads();
        if (MODE == 1) {
            { const int t = tid >> 3, dg = (tid & 7) * 8;
              const bf16x8 qv = *(const bf16x8*)(proj + (size_t)(t0 + t) * DINP + 1024 + 64 * h + dg), kv = *(const bf16x8*)(proj + (size_t)(t0 + t) * DINP + 1280 + 64 * h + dg);
#pragma unroll
              for (int dir = 0; dir < 2; ++dir) { float qe[8], ke[8];
#pragma unroll
                  for (int k = 0; k < 8; ++k) { const float b = LA0[dir * 4096 + t * 64 + dg + k]; qe[k] = bf2f((bf16_t)qv[k]) * 0.125f * __expf(b); ke[k] = bf2f((bf16_t)kv[k]) * __expf(-b); }
                  *(LAS u32x4*)(QE0 + dir * 9216 + t * 72 + dg) = (u32x4){pk2(qe[0], qe[1]), pk2(qe[2], qe[3]), pk2(qe[4], qe[5]), pk2(qe[6], qe[7])};
                  *(LAS u32x4*)(QE0 + dir * 9216 + 4608 + t * 72 + dg) = (u32x4){pk2(ke[0], ke[1]), pk2(ke[2], ke[3]), pk2(ke[4], ke[5]), pk2(ke[6], ke[7])}; } }
            __syncthreads();
            { const int dir = wave >> 2, ti = wave & 3; LAS bf16_t* QE = QE0 + dir * 9216; LAS bf16_t* KE = QE + 4608; LAS bf16_t* P = P0 + dir * 4608;
              bf16x8 qf[2];
#pragma unroll
              for (int ks = 0; ks < 2; ++ks) qf[ks] = *(const LAS bf16x8*)(QE + (16 * ti + c) * 72 + 32 * ks + 8 * q);
#pragma unroll
              for (int tj = 0; tj < 4; ++tj) { f32x4 sc = (f32x4){0.f, 0.f, 0.f, 0.f};
#pragma unroll
                  for (int ks = 0; ks < 2; ++ks) { const bf16x8 kf = *(const LAS bf16x8*)(KE + (16 * tj + c) * 72 + 32 * ks + 8 * q); sc = mfma16(kf, qf[ks], sc); }
                  const int i = 16 * ti + c, j0 = 16 * tj + 4 * q; float m[4];
#pragma unroll
                  for (int r = 0; r < 4; ++r) { const int j = j0 + r; const bool keep = dir == 0 ? (j <= i) : (j >= i); m[r] = keep ? sc[r] : 0.f; }
                  *(LAS u32x2*)(P + i * 72 + j0) = (u32x2){pk2(m[0], m[1]), pk2(m[2], m[3])}; } }
            __syncthreads();
            { const int ti = wave & 3, vb = (wave >> 2) * 4;
              f32x4 acc[4];
#pragma unroll
              for (int i = 0; i < 4; ++i) acc[i] = (f32x4){0.f, 0.f, 0.f, 0.f};
#pragma unroll
              for (int dir = 0; dir < 2; ++dir) {
                  LAS bf16_t* QE = QE0 + dir * 9216; LAS bf16_t* P = P0 + dir * 4608;
                  const bf16_t* SP = spT + ((size_t)(dir * NCH + n) * 4 + h) * 8192;
#pragma unroll
                  for (int ks = 0; ks < 2; ++ks) {
                      const bf16x8 pf = *(const LAS bf16x8*)(P + (16 * ti + c) * 72 + 32 * ks + 8 * q), qf = *(const LAS bf16x8*)(QE + (16 * ti + c) * 72 + 32 * ks + 8 * q);
#pragma unroll
                      for (int vl = 0; vl < 4; ++vl) { const int vf = vb + vl;
                          const bf16x8 vtf = *(const LAS bf16x8*)(VT + (16 * vf + c) * 72 + 32 * ks + 8 * q); acc[vl] = mfma16(vtf, pf, acc[vl]);
                          const bf16x8 sf = *(const bf16x8*)(SP + (16 * vf + c) * 64 + 32 * ks + 8 * q); acc[vl] = mfma16(sf, qf, acc[vl]); }
                  }
              }
              float ss = 0.f;
#pragma unroll
              for (int vl = 0; vl < 4; ++vl) ss += acc[vl][0] * acc[vl][0] + acc[vl][1] * acc[vl][1] + acc[vl][2] * acc[vl][2] + acc[vl][3] * acc[vl][3];
              ss += __shfl_xor(ss, 16); ss += __shfl_xor(ss, 32);
              const int t = 16 * ti + c;
              if (q == 0) SSQ[t * 2 + (wave >> 2)] = ss;
              __syncthreads();
              const float rs = rsqrtf((SSQ[t * 2] + SSQ[t * 2 + 1]) * (1.0f / 128.0f) + EPS);
              const float* gn = p.in[14] + (size_t)l * 128;
#pragma unroll
              for (int vl = 0; vl < 4; ++vl) { const int v = 16 * (vb + vl) + 4 * q; const f32x4 g4 = *(const f32x4*)(gn + v);
                  const bf16x4 gg = *(const bf16x4*)(proj + (size_t)(t0 + t) * DINP + 2048 + 128 * h + v); float o[4];
#pragma unroll
                  for (int r = 0; r < 4; ++r) o[r] = acc[vl][r] * rs * g4[r] * siluf_(bf2f((bf16_t)gg[r]));
                  *(u32x2*)(y + (size_t)(t0 + t) * D + 512 + 128 * h + v) = (u32x2){pk2(o[0], o[1]), pk2(o[2], o[3])}; }
            }
            __syncthreads();
        } else {
            { const int d = tid & 63, tg = tid >> 6; float kk[8];
#pragma unroll
              for (int i = 0; i < 8; ++i) kk[i] = bf2f(proj[(size_t)(t0 + 8 * tg + i) * DINP + 1280 + 64 * h + d]);
#pragma unroll
              for (int dir = 0; dir < 2; ++dir) { float kd[8];
#pragma unroll
                  for (int i = 0; i < 8; ++i) kd[i] = kk[i] * __expf(LA0[dir * 4096 + (8 * tg + i) * 64 + d]);
                  *(LAS u32x4*)(QE0 + dir * 9216 + d * 72 + 8 * tg) = (u32x4){pk2(kd[0], kd[1]), pk2(kd[2], kd[3]), pk2(kd[4], kd[5]), pk2(kd[6], kd[7])}; } }
            __syncthreads();
            { const int dir = wave >> 2, df = wave & 3; LAS bf16_t* KDT = QE0 + dir * 9216;
              bf16x8 kf[2];
#pragma unroll
              for (int ks = 0; ks < 2; ++ks) kf[ks] = *(const LAS bf16x8*)(KDT + (16 * df + c) * 72 + 32 * ks + 8 * q);
              bf16_t* U = uT + ((size_t)(dir * NCH + n) * 4 + h) * 8192;
#pragma unroll
              for (int vf = 0; vf < 8; ++vf) { f32x4 a = (f32x4){0.f, 0.f, 0.f, 0.f};
#pragma unroll
                  for (int ks = 0; ks < 2; ++ks) { const bf16x8 vtf = *(const LAS bf16x8*)(VT + (16 * vf + c) * 72 + 32 * ks + 8 * q); a = mfma16(kf[ks], vtf, a); }
                  *(u32x2*)(U + (16 * vf + c) * 64 + 16 * df + 4 * q) = (u32x2){pk2(a[0], a[1]), pk2(a[2], a[3])}; } }
            __syncthreads();
        }
    }
}

__device__ void phase_scan(const Params& p) {
    unsigned char* ws = p.ws; const int tid = otid();
    if (tid < 256) {
        const bf16_t* uT = (const bf16_t*)(ws + WS_M); bf16_t* spT = (bf16_t*)(ws + WS_M + (size_t)S * D * 2); const float* dec = (const float*)(ws + WS_DEC);
        for (int gid = obid() * 256 + tid; gid < 65536; gid += gridDim.x * 256) {
            const int dir = gid >> 15, rem = gid & 32767, h = rem >> 13, vd = rem & 8191, d = vd & 63;
            float s = 0.f;
#pragma unroll 8
            for (int st = 0; st < NCH; ++st) { const int n = dir ? (NCH - 1 - st) : st; const size_t idx = ((size_t)(dir * NCH + n) * 4 + h) * 8192 + vd;
                const float u = bf2f(uT[idx]); const float dc = dec[((size_t)(dir * NCH + n) * 4 + h) * 64 + d]; spT[idx] = f2bf(s); s = dc * s + u; }
        }
    } else if (tid < 384 && obid() < 8) {
        const float* Aprod = (const float*)(ws + WS_AP); const float* Hend = (const float*)(ws + WS_HE); float* carry = (float*)(ws + WS_CA);
        const int gid = obid() * 128 + (tid - 256); const int dir = gid >> 9, ch = gid & 511;
        float hc = 0.f;
#pragma unroll 8
        for (int st = 0; st < NCH; ++st) { const int n = dir ? (NCH - 1 - st) : st; const size_t idx = (size_t)(dir * NCH + n) * 512 + ch;
            const float a = Aprod[idx], he = Hend[idx]; carry[idx] = hc; hc = a * hc + he; }
    }
}

#define XB_TMO      128
#define XB_XCNT(j)  (256  + 64 * (j))
#define XB_XSUB(j)  (1280 + 64 * (j))
#define XB_XGEN(j)  (2304 + 64 * (j))
#define XB_TOP      3328
#define XB_TOPGEN   3392
#define XCD_BAR_WORDS 3456
#define XB_SPIN_CAP (1u << 18)

__device__ __forceinline__ unsigned xb_ld(unsigned* p)              { return __hip_atomic_load(p, __ATOMIC_RELAXED, __HIP_MEMORY_SCOPE_AGENT); }
__device__ __forceinline__ unsigned xb_add(unsigned* p, unsigned v) { return __hip_atomic_fetch_add(p, v, __ATOMIC_RELAXED, __HIP_MEMORY_SCOPE_AGENT); }
__device__ __forceinline__ unsigned xb_xcc_id() { return (unsigned)__builtin_amdgcn_s_getreg((3 << 11) | 20) & 0xFu; }
#define XB_SPIN(cond, bar) do { unsigned _sp = 0; while (cond) { __builtin_amdgcn_s_sleep(1); \
    if ((++_sp & 255u) == 0u) { if (xb_ld(&(bar)[XB_TMO])) break; if (_sp > XB_SPIN_CAP) { atomicAdd(&(bar)[XB_TMO], 1u); break; } } } } while (0)

struct XcdBarrier {
    unsigned* bar; unsigned x;
    volatile LAS unsigned* st;
};

__device__ __forceinline__ XcdBarrier xcd_barrier_post(unsigned* bar, volatile LAS unsigned* st) {
    XcdBarrier b; b.bar = bar; b.x = xb_xcc_id(); b.st = st;
    if (threadIdx.x == 0) (void)xb_add(&bar[XB_XCNT(b.x)], 1u);
    return b;
}
__device__ __forceinline__ void xcd_barrier_complete(unsigned* bar, unsigned x, unsigned& nloc, unsigned& nx) {
    const unsigned G = gridDim.x * gridDim.y * gridDim.z;
    unsigned sum, cnt, mine, sp = 0u;
    for (;;) {
        sum = 0u; cnt = 0u; mine = 0u;
#pragma unroll
        for (unsigned j = 0; j < 16; ++j) { const unsigned c = xb_ld(&bar[XB_XCNT(j)]); sum += c; cnt += (c > 0u) ? 1u : 0u; mine = (j == x) ? c : mine; }
        if (sum == G) break;
        __builtin_amdgcn_s_sleep(1);
        if ((++sp & 255u) == 0u) { if (xb_ld(&bar[XB_TMO])) break; if (sp > XB_SPIN_CAP) { atomicAdd(&bar[XB_TMO], 1u); break; } }
    }
    nloc = mine > 0u ? mine : 1u; nx = cnt > 0u ? cnt : 1u;
}

__device__ __forceinline__ void xcd_barrier(const XcdBarrier& b) {
    asm volatile("s_waitcnt vmcnt(0)" ::: "memory");
    __syncthreads();
    if (threadIdx.x == 0) {
        unsigned* bar = b.bar;
        __builtin_amdgcn_s_waitcnt(0);
        unsigned nloc = b.st[0], nx = b.st[1];
        if (nloc == 0u) { xcd_barrier_complete(bar, b.x, nloc, nx); b.st[0] = nloc; b.st[1] = nx; }
        const unsigned old = xb_add(&bar[XB_XSUB(b.x)], 1u);
        const unsigned gen = old / nloc;
        if (old + 1u == (gen + 1u) * nloc) {
            __builtin_amdgcn_fence(__ATOMIC_RELEASE, "agent");
            asm volatile("s_waitcnt vmcnt(0)" ::: "memory");
            const unsigned og = xb_add(&bar[XB_TOP], 1u);
            const unsigned tg = og / nx;
            if (og + 1u == (tg + 1u) * nx) xb_add(&bar[XB_TOPGEN], 1u);
            else XB_SPIN(xb_ld(&bar[XB_TOPGEN]) == tg, bar);
            __builtin_amdgcn_fence(__ATOMIC_ACQUIRE, "agent");
            xb_add(&bar[XB_XGEN(b.x)], 1u);
            asm volatile("s_waitcnt vmcnt(0)" ::: "memory");
        } else {
            XB_SPIN(xb_ld(&bar[XB_XGEN(b.x)]) == gen, bar);
            __builtin_amdgcn_fence(__ATOMIC_ACQUIRE, "agent");
            asm volatile("s_waitcnt vmcnt(0)" ::: "memory");
        }
    }
    __syncthreads();
}

__global__ void __launch_bounds__(NTHR, 2) mk_fwd(Params p) {
    extern __shared__ __attribute__((aligned(16))) unsigned char lds_raw[];
    LAS unsigned char* lds = (LAS unsigned char*)lds_raw;
    unsigned char* ws = p.ws;
    bf16_t* WinT = (bf16_t*)(ws + WS_WIN); bf16_t* WoutT = (bf16_t*)(ws + WS_WOUT); bf16_t* WguT = (bf16_t*)(ws + WS_WGU); bf16_t* WdT = (bf16_t*)(ws + WS_WD);
    bf16_t* Hb = (bf16_t*)(ws + WS_H); bf16_t* PROJ = (bf16_t*)(ws + WS_PROJ); float* Mb = (float*)(ws + WS_M);
    const float* xin = p.in[0]; float* out = p.out;
    volatile LAS unsigned* bst = (volatile LAS unsigned*)(lds + LDS_BYTES - 16);
    if (threadIdx.x == 0) { bst[0] = 0u; bst[1] = 0u; }
    __syncthreads();
    XcdBarrier bar = xcd_barrier_post((unsigned*)(ws + WS_CTL), bst);
    for (int ph = p.ph_lo; ph < p.ph_hi; ++ph) {
        if (ph == p.ph_lo + 1) cg::this_grid().sync();
        else if (ph > p.ph_lo) xcd_barrier(bar);
        if (ph == 9 * NL) { phase_rowprep(out, Mb, p.in[17] + (size_t)(NL - 1) * D, out, nullptr, nullptr); continue; }
        const int l = ph / 9, s = ph % 9;
        switch (s) {
#ifndef PHMASK
#define PHMASK 0x1ff
#endif
        case 0: if (!(PHMASK & 1)) break; phase_weights(p, l, lds);
                if (l == 0) phase_rowprep(xin, nullptr, nullptr, nullptr, p.in[1], Hb);
                else phase_rowprep(out, Mb, p.in[17] + (size_t)(l - 1) * D, out, p.in[1] + (size_t)l * D, Hb);
                break;
        case 1: if (!(PHMASK & 2)) break; gemm_fast(lds, Hb, WinT, S, DINP, D, EpiB16{PROJ, DINP}); break;
        case 2: if (!(PHMASK & 4)) break; for (int n = obid(); n < NCH; n += gridDim.x) mixer_lru<0>(p, l, n, lds);
                for (int n = obid(); n < NCH; n += gridDim.x) mixer_gla<0>(p, l, n, lds); break;
        case 3: if (!(PHMASK & 8)) break; phase_scan(p); break;
        case 4: if (!(PHMASK & 16)) break; for (int n = obid(); n < NCH; n += gridDim.x) mixer_lru<1>(p, l, n, lds);
                for (int n = obid(); n < NCH; n += gridDim.x) mixer_gla<1>(p, l, n, lds); break;
        case 5: if (!(PHMASK & 32)) break; gemm_fast(lds, Hb, WoutT, S, D, D, EpiF32m{Mb, D}); break;
        case 6: if (!(PHMASK & 64)) break; phase_rowprep(l == 0 ? xin : out, Mb, p.in[2] + (size_t)l * D, out, p.in[16] + (size_t)l * D, Hb); break;
        case 7: if (!(PHMASK & 128)) break; gemm_fast(lds, Hb, WguT, S, 2 * DFF, D, EpiSwiglu{PROJ, DFF}); break;
        case 8: if (!(PHMASK & 256)) break; gemm_fast(lds, PROJ, WdT, S, D, DFF, EpiF32m{Mb, D}); break;
        }
    }
}

extern "C" void kernel_launch(void* const* d_in, const int* in_sizes, int n_in, void* d_out, int out_size, void* d_ws, size_t ws_size, hipStream_t stream) {
    static int grid = 0;
    if (grid == 0) {
        if (n_in != 21 || out_size != S * D || ws_size < WS_END) { fprintf(stderr, "kernel_launch: unexpected shapes: n_in %d out %d ws %zu (need %zu)\n", n_in, out_size, ws_size, (size_t)WS_END); grid = -1; return; }
        int dev = 0, cus = 0, per_cu = 0;
        (void)hipGetDevice(&dev); (void)hipDeviceGetAttribute(&cus, hipDeviceAttributeMultiprocessorCount, dev);
        if (hipFuncSetAttribute((const void*)mk_fwd, hipFuncAttributeMaxDynamicSharedMemorySize, LDS_BYTES) != hipSuccess) { fprintf(stderr, "kernel_launch: hipFuncSetAttribute failed\n"); grid = -1; return; }
        if (hipOccupancyMaxActiveBlocksPerMultiprocessor(&per_cu, (const void*)mk_fwd, NTHR, LDS_BYTES) != hipSuccess || per_cu < 1) { fprintf(stderr, "kernel_launch: occupancy query says %d\n", per_cu); per_cu = 1; }
        (void)hipGetLastError();
        grid = cus;
    }
    if (grid < 0) return;
    Params p{};
    for (int i = 0; i < 21; ++i) p.in[i] = (const float*)d_in[i];
    p.out = (float*)d_out; p.ws = (unsigned char*)d_ws;
    (void)hipMemsetAsync((unsigned char*)d_ws + WS_CTL, 0, 16384, stream);
#if ONE_LAUNCH
    p.ph_lo = 0; p.ph_hi = 9 * NL + 1;
    void* args[] = {&p};
    hipError_t e = hipLaunchCooperativeKernel((const void*)mk_fwd, dim3(grid), dim3(NTHR), args, LDS_BYTES, stream);
    if (e != hipSuccess) fprintf(stderr, "cooperative launch failed: %s (grid %d)\n", hipGetErrorString(e), grid);
#else
    for (int ph = 0; ph < 9 * NL + 1; ++ph) { p.ph_lo = ph; p.ph_hi = ph + 1; hipLaunchKernelGGL(mk_fwd, dim3(grid), dim3(NTHR), LDS_BYTES, stream, p); }
#endif
}
```

```cpp
#include <hip/hip_runtime.h>
#include <hip/hip_cooperative_groups.h>
#include <cstdio>
namespace cg = cooperative_groups;

#ifndef REPEAT_SUB
#define REPEAT_SUB 0
#endif
#ifndef NEW0_WRITE
#define NEW0_WRITE 3
#endif
#ifndef ONE_LAUNCH
#define ONE_LAUNCH 1
#endif

#define LAS __attribute__((address_space(3)))
typedef unsigned short bf16_t;
typedef short bf16x8 __attribute__((ext_vector_type(8)));
typedef short bf16x4 __attribute__((ext_vector_type(4)));
typedef float f32x4 __attribute__((ext_vector_type(4)));
typedef unsigned u32x4 __attribute__((ext_vector_type(4)));
typedef unsigned u32x2 __attribute__((ext_vector_type(2)));
typedef float f32x2 __attribute__((ext_vector_type(2)));
typedef __bf16 bf16v2 __attribute__((ext_vector_type(2)));

constexpr int S = 16384, D = 1024, DIN = 2592, DINP = 2816, DFF = 2816, NL = 4, NCH = 256;
constexpr int NTHR = 512;
constexpr int LDS_BYTES = 147456;
constexpr float EPS = 1e-6f;

constexpr size_t WS_CTL = 0;
constexpr size_t WS_WIN = 65536;
constexpr size_t WS_WOUT = WS_WIN + (size_t)DINP * D * 2;
constexpr size_t WS_WGU = WS_WOUT + (size_t)D * D * 2;
constexpr size_t WS_WD = WS_WGU + (size_t)2 * DFF * D * 2;
constexpr size_t WS_LRUW = WS_WD + (size_t)D * DFF * 2;
constexpr size_t WS_GW = WS_LRUW + (size_t)2 * 2 * 8 * 64 * 64 * 2;
constexpr size_t WS_H = WS_GW + (size_t)2 * 256 * 32 * 2;
constexpr size_t WS_PROJ = WS_H + (size_t)S * D * 2;
constexpr size_t WS_M = WS_PROJ + (size_t)S * DINP * 2;
constexpr size_t WS_AP = WS_M + (size_t)S * D * 4;
constexpr size_t WS_HE = WS_AP + (size_t)2 * NCH * 512 * 4;
constexpr size_t WS_CA = WS_HE + (size_t)2 * NCH * 512 * 4;
constexpr size_t WS_DEC = WS_CA + (size_t)2 * NCH * 512 * 4;
constexpr size_t WS_PB = WS_DEC + (size_t)2 * NCH * 4 * 64 * 4;
constexpr size_t WS_END = WS_PB + (size_t)S * 512 * 2;

struct Params { const float* in[21]; float* out; unsigned char* ws; int ph_lo, ph_hi; };

__device__ __forceinline__ float bf2f(bf16_t b) { return __uint_as_float(((unsigned)b) << 16); }
__device__ __forceinline__ bf16_t f2bf(float f) { unsigned u = __float_as_uint(f); return (bf16_t)((u + 0x7fffu + ((u >> 16) & 1u)) >> 16); }
__device__ __forceinline__ unsigned pk2(float lo, float hi) { return (unsigned)f2bf(lo) | ((unsigned)f2bf(hi) << 16); }
__device__ __forceinline__ unsigned cvtpk(float lo, float hi) { const f32x2 v = (f32x2){lo, hi}; const bf16v2 b = __builtin_convertvector(v, bf16v2); return __builtin_bit_cast(unsigned, b); }
__device__ __forceinline__ float sigmoidf_(float x) { return __builtin_amdgcn_rcpf(1.0f + __expf(-x)); }
__device__ __forceinline__ float siluf_(float x) { return x * sigmoidf_(x); }
__device__ __forceinline__ float geluf_(float x) { const float y = 0.7978845608028654f * (x + 0.044715f * x * x * x); const float t = 1.0f - 2.0f * __builtin_amdgcn_rcpf(__expf(2.0f * y) + 1.0f); return 0.5f * x * (1.0f + t); }
__device__ __forceinline__ f32x4 mfma16(bf16x8 a, bf16x8 b, f32x4 c) { return __builtin_amdgcn_mfma_f32_16x16x32_bf16(a, b, c, 0, 0, 0); }
__device__ __forceinline__ int otid() { int t = threadIdx.x; asm volatile("" : "+v"(t)); return t; }
__device__ __forceinline__ int obid() { int t = blockIdx.x; asm volatile("" : "+s"(t)); return t; }
#define LDS_FENCE() asm volatile("s_waitcnt lgkmcnt(0)" ::: "memory")

__device__ __forceinline__ void wtile(const float* __restrict__ src, int ldsrc, int c0, int nvalid, int k0, bf16_t* __restrict__ dst, int lddst, int r0, LAS float* T) {
    const int tid = otid();
    { const int k = tid >> 3, cg8 = (tid & 7) * 8;
      const float* sp = src + (size_t)(k0 + k) * ldsrc + c0 + cg8;
#pragma unroll
      for (int i = 0; i < 2; ++i) { f32x4 v = (f32x4){0.f, 0.f, 0.f, 0.f}; if (cg8 + 4 * i + 3 < nvalid) v = *(const f32x4*)(sp + 4 * i);
          T[k * 65 + cg8 + 4 * i + 0] = v[0]; T[k * 65 + cg8 + 4 * i + 1] = v[1]; T[k * 65 + cg8 + 4 * i + 2] = v[2]; T[k * 65 + cg8 + 4 * i + 3] = v[3]; } }
    __syncthreads();
    { const int r = tid >> 3, kg = (tid & 7) * 8; u32x4 w;
      w.x = pk2(T[(kg + 0) * 65 + r], T[(kg + 1) * 65 + r]); w.y = pk2(T[(kg + 2) * 65 + r], T[(kg + 3) * 65 + r]);
      w.z = pk2(T[(kg + 4) * 65 + r], T[(kg + 5) * 65 + r]); w.w = pk2(T[(kg + 6) * 65 + r], T[(kg + 7) * 65 + r]);
      *(u32x4*)(dst + (size_t)(r0 + r) * lddst + k0 + kg) = w; }
    __syncthreads();
}

__device__ void phase_weights(const Params& p, int l, LAS unsigned char* lds) {
    LAS float* T = (LAS float*)lds;
    unsigned char* ws = p.ws;
    bf16_t* WinT = (bf16_t*)(ws + WS_WIN); bf16_t* WoutT = (bf16_t*)(ws + WS_WOUT); bf16_t* WguT = (bf16_t*)(ws + WS_WGU); bf16_t* WdT = (bf16_t*)(ws + WS_WD); bf16_t* LW = (bf16_t*)(ws + WS_LRUW);
    const float* w_in = p.in[3] + (size_t)l * D * DIN; const float* w_out = p.in[15] + (size_t)l * D * D;
    const float* w_g = p.in[18] + (size_t)l * D * DFF; const float* w_u = p.in[19] + (size_t)l * D * DFF; const float* w_d = p.in[20] + (size_t)l * DFF * D;
    constexpr int T_IN = 44 * 16, T_OUT = 16 * 16, T_GU = 88 * 16, T_D = 16 * 44, T_L = 32;
    constexpr int TOT = T_IN + T_OUT + T_GU + T_D + T_L;
    for (int u = obid(); u < TOT; u += gridDim.x) {
        int v = u;
        if (v < T_IN) { const int rt = v / 16, kt = v % 16; int nv = DIN - rt * 64; nv = nv > 64 ? 64 : (nv < 0 ? 0 : nv); wtile(w_in, DIN, nv > 0 ? rt * 64 : 0, nv, kt * 64, WinT, D, rt * 64, T); continue; }
        v -= T_IN;
        if (v < T_OUT) { const int rt = v / 16, kt = v % 16; wtile(w_out, D, rt * 64, 64, kt * 64, WoutT, D, rt * 64, T); continue; }
        v -= T_OUT;
        if (v < T_GU) { const int rt = v / 16, kt = v % 16; const int r0 = rt * 64, j = r0 / 256, within = r0 % 256; const float* src = within < 128 ? w_g : w_u; const int col = j * 128 + (within & 127);
            wtile(src, DFF, col, 64, kt * 64, WguT, D, r0, T); continue; }
        v -= T_GU;
        if (v < T_D) { const int rt = v / 44, kt = v % 44; wtile(w_d, D, rt * 64, 64, kt * 64, WdT, DFF, rt * 64, T); continue; }
        v -= T_D;
        { const int dir = v / 16, gate = (v / 8) % 2, h = v % 8; const float* src = (gate ? p.in[8] : p.in[6]) + ((size_t)(l * 2 + dir) * 8 + h) * 4096;
          wtile(src, 64, 0, 64, 0, LW + ((size_t)(dir * 2 + gate) * 8 + h) * 4096, 64, 0, T); }
    }
    { bf16_t* GW = (bf16_t*)(ws + WS_GW); const float* wg = p.in[12] + (size_t)l * 2 * 16 * 256;
      for (int idx = obid() * NTHR + otid(); idx < 2 * 256 * 32; idx += gridDim.x * NTHR) { const int dir = idx >> 13, e = (idx >> 5) & 255, r = idx & 31;
          GW[idx] = r < 16 ? f2bf(wg[(size_t)(dir * 16 + r) * 256 + e]) : (bf16_t)0; } }
}

__device__ void phase_rowprep(const float* __restrict__ xsrc, const float* __restrict__ m, const float* __restrict__ gpost, float* __restrict__ xdst, const float* __restrict__ gpre, bf16_t* __restrict__ hdst) {
    const int tid = otid(); const int lane = tid & 63, wave = tid >> 6;
    for (int row = obid() * 8 + wave; row < S; row += gridDim.x * 8) {
        f32x4 xv[4];
#pragma unroll
        for (int i = 0; i < 4; ++i) xv[i] = *(const f32x4*)(xsrc + (size_t)row * D + i * 256 + lane * 4);
        if (m) {
            f32x4 mv[4]; float ss = 0.f;
#pragma unroll
            for (int i = 0; i < 4; ++i) { mv[i] = *(const f32x4*)(m + (size_t)row * D + i * 256 + lane * 4); ss += mv[i][0] * mv[i][0] + mv[i][1] * mv[i][1] + mv[i][2] * mv[i][2] + mv[i][3] * mv[i][3]; }
#pragma unroll
            for (int o = 32; o >= 1; o >>= 1) ss += __shfl_xor(ss, o);
            const float rs = rsqrtf(ss * (1.0f / D) + EPS);
#pragma unroll
            for (int i = 0; i < 4; ++i) { const f32x4 g = *(const f32x4*)(gpost + i * 256 + lane * 4); xv[i] += mv[i] * rs * g; }
        }
        if (xdst) {
#pragma unroll
            for (int i = 0; i < 4; ++i) *(f32x4*)(xdst + (size_t)row * D + i * 256 + lane * 4) = xv[i];
        }
        if (hdst) {
            float ss = 0.f;
#pragma unroll
            for (int i = 0; i < 4; ++i) ss += xv[i][0] * xv[i][0] + xv[i][1] * xv[i][1] + xv[i][2] * xv[i][2] + xv[i][3] * xv[i][3];
#pragma unroll
            for (int o = 32; o >= 1; o >>= 1) ss += __shfl_xor(ss, o);
            const float rs = rsqrtf(ss * (1.0f / D) + EPS);
#pragma unroll
            for (int i = 0; i < 4; ++i) { const f32x4 g = *(const f32x4*)(gpre + i * 256 + lane * 4); const f32x4 hv = xv[i] * rs * g; u32x2 w; w.x = pk2(hv[0], hv[1]); w.y = pk2(hv[2], hv[3]);
                *(u32x2*)(hdst + (size_t)row * D + i * 256 + lane * 4) = w; }
        }
    }
}

template <int EPI> __device__ void gemm_simple(const bf16_t* __restrict__ A, int lda, const bf16_t* __restrict__ Bt, int K, int M, int N, void* __restrict__ Cv, int ldc) {
    const int tid = otid(), lane = tid & 63, wave = tid >> 6, wr = wave >> 2, wc = wave & 3, c = lane & 15, q = lane >> 4;
    const int nM = M / 128, nN = N / 256;
    for (int u = obid(); u < nM * nN; u += gridDim.x) {
        const int pn = u / nM, pm = u % nM; const int m0 = pm * 128 + wr * 64;
        f32x4 acc[4][4];
#pragma unroll
        for (int i = 0; i < 4; ++i)
#pragma unroll
            for (int j = 0; j < 4; ++j) acc[i][j] = (f32x4){0.f, 0.f, 0.f, 0.f};
        const bf16_t* ap = A + (size_t)(m0 + c) * lda + 8 * q;
        const bf16_t* bp = Bt + (size_t)(pn * 256 + wc * 32 + c) * K + 8 * q;
        for (int k0 = 0; k0 < K; k0 += 32) {
            bf16x8 af[4], bfr[4];
#pragma unroll
            for (int mi = 0; mi < 4; ++mi) af[mi] = *(const bf16x8*)(ap + (size_t)(16 * mi) * lda + k0);
#pragma unroll
            for (int nf = 0; nf < 4; ++nf) bfr[nf] = *(const bf16x8*)(bp + (size_t)((nf >> 1) * 128 + (nf & 1) * 16) * K + k0);
#pragma unroll
            for (int mi = 0; mi < 4; ++mi)
#pragma unroll
                for (int nf = 0; nf < 4; ++nf) acc[mi][nf] = mfma16(bfr[nf], af[mi], acc[mi][nf]);
        }
#pragma unroll
        for (int mi = 0; mi < 4; ++mi) { const int row = m0 + 16 * mi + c;
            if (EPI == 2) {
#pragma unroll
                for (int nf = 0; nf < 2; ++nf) { const f32x4 g = acc[mi][nf], uu = acc[mi][nf + 2]; const int col = pn * 128 + wc * 32 + nf * 16 + 4 * q;
                    u32x2 w; w.x = pk2(siluf_(g[0]) * uu[0], siluf_(g[1]) * uu[1]); w.y = pk2(siluf_(g[2]) * uu[2], siluf_(g[3]) * uu[3]);
                    *(u32x2*)((bf16_t*)Cv + (size_t)row * ldc + col) = w; }
            } else {
#pragma unroll
                for (int nf = 0; nf < 4; ++nf) { const int col = pn * 256 + (nf >> 1) * 128 + wc * 32 + (nf & 1) * 16 + 4 * q; const f32x4 v = acc[mi][nf];
                    if (EPI == 0) { u32x2 w; w.x = pk2(v[0], v[1]); w.y = pk2(v[2], v[3]); *(u32x2*)((bf16_t*)Cv + (size_t)row * ldc + col) = w; }
                    else *(f32x4*)((float*)Cv + (size_t)row * ldc + col) = v; }
            }
        }
    }
}

namespace pg8 {
#define PG8_LAS __attribute__((address_space(3)))
constexpr int BM = 256, BK = 64, HALF = 128, HTB = HALF * BK * 2  , STAGE_BYTES = 8 * HTB, NXCD = 8, WGM = 8;
__host__ __device__ __forceinline__ int lds_byte(int r, int c) { const int st = (r >> 4) * 2 + (c >> 5), rr = r & 15, cc = c & 31, ob = rr * 64 + cc * 2; return st * 1024 + (ob ^ (((ob >> 9) & 1) << 5)); }
__host__ __device__ __forceinline__ void stage_rc(int b, int& R, int& C) { const int st = b / 1024, sb = b % 1024, swz = sb ^ (((sb >> 9) & 1) << 5); R = (st >> 1) * 16 + swz / 64; C = (st & 1) * 32 + (swz % 64) / 2; }
__host__ __device__ __forceinline__ int perm32(int rho) { const int n = rho >> 4, i = rho & 15; return 8 * (i >> 2) + 4 * n + (i & 3); }
struct Unit { int pm, pn; };
struct Gemm { const bf16_t* A; const bf16_t* Bt; int M, N, K; };
struct StaticOrder {
    int nM, nN, nwg, G, c;
    __host__ __device__ void init(int M, int N, int G_, int c_) { nM = M / BM; nN = N / BM; nwg = nM * nN; G = G_; c = c_; }
    __host__ __device__ bool next(int i, Unit& u) const {
        const long L = (long)i * G + c; if (L >= nwg) return false;
        int wgid = (int)L; { const int q = nwg / NXCD, r = nwg % NXCD, xcd = wgid % NXCD, off = wgid / NXCD; wgid = (xcd < r ? xcd * (q + 1) : r * (q + 1) + (xcd - r) * q) + off; }
        const int nig = WGM * nN, gid = wgid / nig, fm = gid * WGM, gsz = (nM - fm) < WGM ? (nM - fm) : WGM;
        u.pm = fm + ((wgid % nig) % gsz); u.pn = (wgid % nig) / gsz; return true;
    }
    __device__ __forceinline__ void a_ready(const Unit&) const {}
    __device__ __forceinline__ void done(const Unit&) const {}
};
__device__ __forceinline__ unsigned cvt_pk_bf16(float lo, float hi) { unsigned r; asm volatile("v_cvt_pk_bf16_f32 %0, %1, %2" : "=v"(r) : "v"(lo), "v"(hi)); return r; }
template <class Epi, class Sched>
__device__ __forceinline__ void gemm_phase(PG8_LAS unsigned char* lds, const Gemm g, const Sched& S, const Epi& E) {
    const int tid = otid(), wid = __builtin_amdgcn_readfirstlane(tid >> 6), lane = tid & 63, wr = wid >> 2, wc = wid & 3, fr = lane & 15, fq = lane >> 4;
    const int K = g.K, nt = K / BK;
    unsigned voffA[2], voffB[2];
#pragma unroll
    for (int i = 0; i < 2; ++i) { int R, C; stage_rc(tid * 16 + i * 8192, R, C); const int Rb = Epi::PERM ? ((R & ~31) + perm32(R & 31)) : R;
        voffA[i] = (unsigned)(R * K + C) * 2u; voffB[i] = (unsigned)(Rb * K + C) * 2u; }
    const size_t kstep = (size_t)(BK * 2);
    const size_t hstep = (size_t)HALF * K * 2;
    const size_t tstep = 2 * hstep;
    const unsigned ldsw = (unsigned)wid * 1024u;
    const int aoff = lds_byte(wr * 64 + fr, fq * 8), boff = lds_byte(wc * 32 + fr, fq * 8);
#define PG8_SA(b, h) (((b) * 2 + (h)) * HTB)
#define PG8_SB(b, h) ((4 + (b) * 2 + (h)) * HTB)
#define PG8_STAGE(bufoff, gbase, voff) do { _Pragma("unroll") for (int _i = 0; _i < 2; ++_i) \
        __builtin_amdgcn_global_load_lds((const unsigned*)((const char*)(gbase) + (voff)[_i]), (PG8_LAS unsigned*)(lds + (bufoff) + ldsw + _i * 8192), 16, 0, 0); } while (0)
#define PG8_LDA(dst, b, h) do { _Pragma("unroll") for (int m = 0; m < 4; ++m) _Pragma("unroll") for (int k = 0; k < 2; ++k) dst[m][k] = *(const PG8_LAS bf16x8*)(lds + PG8_SA(b, h) + aoff + m * 2048 + k * 1024); } while (0)
#define PG8_LDB(dst, b, h) do { _Pragma("unroll") for (int n = 0; n < 2; ++n) _Pragma("unroll") for (int k = 0; k < 2; ++k) dst[n][k] = *(const PG8_LAS bf16x8*)(lds + PG8_SB(b, h) + boff + n * 2048 + k * 1024); } while (0)
#define PG8_MMA(ai, bj, At, Bt) do { __builtin_amdgcn_s_setprio(1); _Pragma("unroll") for (int m = 0; m < 4; ++m) _Pragma("unroll") for (int n = 0; n < 2; ++n) _Pragma("unroll") for (int k = 0; k < 2; ++k) \
        acc[ai][bj][m][n] = __builtin_amdgcn_mfma_f32_16x16x32_bf16(Bt[n][k], At[m][k], acc[ai][bj][m][n], 0, 0, 0); __builtin_amdgcn_s_setprio(0); } while (0)
#define PG8_WAIT_V(n) asm volatile("s_waitcnt vmcnt(" #n ")" ::: "memory")
#define PG8_WAIT_L(n) asm volatile("s_waitcnt lgkmcnt(" #n ")" ::: "memory")
#define PG8_BAR __builtin_amdgcn_s_barrier()
#define PG8_SCHED __builtin_amdgcn_sched_barrier(0)
    Unit cur, nxt; int ui = 0;
    if (!S.next(0, cur)) return;
    f32x4 acc[2][2][4][2];
#pragma unroll
    for (int a = 0; a < 2; ++a)
#pragma unroll
        for (int b = 0; b < 2; ++b)
#pragma unroll
            for (int m = 0; m < 4; ++m)
#pragma unroll
                for (int n = 0; n < 2; ++n) acc[a][b][m][n] = (f32x4){0.f, 0.f, 0.f, 0.f};
    bf16x8 At[4][2], B0[2][2], B1[2][2];
    const char* cA = (const char*)g.A + (size_t)cur.pm * tstep; const char* cB = (const char*)g.Bt + (size_t)cur.pn * tstep;
    S.a_ready(cur);
    PG8_STAGE(PG8_SB(0, 0), cB, voffB); PG8_STAGE(PG8_SA(0, 0), cA, voffA); PG8_STAGE(PG8_SB(0, 1), cB + hstep, voffB); PG8_STAGE(PG8_SA(0, 1), cA + hstep, voffA);
    if (wr == 1) PG8_BAR;
    PG8_WAIT_V(4); PG8_BAR;
    PG8_STAGE(PG8_SB(1, 0), cB + kstep, voffB); PG8_STAGE(PG8_SA(1, 0), cA + kstep, voffA); PG8_STAGE(PG8_SB(1, 1), cB + hstep + kstep, voffB);
    PG8_WAIT_V(6); PG8_BAR;
    for (;;) {
        const bool has_next = S.next(ui + 1, nxt);
        const char* nA = has_next ? (const char*)g.A + (size_t)nxt.pm * tstep : cA; const char* nB = has_next ? (const char*)g.Bt + (size_t)nxt.pn * tstep : cB;
        for (int t = 0; t < nt; t += 2) {
            const bool last = (t == nt - 2);
            const char* a1 = cA + (size_t)(t + 1) * kstep;
            const char* a2 = last ? nA : cA + (size_t)(t + 2) * kstep; const char* b2 = last ? nB : cB + (size_t)(t + 2) * kstep;
            const char* a3 = a2 + kstep; const char* b3 = b2 + kstep;
            if (last && has_next) S.a_ready(nxt);
            PG8_LDB(B0, 0, 0); PG8_SCHED; PG8_LDA(At, 0, 0); PG8_STAGE(PG8_SA(1, 1), a1 + hstep, voffA);
            PG8_WAIT_L(8); PG8_BAR; PG8_WAIT_L(0); PG8_MMA(0, 0, At, B0); PG8_BAR; PG8_SCHED;
            PG8_LDB(B1, 0, 1); PG8_STAGE(PG8_SB(0, 0), b2, voffB);
            PG8_BAR; PG8_WAIT_L(0); PG8_MMA(0, 1, At, B1); PG8_BAR;
            PG8_LDA(At, 0, 1); PG8_STAGE(PG8_SA(0, 0), a2, voffA);
            PG8_BAR; PG8_WAIT_L(0); PG8_MMA(1, 0, At, B0); PG8_BAR; PG8_SCHED;
            PG8_STAGE(PG8_SB(0, 1), b2 + hstep, voffB);
            PG8_WAIT_V(6); PG8_BAR; PG8_MMA(1, 1, At, B1); PG8_BAR;
            PG8_LDB(B0, 1, 0); PG8_SCHED; PG8_LDA(At, 1, 0); PG8_STAGE(PG8_SA(0, 1), a2 + hstep, voffA);
            PG8_WAIT_L(8); PG8_BAR; PG8_WAIT_L(0); PG8_MMA(0, 0, At, B0); PG8_BAR; PG8_SCHED;
            PG8_LDB(B1, 1, 1); PG8_STAGE(PG8_SB(1, 0), b3, voffB);
            PG8_BAR; PG8_WAIT_L(0); PG8_MMA(0, 1, At, B1); PG8_BAR;
            PG8_LDA(At, 1, 1); PG8_STAGE(PG8_SA(1, 0), a3, voffA);
            PG8_BAR; PG8_WAIT_L(0); PG8_MMA(1, 0, At, B0); PG8_BAR; PG8_SCHED;
            PG8_STAGE(PG8_SB(1, 1), b3 + hstep, voffB);
            PG8_WAIT_V(6); PG8_BAR; PG8_MMA(1, 1, At, B1); PG8_BAR;
        }
        if constexpr (!Epi::AFTER_DRAIN) { E(acc, cur, wr, wc, fr, fq); S.done(cur); }
        if (!has_next) break;
#pragma unroll
        for (int a = 0; a < 2; ++a)
#pragma unroll
            for (int b = 0; b < 2; ++b)
#pragma unroll
                for (int m = 0; m < 4; ++m)
#pragma unroll
                    for (int n = 0; n < 2; ++n) acc[a][b][m][n] = (f32x4){0.f, 0.f, 0.f, 0.f};
        cur = nxt; cA = nA; cB = nB; ++ui;
    }
    PG8_WAIT_V(0);
    if (wr == 0) PG8_BAR;
    PG8_BAR;
    if constexpr (Epi::AFTER_DRAIN) { E.fused(acc, cur, wr, wc, fr, fq, lds, wid, lane); S.done(cur); }
#undef PG8_SA
#undef PG8_SB
#undef PG8_STAGE
#undef PG8_LDA
#undef PG8_LDB
#undef PG8_MMA
#undef PG8_WAIT_V
#undef PG8_WAIT_L
#undef PG8_BAR
#undef PG8_SCHED
}
}

struct EpiF32m {
    static constexpr bool PERM = false, AFTER_DRAIN = false;
    float* C; int ldc;
    __device__ __forceinline__ void operator()(const f32x4 (&acc)[2][2][4][2], const pg8::Unit& u, int wr, int wc, int fr, int fq) const {
        const int row0 = u.pm * 256 + wr * 64 + fr, col0 = u.pn * 256 + wc * 32 + 4 * fq;
#pragma unroll
        for (int ai = 0; ai < 2; ++ai)
#pragma unroll
            for (int m = 0; m < 4; ++m) { float* rowp = C + (size_t)(row0 + ai * 128 + m * 16) * ldc + col0;
#pragma unroll
                for (int bj = 0; bj < 2; ++bj)
#pragma unroll
                    for (int n = 0; n < 2; ++n) *(f32x4*)(rowp + bj * 128 + n * 16) = acc[ai][bj][m][n]; }
    }
};
struct EpiB16 {
    static constexpr bool PERM = true, AFTER_DRAIN = false;
    bf16_t* O; int ldc;
    __device__ __forceinline__ void operator()(const f32x4 (&acc)[2][2][4][2], const pg8::Unit& u, int wr, int wc, int fr, int fq) const {
        const int row0 = u.pm * 256 + wr * 64 + fr, col0 = u.pn * 256 + wc * 32 + 8 * fq;
#pragma unroll
        for (int ai = 0; ai < 2; ++ai)
#pragma unroll
            for (int m = 0; m < 4; ++m) { bf16_t* rowp = O + (size_t)(row0 + ai * 128 + m * 16) * ldc + col0;
#pragma unroll
                for (int bj = 0; bj < 2; ++bj) { const f32x4 v0 = acc[ai][bj][m][0], v1 = acc[ai][bj][m][1];
                    u32x4 w; w.x = cvtpk(v0[0], v0[1]); w.y = cvtpk(v0[2], v0[3]); w.z = cvtpk(v1[0], v1[1]); w.w = cvtpk(v1[2], v1[3]);
                    *(u32x4*)(rowp + bj * 128) = w; } }
    }
};
struct EpiSwiglu {
    static constexpr bool PERM = true, AFTER_DRAIN = false;
    bf16_t* O; int ldc;
    __device__ __forceinline__ void operator()(const f32x4 (&acc)[2][2][4][2], const pg8::Unit& u, int wr, int wc, int fr, int fq) const {
        const int row0 = u.pm * 256 + wr * 64 + fr, col0 = u.pn * 128 + wc * 32 + 8 * fq;
#pragma unroll
        for (int ai = 0; ai < 2; ++ai)
#pragma unroll
            for (int m = 0; m < 4; ++m) { bf16_t* rowp = O + (size_t)(row0 + ai * 128 + m * 16) * ldc + col0;
                const f32x4 g0 = acc[ai][0][m][0], g1 = acc[ai][0][m][1], u0 = acc[ai][1][m][0], u1 = acc[ai][1][m][1];
                u32x4 w; w.x = cvtpk(siluf_(g0[0]) * u0[0], siluf_(g0[1]) * u0[1]); w.y = cvtpk(siluf_(g0[2]) * u0[2], siluf_(g0[3]) * u0[3]);
                w.z = cvtpk(siluf_(g1[0]) * u1[0], siluf_(g1[1]) * u1[1]); w.w = cvtpk(siluf_(g1[2]) * u1[2], siluf_(g1[3]) * u1[3]);
                *(u32x4*)rowp = w; }
    }
};
template <class Epi> __device__ __forceinline__ void gemm_fast(LAS unsigned char* lds, const bf16_t* A, const bf16_t* Bt, int M, int N, int K, const Epi& E) {
    pg8::Gemm g; g.A = A; g.Bt = Bt; g.M = M; g.N = N; g.K = K;
    pg8::StaticOrder so; so.init(M, N, (int)gridDim.x, obid());
    pg8::gemm_phase<Epi, pg8::StaticOrder>(lds, g, so, E);
    __syncthreads();
}

template <int DIR> __device__ __forceinline__ void lru_dir(const Params& p, int l, int n, int h, int lane, LAS bf16_t* XC, LAS float* STA, LAS float* STU) {
    const int c = lane & 15, q = lane >> 4, j = lane, t0 = n * 64;
    unsigned char* ws = p.ws;
    bf16_t* y = (bf16_t*)(ws + WS_H); bf16_t* PB = (bf16_t*)(ws + WS_PB);
    const bf16_t* LW = (const bf16_t*)(ws + WS_LRUW);
    float* Aprod = (float*)(ws + WS_AP); float* Hend = (float*)(ws + WS_HE);
    const float* lam = p.in[10] + (size_t)(l * 2 + DIR) * 512 + 64 * h; const float* b_a = p.in[7] + (size_t)(l * 2 + DIR) * 512 + 64 * h; const float* b_x = p.in[9] + (size_t)(l * 2 + DIR) * 512 + 64 * h;
    const bf16_t* LWa = LW + ((size_t)(DIR * 2 + 0) * 8 + h) * 4096 + c * 64 + 8 * q; const bf16_t* LWx = LW + ((size_t)(DIR * 2 + 1) * 8 + h) * 4096 + c * 64 + 8 * q;
    bf16x8 wa[4][2], wx[4][2]; f32x4 sp4[4], ba4[4], bx4[4];
#pragma unroll
    for (int nf = 0; nf < 4; ++nf) {
#pragma unroll
        for (int ks = 0; ks < 2; ++ks) { wa[nf][ks] = *(const bf16x8*)(LWa + nf * 1024 + 32 * ks); wx[nf][ks] = *(const bf16x8*)(LWx + nf * 1024 + 32 * ks); }
        const f32x4 lam4 = *(const f32x4*)(lam + 16 * nf + 4 * q); ba4[nf] = *(const f32x4*)(b_a + 16 * nf + 4 * q); bx4[nf] = *(const f32x4*)(b_x + 16 * nf + 4 * q);
#pragma unroll
        for (int r = 0; r < 4; ++r) { const float e = __expf(-lam4[r]); const float l1p = e < 0.05f ? e * (1.0f - e * (0.5f - e * (0.33333334f - e * 0.25f))) : __logf(1.0f + e); sp4[nf][r] = -8.0f * l1p; }
    }
    float hcar = 0.f, P = 1.f;
#pragma unroll 1
    for (int g = 0; g < 4; ++g) {
        const int mi = DIR == 0 ? g : 3 - g;
        bf16_t hfp[16];
        if (DIR == 1) {
#pragma unroll
            for (int s = 0; s < 16; ++s) hfp[s] = y[(size_t)(t0 + 16 * mi + s) * D + 64 * h + j];
        }
        bf16x8 xf[2];
#pragma unroll
        for (int ks = 0; ks < 2; ++ks) xf[ks] = *(const LAS bf16x8*)(XC + (16 * mi + c) * 520 + 64 * h + 32 * ks + 8 * q);
        f32x4 za[4], zx[4];
#pragma unroll
        for (int nf = 0; nf < 4; ++nf) { za[nf] = (f32x4){0.f, 0.f, 0.f, 0.f}; zx[nf] = za[nf];
            za[nf] = mfma16(wa[nf][0], xf[0], za[nf]); za[nf] = mfma16(wa[nf][1], xf[1], za[nf]);
            zx[nf] = mfma16(wx[nf][0], xf[0], zx[nf]); zx[nf] = mfma16(wx[nf][1], xf[1], zx[nf]); }
#pragma unroll
        for (int nf = 0; nf < 4; ++nf) {
            const int jo = 16 * nf + 4 * q;
            const bf16x4 xc4 = *(const LAS bf16x4*)(XC + (16 * mi + c) * 520 + 64 * h + jo);
            const f32x4 zav = za[nf] + ba4[nf], zxv = zx[nf] + bx4[nf];
            f32x4 av, uv;
#pragma unroll
            for (int r = 0; r < 4; ++r) {
                const float ra = sigmoidf_(zav[r]), ix = sigmoidf_(zxv[r]);
                const float la = ra * sp4[nf][r];
                av[r] = __expf(la);
                const float x2 = 2.0f * la;
                float om = -x2 * (1.0f + x2 * (0.5f + x2 * (0.16666667f + x2 * (0.041666668f + x2 * 0.0083333338f))));
                if (__builtin_expect(x2 <= -0.25f, 0)) om = 1.0f - __expf(x2);
                uv[r] = bf2f((bf16_t)xc4[r]) * ix * __builtin_amdgcn_sqrtf(fmaxf(om, 0.f));
            }
            *(LAS f32x4*)(STA + c * 68 + jo) = av; *(LAS f32x4*)(STU + c * 68 + jo) = uv;
        }
        LDS_FENCE();
        float aa[16], uu[16];
#pragma unroll
        for (int s = 0; s < 16; ++s) { aa[s] = STA[s * 68 + j]; uu[s] = STU[s * 68 + j]; }
        LDS_FENCE();
#pragma unroll
        for (int s = 0; s < 16; ++s) {
            const int tl = DIR == 0 ? s : 15 - s;
            hcar = aa[tl] * hcar + uu[tl]; P *= aa[tl];
            const size_t row = (size_t)(t0 + 16 * mi + tl);
            if (DIR == 0) { y[row * D + 64 * h + j] = f2bf(hcar); y[row * D + 512 + 64 * h + j] = f2bf(P); }
            else { y[row * D + 64 * h + j] = f2bf(bf2f(hfp[tl]) + hcar); PB[row * 512 + 64 * h + j] = f2bf(P); }
        }
    }
    Aprod[(size_t)(DIR * NCH + n) * 512 + 64 * h + j] = P; Hend[(size_t)(DIR * NCH + n) * 512 + 64 * h + j] = hcar;
}

template <int MODE> __device__ void mixer_lru(const Params& p, int l, int n, LAS unsigned char* lds) {
    const int tid = otid(), lane = tid & 63, wave = tid >> 6;
    unsigned char* ws = p.ws;
    const bf16_t* proj = (const bf16_t*)(ws + WS_PROJ); bf16_t* y = (bf16_t*)(ws + WS_H);
    LAS bf16_t* XC = (LAS bf16_t*)lds;
    const int t0 = n * 64;
    if (MODE == 0) {
        LAS float* STA = (LAS float*)(lds + 66560 + wave * 8704);
        LAS float* STU = STA + 16 * 68;
        {
            const int ch = tid;
            const float cw0 = p.in[4][(size_t)(l * 4 + 0) * 512 + ch], cw1 = p.in[4][(size_t)(l * 4 + 1) * 512 + ch], cw2 = p.in[4][(size_t)(l * 4 + 2) * 512 + ch], cw3 = p.in[4][(size_t)(l * 4 + 3) * 512 + ch];
            const float cb = p.in[5][(size_t)l * 512 + ch];
            bf16_t xs[67];
#pragma unroll
            for (int i = 0; i < 67; ++i) { const int s_ = t0 - 2 + i; const int sc = s_ < 0 ? 0 : (s_ >= S ? S - 1 : s_); const bf16_t v = proj[(size_t)sc * DINP + ch]; xs[i] = s_ == sc ? v : (bf16_t)0; }
#pragma unroll
            for (int t = 0; t < 64; ++t) { const float xc = cb + cw0 * bf2f(xs[t]) + cw1 * bf2f(xs[t + 1]) + cw2 * bf2f(xs[t + 2]) + cw3 * bf2f(xs[t + 3]); XC[t * 520 + ch] = f2bf(xc); }
        }
        __syncthreads();
        lru_dir<0>(p, l, n, wave, lane, XC, STA, STU);
        lru_dir<1>(p, l, n, wave, lane, XC, STA, STU);
        __syncthreads();
    } else {
        const bf16_t* PB = (const bf16_t*)(ws + WS_PB); const float* carry = (const float*)(ws + WS_CA);
        LAS float* CAR = (LAS float*)(lds + 66560);
        CAR[tid] = carry[(size_t)(0 * NCH + n) * 512 + tid]; CAR[512 + tid] = carry[(size_t)(1 * NCH + n) * 512 + tid];
        __syncthreads();
        const int t = tid >> 3, seg = tid & 7; const size_t row = (size_t)(t0 + t);
#pragma unroll 2
        for (int i = 0; i < 8; ++i) { const int ch = 64 * seg + 8 * i;
            const bf16x8 h0 = *(const bf16x8*)(y + row * D + ch), pf = *(const bf16x8*)(y + row * D + 512 + ch), pb = *(const bf16x8*)(PB + row * 512 + ch), gt = *(const bf16x8*)(proj + row * DINP + 512 + ch);
            float v[8];
#pragma unroll
            for (int k = 0; k < 8; ++k) v[k] = (bf2f((bf16_t)h0[k]) + bf2f((bf16_t)pf[k]) * CAR[ch + k] + bf2f((bf16_t)pb[k]) * CAR[512 + ch + k]) * geluf_(bf2f((bf16_t)gt[k]));
            *(LAS u32x4*)(XC + t * 520 + ch) = (u32x4){pk2(v[0], v[1]), pk2(v[2], v[3]), pk2(v[4], v[5]), pk2(v[6], v[7])}; }
        __syncthreads();
        float ss = 0.f;
#pragma unroll
        for (int i = 0; i < 8; ++i) { const bf16x8 b = *(const LAS bf16x8*)(XC + t * 520 + 64 * seg + 8 * i);
#pragma unroll
            for (int k = 0; k < 8; ++k) { const float f = bf2f((bf16_t)b[k]); ss += f * f; } }
        ss += __shfl_xor(ss, 1); ss += __shfl_xor(ss, 2); ss += __shfl_xor(ss, 4);
        const float rs = rsqrtf(ss * (1.0f / 512.0f) + EPS);
        const float* gn = p.in[11] + (size_t)l * 512 + 64 * seg;
#pragma unroll 2
        for (int i = 0; i < 8; ++i) { const bf16x8 b = *(const LAS bf16x8*)(XC + t * 520 + 64 * seg + 8 * i); const f32x4 g0 = *(const f32x4*)(gn + 8 * i), g1 = *(const f32x4*)(gn + 8 * i + 4); u32x4 w;
            w.x = pk2(bf2f((bf16_t)b[0]) * rs * g0[0], bf2f((bf16_t)b[1]) * rs * g0[1]); w.y = pk2(bf2f((bf16_t)b[2]) * rs * g0[2], bf2f((bf16_t)b[3]) * rs * g0[3]);
            w.z = pk2(bf2f((bf16_t)b[4]) * rs * g1[0], bf2f((bf16_t)b[5]) * rs * g1[1]); w.w = pk2(bf2f((bf16_t)b[6]) * rs * g1[2], bf2f((bf16_t)b[7]) * rs * g1[3]);
            *(u32x4*)(y + (size_t)(t0 + t) * D + 64 * seg + 8 * i) = w; }
        __syncthreads();
    }
}

__device__ __forceinline__ bf16x8 pack8(const f32x4 a, const f32x4 b) {
    const u32x4 w = (u32x4){cvtpk(a[0], a[1]), cvtpk(a[2], a[3]), cvtpk(b[0], b[1]), cvtpk(b[2], b[3])}; return __builtin_bit_cast(bf16x8, w); }
#define SLOT(ks, q, jj) (32 * (ks) + 16 * ((jj) >> 2) + 4 * (q) + ((jj) & 3))

template <int MODE> __device__ void mixer_gla(const Params& p, int l, int n, LAS unsigned char* lds) {
    const int tid = otid(), lane = tid & 63, wave = tid >> 6, c = lane & 15, q = lane >> 4;
    const int h = wave >> 1, vh = wave & 1;
    unsigned char* ws = p.ws;
    const bf16_t* proj = (const bf16_t*)(ws + WS_PROJ); bf16_t* y = (bf16_t*)(ws + WS_H); const bf16_t* GW = (const bf16_t*)(ws + WS_GW);
    bf16_t* uT = (bf16_t*)(ws + WS_M); const bf16_t* spT = (const bf16_t*)(ws + WS_M + (size_t)S * D * 2); float* dec = (float*)(ws + WS_DEC);
    LAS bf16_t* VTw = (LAS bf16_t*)(lds + 66560 + wave * 9216);
    LAS float* SSQ = (LAS float*)(lds + 66560 + 8 * 9216);
    const int t0 = n * 64;
    const f32x4 zero4 = (f32x4){0.f, 0.f, 0.f, 0.f};
    {
        unsigned wv[32];
#pragma unroll
        for (int i = 0; i < 32; ++i) { const bf16_t* vp = proj + (size_t)(t0 + 2 * i) * DINP + 1536 + 128 * h + 64 * vh + lane; wv[i] = (unsigned)vp[0] | ((unsigned)vp[DINP] << 16); }
#pragma unroll
        for (int g = 0; g < 8; ++g) *(LAS u32x4*)(VTw + lane * 72 + 8 * g) = (u32x4){wv[4 * g], wv[4 * g + 1], wv[4 * g + 2], wv[4 * g + 3]};
    }
    LDS_FENCE();
    f32x4 acc[4][4];
#pragma unroll
    for (int a = 0; a < 4; ++a)
#pragma unroll
        for (int b = 0; b < 4; ++b) acc[a][b] = zero4;
#pragma unroll 1
    for (int dir = 0; dir < 2; ++dir) {
        bf16x8 laop[4][2]; float tot[4];
        {
            bf16x8 lrf[4], gwf[4]; float bgv[4];
#pragma unroll
            for (int tt = 0; tt < 4; ++tt) { lrf[tt] = (bf16x8){0, 0, 0, 0, 0, 0, 0, 0}; if (q < 2) lrf[tt] = *(const bf16x8*)(proj + (size_t)(t0 + 16 * tt + c) * DINP + 2560 + dir * 16 + 8 * q); }
#pragma unroll
            for (int ef = 0; ef < 4; ++ef) { gwf[ef] = *(const bf16x8*)(GW + (size_t)(dir * 256 + 64 * h + 16 * ef + c) * 32 + 8 * q); bgv[ef] = p.in[13][(size_t)(l * 2 + dir) * 256 + 64 * h + 16 * ef + c]; }
#pragma unroll
            for (int ef = 0; ef < 4; ++ef) { tot[ef] = 0.f;
#pragma unroll
                for (int ks = 0; ks < 2; ++ks) { f32x4 la2[2];
#pragma unroll
                    for (int t2 = 0; t2 < 2; ++t2) { const f32x4 z = mfma16(lrf[2 * ks + t2], gwf[ef], zero4);
#pragma unroll
                        for (int r = 0; r < 4; ++r) { const float zz = z[r] + bgv[ef]; const float la = (fminf(zz, 0.f) - __logf(1.0f + __expf(-fabsf(zz)))) * (1.0f / 16.0f); la2[t2][r] = la; tot[ef] += la; } }
                    laop[ef][ks] = pack8(la2[0], la2[1]); __builtin_amdgcn_sched_barrier(0); } }
        }
        if (MODE == 1) {
            bf16x8 QEop[4][2], KEop[4][2];
            bf16x4 qv[4][4], kv[4][4];
#pragma unroll
            for (int tj = 0; tj < 4; ++tj)
#pragma unroll
                for (int ef = 0; ef < 4; ++ef) { const bf16_t* rp = proj + (size_t)(t0 + 16 * tj + c) * DINP + 64 * h + 4 * q + 16 * ef; qv[tj][ef] = *(const bf16x4*)(rp + 1024); kv[tj][ef] = *(const bf16x4*)(rp + 1280); }
            __builtin_amdgcn_sched_barrier(0);
#pragma unroll
            for (int tj = 0; tj < 4; ++tj) {
                const int t = 16 * tj + c;
                bf16x8 mk[2];
#pragma unroll
                for (int ks = 0; ks < 2; ++ks)
#pragma unroll
                    for (int jj = 0; jj < 8; ++jj) { const int sidx = SLOT(ks, q, jj); const bool on = dir == 0 ? sidx <= t : sidx >= t; mk[ks][jj] = on ? (short)0x3F80 : (short)0; }
#pragma unroll
                for (int ks2 = 0; ks2 < 2; ++ks2) { f32x4 qe2[2], ke2[2];
#pragma unroll
                    for (int e2 = 0; e2 < 2; ++e2) { const int ef = 2 * ks2 + e2;
                        f32x4 b = mfma16(laop[ef][0], mk[0], zero4); b = mfma16(laop[ef][1], mk[1], b);
#pragma unroll
                        for (int r = 0; r < 4; ++r) { qe2[e2][r] = bf2f((bf16_t)qv[tj][ef][r]) * 0.125f * __expf(b[r]); ke2[e2][r] = bf2f((bf16_t)kv[tj][ef][r]) * __expf(-b[r]); } }
                    QEop[tj][ks2] = pack8(qe2[0], qe2[1]); KEop[tj][ks2] = pack8(ke2[0], ke2[1]); }
                __builtin_amdgcn_sched_barrier(0);
            }
            const bf16_t* SP = spT + ((size_t)(dir * NCH + n) * 4 + h) * 8192 + (size_t)(64 * vh) * 64;
            bf16x8 spf[4][2];
#pragma unroll
            for (int vf = 0; vf < 4; ++vf)
#pragma unroll
                for (int ks = 0; ks < 2; ++ks) { const u32x2 s0 = *(const u32x2*)(SP + (16 * vf + c) * 64 + 32 * ks + 4 * q), s1 = *(const u32x2*)(SP + (16 * vf + c) * 64 + 32 * ks + 16 + 4 * q);
                    spf[vf][ks] = __builtin_bit_cast(bf16x8, (u32x4){s0.x, s0.y, s1.x, s1.y}); }
            __builtin_amdgcn_sched_barrier(0);
            bf16x8 Pop[4][2];
#pragma unroll
            for (int ti = 0; ti < 4; ++ti)
#pragma unroll
                for (int ksp = 0; ksp < 2; ++ksp) { f32x4 pm[2];
#pragma unroll
                    for (int j2 = 0; j2 < 2; ++j2) { const int tjj = 2 * ksp + j2;
                        f32x4 sc = mfma16(KEop[tjj][0], QEop[ti][0], zero4); sc = mfma16(KEop[tjj][1], QEop[ti][1], sc);
#pragma unroll
                        for (int r = 0; r < 4; ++r) { const int j = 16 * tjj + 4 * q + r, i = 16 * ti + c; const bool keep = dir == 0 ? j <= i : j >= i; pm[j2][r] = keep ? sc[r] : 0.f; } }
                    Pop[ti][ksp] = pack8(pm[0], pm[1]); __builtin_amdgcn_sched_barrier(0); }
#pragma unroll
            for (int vf = 0; vf < 4; ++vf)
#pragma unroll
                for (int ks = 0; ks < 2; ++ks) {
                    const u32x2 v0 = *(const LAS u32x2*)(VTw + (16 * vf + c) * 72 + 32 * ks + 4 * q), v1 = *(const LAS u32x2*)(VTw + (16 * vf + c) * 72 + 32 * ks + 16 + 4 * q);
                    const bf16x8 vtf = __builtin_bit_cast(bf16x8, (u32x4){v0.x, v0.y, v1.x, v1.y});
#pragma unroll
                    for (int ti = 0; ti < 4; ++ti) { acc[vf][ti] = mfma16(vtf, Pop[ti][ks], acc[vf][ti]); acc[vf][ti] = mfma16(spf[vf][ks], QEop[ti][ks], acc[vf][ti]); }
                    __builtin_amdgcn_sched_barrier(0);
                }
        } else {
#pragma unroll
            for (int ef = 0; ef < 4; ++ef) { float tt = tot[ef]; tt += __shfl_xor(tt, 16); tt += __shfl_xor(tt, 32);
                if ((NEW0_WRITE & 1) && vh == 0 && q == 0) dec[((size_t)(dir * NCH + n) * 4 + h) * 64 + 16 * ef + c] = __expf(tt); }
            bf16x8 kn[4][2];
#pragma unroll
            for (int tj = 0; tj < 4; ++tj)
#pragma unroll
                for (int ks = 0; ks < 2; ++ks) kn[tj][ks] = *(const bf16x8*)(proj + (size_t)(t0 + 16 * tj + c) * DINP + 1280 + 64 * h + 32 * ks + 8 * q);
            bf16x8 ident[2];
#pragma unroll
            for (int e1 = 0; e1 < 2; ++e1)
#pragma unroll
                for (int jj = 0; jj < 8; ++jj) ident[e1][jj] = (8 * q + jj == 16 * e1 + c) ? (short)0x3F80 : (short)0;
            bf16x8 kdop[4][2];
#pragma unroll
            for (int ks = 0; ks < 2; ++ks) {
                bf16x8 mk[2][2];
#pragma unroll
                for (int t2 = 0; t2 < 2; ++t2)
#pragma unroll
                    for (int k2 = 0; k2 < 2; ++k2)
#pragma unroll
                        for (int jj = 0; jj < 8; ++jj) { const int tp = 16 * (2 * ks + t2) + c, sidx = SLOT(k2, q, jj); const bool on = dir == 0 ? sidx > tp : sidx < tp; mk[t2][k2][jj] = on ? (short)0x3F80 : (short)0; }
#pragma unroll
                for (int ef = 0; ef < 4; ++ef) { f32x4 kd2[2];
#pragma unroll
                    for (int t2 = 0; t2 < 2; ++t2) { const int tj = 2 * ks + t2;
                        f32x4 E = mfma16(mk[t2][0], laop[ef][0], zero4); E = mfma16(mk[t2][1], laop[ef][1], E);
                        const f32x4 kR = mfma16(kn[tj][ef >> 1], ident[ef & 1], zero4);
#pragma unroll
                        for (int r = 0; r < 4; ++r) kd2[t2][r] = kR[r] * __expf(E[r]); }
                    kdop[ef][ks] = pack8(kd2[0], kd2[1]); __builtin_amdgcn_sched_barrier(0); }
            }
            bf16_t* U = uT + ((size_t)(dir * NCH + n) * 4 + h) * 8192 + (size_t)(64 * vh) * 64;
#pragma unroll
            for (int vf = 0; vf < 4; ++vf) { bf16x8 vtf[2];
#pragma unroll
                for (int ks = 0; ks < 2; ++ks) { const u32x2 v0 = *(const LAS u32x2*)(VTw + (16 * vf + c) * 72 + 32 * ks + 4 * q), v1 = *(const LAS u32x2*)(VTw + (16 * vf + c) * 72 + 32 * ks + 16 + 4 * q);
                    vtf[ks] = __builtin_bit_cast(bf16x8, (u32x4){v0.x, v0.y, v1.x, v1.y}); }
#pragma unroll
                for (int ef = 0; ef < 4; ++ef) { f32x4 u = mfma16(kdop[ef][0], vtf[0], zero4); u = mfma16(kdop[ef][1], vtf[1], u);
                    if (NEW0_WRITE & 2) *(u32x2*)(U + (16 * vf + c) * 64 + 16 * ef + 4 * q) = (u32x2){cvtpk(u[0], u[1]), cvtpk(u[2], u[3])}; } }
        }
    }
    if (MODE == 1) {
#pragma unroll
        for (int ti = 0; ti < 4; ++ti) { float ss = 0.f;
#pragma unroll
            for (int vf = 0; vf < 4; ++vf) ss += acc[vf][ti][0] * acc[vf][ti][0] + acc[vf][ti][1] * acc[vf][ti][1] + acc[vf][ti][2] * acc[vf][ti][2] + acc[vf][ti][3] * acc[vf][ti][3];
            ss += __shfl_xor(ss, 16); ss += __shfl_xor(ss, 32);
            if (q == 0) SSQ[(h * 64 + 16 * ti + c) * 2 + vh] = ss; }
        __syncthreads();
        const float* gn = p.in[14] + (size_t)l * 128;
#pragma unroll
        for (int ti = 0; ti < 4; ++ti) { const int t = 16 * ti + c; const float rs = rsqrtf((SSQ[(h * 64 + t) * 2] + SSQ[(h * 64 + t) * 2 + 1]) * (1.0f / 128.0f) + EPS);
#pragma unroll
            for (int vf = 0; vf < 4; ++vf) { const int v = 64 * vh + 16 * vf + 4 * q; const f32x4 g4 = *(const f32x4*)(gn + v);
                const bf16x4 gg = *(const bf16x4*)(proj + (size_t)(t0 + t) * DINP + 2048 + 128 * h + v); float o[4];
#pragma unroll
                for (int r = 0; r < 4; ++r) o[r] = acc[vf][ti][r] * rs * g4[r] * siluf_(bf2f((bf16_t)gg[r]));
                *(u32x2*)(y + (size_t)(t0 + t) * D + 512 + 128 * h + v) = (u32x2){pk2(o[0], o[1]), pk2(o[2], o[3])}; } }
    }
    __syncthreads();
}

__device__ void phase_scan(const Params& p) {
    unsigned char* ws = p.ws; const int tid = otid();
    if (tid < 256) {
        const bf16_t* __restrict__ uT = (const bf16_t*)(ws + WS_M); bf16_t* __restrict__ spT = (bf16_t*)(ws + WS_M + (size_t)S * D * 2); const float* __restrict__ dec = (const float*)(ws + WS_DEC);
        for (int gid = obid() * 256 + tid; gid < 65536; gid += gridDim.x * 256) {
            const int dir = gid >> 15, rem = gid & 32767, h = rem >> 13, vd = rem & 8191, d = vd & 63;
            float s = 0.f;
            const long step = dir ? -1 : 1; const int nfirst = dir ? NCH - 1 : 0;
            const bf16_t* up = uT + ((size_t)(dir * NCH + nfirst) * 4 + h) * 8192 + vd; bf16_t* sp = spT + ((size_t)(dir * NCH + nfirst) * 4 + h) * 8192 + vd;
            const float* dp = dec + ((size_t)(dir * NCH + nfirst) * 4 + h) * 64 + d;
#pragma unroll 1
            for (int st = 0; st < NCH; st += 16) {
                bf16_t ub[16]; float db[16];
#pragma unroll
                for (int i = 0; i < 16; ++i) { ub[i] = up[(long)(st + i) * step * 32768]; db[i] = dp[(long)(st + i) * step * 256]; }
#pragma unroll
                for (int i = 0; i < 16; ++i) { sp[(long)(st + i) * step * 32768] = f2bf(s); s = db[i] * s + bf2f(ub[i]); }
            }
        }
    } else if (tid < 384 && obid() < 8) {
        const float* __restrict__ Aprod = (const float*)(ws + WS_AP); const float* __restrict__ Hend = (const float*)(ws + WS_HE); float* __restrict__ carry = (float*)(ws + WS_CA);
        const int gid = obid() * 128 + (tid - 256); const int dir = gid >> 9, ch = gid & 511;
        float hc = 0.f;
        const long step = dir ? -1 : 1; const size_t base = (size_t)(dir * NCH + (dir ? NCH - 1 : 0)) * 512 + ch;
#pragma unroll 1
        for (int st = 0; st < NCH; st += 32) {
            float ab[32], hb[32];
#pragma unroll
            for (int i = 0; i < 32; ++i) { ab[i] = Aprod[base + (long)(st + i) * step * 512]; hb[i] = Hend[base + (long)(st + i) * step * 512]; }
#pragma unroll
            for (int i = 0; i < 32; ++i) { carry[base + (long)(st + i) * step * 512] = hc; hc = ab[i] * hc + hb[i]; }
        }
    }
}

#define XB_TMO      128
#define XB_XCNT(j)  (256  + 64 * (j))
#define XB_XSUB(j)  (1280 + 64 * (j))
#define XB_XGEN(j)  (2304 + 64 * (j))
#define XB_TOP      3328
#define XB_TOPGEN   3392
#define XCD_BAR_WORDS 3456
#define XB_SPIN_CAP (1u << 18)

__device__ __forceinline__ unsigned xb_ld(unsigned* p)              { return __hip_atomic_load(p, __ATOMIC_RELAXED, __HIP_MEMORY_SCOPE_AGENT); }
__device__ __forceinline__ unsigned xb_add(unsigned* p, unsigned v) { return __hip_atomic_fetch_add(p, v, __ATOMIC_RELAXED, __HIP_MEMORY_SCOPE_AGENT); }
__device__ __forceinline__ unsigned xb_xcc_id() { return (unsigned)__builtin_amdgcn_s_getreg((3 << 11) | 20) & 0xFu; }
#define XB_SPIN(cond, bar) do { unsigned _sp = 0; while (cond) { __builtin_amdgcn_s_sleep(1); \
    if ((++_sp & 255u) == 0u) { if (xb_ld(&(bar)[XB_TMO])) break; if (_sp > XB_SPIN_CAP) { atomicAdd(&(bar)[XB_TMO], 1u); break; } } } } while (0)

struct XcdBarrier {
    unsigned* bar; unsigned x;
    volatile LAS unsigned* st;
};

__device__ __forceinline__ XcdBarrier xcd_barrier_post(unsigned* bar, volatile LAS unsigned* st) {
    XcdBarrier b; b.bar = bar; b.x = xb_xcc_id(); b.st = st;
    if (threadIdx.x == 0) (void)xb_add(&bar[XB_XCNT(b.x)], 1u);
    return b;
}
__device__ __forceinline__ void xcd_barrier_complete(unsigned* bar, unsigned x, unsigned& nloc, unsigned& nx) {
    const unsigned G = gridDim.x * gridDim.y * gridDim.z;
    unsigned sum, cnt, mine, sp = 0u;
    for (;;) {
        sum = 0u; cnt = 0u; mine = 0u;
#pragma unroll
        for (unsigned j = 0; j < 16; ++j) { const unsigned c = xb_ld(&bar[XB_XCNT(j)]); sum += c; cnt += (c > 0u) ? 1u : 0u; mine = (j == x) ? c : mine; }
        if (sum == G) break;
        __builtin_amdgcn_s_sleep(1);
        if ((++sp & 255u) == 0u) { if (xb_ld(&bar[XB_TMO])) break; if (sp > XB_SPIN_CAP) { atomicAdd(&bar[XB_TMO], 1u); break; } }
    }
    nloc = mine > 0u ? mine : 1u; nx = cnt > 0u ? cnt : 1u;
}

__device__ __forceinline__ void xcd_barrier(const XcdBarrier& b) {
    asm volatile("s_waitcnt vmcnt(0)" ::: "memory");
    __syncthreads();
    if (threadIdx.x == 0) {
        unsigned* bar = b.bar;
        __builtin_amdgcn_s_waitcnt(0);
        unsigned nloc = b.st[0], nx = b.st[1];
        if (nloc == 0u) { xcd_barrier_complete(bar, b.x, nloc, nx); b.st[0] = nloc; b.st[1] = nx; }
        const unsigned old = xb_add(&bar[XB_XSUB(b.x)], 1u);
        const unsigned gen = old / nloc;
        if (old + 1u == (gen + 1u) * nloc) {
            __builtin_amdgcn_fence(__ATOMIC_RELEASE, "agent");
            asm volatile("s_waitcnt vmcnt(0)" ::: "memory");
            const unsigned og = xb_add(&bar[XB_TOP], 1u);
            const unsigned tg = og / nx;
            if (og + 1u == (tg + 1u) * nx) xb_add(&bar[XB_TOPGEN], 1u);
            else XB_SPIN(xb_ld(&bar[XB_TOPGEN]) == tg, bar);
            __builtin_amdgcn_fence(__ATOMIC_ACQUIRE, "agent");
            xb_add(&bar[XB_XGEN(b.x)], 1u);
            asm volatile("s_waitcnt vmcnt(0)" ::: "memory");
        } else {
            XB_SPIN(xb_ld(&bar[XB_XGEN(b.x)]) == gen, bar);
            __builtin_amdgcn_fence(__ATOMIC_ACQUIRE, "agent");
            asm volatile("s_waitcnt vmcnt(0)" ::: "memory");
        }
    }
    __syncthreads();
}

__global__ void __launch_bounds__(NTHR, 2) mk_fwd(Params p) {
    extern __shared__ __attribute__((aligned(16))) unsigned char lds_raw[];
    LAS unsigned char* lds = (LAS unsigned char*)lds_raw;
    unsigned char* ws = p.ws;
    bf16_t* WinT = (bf16_t*)(ws + WS_WIN); bf16_t* WoutT = (bf16_t*)(ws + WS_WOUT); bf16_t* WguT = (bf16_t*)(ws + WS_WGU); bf16_t* WdT = (bf16_t*)(ws + WS_WD);
    bf16_t* Hb = (bf16_t*)(ws + WS_H); bf16_t* PROJ = (bf16_t*)(ws + WS_PROJ); float* Mb = (float*)(ws + WS_M);
    const float* xin = p.in[0]; float* out = p.out;
    volatile LAS unsigned* bst = (volatile LAS unsigned*)(lds + LDS_BYTES - 16);
    if (threadIdx.x == 0) { bst[0] = 0u; bst[1] = 0u; }
    __syncthreads();
    XcdBarrier bar = xcd_barrier_post((unsigned*)(ws + WS_CTL), bst);
    for (int ph = p.ph_lo; ph < p.ph_hi; ++ph) {
        if (ph == p.ph_lo + 1) cg::this_grid().sync();
        else if (ph > p.ph_lo) xcd_barrier(bar);
        if (ph == 9 * NL) { phase_rowprep(out, Mb, p.in[17] + (size_t)(NL - 1) * D, out, nullptr, nullptr); continue; }
        const int l = ph / 9, s = ph % 9;
#ifndef REPEAT_MASK
#define REPEAT_MASK 0
#endif
        for (int rep = 0; rep < (((REPEAT_MASK >> s) & 1) ? 2 : 1); ++rep) {
        if (rep) xcd_barrier(bar);
        switch (s) {
#ifndef PHMASK
#define PHMASK 0x1ff
#endif
        case 0: if (!(PHMASK & 1)) break; phase_weights(p, l, lds);
                if (rep) break;
                if (l == 0) phase_rowprep(xin, nullptr, nullptr, nullptr, p.in[1], Hb);
                else phase_rowprep(out, Mb, p.in[17] + (size_t)(l - 1) * D, out, p.in[1] + (size_t)l * D, Hb);
                break;
        case 1: if (!(PHMASK & 2)) break; gemm_fast(lds, Hb, WinT, S, DINP, D, EpiB16{PROJ, DINP}); break;
        case 2: if (!(PHMASK & 4)) break; for (int rr = 0; rr < ((REPEAT_SUB & 1) ? 2 : 1); ++rr) for (int n = obid(); n < NCH; n += gridDim.x) mixer_lru<0>(p, l, n, lds);
                for (int rr = 0; rr < ((REPEAT_SUB & 2) ? 2 : 1); ++rr) for (int n = obid(); n < NCH; n += gridDim.x) mixer_gla<0>(p, l, n, lds); break;
        case 3: if (!(PHMASK & 8)) break; phase_scan(p); break;
        case 4: if (!(PHMASK & 16)) break; for (int rr = 0; rr < ((REPEAT_SUB & 4) ? 2 : 1); ++rr) for (int n = obid(); n < NCH; n += gridDim.x) mixer_lru<1>(p, l, n, lds);
                for (int rr = 0; rr < ((REPEAT_SUB & 8) ? 2 : 1); ++rr) for (int n = obid(); n < NCH; n += gridDim.x) mixer_gla<1>(p, l, n, lds); break;
        case 5: if (!(PHMASK & 32)) break; gemm_fast(lds, Hb, WoutT, S, D, D, EpiF32m{Mb, D}); break;
        case 6: if (!(PHMASK & 64)) break; phase_rowprep(l == 0 ? xin : out, Mb, p.in[2] + (size_t)l * D, out, p.in[16] + (size_t)l * D, Hb); break;
        case 7: if (!(PHMASK & 128)) break; gemm_fast(lds, Hb, WguT, S, 2 * DFF, D, EpiSwiglu{PROJ, DFF}); break;
        case 8: if (!(PHMASK & 256)) break; gemm_fast(lds, PROJ, WdT, S, D, DFF, EpiF32m{Mb, D}); break;
        }
        }
    }
}

extern "C" void kernel_launch(void* const* d_in, const int* in_sizes, int n_in, void* d_out, int out_size, void* d_ws, size_t ws_size, hipStream_t stream) {
    static int grid = 0;
    if (grid == 0) {
        if (n_in != 21 || out_size != S * D || ws_size < WS_END) { fprintf(stderr, "kernel_launch: unexpected shapes: n_in %d out %d ws %zu (need %zu)\n", n_in, out_size, ws_size, (size_t)WS_END); grid = -1; return; }
        int dev = 0, cus = 0, per_cu = 0;
        (void)hipGetDevice(&dev); (void)hipDeviceGetAttribute(&cus, hipDeviceAttributeMultiprocessorCount, dev);
        if (hipFuncSetAttribute((const void*)mk_fwd, hipFuncAttributeMaxDynamicSharedMemorySize, LDS_BYTES) != hipSuccess) { fprintf(stderr, "kernel_launch: hipFuncSetAttribute failed\n"); grid = -1; return; }
        if (hipOccupancyMaxActiveBlocksPerMultiprocessor(&per_cu, (const void*)mk_fwd, NTHR, LDS_BYTES) != hipSuccess || per_cu < 1) { fprintf(stderr, "kernel_launch: occupancy query says %d\n", per_cu); per_cu = 1; }
        (void)hipGetLastError();
        grid = cus;
    }
    if (grid < 0) return;
    Params p{};
    for (int i = 0; i < 21; ++i) p.in[i] = (const float*)d_in[i];
    p.out = (float*)d_out; p.ws = (unsigned char*)d_ws;
    (void)hipMemsetAsync((unsigned char*)d_ws + WS_CTL, 0, 16384, stream);
#if ONE_LAUNCH
    p.ph_lo = 0; p.ph_hi = 9 * NL + 1;
    void* args[] = {&p};
    hipError_t e = hipLaunchCooperativeKernel((const void*)mk_fwd, dim3(grid), dim3(NTHR), args, LDS_BYTES, stream);
    if (e != hipSuccess) fprintf(stderr, "cooperative launch failed: %s (grid %d)\n", hipGetErrorString(e), grid);
#else
    for (int ph = 0; ph < 9 * NL + 1; ++ph) { p.ph_lo = ph; p.ph_hi = ph + 1; hipLaunchKernelGGL(mk_fwd, dim3(grid), dim3(NTHR), LDS_BYTES, stream, p); }
#endif
}
```

```cpp
#include <hip/hip_runtime.h>
#include <hip/hip_cooperative_groups.h>
#include <cstdio>
namespace cg = cooperative_groups;

#ifndef REPEAT_SUB
#define REPEAT_SUB 0
#endif
#ifndef NEW0_WRITE
#define NEW0_WRITE 3
#endif
#ifndef ONE_LAUNCH
#define ONE_LAUNCH 1
#endif

#define LAS __attribute__((address_space(3)))
typedef unsigned short bf16_t;
typedef short bf16x8 __attribute__((ext_vector_type(8)));
typedef short bf16x4 __attribute__((ext_vector_type(4)));
typedef float f32x4 __attribute__((ext_vector_type(4)));
typedef unsigned u32x4 __attribute__((ext_vector_type(4)));
typedef unsigned u32x2 __attribute__((ext_vector_type(2)));
typedef float f32x2 __attribute__((ext_vector_type(2)));
typedef __bf16 bf16v2 __attribute__((ext_vector_type(2)));

constexpr int S = 16384, D = 1024, DIN = 2592, DINP = 2816, DFF = 2816, NL = 4, NCH = 256;
constexpr int NTHR = 512;
constexpr int LDS_BYTES = 147456;
constexpr float EPS = 1e-6f;

constexpr size_t WS_CTL = 0;
constexpr size_t WS_WIN = 65536;
constexpr size_t WS_WOUT = WS_WIN + (size_t)DINP * D * 2;
constexpr size_t WS_WGU = WS_WOUT + (size_t)D * D * 2;
constexpr size_t WS_WD = WS_WGU + (size_t)2 * DFF * D * 2;
constexpr size_t WS_LRUW = WS_WD + (size_t)D * DFF * 2;
constexpr size_t WS_GW = WS_LRUW + (size_t)2 * 2 * 8 * 64 * 64 * 2;
constexpr size_t WS_H = WS_GW + (size_t)2 * 256 * 32 * 2;
constexpr size_t WS_PROJ = WS_H + (size_t)S * D * 2;
constexpr size_t WS_M = WS_PROJ + (size_t)S * DINP * 2;
constexpr size_t WS_AP = WS_M + (size_t)S * D * 4;
constexpr size_t WS_HE = WS_AP + (size_t)2 * NCH * 512 * 4;
constexpr size_t WS_CA = WS_HE + (size_t)2 * NCH * 512 * 4;
constexpr size_t WS_DEC = WS_CA + (size_t)2 * NCH * 512 * 4;
constexpr size_t WS_PB = WS_DEC + (size_t)2 * NCH * 4 * 64 * 4;
constexpr size_t WS_END = WS_PB + (size_t)S * 512 * 2;

struct Params { const float* in[21]; float* out; unsigned char* ws; int ph_lo, ph_hi; };

__device__ __forceinline__ float bf2f(bf16_t b) { return __uint_as_float(((unsigned)b) << 16); }
__device__ __forceinline__ bf16_t f2bf(float f) { unsigned u = __float_as_uint(f); return (bf16_t)((u + 0x7fffu + ((u >> 16) & 1u)) >> 16); }
__device__ __forceinline__ unsigned pk2(float lo, float hi) { return (unsigned)f2bf(lo) | ((unsigned)f2bf(hi) << 16); }
__device__ __forceinline__ unsigned cvtpk(float lo, float hi) { const f32x2 v = (f32x2){lo, hi}; const bf16v2 b = __builtin_convertvector(v, bf16v2); return __builtin_bit_cast(unsigned, b); }
__device__ __forceinline__ float sigmoidf_(float x) { return __builtin_amdgcn_rcpf(1.0f + __expf(-x)); }
__device__ __forceinline__ float siluf_(float x) { return x * sigmoidf_(x); }
__device__ __forceinline__ float geluf_(float x) { const float y = 0.7978845608028654f * (x + 0.044715f * x * x * x); const float t = 1.0f - 2.0f * __builtin_amdgcn_rcpf(__expf(2.0f * y) + 1.0f); return 0.5f * x * (1.0f + t); }
__device__ __forceinline__ f32x4 mfma16(bf16x8 a, bf16x8 b, f32x4 c) { return __builtin_amdgcn_mfma_f32_16x16x32_bf16(a, b, c, 0, 0, 0); }
__device__ __forceinline__ int otid() { int t = threadIdx.x; asm volatile("" : "+v"(t)); return t; }
__device__ __forceinline__ int obid() { int t = blockIdx.x; asm volatile("" : "+s"(t)); return t; }
#define LDS_FENCE() asm volatile("s_waitcnt lgkmcnt(0)" ::: "memory")

struct WDesc { const float* src; bf16_t* dst; int ldsrc, c0, nvalid, k0, lddst, r0; };
__device__ __forceinline__ WDesc wdesc(const Params& p, int l, int u) {
    unsigned char* ws = p.ws;
    constexpr int T_IN = 44 * 16, T_OUT = 16 * 16, T_GU = 88 * 16, T_D = 16 * 44;
    WDesc d; int v = u;
    if (v < T_IN) { const int rt = v / 16, kt = v % 16; int nv = DIN - rt * 64; nv = nv > 64 ? 64 : (nv < 0 ? 0 : nv);
        d.src = p.in[3] + (size_t)l * D * DIN; d.ldsrc = DIN; d.c0 = nv > 0 ? rt * 64 : 0; d.nvalid = nv; d.k0 = kt * 64; d.dst = (bf16_t*)(ws + WS_WIN); d.lddst = D; d.r0 = rt * 64; return d; }
    v -= T_IN;
    if (v < T_OUT) { const int rt = v / 16, kt = v % 16; d.src = p.in[15] + (size_t)l * D * D; d.ldsrc = D; d.c0 = rt * 64; d.nvalid = 64; d.k0 = kt * 64; d.dst = (bf16_t*)(ws + WS_WOUT); d.lddst = D; d.r0 = rt * 64; return d; }
    v -= T_OUT;
    if (v < T_GU) { const int rt = v / 16, kt = v % 16; const int r0 = rt * 64, j = r0 / 256, within = r0 % 256;
        d.src = (within < 128 ? p.in[18] : p.in[19]) + (size_t)l * D * DFF; d.ldsrc = DFF; d.c0 = j * 128 + (within & 127); d.nvalid = 64; d.k0 = kt * 64; d.dst = (bf16_t*)(ws + WS_WGU); d.lddst = D; d.r0 = r0; return d; }
    v -= T_GU;
    if (v < T_D) { const int rt = v / 44, kt = v % 44; d.src = p.in[20] + (size_t)l * DFF * D; d.ldsrc = D; d.c0 = rt * 64; d.nvalid = 64; d.k0 = kt * 64; d.dst = (bf16_t*)(ws + WS_WD); d.lddst = DFF; d.r0 = rt * 64; return d; }
    v -= T_D;
    { const int dir = v / 16, gate = (v / 8) % 2, h = v % 8; d.src = (gate ? p.in[8] : p.in[6]) + ((size_t)(l * 2 + dir) * 8 + h) * 4096; d.ldsrc = 64; d.c0 = 0; d.nvalid = 64; d.k0 = 0;
      d.dst = (bf16_t*)(ws + WS_LRUW) + ((size_t)(dir * 2 + gate) * 8 + h) * 4096; d.lddst = 64; d.r0 = 0; return d; }
}

__device__ void phase_weights(const Params& p, int l, LAS unsigned char* lds) {
    LAS float* T = (LAS float*)lds;
    unsigned char* ws = p.ws;
    constexpr int TOT = 44 * 16 + 16 * 16 + 88 * 16 + 16 * 44 + 32;
    const int tid = otid(), G = gridDim.x;
    for (int u0 = obid(); u0 < TOT; u0 += 4 * G) {
        f32x4 v[4][2];
        { const int k = tid >> 3, cg8 = (tid & 7) * 8;
#pragma unroll
          for (int j = 0; j < 4; ++j) { const int u = u0 + j * G; v[j][0] = (f32x4){0.f, 0.f, 0.f, 0.f}; v[j][1] = v[j][0];
              if (u < TOT) { const WDesc d = wdesc(p, l, u); const float* sp = d.src + (size_t)(d.k0 + k) * d.ldsrc + d.c0 + cg8;
                  if (cg8 + 3 < d.nvalid) v[j][0] = *(const f32x4*)sp; if (cg8 + 7 < d.nvalid) v[j][1] = *(const f32x4*)(sp + 4); } }
#pragma unroll
          for (int j = 0; j < 4; ++j)
#pragma unroll
              for (int i = 0; i < 2; ++i) { LAS float* Tj = T + j * 4160 + k * 65 + cg8 + 4 * i; Tj[0] = v[j][i][0]; Tj[1] = v[j][i][1]; Tj[2] = v[j][i][2]; Tj[3] = v[j][i][3]; } }
        __syncthreads();
        { const int r = tid >> 3, kg = (tid & 7) * 8;
#pragma unroll
          for (int j = 0; j < 4; ++j) { const int u = u0 + j * G;
              if (u < TOT) { const WDesc d = wdesc(p, l, u); const LAS float* Tj = T + j * 4160; u32x4 w;
                  w.x = cvtpk(Tj[(kg + 0) * 65 + r], Tj[(kg + 1) * 65 + r]); w.y = cvtpk(Tj[(kg + 2) * 65 + r], Tj[(kg + 3) * 65 + r]);
                  w.z = cvtpk(Tj[(kg + 4) * 65 + r], Tj[(kg + 5) * 65 + r]); w.w = cvtpk(Tj[(kg + 6) * 65 + r], Tj[(kg + 7) * 65 + r]);
                  *(u32x4*)(d.dst + (size_t)(d.r0 + r) * d.lddst + d.k0 + kg) = w; } } }
        __syncthreads();
    }
    { bf16_t* GW = (bf16_t*)(ws + WS_GW); const float* wg = p.in[12] + (size_t)l * 2 * 16 * 256;
      for (int idx = obid() * NTHR + otid(); idx < 2 * 256 * 32; idx += gridDim.x * NTHR) { const int dir = idx >> 13, e = (idx >> 5) & 255, r = idx & 31;
          GW[idx] = r < 16 ? f2bf(wg[(size_t)(dir * 16 + r) * 256 + e]) : (bf16_t)0; } }
}

__device__ void phase_rowprep(const float* __restrict__ xsrc, const bf16_t* __restrict__ m, const float* __restrict__ gpost, float* __restrict__ xdst, const float* __restrict__ gpre, bf16_t* __restrict__ hdst) {
    const int tid = otid(); const int lane = tid & 63, wave = tid >> 6;
    for (int row = obid() * 8 + wave; row < S; row += gridDim.x * 8) {
        f32x4 xv[4];
#pragma unroll
        for (int i = 0; i < 4; ++i) xv[i] = *(const f32x4*)(xsrc + (size_t)row * D + i * 256 + lane * 4);
        if (m) {
            f32x4 mv[4]; float ss = 0.f;
#pragma unroll
            for (int i = 0; i < 4; ++i) { const bf16x4 mb = *(const bf16x4*)(m + (size_t)row * D + i * 256 + lane * 4); mv[i] = (f32x4){bf2f((bf16_t)mb[0]), bf2f((bf16_t)mb[1]), bf2f((bf16_t)mb[2]), bf2f((bf16_t)mb[3])}; ss += mv[i][0] * mv[i][0] + mv[i][1] * mv[i][1] + mv[i][2] * mv[i][2] + mv[i][3] * mv[i][3]; }
#pragma unroll
            for (int o = 32; o >= 1; o >>= 1) ss += __shfl_xor(ss, o);
            const float rs = rsqrtf(ss * (1.0f / D) + EPS);
#pragma unroll
            for (int i = 0; i < 4; ++i) { const f32x4 g = *(const f32x4*)(gpost + i * 256 + lane * 4); xv[i] += mv[i] * rs * g; }
        }
        if (xdst) {
#pragma unroll
            for (int i = 0; i < 4; ++i) *(f32x4*)(xdst + (size_t)row * D + i * 256 + lane * 4) = xv[i];
        }
        if (hdst) {
            float ss = 0.f;
#pragma unroll
            for (int i = 0; i < 4; ++i) ss += xv[i][0] * xv[i][0] + xv[i][1] * xv[i][1] + xv[i][2] * xv[i][2] + xv[i][3] * xv[i][3];
#pragma unroll
            for (int o = 32; o >= 1; o >>= 1) ss += __shfl_xor(ss, o);
            const float rs = rsqrtf(ss * (1.0f / D) + EPS);
#pragma unroll
            for (int i = 0; i < 4; ++i) { const f32x4 g = *(const f32x4*)(gpre + i * 256 + lane * 4); const f32x4 hv = xv[i] * rs * g; u32x2 w; w.x = pk2(hv[0], hv[1]); w.y = pk2(hv[2], hv[3]);
                *(u32x2*)(hdst + (size_t)row * D + i * 256 + lane * 4) = w; }
        }
    }
}

template <int EPI> __device__ void gemm_simple(const bf16_t* __restrict__ A, int lda, const bf16_t* __restrict__ Bt, int K, int M, int N, void* __restrict__ Cv, int ldc) {
    const int tid = otid(), lane = tid & 63, wave = tid >> 6, wr = wave >> 2, wc = wave & 3, c = lane & 15, q = lane >> 4;
    const int nM = M / 128, nN = N / 256;
    for (int u = obid(); u < nM * nN; u += gridDim.x) {
        const int pn = u / nM, pm = u % nM; const int m0 = pm * 128 + wr * 64;
        f32x4 acc[4][4];
#pragma unroll
        for (int i = 0; i < 4; ++i)
#pragma unroll
            for (int j = 0; j < 4; ++j) acc[i][j] = (f32x4){0.f, 0.f, 0.f, 0.f};
        const bf16_t* ap = A + (size_t)(m0 + c) * lda + 8 * q;
        const bf16_t* bp = Bt + (size_t)(pn * 256 + wc * 32 + c) * K + 8 * q;
        for (int k0 = 0; k0 < K; k0 += 32) {
            bf16x8 af[4], bfr[4];
#pragma unroll
            for (int mi = 0; mi < 4; ++mi) af[mi] = *(const bf16x8*)(ap + (size_t)(16 * mi) * lda + k0);
#pragma unroll
            for (int nf = 0; nf < 4; ++nf) bfr[nf] = *(const bf16x8*)(bp + (size_t)((nf >> 1) * 128 + (nf & 1) * 16) * K + k0);
#pragma unroll
            for (int mi = 0; mi < 4; ++mi)
#pragma unroll
                for (int nf = 0; nf < 4; ++nf) acc[mi][nf] = mfma16(bfr[nf], af[mi], acc[mi][nf]);
        }
#pragma unroll
        for (int mi = 0; mi < 4; ++mi) { const int row = m0 + 16 * mi + c;
            if (EPI == 2) {
#pragma unroll
                for (int nf = 0; nf < 2; ++nf) { const f32x4 g = acc[mi][nf], uu = acc[mi][nf + 2]; const int col = pn * 128 + wc * 32 + nf * 16 + 4 * q;
                    u32x2 w; w.x = pk2(siluf_(g[0]) * uu[0], siluf_(g[1]) * uu[1]); w.y = pk2(siluf_(g[2]) * uu[2], siluf_(g[3]) * uu[3]);
                    *(u32x2*)((bf16_t*)Cv + (size_t)row * ldc + col) = w; }
            } else {
#pragma unroll
                for (int nf = 0; nf < 4; ++nf) { const int col = pn * 256 + (nf >> 1) * 128 + wc * 32 + (nf & 1) * 16 + 4 * q; const f32x4 v = acc[mi][nf];
                    if (EPI == 0) { u32x2 w; w.x = pk2(v[0], v[1]); w.y = pk2(v[2], v[3]); *(u32x2*)((bf16_t*)Cv + (size_t)row * ldc + col) = w; }
                    else *(f32x4*)((float*)Cv + (size_t)row * ldc + col) = v; }
            }
        }
    }
}

namespace pg8 {
#define PG8_LAS __attribute__((address_space(3)))
constexpr int BM = 256, BK = 64, HALF = 128, HTB = HALF * BK * 2  , STAGE_BYTES = 8 * HTB, NXCD = 8, WGM = 8;
__host__ __device__ __forceinline__ int lds_byte(int r, int c) { const int st = (r >> 4) * 2 + (c >> 5), rr = r & 15, cc = c & 31, ob = rr * 64 + cc * 2; return st * 1024 + (ob ^ (((ob >> 9) & 1) << 5)); }
__host__ __device__ __forceinline__ void stage_rc(int b, int& R, int& C) { const int st = b / 1024, sb = b % 1024, swz = sb ^ (((sb >> 9) & 1) << 5); R = (st >> 1) * 16 + swz / 64; C = (st & 1) * 32 + (swz % 64) / 2; }
__host__ __device__ __forceinline__ int perm32(int rho) { const int n = rho >> 4, i = rho & 15; return 8 * (i >> 2) + 4 * n + (i & 3); }
struct Unit { int pm, pn; };
struct Gemm { const bf16_t* A; const bf16_t* Bt; int M, N, K; };
struct StaticOrder {
    int nM, nN, nwg, G, c;
    __host__ __device__ void init(int M, int N, int G_, int c_) { nM = M / BM; nN = N / BM; nwg = nM * nN; G = G_; c = c_; }
    __host__ __device__ bool next(int i, Unit& u) const {
        const long L = (long)i * G + c; if (L >= nwg) return false;
        int wgid = (int)L; { const int q = nwg / NXCD, r = nwg % NXCD, xcd = wgid % NXCD, off = wgid / NXCD; wgid = (xcd < r ? xcd * (q + 1) : r * (q + 1) + (xcd - r) * q) + off; }
        const int nig = WGM * nN, gid = wgid / nig, fm = gid * WGM, gsz = (nM - fm) < WGM ? (nM - fm) : WGM;
        u.pm = fm + ((wgid % nig) % gsz); u.pn = (wgid % nig) / gsz; return true;
    }
    __device__ __forceinline__ void a_ready(const Unit&) const {}
    __device__ __forceinline__ void done(const Unit&) const {}
};
__device__ __forceinline__ unsigned cvt_pk_bf16(float lo, float hi) { unsigned r; asm volatile("v_cvt_pk_bf16_f32 %0, %1, %2" : "=v"(r) : "v"(lo), "v"(hi)); return r; }
template <class Epi, class Sched>
__device__ __forceinline__ void gemm_phase(PG8_LAS unsigned char* lds, const Gemm g, const Sched& S, const Epi& E) {
    const int tid = otid(), wid = __builtin_amdgcn_readfirstlane(tid >> 6), lane = tid & 63, wr = wid >> 2, wc = wid & 3, fr = lane & 15, fq = lane >> 4;
    const int K = g.K, nt = K / BK;
    unsigned voffA[2], voffB[2];
#pragma unroll
    for (int i = 0; i < 2; ++i) { int R, C; stage_rc(tid * 16 + i * 8192, R, C); const int Rb = Epi::PERM ? ((R & ~31) + perm32(R & 31)) : R;
        voffA[i] = (unsigned)(R * K + C) * 2u; voffB[i] = (unsigned)(Rb * K + C) * 2u; }
    const size_t kstep = (size_t)(BK * 2);
    const size_t hstep = (size_t)HALF * K * 2;
    const size_t tstep = 2 * hstep;
    const unsigned ldsw = (unsigned)wid * 1024u;
    const int aoff = lds_byte(wr * 64 + fr, fq * 8), boff = lds_byte(wc * 32 + fr, fq * 8);
#define PG8_SA(b, h) (((b) * 2 + (h)) * HTB)
#define PG8_SB(b, h) ((4 + (b) * 2 + (h)) * HTB)
#define PG8_STAGE(bufoff, gbase, voff) do { _Pragma("unroll") for (int _i = 0; _i < 2; ++_i) \
        __builtin_amdgcn_global_load_lds((const unsigned*)((const char*)(gbase) + (voff)[_i]), (PG8_LAS unsigned*)(lds + (bufoff) + ldsw + _i * 8192), 16, 0, 0); } while (0)
#define PG8_LDA(dst, b, h) do { _Pragma("unroll") for (int m = 0; m < 4; ++m) _Pragma("unroll") for (int k = 0; k < 2; ++k) dst[m][k] = *(const PG8_LAS bf16x8*)(lds + PG8_SA(b, h) + aoff + m * 2048 + k * 1024); } while (0)
#define PG8_LDB(dst, b, h) do { _Pragma("unroll") for (int n = 0; n < 2; ++n) _Pragma("unroll") for (int k = 0; k < 2; ++k) dst[n][k] = *(const PG8_LAS bf16x8*)(lds + PG8_SB(b, h) + boff + n * 2048 + k * 1024); } while (0)
#define PG8_MMA(ai, bj, At, Bt) do { __builtin_amdgcn_s_setprio(1); _Pragma("unroll") for (int m = 0; m < 4; ++m) _Pragma("unroll") for (int n = 0; n < 2; ++n) _Pragma("unroll") for (int k = 0; k < 2; ++k) \
        acc[ai][bj][m][n] = __builtin_amdgcn_mfma_f32_16x16x32_bf16(Bt[n][k], At[m][k], acc[ai][bj][m][n], 0, 0, 0); __builtin_amdgcn_s_setprio(0); } while (0)
#define PG8_WAIT_V(n) asm volatile("s_waitcnt vmcnt(" #n ")" ::: "memory")
#define PG8_WAIT_L(n) asm volatile("s_waitcnt lgkmcnt(" #n ")" ::: "memory")
#define PG8_BAR __builtin_amdgcn_s_barrier()
#define PG8_SCHED __builtin_amdgcn_sched_barrier(0)
    Unit cur, nxt; int ui = 0;
    if (!S.next(0, cur)) return;
    f32x4 acc[2][2][4][2];
#pragma unroll
    for (int a = 0; a < 2; ++a)
#pragma unroll
        for (int b = 0; b < 2; ++b)
#pragma unroll
            for (int m = 0; m < 4; ++m)
#pragma unroll
                for (int n = 0; n < 2; ++n) acc[a][b][m][n] = (f32x4){0.f, 0.f, 0.f, 0.f};
    bf16x8 At[4][2], B0[2][2], B1[2][2];
    const char* cA = (const char*)g.A + (size_t)cur.pm * tstep; const char* cB = (const char*)g.Bt + (size_t)cur.pn * tstep;
    S.a_ready(cur);
    PG8_STAGE(PG8_SB(0, 0), cB, voffB); PG8_STAGE(PG8_SA(0, 0), cA, voffA); PG8_STAGE(PG8_SB(0, 1), cB + hstep, voffB); PG8_STAGE(PG8_SA(0, 1), cA + hstep, voffA);
    if (wr == 1) PG8_BAR;
    PG8_WAIT_V(4); PG8_BAR;
    PG8_STAGE(PG8_SB(1, 0), cB + kstep, voffB); PG8_STAGE(PG8_SA(1, 0), cA + kstep, voffA); PG8_STAGE(PG8_SB(1, 1), cB + hstep + kstep, voffB);
    PG8_WAIT_V(6); PG8_BAR;
    for (;;) {
        const bool has_next = S.next(ui + 1, nxt);
        const char* nA = has_next ? (const char*)g.A + (size_t)nxt.pm * tstep : cA; const char* nB = has_next ? (const char*)g.Bt + (size_t)nxt.pn * tstep : cB;
        for (int t = 0; t < nt; t += 2) {
            const bool last = (t == nt - 2);
            const char* a1 = cA + (size_t)(t + 1) * kstep;
            const char* a2 = last ? nA : cA + (size_t)(t + 2) * kstep; const char* b2 = last ? nB : cB + (size_t)(t + 2) * kstep;
            const char* a3 = a2 + kstep; const char* b3 = b2 + kstep;
            if (last && has_next) S.a_ready(nxt);
            PG8_LDB(B0, 0, 0); PG8_SCHED; PG8_LDA(At, 0, 0); PG8_STAGE(PG8_SA(1, 1), a1 + hstep, voffA);
            PG8_WAIT_L(8); PG8_BAR; PG8_WAIT_L(0); PG8_MMA(0, 0, At, B0); PG8_BAR; PG8_SCHED;
            PG8_LDB(B1, 0, 1); PG8_STAGE(PG8_SB(0, 0), b2, voffB);
            PG8_BAR; PG8_WAIT_L(0); PG8_MMA(0, 1, At, B1); PG8_BAR;
            PG8_LDA(At, 0, 1); PG8_STAGE(PG8_SA(0, 0), a2, voffA);
            PG8_BAR; PG8_WAIT_L(0); PG8_MMA(1, 0, At, B0); PG8_BAR; PG8_SCHED;
            PG8_STAGE(PG8_SB(0, 1), b2 + hstep, voffB);
            PG8_WAIT_V(6); PG8_BAR; PG8_MMA(1, 1, At, B1); PG8_BAR;
            PG8_LDB(B0, 1, 0); PG8_SCHED; PG8_LDA(At, 1, 0); PG8_STAGE(PG8_SA(0, 1), a2 + hstep, voffA);
            PG8_WAIT_L(8); PG8_BAR; PG8_WAIT_L(0); PG8_MMA(0, 0, At, B0); PG8_BAR; PG8_SCHED;
            PG8_LDB(B1, 1, 1); PG8_STAGE(PG8_SB(1, 0), b3, voffB);
            PG8_BAR; PG8_WAIT_L(0); PG8_MMA(0, 1, At, B1); PG8_BAR;
            PG8_LDA(At, 1, 1); PG8_STAGE(PG8_SA(1, 0), a3, voffA);
            PG8_BAR; PG8_WAIT_L(0); PG8_MMA(1, 0, At, B0); PG8_BAR; PG8_SCHED;
            PG8_STAGE(PG8_SB(1, 1), b3 + hstep, voffB);
            PG8_WAIT_V(6); PG8_BAR; PG8_MMA(1, 1, At, B1); PG8_BAR;
        }
        if constexpr (!Epi::AFTER_DRAIN) { E(acc, cur, wr, wc, fr, fq); S.done(cur); }
        if (!has_next) break;
#pragma unroll
        for (int a = 0; a < 2; ++a)
#pragma unroll
            for (int b = 0; b < 2; ++b)
#pragma unroll
                for (int m = 0; m < 4; ++m)
#pragma unroll
                    for (int n = 0; n < 2; ++n) acc[a][b][m][n] = (f32x4){0.f, 0.f, 0.f, 0.f};
        cur = nxt; cA = nA; cB = nB; ++ui;
    }
    PG8_WAIT_V(0);
    if (wr == 0) PG8_BAR;
    PG8_BAR;
    if constexpr (Epi::AFTER_DRAIN) { E.fused(acc, cur, wr, wc, fr, fq, lds, wid, lane); S.done(cur); }
#undef PG8_SA
#undef PG8_SB
#undef PG8_STAGE
#undef PG8_LDA
#undef PG8_LDB
#undef PG8_MMA
#undef PG8_WAIT_V
#undef PG8_WAIT_L
#undef PG8_BAR
#undef PG8_SCHED
}
}

struct EpiF32m {
    static constexpr bool PERM = false, AFTER_DRAIN = false;
    float* C; int ldc;
    __device__ __forceinline__ void operator()(const f32x4 (&acc)[2][2][4][2], const pg8::Unit& u, int wr, int wc, int fr, int fq) const {
        const int row0 = u.pm * 256 + wr * 64 + fr, col0 = u.pn * 256 + wc * 32 + 4 * fq;
#pragma unroll
        for (int ai = 0; ai < 2; ++ai)
#pragma unroll
            for (int m = 0; m < 4; ++m) { float* rowp = C + (size_t)(row0 + ai * 128 + m * 16) * ldc + col0;
#pragma unroll
                for (int bj = 0; bj < 2; ++bj)
#pragma unroll
                    for (int n = 0; n < 2; ++n) *(f32x4*)(rowp + bj * 128 + n * 16) = acc[ai][bj][m][n]; }
    }
};
struct EpiB16 {
    static constexpr bool PERM = true, AFTER_DRAIN = false;
    bf16_t* O; int ldc;
    __device__ __forceinline__ void operator()(const f32x4 (&acc)[2][2][4][2], const pg8::Unit& u, int wr, int wc, int fr, int fq) const {
        const int row0 = u.pm * 256 + wr * 64 + fr, col0 = u.pn * 256 + wc * 32 + 8 * fq;
#pragma unroll
        for (int ai = 0; ai < 2; ++ai)
#pragma unroll
            for (int m = 0; m < 4; ++m) { bf16_t* rowp = O + (size_t)(row0 + ai * 128 + m * 16) * ldc + col0;
#pragma unroll
                for (int bj = 0; bj < 2; ++bj) { const f32x4 v0 = acc[ai][bj][m][0], v1 = acc[ai][bj][m][1];
                    u32x4 w; w.x = cvtpk(v0[0], v0[1]); w.y = cvtpk(v0[2], v0[3]); w.z = cvtpk(v1[0], v1[1]); w.w = cvtpk(v1[2], v1[3]);
                    *(u32x4*)(rowp + bj * 128) = w; } }
    }
};
struct EpiSwiglu {
    static constexpr bool PERM = true, AFTER_DRAIN = false;
    bf16_t* O; int ldc;
    __device__ __forceinline__ void operator()(const f32x4 (&acc)[2][2][4][2], const pg8::Unit& u, int wr, int wc, int fr, int fq) const {
        const int row0 = u.pm * 256 + wr * 64 + fr, col0 = u.pn * 128 + wc * 32 + 8 * fq;
#pragma unroll
        for (int ai = 0; ai < 2; ++ai)
#pragma unroll
            for (int m = 0; m < 4; ++m) { bf16_t* rowp = O + (size_t)(row0 + ai * 128 + m * 16) * ldc + col0;
                const f32x4 g0 = acc[ai][0][m][0], g1 = acc[ai][0][m][1], u0 = acc[ai][1][m][0], u1 = acc[ai][1][m][1];
                u32x4 w; w.x = cvtpk(siluf_(g0[0]) * u0[0], siluf_(g0[1]) * u0[1]); w.y = cvtpk(siluf_(g0[2]) * u0[2], siluf_(g0[3]) * u0[3]);
                w.z = cvtpk(siluf_(g1[0]) * u1[0], siluf_(g1[1]) * u1[1]); w.w = cvtpk(siluf_(g1[2]) * u1[2], siluf_(g1[3]) * u1[3]);
                *(u32x4*)rowp = w; }
    }
};
template <class Epi> __device__ __forceinline__ void gemm_fast(LAS unsigned char* lds, const bf16_t* A, const bf16_t* Bt, int M, int N, int K, const Epi& E) {
    pg8::Gemm g; g.A = A; g.Bt = Bt; g.M = M; g.N = N; g.K = K;
    pg8::StaticOrder so; so.init(M, N, (int)gridDim.x, obid());
    pg8::gemm_phase<Epi, pg8::StaticOrder>(lds, g, so, E);
    __syncthreads();
}

template <int DIR> __device__ __forceinline__ void lru_dir(const Params& p, int l, int n, int h, int lane, LAS bf16_t* XC, LAS float* STA, LAS float* STU) {
    const int c = lane & 15, q = lane >> 4, j = lane, t0 = n * 64;
    unsigned char* ws = p.ws;
    bf16_t* y = (bf16_t*)(ws + WS_H); bf16_t* PB = (bf16_t*)(ws + WS_PB);
    const bf16_t* LW = (const bf16_t*)(ws + WS_LRUW);
    float* Aprod = (float*)(ws + WS_AP); float* Hend = (float*)(ws + WS_HE);
    const float* lam = p.in[10] + (size_t)(l * 2 + DIR) * 512 + 64 * h; const float* b_a = p.in[7] + (size_t)(l * 2 + DIR) * 512 + 64 * h; const float* b_x = p.in[9] + (size_t)(l * 2 + DIR) * 512 + 64 * h;
    const bf16_t* LWa = LW + ((size_t)(DIR * 2 + 0) * 8 + h) * 4096 + c * 64 + 8 * q; const bf16_t* LWx = LW + ((size_t)(DIR * 2 + 1) * 8 + h) * 4096 + c * 64 + 8 * q;
    bf16x8 wa[4][2], wx[4][2]; f32x4 sp4[4], ba4[4], bx4[4];
#pragma unroll
    for (int nf = 0; nf < 4; ++nf) {
#pragma unroll
        for (int ks = 0; ks < 2; ++ks) { wa[nf][ks] = *(const bf16x8*)(LWa + nf * 1024 + 32 * ks); wx[nf][ks] = *(const bf16x8*)(LWx + nf * 1024 + 32 * ks); }
        const f32x4 lam4 = *(const f32x4*)(lam + 16 * nf + 4 * q); ba4[nf] = *(const f32x4*)(b_a + 16 * nf + 4 * q); bx4[nf] = *(const f32x4*)(b_x + 16 * nf + 4 * q);
#pragma unroll
        for (int r = 0; r < 4; ++r) { const float e = __expf(-lam4[r]); const float l1p = e < 0.05f ? e * (1.0f - e * (0.5f - e * (0.33333334f - e * 0.25f))) : __logf(1.0f + e); sp4[nf][r] = -8.0f * l1p; }
    }
    float hcar = 0.f, P = 1.f;
#pragma unroll 1
    for (int g = 0; g < 4; ++g) {
        const int mi = DIR == 0 ? g : 3 - g;
        bf16_t hfp[16];
        if (DIR == 1) {
#pragma unroll
            for (int s = 0; s < 16; ++s) hfp[s] = y[(size_t)(t0 + 16 * mi + s) * D + 64 * h + j];
        }
        bf16x8 xf[2];
#pragma unroll
        for (int ks = 0; ks < 2; ++ks) xf[ks] = *(const LAS bf16x8*)(XC + (16 * mi + c) * 520 + 64 * h + 32 * ks + 8 * q);
        f32x4 za[4], zx[4];
#pragma unroll
        for (int nf = 0; nf < 4; ++nf) { za[nf] = (f32x4){0.f, 0.f, 0.f, 0.f}; zx[nf] = za[nf];
            za[nf] = mfma16(wa[nf][0], xf[0], za[nf]); za[nf] = mfma16(wa[nf][1], xf[1], za[nf]);
            zx[nf] = mfma16(wx[nf][0], xf[0], zx[nf]); zx[nf] = mfma16(wx[nf][1], xf[1], zx[nf]); }
#pragma unroll
        for (int nf = 0; nf < 4; ++nf) {
            const int jo = 16 * nf + 4 * q;
            const bf16x4 xc4 = *(const LAS bf16x4*)(XC + (16 * mi + c) * 520 + 64 * h + jo);
            const f32x4 zav = za[nf] + ba4[nf], zxv = zx[nf] + bx4[nf];
            f32x4 av, uv;
#pragma unroll
            for (int r = 0; r < 4; ++r) {
                const float ra = sigmoidf_(zav[r]), ix = sigmoidf_(zxv[r]);
                const float la = ra * sp4[nf][r];
                av[r] = __expf(la);
                const float x2 = 2.0f * la;
                const float om = -x2 * (1.0f + x2 * (0.5f + x2 * (0.16666667f + x2 * (0.041666668f + x2 * (0.0083333338f + x2 * (0.0013888889f + x2 * 0.0001984127f))))));
                uv[r] = bf2f((bf16_t)xc4[r]) * ix * __builtin_amdgcn_sqrtf(fmaxf(om, 0.f));
            }
            *(LAS f32x4*)(STA + c * 68 + jo) = av; *(LAS f32x4*)(STU + c * 68 + jo) = uv;
        }
        LDS_FENCE();
        float aa[16], uu[16];
#pragma unroll
        for (int s = 0; s < 16; ++s) { aa[s] = STA[s * 68 + j]; uu[s] = STU[s * 68 + j]; }
        LDS_FENCE();
#pragma unroll
        for (int s = 0; s < 16; ++s) {
            const int tl = DIR == 0 ? s : 15 - s;
            hcar = aa[tl] * hcar + uu[tl]; P *= aa[tl];
            const size_t row = (size_t)(t0 + 16 * mi + tl);
            if (DIR == 0) { const unsigned w = cvtpk(hcar, P); y[row * D + 64 * h + j] = (bf16_t)(w & 0xffffu); y[row * D + 512 + 64 * h + j] = (bf16_t)(w >> 16); }
            else { const unsigned w = cvtpk(bf2f(hfp[tl]) + hcar, P); y[row * D + 64 * h + j] = (bf16_t)(w & 0xffffu); PB[row * 512 + 64 * h + j] = (bf16_t)(w >> 16); }
        }
    }
    Aprod[(size_t)(DIR * NCH + n) * 512 + 64 * h + j] = P; Hend[(size_t)(DIR * NCH + n) * 512 + 64 * h + j] = hcar;
}

template <int MODE> __device__ void mixer_lru(const Params& p, int l, int n, LAS unsigned char* lds) {
    const int tid = otid(), lane = tid & 63, wave = tid >> 6;
    unsigned char* ws = p.ws;
    const bf16_t* proj = (const bf16_t*)(ws + WS_PROJ); bf16_t* y = (bf16_t*)(ws + WS_H);
    LAS bf16_t* XC = (LAS bf16_t*)lds;
    const int t0 = n * 64;
    if (MODE == 0) {
        LAS float* STA = (LAS float*)(lds + 66560 + wave * 8704);
        LAS float* STU = STA + 16 * 68;
        {
            const int ch = tid;
            const float cw0 = p.in[4][(size_t)(l * 4 + 0) * 512 + ch], cw1 = p.in[4][(size_t)(l * 4 + 1) * 512 + ch], cw2 = p.in[4][(size_t)(l * 4 + 2) * 512 + ch], cw3 = p.in[4][(size_t)(l * 4 + 3) * 512 + ch];
            const float cb = p.in[5][(size_t)l * 512 + ch];
            bf16_t xs[67];
#pragma unroll
            for (int i = 0; i < 67; ++i) { const int s_ = t0 - 2 + i; const int sc = s_ < 0 ? 0 : (s_ >= S ? S - 1 : s_); const bf16_t v = proj[(size_t)sc * DINP + ch]; xs[i] = s_ == sc ? v : (bf16_t)0; }
#pragma unroll
            for (int t = 0; t < 64; ++t) { const float xc = cb + cw0 * bf2f(xs[t]) + cw1 * bf2f(xs[t + 1]) + cw2 * bf2f(xs[t + 2]) + cw3 * bf2f(xs[t + 3]); XC[t * 520 + ch] = f2bf(xc); }
        }
        __syncthreads();
        lru_dir<0>(p, l, n, wave, lane, XC, STA, STU);
        lru_dir<1>(p, l, n, wave, lane, XC, STA, STU);
        __syncthreads();
    } else {
        const bf16_t* PB = (const bf16_t*)(ws + WS_PB); const float* carry = (const float*)(ws + WS_CA);
        LAS float* CAR = (LAS float*)(lds + 66560);
        CAR[tid] = carry[(size_t)(0 * NCH + n) * 512 + tid]; CAR[512 + tid] = carry[(size_t)(1 * NCH + n) * 512 + tid];
        __syncthreads();
        const int t = tid >> 3, seg = tid & 7; const size_t row = (size_t)(t0 + t);
#pragma unroll 2
        for (int i = 0; i < 8; ++i) { const int ch = 64 * seg + 8 * i;
            const bf16x8 h0 = *(const bf16x8*)(y + row * D + ch), pf = *(const bf16x8*)(y + row * D + 512 + ch), pb = *(const bf16x8*)(PB + row * 512 + ch), gt = *(const bf16x8*)(proj + row * DINP + 512 + ch);
            float v[8];
#pragma unroll
            for (int k = 0; k < 8; ++k) v[k] = (bf2f((bf16_t)h0[k]) + bf2f((bf16_t)pf[k]) * CAR[ch + k] + bf2f((bf16_t)pb[k]) * CAR[512 + ch + k]) * geluf_(bf2f((bf16_t)gt[k]));
            *(LAS u32x4*)(XC + t * 520 + ch) = (u32x4){pk2(v[0], v[1]), pk2(v[2], v[3]), pk2(v[4], v[5]), pk2(v[6], v[7])}; }
        __syncthreads();
        float ss = 0.f;
#pragma unroll
        for (int i = 0; i < 8; ++i) { const bf16x8 b = *(const LAS bf16x8*)(XC + t * 520 + 64 * seg + 8 * i);
#pragma unroll
            for (int k = 0; k < 8; ++k) { const float f = bf2f((bf16_t)b[k]); ss += f * f; } }
        ss += __shfl_xor(ss, 1); ss += __shfl_xor(ss, 2); ss += __shfl_xor(ss, 4);
        const float rs = rsqrtf(ss * (1.0f / 512.0f) + EPS);
        const float* gn = p.in[11] + (size_t)l * 512 + 64 * seg;
#pragma unroll 2
        for (int i = 0; i < 8; ++i) { const bf16x8 b = *(const LAS bf16x8*)(XC + t * 520 + 64 * seg + 8 * i); const f32x4 g0 = *(const f32x4*)(gn + 8 * i), g1 = *(const f32x4*)(gn + 8 * i + 4); u32x4 w;
            w.x = pk2(bf2f((bf16_t)b[0]) * rs * g0[0], bf2f((bf16_t)b[1]) * rs * g0[1]); w.y = pk2(bf2f((bf16_t)b[2]) * rs * g0[2], bf2f((bf16_t)b[3]) * rs * g0[3]);
            w.z = pk2(bf2f((bf16_t)b[4]) * rs * g1[0], bf2f((bf16_t)b[5]) * rs * g1[1]); w.w = pk2(bf2f((bf16_t)b[6]) * rs * g1[2], bf2f((bf16_t)b[7]) * rs * g1[3]);
            *(u32x4*)(y + (size_t)(t0 + t) * D + 64 * seg + 8 * i) = w; }
        __syncthreads();
    }
}

__device__ __forceinline__ bf16x8 pack8(const f32x4 a, const f32x4 b) {
    const u32x4 w = (u32x4){cvtpk(a[0], a[1]), cvtpk(a[2], a[3]), cvtpk(b[0], b[1]), cvtpk(b[2], b[3])}; return __builtin_bit_cast(bf16x8, w); }
#define SLOT(ks, q, jj) (32 * (ks) + 16 * ((jj) >> 2) + 4 * (q) + ((jj) & 3))

template <int MODE> __device__ void mixer_gla(const Params& p, int l, int n, LAS unsigned char* lds) {
    const int tid = otid(), lane = tid & 63, wave = tid >> 6, c = lane & 15, q = lane >> 4;
    const int h = wave >> 1, vh = wave & 1;
    unsigned char* ws = p.ws;
    const bf16_t* proj = (const bf16_t*)(ws + WS_PROJ); bf16_t* y = (bf16_t*)(ws + WS_H); const bf16_t* GW = (const bf16_t*)(ws + WS_GW);
    bf16_t* uT = (bf16_t*)(ws + WS_M); const bf16_t* spT = (const bf16_t*)(ws + WS_M + (size_t)S * D * 2); float* dec = (float*)(ws + WS_DEC);
    LAS bf16_t* VTw = (LAS bf16_t*)(lds + 66560 + wave * 9216);
    LAS float* SSQ = (LAS float*)(lds + 66560 + 8 * 9216);
    const int t0 = n * 64;
    const f32x4 zero4 = (f32x4){0.f, 0.f, 0.f, 0.f};
    {
        unsigned wv[32];
#pragma unroll
        for (int i = 0; i < 32; ++i) { const bf16_t* vp = proj + (size_t)(t0 + 2 * i) * DINP + 1536 + 128 * h + 64 * vh + lane; wv[i] = (unsigned)vp[0] | ((unsigned)vp[DINP] << 16); }
#pragma unroll
        for (int g = 0; g < 8; ++g) *(LAS u32x4*)(VTw + lane * 72 + 8 * g) = (u32x4){wv[4 * g], wv[4 * g + 1], wv[4 * g + 2], wv[4 * g + 3]};
    }
    LDS_FENCE();
    f32x4 acc[4][4];
#pragma unroll
    for (int a = 0; a < 4; ++a)
#pragma unroll
        for (int b = 0; b < 4; ++b) acc[a][b] = zero4;
#pragma unroll 1
    for (int dir = 0; dir < 2; ++dir) {
        bf16x8 laop[4][2]; float tot[4];
        {
            bf16x8 lrf[4], gwf[4]; float bgv[4];
#pragma unroll
            for (int tt = 0; tt < 4; ++tt) { lrf[tt] = (bf16x8){0, 0, 0, 0, 0, 0, 0, 0}; if (q < 2) lrf[tt] = *(const bf16x8*)(proj + (size_t)(t0 + 16 * tt + c) * DINP + 2560 + dir * 16 + 8 * q); }
#pragma unroll
            for (int ef = 0; ef < 4; ++ef) { gwf[ef] = *(const bf16x8*)(GW + (size_t)(dir * 256 + 64 * h + 16 * ef + c) * 32 + 8 * q); bgv[ef] = p.in[13][(size_t)(l * 2 + dir) * 256 + 64 * h + 16 * ef + c]; }
#pragma unroll
            for (int ef = 0; ef < 4; ++ef) { tot[ef] = 0.f;
#pragma unroll
                for (int ks = 0; ks < 2; ++ks) { f32x4 la2[2];
#pragma unroll
                    for (int t2 = 0; t2 < 2; ++t2) { const f32x4 z = mfma16(lrf[2 * ks + t2], gwf[ef], zero4);
#pragma unroll
                        for (int r = 0; r < 4; ++r) { const float zz = z[r] + bgv[ef]; const float la = (fminf(zz, 0.f) - __logf(1.0f + __expf(-fabsf(zz)))) * (1.0f / 16.0f); la2[t2][r] = la; tot[ef] += la; } }
                    laop[ef][ks] = pack8(la2[0], la2[1]); __builtin_amdgcn_sched_barrier(0); } }
        }
        if (MODE == 1) {
            bf16x8 QEop[4][2], KEop[4][2];
            bf16x4 qv[4][4], kv[4][4];
#pragma unroll
            for (int tj = 0; tj < 4; ++tj)
#pragma unroll
                for (int ef = 0; ef < 4; ++ef) { const bf16_t* rp = proj + (size_t)(t0 + 16 * tj + c) * DINP + 64 * h + 4 * q + 16 * ef; qv[tj][ef] = *(const bf16x4*)(rp + 1024); kv[tj][ef] = *(const bf16x4*)(rp + 1280); }
            __builtin_amdgcn_sched_barrier(0);
#pragma unroll
            for (int tj = 0; tj < 4; ++tj) {
                const int t = 16 * tj + c;
                bf16x8 mk[2];
#pragma unroll
                for (int ks = 0; ks < 2; ++ks)
#pragma unroll
                    for (int jj = 0; jj < 8; ++jj) { const int sidx = SLOT(ks, q, jj); const bool on = dir == 0 ? sidx <= t : sidx >= t; mk[ks][jj] = on ? (short)0x3F80 : (short)0; }
#pragma unroll
                for (int ks2 = 0; ks2 < 2; ++ks2) { f32x4 qe2[2], ke2[2];
#pragma unroll
                    for (int e2 = 0; e2 < 2; ++e2) { const int ef = 2 * ks2 + e2;
                        f32x4 b = mfma16(laop[ef][0], mk[0], zero4); b = mfma16(laop[ef][1], mk[1], b);
#pragma unroll
                        for (int r = 0; r < 4; ++r) { qe2[e2][r] = bf2f((bf16_t)qv[tj][ef][r]) * 0.125f * __expf(b[r]); ke2[e2][r] = bf2f((bf16_t)kv[tj][ef][r]) * __expf(-b[r]); } }
                    QEop[tj][ks2] = pack8(qe2[0], qe2[1]); KEop[tj][ks2] = pack8(ke2[0], ke2[1]); }
                __builtin_amdgcn_sched_barrier(0);
            }
            const bf16_t* SP = spT + ((size_t)(dir * NCH + n) * 4 + h) * 8192 + (size_t)(64 * vh) * 64;
            bf16x8 spf[4][2];
#pragma unroll
            for (int vf = 0; vf < 4; ++vf)
#pragma unroll
                for (int ks = 0; ks < 2; ++ks) { const u32x2 s0 = *(const u32x2*)(SP + (16 * vf + c) * 64 + 32 * ks + 4 * q), s1 = *(const u32x2*)(SP + (16 * vf + c) * 64 + 32 * ks + 16 + 4 * q);
                    spf[vf][ks] = __builtin_bit_cast(bf16x8, (u32x4){s0.x, s0.y, s1.x, s1.y}); }
            __builtin_amdgcn_sched_barrier(0);
            bf16x8 Pop[4][2];
#pragma unroll
            for (int ti = 0; ti < 4; ++ti)
#pragma unroll
                for (int ksp = 0; ksp < 2; ++ksp) { f32x4 pm[2];
#pragma unroll
                    for (int j2 = 0; j2 < 2; ++j2) { const int tjj = 2 * ksp + j2;
                        f32x4 sc = mfma16(KEop[tjj][0], QEop[ti][0], zero4); sc = mfma16(KEop[tjj][1], QEop[ti][1], sc);
#pragma unroll
                        for (int r = 0; r < 4; ++r) { const int j = 16 * tjj + 4 * q + r, i = 16 * ti + c; const bool keep = dir == 0 ? j <= i : j >= i; pm[j2][r] = keep ? sc[r] : 0.f; } }
                    Pop[ti][ksp] = pack8(pm[0], pm[1]); __builtin_amdgcn_sched_barrier(0); }
#pragma unroll
            for (int vf = 0; vf < 4; ++vf)
#pragma unroll
                for (int ks = 0; ks < 2; ++ks) {
                    const u32x2 v0 = *(const LAS u32x2*)(VTw + (16 * vf + c) * 72 + 32 * ks + 4 * q), v1 = *(const LAS u32x2*)(VTw + (16 * vf + c) * 72 + 32 * ks + 16 + 4 * q);
                    const bf16x8 vtf = __builtin_bit_cast(bf16x8, (u32x4){v0.x, v0.y, v1.x, v1.y});
#pragma unroll
                    for (int ti = 0; ti < 4; ++ti) { acc[vf][ti] = mfma16(vtf, Pop[ti][ks], acc[vf][ti]); acc[vf][ti] = mfma16(spf[vf][ks], QEop[ti][ks], acc[vf][ti]); }
                    __builtin_amdgcn_sched_barrier(0);
                }
        } else {
#pragma unroll
            for (int ef = 0; ef < 4; ++ef) { float tt = tot[ef]; tt += __shfl_xor(tt, 16); tt += __shfl_xor(tt, 32);
                if ((NEW0_WRITE & 1) && vh == 0 && q == 0) dec[((size_t)(dir * NCH + n) * 4 + h) * 64 + 16 * ef + c] = __expf(tt); }
            bf16x8 kn[4][2];
#pragma unroll
            for (int tj = 0; tj < 4; ++tj)
#pragma unroll
                for (int ks = 0; ks < 2; ++ks) kn[tj][ks] = *(const bf16x8*)(proj + (size_t)(t0 + 16 * tj + c) * DINP + 1280 + 64 * h + 32 * ks + 8 * q);
            bf16x8 ident[2];
#pragma unroll
            for (int e1 = 0; e1 < 2; ++e1)
#pragma unroll
                for (int jj = 0; jj < 8; ++jj) ident[e1][jj] = (8 * q + jj == 16 * e1 + c) ? (short)0x3F80 : (short)0;
            bf16x8 kdop[4][2];
#pragma unroll
            for (int ks = 0; ks < 2; ++ks) {
                bf16x8 mk[2][2];
#pragma unroll
                for (int t2 = 0; t2 < 2; ++t2)
#pragma unroll
                    for (int k2 = 0; k2 < 2; ++k2)
#pragma unroll
                        for (int jj = 0; jj < 8; ++jj) { const int tp = 16 * (2 * ks + t2) + c, sidx = SLOT(k2, q, jj); const bool on = dir == 0 ? sidx > tp : sidx < tp; mk[t2][k2][jj] = on ? (short)0x3F80 : (short)0; }
#pragma unroll
                for (int ef = 0; ef < 4; ++ef) { f32x4 kd2[2];
#pragma unroll
                    for (int t2 = 0; t2 < 2; ++t2) { const int tj = 2 * ks + t2;
                        f32x4 E = mfma16(mk[t2][0], laop[ef][0], zero4); E = mfma16(mk[t2][1], laop[ef][1], E);
                        const f32x4 kR = mfma16(kn[tj][ef >> 1], ident[ef & 1], zero4);
#pragma unroll
                        for (int r = 0; r < 4; ++r) kd2[t2][r] = kR[r] * __expf(E[r]); }
                    kdop[ef][ks] = pack8(kd2[0], kd2[1]); __builtin_amdgcn_sched_barrier(0); }
            }
            bf16_t* U = uT + ((size_t)(dir * NCH + n) * 4 + h) * 8192 + (size_t)(64 * vh) * 64;
#pragma unroll
            for (int vf = 0; vf < 4; ++vf) { bf16x8 vtf[2];
#pragma unroll
                for (int ks = 0; ks < 2; ++ks) { const u32x2 v0 = *(const LAS u32x2*)(VTw + (16 * vf + c) * 72 + 32 * ks + 4 * q), v1 = *(const LAS u32x2*)(VTw + (16 * vf + c) * 72 + 32 * ks + 16 + 4 * q);
                    vtf[ks] = __builtin_bit_cast(bf16x8, (u32x4){v0.x, v0.y, v1.x, v1.y}); }
#pragma unroll
                for (int ef = 0; ef < 4; ++ef) { f32x4 u = mfma16(kdop[ef][0], vtf[0], zero4); u = mfma16(kdop[ef][1], vtf[1], u);
                    if (NEW0_WRITE & 2) *(u32x2*)(U + (16 * vf + c) * 64 + 16 * ef + 4 * q) = (u32x2){cvtpk(u[0], u[1]), cvtpk(u[2], u[3])}; } }
        }
    }
    if (MODE == 1) {
#pragma unroll
        for (int ti = 0; ti < 4; ++ti) { float ss = 0.f;
#pragma unroll
            for (int vf = 0; vf < 4; ++vf) ss += acc[vf][ti][0] * acc[vf][ti][0] + acc[vf][ti][1] * acc[vf][ti][1] + acc[vf][ti][2] * acc[vf][ti][2] + acc[vf][ti][3] * acc[vf][ti][3];
            ss += __shfl_xor(ss, 16); ss += __shfl_xor(ss, 32);
            if (q == 0) SSQ[(h * 64 + 16 * ti + c) * 2 + vh] = ss; }
        __syncthreads();
        const float* gn = p.in[14] + (size_t)l * 128;
#pragma unroll
        for (int ti = 0; ti < 4; ++ti) { const int t = 16 * ti + c; const float rs = rsqrtf((SSQ[(h * 64 + t) * 2] + SSQ[(h * 64 + t) * 2 + 1]) * (1.0f / 128.0f) + EPS);
#pragma unroll
            for (int vf = 0; vf < 4; ++vf) { const int v = 64 * vh + 16 * vf + 4 * q; const f32x4 g4 = *(const f32x4*)(gn + v);
                const bf16x4 gg = *(const bf16x4*)(proj + (size_t)(t0 + t) * DINP + 2048 + 128 * h + v); float o[4];
#pragma unroll
                for (int r = 0; r < 4; ++r) o[r] = acc[vf][ti][r] * rs * g4[r] * siluf_(bf2f((bf16_t)gg[r]));
                *(u32x2*)(y + (size_t)(t0 + t) * D + 512 + 128 * h + v) = (u32x2){pk2(o[0], o[1]), pk2(o[2], o[3])}; } }
    }
    __syncthreads();
}

__device__ void phase_scan(const Params& p) {
    unsigned char* ws = p.ws; const int tid = otid();
    if (tid < 256) {
        const bf16_t* __restrict__ uT = (const bf16_t*)(ws + WS_M); bf16_t* __restrict__ spT = (bf16_t*)(ws + WS_M + (size_t)S * D * 2); const float* __restrict__ dec = (const float*)(ws + WS_DEC);
        for (int gid = obid() * 256 + tid; gid < 65536; gid += gridDim.x * 256) {
            const int dir = gid >> 15, rem = gid & 32767, h = rem >> 13, vd = rem & 8191, d = vd & 63;
            float s = 0.f;
            const long step = dir ? -1 : 1; const int nfirst = dir ? NCH - 1 : 0;
            const bf16_t* up = uT + ((size_t)(dir * NCH + nfirst) * 4 + h) * 8192 + vd; bf16_t* sp = spT + ((size_t)(dir * NCH + nfirst) * 4 + h) * 8192 + vd;
            const float* dp = dec + ((size_t)(dir * NCH + nfirst) * 4 + h) * 64 + d;
#pragma unroll 1
            for (int st = 0; st < NCH; st += 64) {
                bf16_t ub[64]; float db[64];
#pragma unroll
                for (int i = 0; i < 64; ++i) { ub[i] = up[(long)(st + i) * step * 32768]; db[i] = dp[(long)(st + i) * step * 256]; }
#pragma unroll
                for (int i = 0; i < 64; ++i) { sp[(long)(st + i) * step * 32768] = f2bf(s); s = db[i] * s + bf2f(ub[i]); }
            }
        }
    } else if (tid < 384 && obid() < 8) {
        const float* __restrict__ Aprod = (const float*)(ws + WS_AP); const float* __restrict__ Hend = (const float*)(ws + WS_HE); float* __restrict__ carry = (float*)(ws + WS_CA);
        const int gid = obid() * 128 + (tid - 256); const int dir = gid >> 9, ch = gid & 511;
        float hc = 0.f;
        const long step = dir ? -1 : 1; const size_t base = (size_t)(dir * NCH + (dir ? NCH - 1 : 0)) * 512 + ch;
#pragma unroll 1
        for (int st = 0; st < NCH; st += 64) {
            float ab[64], hb[64];
#pragma unroll
            for (int i = 0; i < 64; ++i) { ab[i] = Aprod[base + (long)(st + i) * step * 512]; hb[i] = Hend[base + (long)(st + i) * step * 512]; }
#pragma unroll
            for (int i = 0; i < 64; ++i) { carry[base + (long)(st + i) * step * 512] = hc; hc = ab[i] * hc + hb[i]; }
        }
    }
}

#define XB_TMO      128
#define XB_XCNT(j)  (256  + 64 * (j))
#define XB_XSUB(j)  (1280 + 64 * (j))
#define XB_XGEN(j)  (2304 + 64 * (j))
#define XB_TOP      3328
#define XB_TOPGEN   3392
#define XCD_BAR_WORDS 3456
#define XB_SPIN_CAP (1u << 18)

__device__ __forceinline__ unsigned xb_ld(unsigned* p)              { return __hip_atomic_load(p, __ATOMIC_RELAXED, __HIP_MEMORY_SCOPE_AGENT); }
__device__ __forceinline__ unsigned xb_add(unsigned* p, unsigned v) { return __hip_atomic_fetch_add(p, v, __ATOMIC_RELAXED, __HIP_MEMORY_SCOPE_AGENT); }
__device__ __forceinline__ unsigned xb_xcc_id() { return (unsigned)__builtin_amdgcn_s_getreg((3 << 11) | 20) & 0xFu; }
#define XB_SPIN(cond, bar) do { unsigned _sp = 0; while (cond) { __builtin_amdgcn_s_sleep(1); \
    if ((++_sp & 255u) == 0u) { if (xb_ld(&(bar)[XB_TMO])) break; if (_sp > XB_SPIN_CAP) { atomicAdd(&(bar)[XB_TMO], 1u); break; } } } } while (0)

struct XcdBarrier {
    unsigned* bar; unsigned x;
    volatile LAS unsigned* st;
};

__device__ __forceinline__ XcdBarrier xcd_barrier_post(unsigned* bar, volatile LAS unsigned* st) {
    XcdBarrier b; b.bar = bar; b.x = xb_xcc_id(); b.st = st;
    if (threadIdx.x == 0) (void)xb_add(&bar[XB_XCNT(b.x)], 1u);
    return b;
}
__device__ __forceinline__ void xcd_barrier_complete(unsigned* bar, unsigned x, unsigned& nloc, unsigned& nx) {
    const unsigned G = gridDim.x * gridDim.y * gridDim.z;
    unsigned sum, cnt, mine, sp = 0u;
    for (;;) {
        sum = 0u; cnt = 0u; mine = 0u;
#pragma unroll
        for (unsigned j = 0; j < 16; ++j) { const unsigned c = xb_ld(&bar[XB_XCNT(j)]); sum += c; cnt += (c > 0u) ? 1u : 0u; mine = (j == x) ? c : mine; }
        if (sum == G) break;
        __builtin_amdgcn_s_sleep(1);
        if ((++sp & 255u) == 0u) { if (xb_ld(&bar[XB_TMO])) break; if (sp > XB_SPIN_CAP) { atomicAdd(&bar[XB_TMO], 1u); break; } }
    }
    nloc = mine > 0u ? mine : 1u; nx = cnt > 0u ? cnt : 1u;
}

__device__ __forceinline__ void xcd_barrier(const XcdBarrier& b) {
    asm volatile("s_waitcnt vmcnt(0)" ::: "memory");
    __syncthreads();
    if (threadIdx.x == 0) {
        unsigned* bar = b.bar;
        __builtin_amdgcn_s_waitcnt(0);
        unsigned nloc = b.st[0], nx = b.st[1];
        if (nloc == 0u) { xcd_barrier_complete(bar, b.x, nloc, nx); b.st[0] = nloc; b.st[1] = nx; }
        const unsigned old = xb_add(&bar[XB_XSUB(b.x)], 1u);
        const unsigned gen = old / nloc;
        if (old + 1u == (gen + 1u) * nloc) {
            __builtin_amdgcn_fence(__ATOMIC_RELEASE, "agent");
            asm volatile("s_waitcnt vmcnt(0)" ::: "memory");
            const unsigned og = xb_add(&bar[XB_TOP], 1u);
            const unsigned tg = og / nx;
            if (og + 1u == (tg + 1u) * nx) xb_add(&bar[XB_TOPGEN], 1u);
            else XB_SPIN(xb_ld(&bar[XB_TOPGEN]) == tg, bar);
            __builtin_amdgcn_fence(__ATOMIC_ACQUIRE, "agent");
            xb_add(&bar[XB_XGEN(b.x)], 1u);
            asm volatile("s_waitcnt vmcnt(0)" ::: "memory");
        } else {
            XB_SPIN(xb_ld(&bar[XB_XGEN(b.x)]) == gen, bar);
            __builtin_amdgcn_fence(__ATOMIC_ACQUIRE, "agent");
            asm volatile("s_waitcnt vmcnt(0)" ::: "memory");
        }
    }
    __syncthreads();
}

__global__ void __launch_bounds__(NTHR, 2) mk_fwd(Params p) {
    extern __shared__ __attribute__((aligned(16))) unsigned char lds_raw[];
    LAS unsigned char* lds = (LAS unsigned char*)lds_raw;
    unsigned char* ws = p.ws;
    bf16_t* WinT = (bf16_t*)(ws + WS_WIN); bf16_t* WoutT = (bf16_t*)(ws + WS_WOUT); bf16_t* WguT = (bf16_t*)(ws + WS_WGU); bf16_t* WdT = (bf16_t*)(ws + WS_WD);
    bf16_t* Hb = (bf16_t*)(ws + WS_H); bf16_t* PROJ = (bf16_t*)(ws + WS_PROJ); float* Mb = (float*)(ws + WS_M);
    const float* xin = p.in[0]; float* out = p.out;
    volatile LAS unsigned* bst = (volatile LAS unsigned*)(lds + LDS_BYTES - 16);
    if (threadIdx.x == 0) { bst[0] = 0u; bst[1] = 0u; }
    __syncthreads();
    XcdBarrier bar = xcd_barrier_post((unsigned*)(ws + WS_CTL), bst);
    for (int ph = p.ph_lo; ph < p.ph_hi; ++ph) {
        if (ph == p.ph_lo + 1) cg::this_grid().sync();
        else if (ph > p.ph_lo) xcd_barrier(bar);
        if (ph == 9 * NL) { phase_rowprep(out, (const bf16_t*)Mb, p.in[17] + (size_t)(NL - 1) * D, out, nullptr, nullptr); continue; }
        const int l = ph / 9, s = ph % 9;
#ifndef REPEAT_MASK
#define REPEAT_MASK 0
#endif
        for (int rep = 0; rep < (((REPEAT_MASK >> s) & 1) ? 2 : 1); ++rep) {
        if (rep) xcd_barrier(bar);
        switch (s) {
#ifndef PHMASK
#define PHMASK 0x1ff
#endif
        case 0: if (!(PHMASK & 1)) break; phase_weights(p, l, lds);
                if (rep) break;
                if (l == 0) phase_rowprep(xin, nullptr, nullptr, nullptr, p.in[1], Hb);
                else phase_rowprep(out, (const bf16_t*)Mb, p.in[17] + (size_t)(l - 1) * D, out, p.in[1] + (size_t)l * D, Hb);
                break;
        case 1: if (!(PHMASK & 2)) break; gemm_fast(lds, Hb, WinT, S, DINP, D, EpiB16{PROJ, DINP}); break;
        case 2: if (!(PHMASK & 4)) break; for (int rr = 0; rr < ((REPEAT_SUB & 1) ? 2 : 1); ++rr) for (int n = obid(); n < NCH; n += gridDim.x) mixer_lru<0>(p, l, n, lds);
                for (int rr = 0; rr < ((REPEAT_SUB & 2) ? 2 : 1); ++rr) for (int n = obid(); n < NCH; n += gridDim.x) mixer_gla<0>(p, l, n, lds); break;
        case 3: if (!(PHMASK & 8)) break; phase_scan(p); break;
        case 4: if (!(PHMASK & 16)) break; for (int rr = 0; rr < ((REPEAT_SUB & 4) ? 2 : 1); ++rr) for (int n = obid(); n < NCH; n += gridDim.x) mixer_lru<1>(p, l, n, lds);
                for (int rr = 0; rr < ((REPEAT_SUB & 8) ? 2 : 1); ++rr) for (int n = obid(); n < NCH; n += gridDim.x) mixer_gla<1>(p, l, n, lds); break;
        case 5: if (!(PHMASK & 32)) break; gemm_fast(lds, Hb, WoutT, S, D, D, EpiB16{(bf16_t*)Mb, D}); break;
        case 6: if (!(PHMASK & 64)) break; phase_rowprep(l == 0 ? xin : out, (const bf16_t*)Mb, p.in[2] + (size_t)l * D, out, p.in[16] + (size_t)l * D, Hb); break;
        case 7: if (!(PHMASK & 128)) break; gemm_fast(lds, Hb, WguT, S, 2 * DFF, D, EpiSwiglu{PROJ, DFF}); break;
        case 8: if (!(PHMASK & 256)) break; gemm_fast(lds, PROJ, WdT, S, D, DFF, EpiB16{(bf16_t*)Mb, D}); break;
        }
        }
    }
}

extern "C" void kernel_launch(void* const* d_in, const int* in_sizes, int n_in, void* d_out, int out_size, void* d_ws, size_t ws_size, hipStream_t stream) {
    static int grid = 0;
    if (grid == 0) {
        if (n_in != 21 || out_size != S * D || ws_size < WS_END) { fprintf(stderr, "kernel_launch: unexpected shapes: n_in %d out %d ws %zu (need %zu)\n", n_in, out_size, ws_size, (size_t)WS_END); grid = -1; return; }
        int dev = 0, cus = 0, per_cu = 0;
        (void)hipGetDevice(&dev); (void)hipDeviceGetAttribute(&cus, hipDeviceAttributeMultiprocessorCount, dev);
        if (hipFuncSetAttribute((const void*)mk_fwd, hipFuncAttributeMaxDynamicSharedMemorySize, LDS_BYTES) != hipSuccess) { fprintf(stderr, "kernel_launch: hipFuncSetAttribute failed\n"); grid = -1; return; }
        if (hipOccupancyMaxActiveBlocksPerMultiprocessor(&per_cu, (const void*)mk_fwd, NTHR, LDS_BYTES) != hipSuccess || per_cu < 1) { fprintf(stderr, "kernel_launch: occupancy query says %d\n", per_cu); per_cu = 1; }
        (void)hipGetLastError();
        grid = cus;
    }
    if (grid < 0) return;
    Params p{};
    for (int i = 0; i < 21; ++i) p.in[i] = (const float*)d_in[i];
    p.out = (float*)d_out; p.ws = (unsigned char*)d_ws;
    (void)hipMemsetAsync((unsigned char*)d_ws + WS_CTL, 0, 16384, stream);
#if ONE_LAUNCH
    p.ph_lo = 0; p.ph_hi = 9 * NL + 1;
    void* args[] = {&p};
    hipError_t e = hipLaunchCooperativeKernel((const void*)mk_fwd, dim3(grid), dim3(NTHR), args, LDS_BYTES, stream);
    if (e != hipSuccess) fprintf(stderr, "cooperative launch failed: %s (grid %d)\n", hipGetErrorString(e), grid);
#else
    for (int ph = 0; ph < 9 * NL + 1; ++ph) { p.ph_lo = ph; p.ph_hi = ph + 1; hipLaunchKernelGGL(mk_fwd, dim3(grid), dim3(NTHR), LDS_BYTES, stream, p); }
#endif
}
```

```cpp
#include <hip/hip_runtime.h>
#include <hip/hip_cooperative_groups.h>
#include <cstdio>
namespace cg = cooperative_groups;

#ifndef ONE_LAUNCH
#define ONE_LAUNCH 1
#endif

#define LAS __attribute__((address_space(3)))
typedef unsigned short bf16_t;
typedef short bf16x8 __attribute__((ext_vector_type(8)));
typedef short bf16x4 __attribute__((ext_vector_type(4)));
typedef float f32x4 __attribute__((ext_vector_type(4)));
typedef unsigned u32x4 __attribute__((ext_vector_type(4)));
typedef unsigned u32x2 __attribute__((ext_vector_type(2)));
typedef float f32x2 __attribute__((ext_vector_type(2)));
typedef __bf16 bf16v2 __attribute__((ext_vector_type(2)));

constexpr int S = 16384, D = 1024, DIN = 2592, DINP = 2816, DFF = 2816, NL = 4, NCH = 256;
constexpr int NTHR = 512;
constexpr int LDS_BYTES = 147456;
constexpr float EPS = 1e-6f;

constexpr size_t WS_CTL = 0;
constexpr size_t WS_WIN = 65536;
constexpr size_t WS_WOUT = WS_WIN + (size_t)DINP * D * 2;
constexpr size_t WS_WGU = WS_WOUT + (size_t)D * D * 2;
constexpr size_t WS_WD = WS_WGU + (size_t)2 * DFF * D * 2;
constexpr size_t WS_LRUW = WS_WD + (size_t)D * DFF * 2;
constexpr size_t WS_GW = WS_LRUW + (size_t)2 * 2 * 8 * 64 * 64 * 2;
constexpr size_t WS_H = WS_GW + (size_t)2 * 256 * 32 * 2;
constexpr size_t WS_PROJ = WS_H + (size_t)S * D * 2;
constexpr size_t WS_M = WS_PROJ + (size_t)S * DINP * 2;
constexpr size_t WS_AP = WS_M + (size_t)S * D * 4;
constexpr size_t WS_HE = WS_AP + (size_t)2 * NCH * 512 * 4;
constexpr size_t WS_CA = WS_HE + (size_t)2 * NCH * 512 * 4;
constexpr size_t WS_DEC = WS_CA + (size_t)2 * NCH * 512 * 4;
constexpr size_t WS_PB = WS_DEC + (size_t)2 * NCH * 4 * 64 * 4;
constexpr size_t WS_END = WS_PB + (size_t)S * 512 * 2;

struct Params { const float* in[21]; float* out; unsigned char* ws; int ph_lo, ph_hi; };

__device__ __forceinline__ float bf2f(bf16_t b) { return __uint_as_float(((unsigned)b) << 16); }
__device__ __forceinline__ bf16_t f2bf(float f) { unsigned u = __float_as_uint(f); return (bf16_t)((u + 0x7fffu + ((u >> 16) & 1u)) >> 16); }
__device__ __forceinline__ unsigned pk2(float lo, float hi) { return (unsigned)f2bf(lo) | ((unsigned)f2bf(hi) << 16); }
__device__ __forceinline__ unsigned cvtpk(float lo, float hi) { const f32x2 v = (f32x2){lo, hi}; const bf16v2 b = __builtin_convertvector(v, bf16v2); return __builtin_bit_cast(unsigned, b); }
__device__ __forceinline__ float sigmoidf_(float x) { return __builtin_amdgcn_rcpf(1.0f + __expf(-x)); }
__device__ __forceinline__ float siluf_(float x) { return x * sigmoidf_(x); }
__device__ __forceinline__ float geluf_(float x) { const float y = 0.7978845608028654f * (x + 0.044715f * x * x * x); const float t = 1.0f - 2.0f * __builtin_amdgcn_rcpf(__expf(2.0f * y) + 1.0f); return 0.5f * x * (1.0f + t); }
__device__ __forceinline__ f32x4 mfma16(bf16x8 a, bf16x8 b, f32x4 c) { return __builtin_amdgcn_mfma_f32_16x16x32_bf16(a, b, c, 0, 0, 0); }
__device__ __forceinline__ int otid() { int t = threadIdx.x; asm volatile("" : "+v"(t)); return t; }
__device__ __forceinline__ int obid() { int t = blockIdx.x; asm volatile("" : "+s"(t)); return t; }
#define LDS_FENCE() asm volatile("s_waitcnt lgkmcnt(0)" ::: "memory")

struct WDesc { const float* src; bf16_t* dst; int ldsrc, c0, nvalid, k0, lddst, r0; };
__device__ __forceinline__ WDesc wdesc(const Params& p, int l, int u) {
    unsigned char* ws = p.ws;
    constexpr int T_IN = 44 * 16, T_OUT = 16 * 16, T_GU = 88 * 16, T_D = 16 * 44;
    WDesc d; int v = u;
    if (v < T_IN) { const int rt = v / 16, kt = v % 16; int nv = DIN - rt * 64; nv = nv > 64 ? 64 : (nv < 0 ? 0 : nv);
        d.src = p.in[3] + (size_t)l * D * DIN; d.ldsrc = DIN; d.c0 = nv > 0 ? rt * 64 : 0; d.nvalid = nv; d.k0 = kt * 64; d.dst = (bf16_t*)(ws + WS_WIN); d.lddst = D; d.r0 = rt * 64; return d; }
    v -= T_IN;
    if (v < T_OUT) { const int rt = v / 16, kt = v % 16; d.src = p.in[15] + (size_t)l * D * D; d.ldsrc = D; d.c0 = rt * 64; d.nvalid = 64; d.k0 = kt * 64; d.dst = (bf16_t*)(ws + WS_WOUT); d.lddst = D; d.r0 = rt * 64; return d; }
    v -= T_OUT;
    if (v < T_GU) { const int rt = v / 16, kt = v % 16; const int r0 = rt * 64, j = r0 / 256, within = r0 % 256;
        d.src = (within < 128 ? p.in[18] : p.in[19]) + (size_t)l * D * DFF; d.ldsrc = DFF; d.c0 = j * 128 + (within & 127); d.nvalid = 64; d.k0 = kt * 64; d.dst = (bf16_t*)(ws + WS_WGU); d.lddst = D; d.r0 = r0; return d; }
    v -= T_GU;
    if (v < T_D) { const int rt = v / 44, kt = v % 44; d.src = p.in[20] + (size_t)l * DFF * D; d.ldsrc = D; d.c0 = rt * 64; d.nvalid = 64; d.k0 = kt * 64; d.dst = (bf16_t*)(ws + WS_WD); d.lddst = DFF; d.r0 = rt * 64; return d; }
    v -= T_D;
    { const int dir = v / 16, gate = (v / 8) % 2, h = v % 8; d.src = (gate ? p.in[8] : p.in[6]) + ((size_t)(l * 2 + dir) * 8 + h) * 4096; d.ldsrc = 64; d.c0 = 0; d.nvalid = 64; d.k0 = 0;
      d.dst = (bf16_t*)(ws + WS_LRUW) + ((size_t)(dir * 2 + gate) * 8 + h) * 4096; d.lddst = 64; d.r0 = 0; return d; }
}

__device__ void phase_weights(const Params& p, int l, LAS unsigned char* lds) {
    LAS float* T = (LAS float*)lds;
    unsigned char* ws = p.ws;
    constexpr int TOT = 44 * 16 + 16 * 16 + 88 * 16 + 16 * 44 + 32;
    const int tid = otid(), G = gridDim.x;
    for (int u0 = obid(); u0 < TOT; u0 += 4 * G) {
        f32x4 v[4][2];
        { const int k = tid >> 3, cg8 = (tid & 7) * 8;
#pragma unroll
          for (int j = 0; j < 4; ++j) { const int u = u0 + j * G; v[j][0] = (f32x4){0.f, 0.f, 0.f, 0.f}; v[j][1] = v[j][0];
              if (u < TOT) { const WDesc d = wdesc(p, l, u); const float* sp = d.src + (size_t)(d.k0 + k) * d.ldsrc + d.c0 + cg8;
                  if (cg8 + 3 < d.nvalid) v[j][0] = *(const f32x4*)sp; if (cg8 + 7 < d.nvalid) v[j][1] = *(const f32x4*)(sp + 4); } }
#pragma unroll
          for (int j = 0; j < 4; ++j)
#pragma unroll
              for (int i = 0; i < 2; ++i) { LAS float* Tj = T + j * 4160 + k * 65 + cg8 + 4 * i; Tj[0] = v[j][i][0]; Tj[1] = v[j][i][1]; Tj[2] = v[j][i][2]; Tj[3] = v[j][i][3]; } }
        __syncthreads();
        { const int r = tid >> 3, kg = (tid & 7) * 8;
#pragma unroll
          for (int j = 0; j < 4; ++j) { const int u = u0 + j * G;
              if (u < TOT) { const WDesc d = wdesc(p, l, u); const LAS float* Tj = T + j * 4160; u32x4 w;
                  w.x = cvtpk(Tj[(kg + 0) * 65 + r], Tj[(kg + 1) * 65 + r]); w.y = cvtpk(Tj[(kg + 2) * 65 + r], Tj[(kg + 3) * 65 + r]);
                  w.z = cvtpk(Tj[(kg + 4) * 65 + r], Tj[(kg + 5) * 65 + r]); w.w = cvtpk(Tj[(kg + 6) * 65 + r], Tj[(kg + 7) * 65 + r]);
                  *(u32x4*)(d.dst + (size_t)(d.r0 + r) * d.lddst + d.k0 + kg) = w; } } }
        __syncthreads();
    }
    { bf16_t* GW = (bf16_t*)(ws + WS_GW); const float* wg = p.in[12] + (size_t)l * 2 * 16 * 256;
      for (int idx = obid() * NTHR + otid(); idx < 2 * 256 * 32; idx += gridDim.x * NTHR) { const int dir = idx >> 13, e = (idx >> 5) & 255, r = idx & 31;
          GW[idx] = r < 16 ? f2bf(wg[(size_t)(dir * 16 + r) * 256 + e]) : (bf16_t)0; } }
}

__device__ void phase_rowprep(const float* __restrict__ xsrc, const bf16_t* __restrict__ m, const float* __restrict__ gpost, float* __restrict__ xdst, const float* __restrict__ gpre, bf16_t* __restrict__ hdst) {
    const int tid = otid(); const int lane = tid & 63, wave = tid >> 6;
    for (int row = obid() * 8 + wave; row < S; row += gridDim.x * 8) {
        f32x4 xv[4];
#pragma unroll
        for (int i = 0; i < 4; ++i) xv[i] = *(const f32x4*)(xsrc + (size_t)row * D + i * 256 + lane * 4);
        if (m) {
            f32x4 mv[4]; float ss = 0.f;
#pragma unroll
            for (int i = 0; i < 4; ++i) { const bf16x4 mb = *(const bf16x4*)(m + (size_t)row * D + i * 256 + lane * 4); mv[i] = (f32x4){bf2f((bf16_t)mb[0]), bf2f((bf16_t)mb[1]), bf2f((bf16_t)mb[2]), bf2f((bf16_t)mb[3])}; ss += mv[i][0] * mv[i][0] + mv[i][1] * mv[i][1] + mv[i][2] * mv[i][2] + mv[i][3] * mv[i][3]; }
#pragma unroll
            for (int o = 32; o >= 1; o >>= 1) ss += __shfl_xor(ss, o);
            const float rs = rsqrtf(ss * (1.0f / D) + EPS);
#pragma unroll
            for (int i = 0; i < 4; ++i) { const f32x4 g = *(const f32x4*)(gpost + i * 256 + lane * 4); xv[i] += mv[i] * rs * g; }
        }
        if (xdst) {
#pragma unroll
            for (int i = 0; i < 4; ++i) *(f32x4*)(xdst + (size_t)row * D + i * 256 + lane * 4) = xv[i];
        }
        if (hdst) {
            float ss = 0.f;
#pragma unroll
            for (int i = 0; i < 4; ++i) ss += xv[i][0] * xv[i][0] + xv[i][1] * xv[i][1] + xv[i][2] * xv[i][2] + xv[i][3] * xv[i][3];
#pragma unroll
            for (int o = 32; o >= 1; o >>= 1) ss += __shfl_xor(ss, o);
            const float rs = rsqrtf(ss * (1.0f / D) + EPS);
#pragma unroll
            for (int i = 0; i < 4; ++i) { const f32x4 g = *(const f32x4*)(gpre + i * 256 + lane * 4); const f32x4 hv = xv[i] * rs * g; u32x2 w; w.x = pk2(hv[0], hv[1]); w.y = pk2(hv[2], hv[3]);
                *(u32x2*)(hdst + (size_t)row * D + i * 256 + lane * 4) = w; }
        }
    }
}

namespace pg8 {
#define PG8_LAS __attribute__((address_space(3)))
constexpr int BM = 256, BK = 64, HALF = 128, HTB = HALF * BK * 2  , STAGE_BYTES = 8 * HTB, NXCD = 8, WGM = 8;
__host__ __device__ __forceinline__ int lds_byte(int r, int c) { const int st = (r >> 4) * 2 + (c >> 5), rr = r & 15, cc = c & 31, ob = rr * 64 + cc * 2; return st * 1024 + (ob ^ (((ob >> 9) & 1) << 5)); }
__host__ __device__ __forceinline__ void stage_rc(int b, int& R, int& C) { const int st = b / 1024, sb = b % 1024, swz = sb ^ (((sb >> 9) & 1) << 5); R = (st >> 1) * 16 + swz / 64; C = (st & 1) * 32 + (swz % 64) / 2; }
__host__ __device__ __forceinline__ int perm32(int rho) { const int n = rho >> 4, i = rho & 15; return 8 * (i >> 2) + 4 * n + (i & 3); }
struct Unit { int pm, pn; };
struct Gemm { const bf16_t* A; const bf16_t* Bt; int M, N, K; };
struct StaticOrder {
    int nM, nN, nwg, G, c;
    __host__ __device__ void init(int M, int N, int G_, int c_) { nM = M / BM; nN = N / BM; nwg = nM * nN; G = G_; c = c_; }
    __host__ __device__ bool next(int i, Unit& u) const {
        const long L = (long)i * G + c; if (L >= nwg) return false;
        int wgid = (int)L; { const int q = nwg / NXCD, r = nwg % NXCD, xcd = wgid % NXCD, off = wgid / NXCD; wgid = (xcd < r ? xcd * (q + 1) : r * (q + 1) + (xcd - r) * q) + off; }
        const int nig = WGM * nN, gid = wgid / nig, fm = gid * WGM, gsz = (nM - fm) < WGM ? (nM - fm) : WGM;
        u.pm = fm + ((wgid % nig) % gsz); u.pn = (wgid % nig) / gsz; return true;
    }
    __device__ __forceinline__ void a_ready(const Unit&) const {}
    __device__ __forceinline__ void done(const Unit&) const {}
};
__device__ __forceinline__ unsigned cvt_pk_bf16(float lo, float hi) { unsigned r; asm volatile("v_cvt_pk_bf16_f32 %0, %1, %2" : "=v"(r) : "v"(lo), "v"(hi)); return r; }
template <class Epi, class Sched>
__device__ __forceinline__ void gemm_phase(PG8_LAS unsigned char* lds, const Gemm g, const Sched& S, const Epi& E) {
    const int tid = otid(), wid = __builtin_amdgcn_readfirstlane(tid >> 6), lane = tid & 63, wr = wid >> 2, wc = wid & 3, fr = lane & 15, fq = lane >> 4;
    const int K = g.K, nt = K / BK;
    unsigned voffA[2], voffB[2];
#pragma unroll
    for (int i = 0; i < 2; ++i) { int R, C; stage_rc(tid * 16 + i * 8192, R, C); const int Rb = Epi::PERM ? ((R & ~31) + perm32(R & 31)) : R;
        voffA[i] = (unsigned)(R * K + C) * 2u; voffB[i] = (unsigned)(Rb * K + C) * 2u; }
    const size_t kstep = (size_t)(BK * 2);
    const size_t hstep = (size_t)HALF * K * 2;
    const size_t tstep = 2 * hstep;
    const unsigned ldsw = (unsigned)wid * 1024u;
    const int aoff = lds_byte(wr * 64 + fr, fq * 8), boff = lds_byte(wc * 32 + fr, fq * 8);
#define PG8_SA(b, h) (((b) * 2 + (h)) * HTB)
#define PG8_SB(b, h) ((4 + (b) * 2 + (h)) * HTB)
#define PG8_STAGE(bufoff, gbase, voff) do { _Pragma("unroll") for (int _i = 0; _i < 2; ++_i) \
        __builtin_amdgcn_global_load_lds((const unsigned*)((const char*)(gbase) + (voff)[_i]), (PG8_LAS unsigned*)(lds + (bufoff) + ldsw + _i * 8192), 16, 0, 0); } while (0)
#define PG8_LDA(dst, b, h) do { _Pragma("unroll") for (int m = 0; m < 4; ++m) _Pragma("unroll") for (int k = 0; k < 2; ++k) dst[m][k] = *(const PG8_LAS bf16x8*)(lds + PG8_SA(b, h) + aoff + m * 2048 + k * 1024); } while (0)
#define PG8_LDB(dst, b, h) do { _Pragma("unroll") for (int n = 0; n < 2; ++n) _Pragma("unroll") for (int k = 0; k < 2; ++k) dst[n][k] = *(const PG8_LAS bf16x8*)(lds + PG8_SB(b, h) + boff + n * 2048 + k * 1024); } while (0)
#define PG8_MMA(ai, bj, At, Bt) do { __builtin_amdgcn_s_setprio(1); _Pragma("unroll") for (int m = 0; m < 4; ++m) _Pragma("unroll") for (int n = 0; n < 2; ++n) _Pragma("unroll") for (int k = 0; k < 2; ++k) \
        acc[ai][bj][m][n] = __builtin_amdgcn_mfma_f32_16x16x32_bf16(Bt[n][k], At[m][k], acc[ai][bj][m][n], 0, 0, 0); __builtin_amdgcn_s_setprio(0); } while (0)
#define PG8_WAIT_V(n) asm volatile("s_waitcnt vmcnt(" #n ")" ::: "memory")
#define PG8_WAIT_L(n) asm volatile("s_waitcnt lgkmcnt(" #n ")" ::: "memory")
#define PG8_BAR __builtin_amdgcn_s_barrier()
#define PG8_SCHED __builtin_amdgcn_sched_barrier(0)
    Unit cur, nxt; int ui = 0;
    if (!S.next(0, cur)) return;
    f32x4 acc[2][2][4][2];
#pragma unroll
    for (int a = 0; a < 2; ++a)
#pragma unroll
        for (int b = 0; b < 2; ++b)
#pragma unroll
            for (int m = 0; m < 4; ++m)
#pragma unroll
                for (int n = 0; n < 2; ++n) acc[a][b][m][n] = (f32x4){0.f, 0.f, 0.f, 0.f};
    bf16x8 At[4][2], B0[2][2], B1[2][2];
    const char* cA = (const char*)g.A + (size_t)cur.pm * tstep; const char* cB = (const char*)g.Bt + (size_t)cur.pn * tstep;
    S.a_ready(cur);
    PG8_STAGE(PG8_SB(0, 0), cB, voffB); PG8_STAGE(PG8_SA(0, 0), cA, voffA); PG8_STAGE(PG8_SB(0, 1), cB + hstep, voffB); PG8_STAGE(PG8_SA(0, 1), cA + hstep, voffA);
    if (wr == 1) PG8_BAR;
    PG8_WAIT_V(4); PG8_BAR;
    PG8_STAGE(PG8_SB(1, 0), cB + kstep, voffB); PG8_STAGE(PG8_SA(1, 0), cA + kstep, voffA); PG8_STAGE(PG8_SB(1, 1), cB + hstep + kstep, voffB);
    PG8_WAIT_V(6); PG8_BAR;
    for (;;) {
        const bool has_next = S.next(ui + 1, nxt);
        const char* nA = has_next ? (const char*)g.A + (size_t)nxt.pm * tstep : cA; const char* nB = has_next ? (const char*)g.Bt + (size_t)nxt.pn * tstep : cB;
        for (int t = 0; t < nt; t += 2) {
            const bool last = (t == nt - 2);
            const char* a1 = cA + (size_t)(t + 1) * kstep;
            const char* a2 = last ? nA : cA + (size_t)(t + 2) * kstep; const char* b2 = last ? nB : cB + (size_t)(t + 2) * kstep;
            const char* a3 = a2 + kstep; const char* b3 = b2 + kstep;
            if (last && has_next) S.a_ready(nxt);
            PG8_LDB(B0, 0, 0); PG8_SCHED; PG8_LDA(At, 0, 0); PG8_STAGE(PG8_SA(1, 1), a1 + hstep, voffA);
            PG8_WAIT_L(8); PG8_BAR; PG8_WAIT_L(0); PG8_MMA(0, 0, At, B0); PG8_BAR; PG8_SCHED;
            PG8_LDB(B1, 0, 1); PG8_STAGE(PG8_SB(0, 0), b2, voffB);
            PG8_BAR; PG8_WAIT_L(0); PG8_MMA(0, 1, At, B1); PG8_BAR;
            PG8_LDA(At, 0, 1); PG8_STAGE(PG8_SA(0, 0), a2, voffA);
            PG8_BAR; PG8_WAIT_L(0); PG8_MMA(1, 0, At, B0); PG8_BAR; PG8_SCHED;
            PG8_STAGE(PG8_SB(0, 1), b2 + hstep, voffB);
            PG8_WAIT_V(6); PG8_BAR; PG8_MMA(1, 1, At, B1); PG8_BAR;
            PG8_LDB(B0, 1, 0); PG8_SCHED; PG8_LDA(At, 1, 0); PG8_STAGE(PG8_SA(0, 1), a2 + hstep, voffA);
            PG8_WAIT_L(8); PG8_BAR; PG8_WAIT_L(0); PG8_MMA(0, 0, At, B0); PG8_BAR; PG8_SCHED;
            PG8_LDB(B1, 1, 1); PG8_STAGE(PG8_SB(1, 0), b3, voffB);
            PG8_BAR; PG8_WAIT_L(0); PG8_MMA(0, 1, At, B1); PG8_BAR;
            PG8_LDA(At, 1, 1); PG8_STAGE(PG8_SA(1, 0), a3, voffA);
            PG8_BAR; PG8_WAIT_L(0); PG8_MMA(1, 0, At, B0); PG8_BAR; PG8_SCHED;
            PG8_STAGE(PG8_SB(1, 1), b3 + hstep, voffB);
            PG8_WAIT_V(6); PG8_BAR; PG8_MMA(1, 1, At, B1); PG8_BAR;
        }
        if constexpr (!Epi::AFTER_DRAIN) { E(acc, cur, wr, wc, fr, fq); S.done(cur); }
        if (!has_next) break;
#pragma unroll
        for (int a = 0; a < 2; ++a)
#pragma unroll
            for (int b = 0; b < 2; ++b)
#pragma unroll
                for (int m = 0; m < 4; ++m)
#pragma unroll
                    for (int n = 0; n < 2; ++n) acc[a][b][m][n] = (f32x4){0.f, 0.f, 0.f, 0.f};
        cur = nxt; cA = nA; cB = nB; ++ui;
    }
    PG8_WAIT_V(0);
    if (wr == 0) PG8_BAR;
    PG8_BAR;
    if constexpr (Epi::AFTER_DRAIN) { E.fused(acc, cur, wr, wc, fr, fq, lds, wid, lane); S.done(cur); }
#undef PG8_SA
#undef PG8_SB
#undef PG8_STAGE
#undef PG8_LDA
#undef PG8_LDB
#undef PG8_MMA
#undef PG8_WAIT_V
#undef PG8_WAIT_L
#undef PG8_BAR
#undef PG8_SCHED
}
}

struct EpiB16 {
    static constexpr bool PERM = true, AFTER_DRAIN = false;
    bf16_t* O; int ldc;
    __device__ __forceinline__ void operator()(const f32x4 (&acc)[2][2][4][2], const pg8::Unit& u, int wr, int wc, int fr, int fq) const {
        const int row0 = u.pm * 256 + wr * 64 + fr, col0 = u.pn * 256 + wc * 32 + 8 * fq;
#pragma unroll
        for (int ai = 0; ai < 2; ++ai)
#pragma unroll
            for (int m = 0; m < 4; ++m) { bf16_t* rowp = O + (size_t)(row0 + ai * 128 + m * 16) * ldc + col0;
#pragma unroll
                for (int bj = 0; bj < 2; ++bj) { const f32x4 v0 = acc[ai][bj][m][0], v1 = acc[ai][bj][m][1];
                    u32x4 w; w.x = cvtpk(v0[0], v0[1]); w.y = cvtpk(v0[2], v0[3]); w.z = cvtpk(v1[0], v1[1]); w.w = cvtpk(v1[2], v1[3]);
                    *(u32x4*)(rowp + bj * 128) = w; } }
    }
};
struct EpiSwiglu {
    static constexpr bool PERM = true, AFTER_DRAIN = false;
    bf16_t* O; int ldc;
    __device__ __forceinline__ void operator()(const f32x4 (&acc)[2][2][4][2], const pg8::Unit& u, int wr, int wc, int fr, int fq) const {
        const int row0 = u.pm * 256 + wr * 64 + fr, col0 = u.pn * 128 + wc * 32 + 8 * fq;
#pragma unroll
        for (int ai = 0; ai < 2; ++ai)
#pragma unroll
            for (int m = 0; m < 4; ++m) { bf16_t* rowp = O + (size_t)(row0 + ai * 128 + m * 16) * ldc + col0;
                const f32x4 g0 = acc[ai][0][m][0], g1 = acc[ai][0][m][1], u0 = acc[ai][1][m][0], u1 = acc[ai][1][m][1];
                u32x4 w; w.x = cvtpk(siluf_(g0[0]) * u0[0], siluf_(g0[1]) * u0[1]); w.y = cvtpk(siluf_(g0[2]) * u0[2], siluf_(g0[3]) * u0[3]);
                w.z = cvtpk(siluf_(g1[0]) * u1[0], siluf_(g1[1]) * u1[1]); w.w = cvtpk(siluf_(g1[2]) * u1[2], siluf_(g1[3]) * u1[3]);
                *(u32x4*)rowp = w; }
    }
};
template <class Epi> __device__ __forceinline__ void gemm_fast(LAS unsigned char* lds, const bf16_t* A, const bf16_t* Bt, int M, int N, int K, const Epi& E) {
    pg8::Gemm g; g.A = A; g.Bt = Bt; g.M = M; g.N = N; g.K = K;
    pg8::StaticOrder so; so.init(M, N, (int)gridDim.x, obid());
    pg8::gemm_phase<Epi, pg8::StaticOrder>(lds, g, so, E);
    __syncthreads();
}

template <int DIR> __device__ __forceinline__ void lru_dir(const Params& p, int l, int n, int h, int lane, LAS bf16_t* XC, LAS float* STA, LAS float* STU) {
    const int c = lane & 15, q = lane >> 4, j = lane, t0 = n * 64;
    unsigned char* ws = p.ws;
    bf16_t* y = (bf16_t*)(ws + WS_H); bf16_t* PB = (bf16_t*)(ws + WS_PB);
    const bf16_t* LW = (const bf16_t*)(ws + WS_LRUW);
    float* Aprod = (float*)(ws + WS_AP); float* Hend = (float*)(ws + WS_HE);
    const float* lam = p.in[10] + (size_t)(l * 2 + DIR) * 512 + 64 * h; const float* b_a = p.in[7] + (size_t)(l * 2 + DIR) * 512 + 64 * h; const float* b_x = p.in[9] + (size_t)(l * 2 + DIR) * 512 + 64 * h;
    const bf16_t* LWa = LW + ((size_t)(DIR * 2 + 0) * 8 + h) * 4096 + c * 64 + 8 * q; const bf16_t* LWx = LW + ((size_t)(DIR * 2 + 1) * 8 + h) * 4096 + c * 64 + 8 * q;
    bf16x8 wa[4][2], wx[4][2]; f32x4 sp4[4], ba4[4], bx4[4];
#pragma unroll
    for (int nf = 0; nf < 4; ++nf) {
#pragma unroll
        for (int ks = 0; ks < 2; ++ks) { wa[nf][ks] = *(const bf16x8*)(LWa + nf * 1024 + 32 * ks); wx[nf][ks] = *(const bf16x8*)(LWx + nf * 1024 + 32 * ks); }
        const f32x4 lam4 = *(const f32x4*)(lam + 16 * nf + 4 * q); ba4[nf] = *(const f32x4*)(b_a + 16 * nf + 4 * q); bx4[nf] = *(const f32x4*)(b_x + 16 * nf + 4 * q);
#pragma unroll
        for (int r = 0; r < 4; ++r) { const float e = __expf(-lam4[r]); const float l1p = e < 0.05f ? e * (1.0f - e * (0.5f - e * (0.33333334f - e * 0.25f))) : __logf(1.0f + e); sp4[nf][r] = -8.0f * l1p; }
    }
    float hcar = 0.f, P = 1.f;
#pragma unroll 1
    for (int g = 0; g < 4; ++g) {
        const int mi = DIR == 0 ? g : 3 - g;
        bf16_t hfp[16];
        if (DIR == 1) {
#pragma unroll
            for (int s = 0; s < 16; ++s) hfp[s] = y[(size_t)(t0 + 16 * mi + s) * D + 64 * h + j];
        }
        bf16x8 xf[2];
#pragma unroll
        for (int ks = 0; ks < 2; ++ks) xf[ks] = *(const LAS bf16x8*)(XC + (16 * mi + c) * 520 + 64 * h + 32 * ks + 8 * q);
        f32x4 za[4], zx[4];
#pragma unroll
        for (int nf = 0; nf < 4; ++nf) { za[nf] = (f32x4){0.f, 0.f, 0.f, 0.f}; zx[nf] = za[nf];
            za[nf] = mfma16(wa[nf][0], xf[0], za[nf]); za[nf] = mfma16(wa[nf][1], xf[1], za[nf]);
            zx[nf] = mfma16(wx[nf][0], xf[0], zx[nf]); zx[nf] = mfma16(wx[nf][1], xf[1], zx[nf]); }
#pragma unroll
        for (int nf = 0; nf < 4; ++nf) {
            const int jo = 16 * nf + 4 * q;
            const bf16x4 xc4 = *(const LAS bf16x4*)(XC + (16 * mi + c) * 520 + 64 * h + jo);
            const f32x4 zav = za[nf] + ba4[nf], zxv = zx[nf] + bx4[nf];
            f32x4 av, uv;
#pragma unroll
            for (int r = 0; r < 4; ++r) {
                const float ra = sigmoidf_(zav[r]), ix = sigmoidf_(zxv[r]);
                const float la = ra * sp4[nf][r];
                av[r] = __expf(la);
                const float x2 = 2.0f * la;
                const float om = -x2 * (1.0f + x2 * (0.5f + x2 * (0.16666667f + x2 * (0.041666668f + x2 * (0.0083333338f + x2 * (0.0013888889f + x2 * 0.0001984127f))))));
                uv[r] = bf2f((bf16_t)xc4[r]) * ix * __builtin_amdgcn_sqrtf(fmaxf(om, 0.f));
            }
            *(LAS f32x4*)(STA + c * 68 + jo) = av; *(LAS f32x4*)(STU + c * 68 + jo) = uv;
        }
        LDS_FENCE();
        float aa[16], uu[16];
#pragma unroll
        for (int s = 0; s < 16; ++s) { aa[s] = STA[s * 68 + j]; uu[s] = STU[s * 68 + j]; }
        LDS_FENCE();
#pragma unroll
        for (int s = 0; s < 16; ++s) {
            const int tl = DIR == 0 ? s : 15 - s;
            hcar = aa[tl] * hcar + uu[tl]; P *= aa[tl];
            const size_t row = (size_t)(t0 + 16 * mi + tl);
            if (DIR == 0) { const unsigned w = cvtpk(hcar, P); y[row * D + 64 * h + j] = (bf16_t)(w & 0xffffu); y[row * D + 512 + 64 * h + j] = (bf16_t)(w >> 16); }
            else { const unsigned w = cvtpk(bf2f(hfp[tl]) + hcar, P); y[row * D + 64 * h + j] = (bf16_t)(w & 0xffffu); PB[row * 512 + 64 * h + j] = (bf16_t)(w >> 16); }
        }
    }
    Aprod[(size_t)(DIR * NCH + n) * 512 + 64 * h + j] = P; Hend[(size_t)(DIR * NCH + n) * 512 + 64 * h + j] = hcar;
}

template <int MODE> __device__ void mixer_lru(const Params& p, int l, int n, LAS unsigned char* lds) {
    const int tid = otid(), lane = tid & 63, wave = tid >> 6;
    unsigned char* ws = p.ws;
    const bf16_t* proj = (const bf16_t*)(ws + WS_PROJ); bf16_t* y = (bf16_t*)(ws + WS_H);
    LAS bf16_t* XC = (LAS bf16_t*)lds;
    const int t0 = n * 64;
    if (MODE == 0) {
        LAS float* STA = (LAS float*)(lds + 66560 + wave * 8704);
        LAS float* STU = STA + 16 * 68;
        {
            const int ch = tid;
            const float cw0 = p.in[4][(size_t)(l * 4 + 0) * 512 + ch], cw1 = p.in[4][(size_t)(l * 4 + 1) * 512 + ch], cw2 = p.in[4][(size_t)(l * 4 + 2) * 512 + ch], cw3 = p.in[4][(size_t)(l * 4 + 3) * 512 + ch];
            const float cb = p.in[5][(size_t)l * 512 + ch];
            bf16_t xs[67];
#pragma unroll
            for (int i = 0; i < 67; ++i) { const int s_ = t0 - 2 + i; const int sc = s_ < 0 ? 0 : (s_ >= S ? S - 1 : s_); const bf16_t v = proj[(size_t)sc * DINP + ch]; xs[i] = s_ == sc ? v : (bf16_t)0; }
#pragma unroll
            for (int t = 0; t < 64; ++t) { const float xc = cb + cw0 * bf2f(xs[t]) + cw1 * bf2f(xs[t + 1]) + cw2 * bf2f(xs[t + 2]) + cw3 * bf2f(xs[t + 3]); XC[t * 520 + ch] = f2bf(xc); }
        }
        __syncthreads();
        lru_dir<0>(p, l, n, wave, lane, XC, STA, STU);
        lru_dir<1>(p, l, n, wave, lane, XC, STA, STU);
        __syncthreads();
    } else {
        const bf16_t* PB = (const bf16_t*)(ws + WS_PB); const float* carry = (const float*)(ws + WS_CA);
        LAS float* CAR = (LAS float*)(lds + 66560);
        CAR[tid] = carry[(size_t)(0 * NCH + n) * 512 + tid]; CAR[512 + tid] = carry[(size_t)(1 * NCH + n) * 512 + tid];
        __syncthreads();
        const int t = tid >> 3, seg = tid & 7; const size_t row = (size_t)(t0 + t);
#pragma unroll 2
        for (int i = 0; i < 8; ++i) { const int ch = 64 * seg + 8 * i;
            const bf16x8 h0 = *(const bf16x8*)(y + row * D + ch), pf = *(const bf16x8*)(y + row * D + 512 + ch), pb = *(const bf16x8*)(PB + row * 512 + ch), gt = *(const bf16x8*)(proj + row * DINP + 512 + ch);
            float v[8];
#pragma unroll
            for (int k = 0; k < 8; ++k) v[k] = (bf2f((bf16_t)h0[k]) + bf2f((bf16_t)pf[k]) * CAR[ch + k] + bf2f((bf16_t)pb[k]) * CAR[512 + ch + k]) * geluf_(bf2f((bf16_t)gt[k]));
            *(LAS u32x4*)(XC + t * 520 + ch) = (u32x4){pk2(v[0], v[1]), pk2(v[2], v[3]), pk2(v[4], v[5]), pk2(v[6], v[7])}; }
        __syncthreads();
        float ss = 0.f;
#pragma unroll
        for (int i = 0; i < 8; ++i) { const bf16x8 b = *(const LAS bf16x8*)(XC + t * 520 + 64 * seg + 8 * i);
#pragma unroll
            for (int k = 0; k < 8; ++k) { const float f = bf2f((bf16_t)b[k]); ss += f * f; } }
        ss += __shfl_xor(ss, 1); ss += __shfl_xor(ss, 2); ss += __shfl_xor(ss, 4);
        const float rs = rsqrtf(ss * (1.0f / 512.0f) + EPS);
        const float* gn = p.in[11] + (size_t)l * 512 + 64 * seg;
#pragma unroll 2
        for (int i = 0; i < 8; ++i) { const bf16x8 b = *(const LAS bf16x8*)(XC + t * 520 + 64 * seg + 8 * i); const f32x4 g0 = *(const f32x4*)(gn + 8 * i), g1 = *(const f32x4*)(gn + 8 * i + 4); u32x4 w;
            w.x = pk2(bf2f((bf16_t)b[0]) * rs * g0[0], bf2f((bf16_t)b[1]) * rs * g0[1]); w.y = pk2(bf2f((bf16_t)b[2]) * rs * g0[2], bf2f((bf16_t)b[3]) * rs * g0[3]);
            w.z = pk2(bf2f((bf16_t)b[4]) * rs * g1[0], bf2f((bf16_t)b[5]) * rs * g1[1]); w.w = pk2(bf2f((bf16_t)b[6]) * rs * g1[2], bf2f((bf16_t)b[7]) * rs * g1[3]);
            *(u32x4*)(y + (size_t)(t0 + t) * D + 64 * seg + 8 * i) = w; }
        __syncthreads();
    }
}

__device__ __forceinline__ bf16x8 pack8(const f32x4 a, const f32x4 b) {
    const u32x4 w = (u32x4){cvtpk(a[0], a[1]), cvtpk(a[2], a[3]), cvtpk(b[0], b[1]), cvtpk(b[2], b[3])}; return __builtin_bit_cast(bf16x8, w); }
#define SLOT(ks, q, jj) (32 * (ks) + 16 * ((jj) >> 2) + 4 * (q) + ((jj) & 3))

template <int MODE> __device__ void mixer_gla(const Params& p, int l, int n, LAS unsigned char* lds) {
    const int tid = otid(), lane = tid & 63, wave = tid >> 6, c = lane & 15, q = lane >> 4;
    const int h = wave >> 1, vh = wave & 1;
    unsigned char* ws = p.ws;
    const bf16_t* proj = (const bf16_t*)(ws + WS_PROJ); bf16_t* y = (bf16_t*)(ws + WS_H); const bf16_t* GW = (const bf16_t*)(ws + WS_GW);
    bf16_t* uT = (bf16_t*)(ws + WS_M); const bf16_t* spT = (const bf16_t*)(ws + WS_M + (size_t)S * D * 2); float* dec = (float*)(ws + WS_DEC);
    LAS bf16_t* VTw = (LAS bf16_t*)(lds + 66560 + wave * 9216);
    LAS float* SSQ = (LAS float*)(lds + 66560 + 8 * 9216);
    const int t0 = n * 64;
    const f32x4 zero4 = (f32x4){0.f, 0.f, 0.f, 0.f};
    {
        unsigned wv[32];
#pragma unroll
        for (int i = 0; i < 32; ++i) { const bf16_t* vp = proj + (size_t)(t0 + 2 * i) * DINP + 1536 + 128 * h + 64 * vh + lane; wv[i] = (unsigned)vp[0] | ((unsigned)vp[DINP] << 16); }
#pragma unroll
        for (int g = 0; g < 8; ++g) *(LAS u32x4*)(VTw + lane * 72 + 8 * g) = (u32x4){wv[4 * g], wv[4 * g + 1], wv[4 * g + 2], wv[4 * g + 3]};
    }
    LDS_FENCE();
    f32x4 acc[4][4];
#pragma unroll
    for (int a = 0; a < 4; ++a)
#pragma unroll
        for (int b = 0; b < 4; ++b) acc[a][b] = zero4;
#pragma unroll 1
    for (int dir = 0; dir < 2; ++dir) {
        bf16x8 laop[4][2]; float tot[4];
        {
            bf16x8 lrf[4], gwf[4]; float bgv[4];
#pragma unroll
            for (int tt = 0; tt < 4; ++tt) { lrf[tt] = (bf16x8){0, 0, 0, 0, 0, 0, 0, 0}; if (q < 2) lrf[tt] = *(const bf16x8*)(proj + (size_t)(t0 + 16 * tt + c) * DINP + 2560 + dir * 16 + 8 * q); }
#pragma unroll
            for (int ef = 0; ef < 4; ++ef) { gwf[ef] = *(const bf16x8*)(GW + (size_t)(dir * 256 + 64 * h + 16 * ef + c) * 32 + 8 * q); bgv[ef] = p.in[13][(size_t)(l * 2 + dir) * 256 + 64 * h + 16 * ef + c]; }
#pragma unroll
            for (int ef = 0; ef < 4; ++ef) { tot[ef] = 0.f;
#pragma unroll
                for (int ks = 0; ks < 2; ++ks) { f32x4 la2[2];
#pragma unroll
                    for (int t2 = 0; t2 < 2; ++t2) { const f32x4 z = mfma16(lrf[2 * ks + t2], gwf[ef], zero4);
#pragma unroll
                        for (int r = 0; r < 4; ++r) { const float zz = z[r] + bgv[ef]; const float la = (fminf(zz, 0.f) - __logf(1.0f + __expf(-fabsf(zz)))) * (1.0f / 16.0f); la2[t2][r] = la; tot[ef] += la; } }
                    laop[ef][ks] = pack8(la2[0], la2[1]); __builtin_amdgcn_sched_barrier(0); } }
        }
        if (MODE == 1) {
            bf16x8 QEop[4][2], KEop[4][2];
            bf16x4 qv[4][4], kv[4][4];
#pragma unroll
            for (int tj = 0; tj < 4; ++tj)
#pragma unroll
                for (int ef = 0; ef < 4; ++ef) { const bf16_t* rp = proj + (size_t)(t0 + 16 * tj + c) * DINP + 64 * h + 4 * q + 16 * ef; qv[tj][ef] = *(const bf16x4*)(rp + 1024); kv[tj][ef] = *(const bf16x4*)(rp + 1280); }
            __builtin_amdgcn_sched_barrier(0);
#pragma unroll
            for (int tj = 0; tj < 4; ++tj) {
                const int t = 16 * tj + c;
                bf16x8 mk[2];
#pragma unroll
                for (int ks = 0; ks < 2; ++ks)
#pragma unroll
                    for (int jj = 0; jj < 8; ++jj) { const int sidx = SLOT(ks, q, jj); const bool on = dir == 0 ? sidx <= t : sidx >= t; mk[ks][jj] = on ? (short)0x3F80 : (short)0; }
#pragma unroll
                for (int ks2 = 0; ks2 < 2; ++ks2) { f32x4 qe2[2], ke2[2];
#pragma unroll
                    for (int e2 = 0; e2 < 2; ++e2) { const int ef = 2 * ks2 + e2;
                        f32x4 b = mfma16(laop[ef][0], mk[0], zero4); b = mfma16(laop[ef][1], mk[1], b);
#pragma unroll
                        for (int r = 0; r < 4; ++r) { qe2[e2][r] = bf2f((bf16_t)qv[tj][ef][r]) * 0.125f * __expf(b[r]); ke2[e2][r] = bf2f((bf16_t)kv[tj][ef][r]) * __expf(-b[r]); } }
                    QEop[tj][ks2] = pack8(qe2[0], qe2[1]); KEop[tj][ks2] = pack8(ke2[0], ke2[1]); }
                __builtin_amdgcn_sched_barrier(0);
            }
            const bf16_t* SP = spT + ((size_t)(dir * NCH + n) * 4 + h) * 8192 + (size_t)(64 * vh) * 64;
            bf16x8 spf[4][2];
#pragma unroll
            for (int vf = 0; vf < 4; ++vf)
#pragma unroll
                for (int ks = 0; ks < 2; ++ks) { const u32x2 s0 = *(const u32x2*)(SP + (16 * vf + c) * 64 + 32 * ks + 4 * q), s1 = *(const u32x2*)(SP + (16 * vf + c) * 64 + 32 * ks + 16 + 4 * q);
                    spf[vf][ks] = __builtin_bit_cast(bf16x8, (u32x4){s0.x, s0.y, s1.x, s1.y}); }
            __builtin_amdgcn_sched_barrier(0);
            bf16x8 Pop[4][2];
#pragma unroll
            for (int ti = 0; ti < 4; ++ti)
#pragma unroll
                for (int ksp = 0; ksp < 2; ++ksp) { f32x4 pm[2];
#pragma unroll
                    for (int j2 = 0; j2 < 2; ++j2) { const int tjj = 2 * ksp + j2;
                        f32x4 sc = mfma16(KEop[tjj][0], QEop[ti][0], zero4); sc = mfma16(KEop[tjj][1], QEop[ti][1], sc);
#pragma unroll
                        for (int r = 0; r < 4; ++r) { const int j = 16 * tjj + 4 * q + r, i = 16 * ti + c; const bool keep = dir == 0 ? j <= i : j >= i; pm[j2][r] = keep ? sc[r] : 0.f; } }
                    Pop[ti][ksp] = pack8(pm[0], pm[1]); __builtin_amdgcn_sched_barrier(0); }
#pragma unroll
            for (int vf = 0; vf < 4; ++vf)
#pragma unroll
                for (int ks = 0; ks < 2; ++ks) {
                    const u32x2 v0 = *(const LAS u32x2*)(VTw + (16 * vf + c) * 72 + 32 * ks + 4 * q), v1 = *(const LAS u32x2*)(VTw + (16 * vf + c) * 72 + 32 * ks + 16 + 4 * q);
                    const bf16x8 vtf = __builtin_bit_cast(bf16x8, (u32x4){v0.x, v0.y, v1.x, v1.y});
#pragma unroll
                    for (int ti = 0; ti < 4; ++ti) { acc[vf][ti] = mfma16(vtf, Pop[ti][ks], acc[vf][ti]); acc[vf][ti] = mfma16(spf[vf][ks], QEop[ti][ks], acc[vf][ti]); }
                    __builtin_amdgcn_sched_barrier(0);
                }
        } else {
#pragma unroll
            for (int ef = 0; ef < 4; ++ef) { float tt = tot[ef]; tt += __shfl_xor(tt, 16); tt += __shfl_xor(tt, 32);
                if (vh == 0 && q == 0) dec[((size_t)(dir * NCH + n) * 4 + h) * 64 + 16 * ef + c] = __expf(tt); }
            bf16x8 kn[4][2];
#pragma unroll
            for (int tj = 0; tj < 4; ++tj)
#pragma unroll
                for (int ks = 0; ks < 2; ++ks) kn[tj][ks] = *(const bf16x8*)(proj + (size_t)(t0 + 16 * tj + c) * DINP + 1280 + 64 * h + 32 * ks + 8 * q);
            bf16x8 ident[2];
#pragma unroll
            for (int e1 = 0; e1 < 2; ++e1)
#pragma unroll
                for (int jj = 0; jj < 8; ++jj) ident[e1][jj] = (8 * q + jj == 16 * e1 + c) ? (short)0x3F80 : (short)0;
            bf16x8 kdop[4][2];
#pragma unroll
            for (int ks = 0; ks < 2; ++ks) {
                bf16x8 mk[2][2];
#pragma unroll
                for (int t2 = 0; t2 < 2; ++t2)
#pragma unroll
                    for (int k2 = 0; k2 < 2; ++k2)
#pragma unroll
                        for (int jj = 0; jj < 8; ++jj) { const int tp = 16 * (2 * ks + t2) + c, sidx = SLOT(k2, q, jj); const bool on = dir == 0 ? sidx > tp : sidx < tp; mk[t2][k2][jj] = on ? (short)0x3F80 : (short)0; }
#pragma unroll
                for (int ef = 0; ef < 4; ++ef) { f32x4 kd2[2];
#pragma unroll
                    for (int t2 = 0; t2 < 2; ++t2) { const int tj = 2 * ks + t2;
                        f32x4 E = mfma16(mk[t2][0], laop[ef][0], zero4); E = mfma16(mk[t2][1], laop[ef][1], E);
                        const f32x4 kR = mfma16(kn[tj][ef >> 1], ident[ef & 1], zero4);
#pragma unroll
                        for (int r = 0; r < 4; ++r) kd2[t2][r] = kR[r] * __expf(E[r]); }
                    kdop[ef][ks] = pack8(kd2[0], kd2[1]); __builtin_amdgcn_sched_barrier(0); }
            }
            bf16_t* U = uT + ((size_t)(dir * NCH + n) * 4 + h) * 8192 + (size_t)(64 * vh) * 64;
#pragma unroll
            for (int vf = 0; vf < 4; ++vf) { bf16x8 vtf[2];
#pragma unroll
                for (int ks = 0; ks < 2; ++ks) { const u32x2 v0 = *(const LAS u32x2*)(VTw + (16 * vf + c) * 72 + 32 * ks + 4 * q), v1 = *(const LAS u32x2*)(VTw + (16 * vf + c) * 72 + 32 * ks + 16 + 4 * q);
                    vtf[ks] = __builtin_bit_cast(bf16x8, (u32x4){v0.x, v0.y, v1.x, v1.y}); }
#pragma unroll
                for (int ef = 0; ef < 4; ++ef) { f32x4 u = mfma16(kdop[ef][0], vtf[0], zero4); u = mfma16(kdop[ef][1], vtf[1], u);
                    *(u32x2*)(U + (16 * vf + c) * 64 + 16 * ef + 4 * q) = (u32x2){cvtpk(u[0], u[1]), cvtpk(u[2], u[3])}; } }
        }
    }
    if (MODE == 1) {
#pragma unroll
        for (int ti = 0; ti < 4; ++ti) { float ss = 0.f;
#pragma unroll
            for (int vf = 0; vf < 4; ++vf) ss += acc[vf][ti][0] * acc[vf][ti][0] + acc[vf][ti][1] * acc[vf][ti][1] + acc[vf][ti][2] * acc[vf][ti][2] + acc[vf][ti][3] * acc[vf][ti][3];
            ss += __shfl_xor(ss, 16); ss += __shfl_xor(ss, 32);
            if (q == 0) SSQ[(h * 64 + 16 * ti + c) * 2 + vh] = ss; }
        __syncthreads();
        const float* gn = p.in[14] + (size_t)l * 128;
#pragma unroll
        for (int ti = 0; ti < 4; ++ti) { const int t = 16 * ti + c; const float rs = rsqrtf((SSQ[(h * 64 + t) * 2] + SSQ[(h * 64 + t) * 2 + 1]) * (1.0f / 128.0f) + EPS);
#pragma unroll
            for (int vf = 0; vf < 4; ++vf) { const int v = 64 * vh + 16 * vf + 4 * q; const f32x4 g4 = *(const f32x4*)(gn + v);
                const bf16x4 gg = *(const bf16x4*)(proj + (size_t)(t0 + t) * DINP + 2048 + 128 * h + v); float o[4];
#pragma unroll
                for (int r = 0; r < 4; ++r) o[r] = acc[vf][ti][r] * rs * g4[r] * siluf_(bf2f((bf16_t)gg[r]));
                *(u32x2*)(y + (size_t)(t0 + t) * D + 512 + 128 * h + v) = (u32x2){pk2(o[0], o[1]), pk2(o[2], o[3])}; } }
    }
    __syncthreads();
}

__device__ void phase_scan(const Params& p) {
    unsigned char* ws = p.ws; const int tid = otid();
    if (tid < 256) {
        const bf16_t* __restrict__ uT = (const bf16_t*)(ws + WS_M); bf16_t* __restrict__ spT = (bf16_t*)(ws + WS_M + (size_t)S * D * 2); const float* __restrict__ dec = (const float*)(ws + WS_DEC);
        for (int gid = obid() * 256 + tid; gid < 65536; gid += gridDim.x * 256) {
            const int dir = gid >> 15, rem = gid & 32767, h = rem >> 13, vd = rem & 8191, d = vd & 63;
            float s = 0.f;
            const long step = dir ? -1 : 1; const int nfirst = dir ? NCH - 1 : 0;
            const bf16_t* up = uT + ((size_t)(dir * NCH + nfirst) * 4 + h) * 8192 + vd; bf16_t* sp = spT + ((size_t)(dir * NCH + nfirst) * 4 + h) * 8192 + vd;
            const float* dp = dec + ((size_t)(dir * NCH + nfirst) * 4 + h) * 64 + d;
#pragma unroll 1
            for (int st = 0; st < NCH; st += 64) {
                bf16_t ub[64]; float db[64];
#pragma unroll
                for (int i = 0; i < 64; ++i) { ub[i] = up[(long)(st + i) * step * 32768]; db[i] = dp[(long)(st + i) * step * 256]; }
#pragma unroll
                for (int i = 0; i < 64; ++i) { sp[(long)(st + i) * step * 32768] = f2bf(s); s = db[i] * s + bf2f(ub[i]); }
            }
        }
    } else if (tid < 384 && obid() < 8) {
        const float* __restrict__ Aprod = (const float*)(ws + WS_AP); const float* __restrict__ Hend = (const float*)(ws + WS_HE); float* __restrict__ carry = (float*)(ws + WS_CA);
        const int gid = obid() * 128 + (tid - 256); const int dir = gid >> 9, ch = gid & 511;
        float hc = 0.f;
        const long step = dir ? -1 : 1; const size_t base = (size_t)(dir * NCH + (dir ? NCH - 1 : 0)) * 512 + ch;
#pragma unroll 1
        for (int st = 0; st < NCH; st += 64) {
            float ab[64], hb[64];
#pragma unroll
            for (int i = 0; i < 64; ++i) { ab[i] = Aprod[base + (long)(st + i) * step * 512]; hb[i] = Hend[base + (long)(st + i) * step * 512]; }
#pragma unroll
            for (int i = 0; i < 64; ++i) { carry[base + (long)(st + i) * step * 512] = hc; hc = ab[i] * hc + hb[i]; }
        }
    }
}

#define XB_TMO      128
#define XB_XCNT(j)  (256  + 64 * (j))
#define XB_XSUB(j)  (1280 + 64 * (j))
#define XB_XGEN(j)  (2304 + 64 * (j))
#define XB_TOP      3328
#define XB_TOPGEN   3392
#define XCD_BAR_WORDS 3456
#define XB_SPIN_CAP (1u << 18)

__device__ __forceinline__ unsigned xb_ld(unsigned* p)              { return __hip_atomic_load(p, __ATOMIC_RELAXED, __HIP_MEMORY_SCOPE_AGENT); }
__device__ __forceinline__ unsigned xb_add(unsigned* p, unsigned v) { return __hip_atomic_fetch_add(p, v, __ATOMIC_RELAXED, __HIP_MEMORY_SCOPE_AGENT); }
__device__ __forceinline__ unsigned xb_xcc_id() { return (unsigned)__builtin_amdgcn_s_getreg((3 << 11) | 20) & 0xFu; }
#define XB_SPIN(cond, bar) do { unsigned _sp = 0; while (cond) { __builtin_amdgcn_s_sleep(1); \
    if ((++_sp & 255u) == 0u) { if (xb_ld(&(bar)[XB_TMO])) break; if (_sp > XB_SPIN_CAP) { atomicAdd(&(bar)[XB_TMO], 1u); break; } } } } while (0)

struct XcdBarrier {
    unsigned* bar; unsigned x;
    volatile LAS unsigned* st;
};

__device__ __forceinline__ XcdBarrier xcd_barrier_post(unsigned* bar, volatile LAS unsigned* st) {
    XcdBarrier b; b.bar = bar; b.x = xb_xcc_id(); b.st = st;
    if (threadIdx.x == 0) (void)xb_add(&bar[XB_XCNT(b.x)], 1u);
    return b;
}
__device__ __forceinline__ void xcd_barrier_complete(unsigned* bar, unsigned x, unsigned& nloc, unsigned& nx) {
    const unsigned G = gridDim.x * gridDim.y * gridDim.z;
    unsigned sum, cnt, mine, sp = 0u;
    for (;;) {
        sum = 0u; cnt = 0u; mine = 0u;
#pragma unroll
        for (unsigned j = 0; j < 16; ++j) { const unsigned c = xb_ld(&bar[XB_XCNT(j)]); sum += c; cnt += (c > 0u) ? 1u : 0u; mine = (j == x) ? c : mine; }
        if (sum == G) break;
        __builtin_amdgcn_s_sleep(1);
        if ((++sp & 255u) == 0u) { if (xb_ld(&bar[XB_TMO])) break; if (sp > XB_SPIN_CAP) { atomicAdd(&bar[XB_TMO], 1u); break; } }
    }
    nloc = mine > 0u ? mine : 1u; nx = cnt > 0u ? cnt : 1u;
}

__device__ __forceinline__ void xcd_barrier(const XcdBarrier& b) {
    asm volatile("s_waitcnt vmcnt(0)" ::: "memory");
    __syncthreads();
    if (threadIdx.x == 0) {
        unsigned* bar = b.bar;
        __builtin_amdgcn_s_waitcnt(0);
        unsigned nloc = b.st[0], nx = b.st[1];
        if (nloc == 0u) { xcd_barrier_complete(bar, b.x, nloc, nx); b.st[0] = nloc; b.st[1] = nx; }
        const unsigned old = xb_add(&bar[XB_XSUB(b.x)], 1u);
        const unsigned gen = old / nloc;
        if (old + 1u == (gen + 1u) * nloc) {
            __builtin_amdgcn_fence(__ATOMIC_RELEASE, "agent");
            asm volatile("s_waitcnt vmcnt(0)" ::: "memory");
            const unsigned og = xb_add(&bar[XB_TOP], 1u);
            const unsigned tg = og / nx;
            if (og + 1u == (tg + 1u) * nx) xb_add(&bar[XB_TOPGEN], 1u);
            else XB_SPIN(xb_ld(&bar[XB_TOPGEN]) == tg, bar);
            __builtin_amdgcn_fence(__ATOMIC_ACQUIRE, "agent");
            xb_add(&bar[XB_XGEN(b.x)], 1u);
            asm volatile("s_waitcnt vmcnt(0)" ::: "memory");
        } else {
            XB_SPIN(xb_ld(&bar[XB_XGEN(b.x)]) == gen, bar);
            __builtin_amdgcn_fence(__ATOMIC_ACQUIRE, "agent");
            asm volatile("s_waitcnt vmcnt(0)" ::: "memory");
        }
    }
    __syncthreads();
}

__global__ void __launch_bounds__(NTHR, 2) mk_fwd(Params p) {
    extern __shared__ __attribute__((aligned(16))) unsigned char lds_raw[];
    LAS unsigned char* lds = (LAS unsigned char*)lds_raw;
    unsigned char* ws = p.ws;
    bf16_t* WinT = (bf16_t*)(ws + WS_WIN); bf16_t* WoutT = (bf16_t*)(ws + WS_WOUT); bf16_t* WguT = (bf16_t*)(ws + WS_WGU); bf16_t* WdT = (bf16_t*)(ws + WS_WD);
    bf16_t* Hb = (bf16_t*)(ws + WS_H); bf16_t* PROJ = (bf16_t*)(ws + WS_PROJ); float* Mb = (float*)(ws + WS_M);
    const float* xin = p.in[0]; float* out = p.out;
    volatile LAS unsigned* bst = (volatile LAS unsigned*)(lds + LDS_BYTES - 16);
    if (threadIdx.x == 0) { bst[0] = 0u; bst[1] = 0u; }
    __syncthreads();
    XcdBarrier bar = xcd_barrier_post((unsigned*)(ws + WS_CTL), bst);
    for (int ph = p.ph_lo; ph < p.ph_hi; ++ph) {
        if (ph == p.ph_lo + 1) cg::this_grid().sync();
        else if (ph > p.ph_lo) xcd_barrier(bar);
        if (ph == 9 * NL) { phase_rowprep(out, (const bf16_t*)Mb, p.in[17] + (size_t)(NL - 1) * D, out, nullptr, nullptr); continue; }
        const int l = ph / 9, s = ph % 9;
        switch (s) {
        case 0: phase_weights(p, l, lds);
                if (l == 0) phase_rowprep(xin, nullptr, nullptr, nullptr, p.in[1], Hb);
                else phase_rowprep(out, (const bf16_t*)Mb, p.in[17] + (size_t)(l - 1) * D, out, p.in[1] + (size_t)l * D, Hb);
                break;
        case 1: gemm_fast(lds, Hb, WinT, S, DINP, D, EpiB16{PROJ, DINP}); break;
        case 2: for (int n = obid(); n < NCH; n += gridDim.x) mixer_lru<0>(p, l, n, lds);
                for (int n = obid(); n < NCH; n += gridDim.x) mixer_gla<0>(p, l, n, lds); break;
        case 3: phase_scan(p); break;
        case 4: for (int n = obid(); n < NCH; n += gridDim.x) mixer_lru<1>(p, l, n, lds);
                for (int n = obid(); n < NCH; n += gridDim.x) mixer_gla<1>(p, l, n, lds); break;
        case 5: gemm_fast(lds, Hb, WoutT, S, D, D, EpiB16{(bf16_t*)Mb, D}); break;
        case 6: phase_rowprep(l == 0 ? xin : out, (const bf16_t*)Mb, p.in[2] + (size_t)l * D, out, p.in[16] + (size_t)l * D, Hb); break;
        case 7: gemm_fast(lds, Hb, WguT, S, 2 * DFF, D, EpiSwiglu{PROJ, DFF}); break;
        case 8: gemm_fast(lds, PROJ, WdT, S, D, DFF, EpiB16{(bf16_t*)Mb, D}); break;
        }
    }
}

extern "C" void kernel_launch(void* const* d_in, const int* in_sizes, int n_in, void* d_out, int out_size, void* d_ws, size_t ws_size, hipStream_t stream) {
    static int grid = 0;
    if (grid == 0) {
        if (n_in != 21 || out_size != S * D || ws_size < WS_END) { fprintf(stderr, "kernel_launch: unexpected shapes: n_in %d out %d ws %zu (need %zu)\n", n_in, out_size, ws_size, (size_t)WS_END); grid = -1; return; }
        int dev = 0, cus = 0, per_cu = 0;
        (void)hipGetDevice(&dev); (void)hipDeviceGetAttribute(&cus, hipDeviceAttributeMultiprocessorCount, dev);
        if (hipFuncSetAttribute((const void*)mk_fwd, hipFuncAttributeMaxDynamicSharedMemorySize, LDS_BYTES) != hipSuccess) { fprintf(stderr, "kernel_launch: hipFuncSetAttribute failed\n"); grid = -1; return; }
        if (hipOccupancyMaxActiveBlocksPerMultiprocessor(&per_cu, (const void*)mk_fwd, NTHR, LDS_BYTES) != hipSuccess || per_cu < 1) { fprintf(stderr, "kernel_launch: occupancy query says %d\n", per_cu); per_cu = 1; }
        (void)hipGetLastError();
        grid = cus;
    }
    if (grid < 0) return;
    Params p{};
    for (int i = 0; i < 21; ++i) p.in[i] = (const float*)d_in[i];
    p.out = (float*)d_out; p.ws = (unsigned char*)d_ws;
    (void)hipMemsetAsync((unsigned char*)d_ws + WS_CTL, 0, 16384, stream);
#if ONE_LAUNCH
    p.ph_lo = 0; p.ph_hi = 9 * NL + 1;
    void* args[] = {&p};
    hipError_t e = hipLaunchCooperativeKernel((const void*)mk_fwd, dim3(grid), dim3(NTHR), args, LDS_BYTES, stream);
    if (e != hipSuccess) fprintf(stderr, "cooperative launch failed: %s (grid %d)\n", hipGetErrorString(e), grid);
#else
    for (int ph = 0; ph < 9 * NL + 1; ++ph) { p.ph_lo = ph; p.ph_hi = ph + 1; hipLaunchKernelGGL(mk_fwd, dim3(grid), dim3(NTHR), LDS_BYTES, stream, p); }
#endif
}
```

```cpp
#include <hip/hip_runtime.h>
#include <hip/hip_cooperative_groups.h>
#include <cstdio>
namespace cg = cooperative_groups;

#ifndef ONE_LAUNCH
#define ONE_LAUNCH 1
#endif

#define LAS __attribute__((address_space(3)))
typedef unsigned short bf16_t;
typedef short bf16x8 __attribute__((ext_vector_type(8)));
typedef short bf16x4 __attribute__((ext_vector_type(4)));
typedef float f32x4 __attribute__((ext_vector_type(4)));
typedef unsigned u32x4 __attribute__((ext_vector_type(4)));
typedef unsigned u32x2 __attribute__((ext_vector_type(2)));
typedef float f32x2 __attribute__((ext_vector_type(2)));
typedef __bf16 bf16v2 __attribute__((ext_vector_type(2)));

constexpr int S = 16384, D = 1024, DIN = 2592, DINP = 2816, DFF = 2816, NL = 4, NCH = 256;
constexpr int NTHR = 512;
constexpr int LDS_BYTES = 147456;
constexpr float EPS = 1e-6f;

constexpr size_t WS_CTL = 0;
constexpr size_t WS_WIN = 65536;
constexpr size_t WS_WOUT = WS_WIN + (size_t)DINP * D * 2;
constexpr size_t WS_WGU = WS_WOUT + (size_t)D * D * 2;
constexpr size_t WS_WD = WS_WGU + (size_t)2 * DFF * D * 2;
constexpr size_t WS_LRUW = WS_WD + (size_t)D * DFF * 2;
constexpr size_t WS_GW = WS_LRUW + (size_t)2 * 2 * 8 * 64 * 64 * 2;
constexpr size_t WS_H = WS_GW + (size_t)2 * 256 * 32 * 2;
constexpr size_t WS_PROJ = WS_H + (size_t)S * D * 2;
constexpr size_t WS_M = WS_PROJ + (size_t)S * DINP * 2;
constexpr size_t WS_AP = WS_M + (size_t)S * D * 4;
constexpr size_t WS_HE = WS_AP + (size_t)2 * NCH * 512 * 4;
constexpr size_t WS_CA = WS_HE + (size_t)2 * NCH * 512 * 4;
constexpr size_t WS_DEC = WS_CA + (size_t)2 * NCH * 512 * 4;
constexpr size_t WS_PB = WS_DEC + (size_t)2 * NCH * 4 * 64 * 4;
constexpr size_t WS_END = WS_PB + (size_t)S * 512 * 2;

struct Params { const float* in[21]; float* out; unsigned char* ws; int ph_lo, ph_hi; };

__device__ __forceinline__ float bf2f(bf16_t b) { return __uint_as_float(((unsigned)b) << 16); }
__device__ __forceinline__ bf16_t f2bf(float f) { unsigned u = __float_as_uint(f); return (bf16_t)((u + 0x7fffu + ((u >> 16) & 1u)) >> 16); }
__device__ __forceinline__ unsigned pk2(float lo, float hi) { return (unsigned)f2bf(lo) | ((unsigned)f2bf(hi) << 16); }
__device__ __forceinline__ unsigned cvtpk(float lo, float hi) { const f32x2 v = (f32x2){lo, hi}; const bf16v2 b = __builtin_convertvector(v, bf16v2); return __builtin_bit_cast(unsigned, b); }
__device__ __forceinline__ float sigmoidf_(float x) { return __builtin_amdgcn_rcpf(1.0f + __expf(-x)); }
__device__ __forceinline__ float siluf_(float x) { return x * sigmoidf_(x); }
__device__ __forceinline__ float geluf_(float x) { const float y = 0.7978845608028654f * (x + 0.044715f * x * x * x); const float t = 1.0f - 2.0f * __builtin_amdgcn_rcpf(__expf(2.0f * y) + 1.0f); return 0.5f * x * (1.0f + t); }
__device__ __forceinline__ f32x4 mfma16(bf16x8 a, bf16x8 b, f32x4 c) { return __builtin_amdgcn_mfma_f32_16x16x32_bf16(a, b, c, 0, 0, 0); }
__device__ __forceinline__ int otid() { int t = threadIdx.x; asm volatile("" : "+v"(t)); return t; }
__device__ __forceinline__ int obid() { int t = blockIdx.x; asm volatile("" : "+s"(t)); return t; }
#define LDS_FENCE() asm volatile("s_waitcnt lgkmcnt(0)" ::: "memory")

struct WDesc { const float* src; bf16_t* dst; int ldsrc, c0, nvalid, k0, lddst, r0; };
__device__ __forceinline__ WDesc wdesc(const Params& p, int l, int u) {
    unsigned char* ws = p.ws;
    constexpr int T_IN = 44 * 16, T_OUT = 16 * 16, T_GU = 88 * 16, T_D = 16 * 44;
    WDesc d; int v = u;
    if (v < T_IN) { const int rt = v / 16, kt = v % 16; int nv = DIN - rt * 64; nv = nv > 64 ? 64 : (nv < 0 ? 0 : nv);
        d.src = p.in[3] + (size_t)l * D * DIN; d.ldsrc = DIN; d.c0 = nv > 0 ? rt * 64 : 0; d.nvalid = nv; d.k0 = kt * 64; d.dst = (bf16_t*)(ws + WS_WIN); d.lddst = D; d.r0 = rt * 64; return d; }
    v -= T_IN;
    if (v < T_OUT) { const int rt = v / 16, kt = v % 16; d.src = p.in[15] + (size_t)l * D * D; d.ldsrc = D; d.c0 = rt * 64; d.nvalid = 64; d.k0 = kt * 64; d.dst = (bf16_t*)(ws + WS_WOUT); d.lddst = D; d.r0 = rt * 64; return d; }
    v -= T_OUT;
    if (v < T_GU) { const int rt = v / 16, kt = v % 16; const int r0 = rt * 64, j = r0 / 256, within = r0 % 256;
        d.src = (within < 128 ? p.in[18] : p.in[19]) + (size_t)l * D * DFF; d.ldsrc = DFF; d.c0 = j * 128 + (within & 127); d.nvalid = 64; d.k0 = kt * 64; d.dst = (bf16_t*)(ws + WS_WGU); d.lddst = D; d.r0 = r0; return d; }
    v -= T_GU;
    if (v < T_D) { const int rt = v / 44, kt = v % 44; d.src = p.in[20] + (size_t)l * DFF * D; d.ldsrc = D; d.c0 = rt * 64; d.nvalid = 64; d.k0 = kt * 64; d.dst = (bf16_t*)(ws + WS_WD); d.lddst = DFF; d.r0 = rt * 64; return d; }
    v -= T_D;
    { const int dir = v / 16, gate = (v / 8) % 2, h = v % 8; d.src = (gate ? p.in[8] : p.in[6]) + ((size_t)(l * 2 + dir) * 8 + h) * 4096; d.ldsrc = 64; d.c0 = 0; d.nvalid = 64; d.k0 = 0;
      d.dst = (bf16_t*)(ws + WS_LRUW) + ((size_t)(dir * 2 + gate) * 8 + h) * 4096; d.lddst = 64; d.r0 = 0; return d; }
}

__device__ void phase_weights(const Params& p, int l, LAS unsigned char* lds) {
    LAS float* T = (LAS float*)lds;
    unsigned char* ws = p.ws;
    constexpr int TOT = 44 * 16 + 16 * 16 + 88 * 16 + 16 * 44 + 32;
    const int tid = otid(), G = gridDim.x;
    for (int u0 = obid(); u0 < TOT; u0 += 4 * G) {
        f32x4 v[4][2];
        { const int k = tid >> 3, cg8 = (tid & 7) * 8;
#pragma unroll
          for (int j = 0; j < 4; ++j) { const int u = u0 + j * G; v[j][0] = (f32x4){0.f, 0.f, 0.f, 0.f}; v[j][1] = v[j][0];
              if (u < TOT) { const WDesc d = wdesc(p, l, u); const float* sp = d.src + (size_t)(d.k0 + k) * d.ldsrc + d.c0 + cg8;
                  if (cg8 + 3 < d.nvalid) v[j][0] = *(const f32x4*)sp; if (cg8 + 7 < d.nvalid) v[j][1] = *(const f32x4*)(sp + 4); } }
#pragma unroll
          for (int j = 0; j < 4; ++j)
#pragma unroll
              for (int i = 0; i < 2; ++i) { LAS float* Tj = T + j * 4160 + k * 65 + cg8 + 4 * i; Tj[0] = v[j][i][0]; Tj[1] = v[j][i][1]; Tj[2] = v[j][i][2]; Tj[3] = v[j][i][3]; } }
        __syncthreads();
        { const int r = tid >> 3, kg = (tid & 7) * 8;
#pragma unroll
          for (int j = 0; j < 4; ++j) { const int u = u0 + j * G;
              if (u < TOT) { const WDesc d = wdesc(p, l, u); const LAS float* Tj = T + j * 4160; u32x4 w;
                  w.x = cvtpk(Tj[(kg + 0) * 65 + r], Tj[(kg + 1) * 65 + r]); w.y = cvtpk(Tj[(kg + 2) * 65 + r], Tj[(kg + 3) * 65 + r]);
                  w.z = cvtpk(Tj[(kg + 4) * 65 + r], Tj[(kg + 5) * 65 + r]); w.w = cvtpk(Tj[(kg + 6) * 65 + r], Tj[(kg + 7) * 65 + r]);
                  *(u32x4*)(d.dst + (size_t)(d.r0 + r) * d.lddst + d.k0 + kg) = w; } } }
        __syncthreads();
    }
    { bf16_t* GW = (bf16_t*)(ws + WS_GW); const float* wg = p.in[12] + (size_t)l * 2 * 16 * 256;
      for (int idx = obid() * NTHR + otid(); idx < 2 * 256 * 32; idx += gridDim.x * NTHR) { const int dir = idx >> 13, e = (idx >> 5) & 255, r = idx & 31;
          GW[idx] = r < 16 ? f2bf(wg[(size_t)(dir * 16 + r) * 256 + e]) : (bf16_t)0; } }
}

__device__ void phase_rowprep(const float* __restrict__ xsrc, const bf16_t* __restrict__ m, const float* __restrict__ gpost, float* __restrict__ xdst, const float* __restrict__ gpre, bf16_t* __restrict__ hdst) {
    const int tid = otid(); const int lane = tid & 63, wave = tid >> 6;
    for (int row = obid() * 8 + wave; row < S; row += gridDim.x * 8) {
        f32x4 xv[4];
#pragma unroll
        for (int i = 0; i < 4; ++i) xv[i] = *(const f32x4*)(xsrc + (size_t)row * D + i * 256 + lane * 4);
        if (m) {
            f32x4 mv[4]; float ss = 0.f;
#pragma unroll
            for (int i = 0; i < 4; ++i) { const bf16x4 mb = *(const bf16x4*)(m + (size_t)row * D + i * 256 + lane * 4); mv[i] = (f32x4){bf2f((bf16_t)mb[0]), bf2f((bf16_t)mb[1]), bf2f((bf16_t)mb[2]), bf2f((bf16_t)mb[3])}; ss += mv[i][0] * mv[i][0] + mv[i][1] * mv[i][1] + mv[i][2] * mv[i][2] + mv[i][3] * mv[i][3]; }
#pragma unroll
            for (int o = 32; o >= 1; o >>= 1) ss += __shfl_xor(ss, o);
            const float rs = rsqrtf(ss * (1.0f / D) + EPS);
#pragma unroll
            for (int i = 0; i < 4; ++i) { const f32x4 g = *(const f32x4*)(gpost + i * 256 + lane * 4); xv[i] += mv[i] * rs * g; }
        }
        if (xdst) {
#pragma unroll
            for (int i = 0; i < 4; ++i) *(f32x4*)(xdst + (size_t)row * D + i * 256 + lane * 4) = xv[i];
        }
        if (hdst) {
            float ss = 0.f;
#pragma unroll
            for (int i = 0; i < 4; ++i) ss += xv[i][0] * xv[i][0] + xv[i][1] * xv[i][1] + xv[i][2] * xv[i][2] + xv[i][3] * xv[i][3];
#pragma unroll
            for (int o = 32; o >= 1; o >>= 1) ss += __shfl_xor(ss, o);
            const float rs = rsqrtf(ss * (1.0f / D) + EPS);
#pragma unroll
            for (int i = 0; i < 4; ++i) { const f32x4 g = *(const f32x4*)(gpre + i * 256 + lane * 4); const f32x4 hv = xv[i] * rs * g; u32x2 w; w.x = pk2(hv[0], hv[1]); w.y = pk2(hv[2], hv[3]);
                *(u32x2*)(hdst + (size_t)row * D + i * 256 + lane * 4) = w; }
        }
    }
}

namespace pg8 {
#define PG8_LAS __attribute__((address_space(3)))
constexpr int BM = 256, BK = 64, HALF = 128, HTB = HALF * BK * 2  , STAGE_BYTES = 8 * HTB, NXCD = 8, WGM = 8;
__host__ __device__ __forceinline__ int lds_byte(int r, int c) { const int st = (r >> 4) * 2 + (c >> 5), rr = r & 15, cc = c & 31, ob = rr * 64 + cc * 2; return st * 1024 + (ob ^ (((ob >> 9) & 1) << 5)); }
__host__ __device__ __forceinline__ void stage_rc(int b, int& R, int& C) { const int st = b / 1024, sb = b % 1024, swz = sb ^ (((sb >> 9) & 1) << 5); R = (st >> 1) * 16 + swz / 64; C = (st & 1) * 32 + (swz % 64) / 2; }
__host__ __device__ __forceinline__ int perm32(int rho) { const int n = rho >> 4, i = rho & 15; return 8 * (i >> 2) + 4 * n + (i & 3); }
struct Unit { int pm, pn; };
struct Gemm { const bf16_t* A; const bf16_t* Bt; int M, N, K; };
struct StaticOrder {
    int nM, nN, nwg, G, c;
    __host__ __device__ void init(int M, int N, int G_, int c_) { nM = M / BM; nN = N / BM; nwg = nM * nN; G = G_; c = c_; }
    __host__ __device__ bool next(int i, Unit& u) const {
        const long L = (long)i * G + c; if (L >= nwg) return false;
        int wgid = (int)L; { const int q = nwg / NXCD, r = nwg % NXCD, xcd = wgid % NXCD, off = wgid / NXCD; wgid = (xcd < r ? xcd * (q + 1) : r * (q + 1) + (xcd - r) * q) + off; }
        const int nig = WGM * nN, gid = wgid / nig, fm = gid * WGM, gsz = (nM - fm) < WGM ? (nM - fm) : WGM;
        u.pm = fm + ((wgid % nig) % gsz); u.pn = (wgid % nig) / gsz; return true;
    }
    __device__ __forceinline__ void a_ready(const Unit&) const {}
    __device__ __forceinline__ void done(const Unit&) const {}
};
__device__ __forceinline__ unsigned cvt_pk_bf16(float lo, float hi) { unsigned r; asm volatile("v_cvt_pk_bf16_f32 %0, %1, %2" : "=v"(r) : "v"(lo), "v"(hi)); return r; }
template <class Epi, class Sched>
__device__ __forceinline__ void gemm_phase(PG8_LAS unsigned char* lds, const Gemm g, const Sched& S, const Epi& E) {
    const int tid = otid(), wid = __builtin_amdgcn_readfirstlane(tid >> 6), lane = tid & 63, wr = wid >> 2, wc = wid & 3, fr = lane & 15, fq = lane >> 4;
    const int K = g.K, nt = K / BK;
    unsigned voffA[2], voffB[2];
#pragma unroll
    for (int i = 0; i < 2; ++i) { int R, C; stage_rc(tid * 16 + i * 8192, R, C); const int Rb = Epi::PERM ? ((R & ~31) + perm32(R & 31)) : R;
        voffA[i] = (unsigned)(R * K + C) * 2u; voffB[i] = (unsigned)(Rb * K + C) * 2u; }
    const size_t kstep = (size_t)(BK * 2);
    const size_t hstep = (size_t)HALF * K * 2;
    const size_t tstep = 2 * hstep;
    const unsigned ldsw = (unsigned)wid * 1024u;
    const int aoff = lds_byte(wr * 64 + fr, fq * 8), boff = lds_byte(wc * 32 + fr, fq * 8);
#define PG8_SA(b, h) (((b) * 2 + (h)) * HTB)
#define PG8_SB(b, h) ((4 + (b) * 2 + (h)) * HTB)
#define PG8_STAGE(bufoff, gbase, voff) do { _Pragma("unroll") for (int _i = 0; _i < 2; ++_i) \
        __builtin_amdgcn_global_load_lds((const unsigned*)((const char*)(gbase) + (voff)[_i]), (PG8_LAS unsigned*)(lds + (bufoff) + ldsw + _i * 8192), 16, 0, 0); } while (0)
#define PG8_LDA(dst, b, h) do { _Pragma("unroll") for (int m = 0; m < 4; ++m) _Pragma("unroll") for (int k = 0; k < 2; ++k) dst[m][k] = *(const PG8_LAS bf16x8*)(lds + PG8_SA(b, h) + aoff + m * 2048 + k * 1024); } while (0)
#define PG8_LDB(dst, b, h) do { _Pragma("unroll") for (int n = 0; n < 2; ++n) _Pragma("unroll") for (int k = 0; k < 2; ++k) dst[n][k] = *(const PG8_LAS bf16x8*)(lds + PG8_SB(b, h) + boff + n * 2048 + k * 1024); } while (0)
#define PG8_MMA(ai, bj, At, Bt) do { __builtin_amdgcn_s_setprio(1); _Pragma("unroll") for (int m = 0; m < 4; ++m) _Pragma("unroll") for (int n = 0; n < 2; ++n) _Pragma("unroll") for (int k = 0; k < 2; ++k) \
        acc[ai][bj][m][n] = __builtin_amdgcn_mfma_f32_16x16x32_bf16(Bt[n][k], At[m][k], acc[ai][bj][m][n], 0, 0, 0); __builtin_amdgcn_s_setprio(0); } while (0)
#define PG8_WAIT_V(n) asm volatile("s_waitcnt vmcnt(" #n ")" ::: "memory")
#define PG8_WAIT_L(n) asm volatile("s_waitcnt lgkmcnt(" #n ")" ::: "memory")
#define PG8_BAR __builtin_amdgcn_s_barrier()
#define PG8_SCHED __builtin_amdgcn_sched_barrier(0)
    Unit cur, nxt; int ui = 0;
    if (!S.next(0, cur)) return;
    f32x4 acc[2][2][4][2];
#pragma unroll
    for (int a = 0; a < 2; ++a)
#pragma unroll
        for (int b = 0; b < 2; ++b)
#pragma unroll
            for (int m = 0; m < 4; ++m)
#pragma unroll
                for (int n = 0; n < 2; ++n) acc[a][b][m][n] = (f32x4){0.f, 0.f, 0.f, 0.f};
    bf16x8 At[4][2], B0[2][2], B1[2][2];
    const char* cA = (const char*)g.A + (size_t)cur.pm * tstep; const char* cB = (const char*)g.Bt + (size_t)cur.pn * tstep;
    S.a_ready(cur);
    PG8_STAGE(PG8_SB(0, 0), cB, voffB); PG8_STAGE(PG8_SA(0, 0), cA, voffA); PG8_STAGE(PG8_SB(0, 1), cB + hstep, voffB); PG8_STAGE(PG8_SA(0, 1), cA + hstep, voffA);
    if (wr == 1) PG8_BAR;
    PG8_WAIT_V(4); PG8_BAR;
    PG8_STAGE(PG8_SB(1, 0), cB + kstep, voffB); PG8_STAGE(PG8_SA(1, 0), cA + kstep, voffA); PG8_STAGE(PG8_SB(1, 1), cB + hstep + kstep, voffB);
    PG8_WAIT_V(6); PG8_BAR;
    for (;;) {
        const bool has_next = S.next(ui + 1, nxt);
        const char* nA = has_next ? (const char*)g.A + (size_t)nxt.pm * tstep : cA; const char* nB = has_next ? (const char*)g.Bt + (size_t)nxt.pn * tstep : cB;
        for (int t = 0; t < nt; t += 2) {
            const bool last = (t == nt - 2);
            const char* a1 = cA + (size_t)(t + 1) * kstep;
            const char* a2 = last ? nA : cA + (size_t)(t + 2) * kstep; const char* b2 = last ? nB : cB + (size_t)(t + 2) * kstep;
            const char* a3 = a2 + kstep; const char* b3 = b2 + kstep;
            if (last && has_next) S.a_ready(nxt);
            PG8_LDB(B0, 0, 0); PG8_SCHED; PG8_LDA(At, 0, 0); PG8_STAGE(PG8_SA(1, 1), a1 + hstep, voffA);
            PG8_WAIT_L(8); PG8_BAR; PG8_WAIT_L(0); PG8_MMA(0, 0, At, B0); PG8_BAR; PG8_SCHED;
            PG8_LDB(B1, 0, 1); PG8_STAGE(PG8_SB(0, 0), b2, voffB);
            PG8_BAR; PG8_WAIT_L(0); PG8_MMA(0, 1, At, B1); PG8_BAR;
            PG8_LDA(At, 0, 1); PG8_STAGE(PG8_SA(0, 0), a2, voffA);
            PG8_BAR; PG8_WAIT_L(0); PG8_MMA(1, 0, At, B0); PG8_BAR; PG8_SCHED;
            PG8_STAGE(PG8_SB(0, 1), b2 + hstep, voffB);
            PG8_WAIT_V(6); PG8_BAR; PG8_MMA(1, 1, At, B1); PG8_BAR;
            PG8_LDB(B0, 1, 0); PG8_SCHED; PG8_LDA(At, 1, 0); PG8_STAGE(PG8_SA(0, 1), a2 + hstep, voffA);
            PG8_WAIT_L(8); PG8_BAR; PG8_WAIT_L(0); PG8_MMA(0, 0, At, B0); PG8_BAR; PG8_SCHED;
            PG8_LDB(B1, 1, 1); PG8_STAGE(PG8_SB(1, 0), b3, voffB);
            PG8_BAR; PG8_WAIT_L(0); PG8_MMA(0, 1, At, B1); PG8_BAR;
            PG8_LDA(At, 1, 1); PG8_STAGE(PG8_SA(1, 0), a3, voffA);
            PG8_BAR; PG8_WAIT_L(0); PG8_MMA(1, 0, At, B0); PG8_BAR; PG8_SCHED;
            PG8_STAGE(PG8_SB(1, 1), b3 + hstep, voffB);
            PG8_WAIT_V(6); PG8_BAR; PG8_MMA(1, 1, At, B1); PG8_BAR;
        }
        if constexpr (!Epi::AFTER_DRAIN) { E(acc, cur, wr, wc, fr, fq); S.done(cur); }
        if (!has_next) break;
#pragma unroll
        for (int a = 0; a < 2; ++a)
#pragma unroll
            for (int b = 0; b < 2; ++b)
#pragma unroll
                for (int m = 0; m < 4; ++m)
#pragma unroll
                    for (int n = 0; n < 2; ++n) acc[a][b][m][n] = (f32x4){0.f, 0.f, 0.f, 0.f};
        cur = nxt; cA = nA; cB = nB; ++ui;
    }
    PG8_WAIT_V(0);
    if (wr == 0) PG8_BAR;
    PG8_BAR;
    if constexpr (Epi::AFTER_DRAIN) { E.fused(acc, cur, wr, wc, fr, fq, lds, wid, lane); S.done(cur); }
#undef PG8_SA
#undef PG8_SB
#undef PG8_STAGE
#undef PG8_LDA
#undef PG8_LDB
#undef PG8_MMA
#undef PG8_WAIT_V
#undef PG8_WAIT_L
#undef PG8_BAR
#undef PG8_SCHED
}
}

struct EpiB16 {
    static constexpr bool PERM = true, AFTER_DRAIN = false;
    bf16_t* O; int ldc;
    __device__ __forceinline__ void operator()(const f32x4 (&acc)[2][2][4][2], const pg8::Unit& u, int wr, int wc, int fr, int fq) const {
        const int row0 = u.pm * 256 + wr * 64 + fr, col0 = u.pn * 256 + wc * 32 + 8 * fq;
#pragma unroll
        for (int ai = 0; ai < 2; ++ai)
#pragma unroll
            for (int m = 0; m < 4; ++m) { bf16_t* rowp = O + (size_t)(row0 + ai * 128 + m * 16) * ldc + col0;
#pragma unroll
                for (int bj = 0; bj < 2; ++bj) { const f32x4 v0 = acc[ai][bj][m][0], v1 = acc[ai][bj][m][1];
                    u32x4 w; w.x = cvtpk(v0[0], v0[1]); w.y = cvtpk(v0[2], v0[3]); w.z = cvtpk(v1[0], v1[1]); w.w = cvtpk(v1[2], v1[3]);
                    *(u32x4*)(rowp + bj * 128) = w; } }
    }
};
struct EpiSwiglu {
    static constexpr bool PERM = true, AFTER_DRAIN = false;
    bf16_t* O; int ldc;
    __device__ __forceinline__ void operator()(const f32x4 (&acc)[2][2][4][2], const pg8::Unit& u, int wr, int wc, int fr, int fq) const {
        const int row0 = u.pm * 256 + wr * 64 + fr, col0 = u.pn * 128 + wc * 32 + 8 * fq;
#pragma unroll
        for (int ai = 0; ai < 2; ++ai)
#pragma unroll
            for (int m = 0; m < 4; ++m) { bf16_t* rowp = O + (size_t)(row0 + ai * 128 + m * 16) * ldc + col0;
                const f32x4 g0 = acc[ai][0][m][0], g1 = acc[ai][0][m][1], u0 = acc[ai][1][m][0], u1 = acc[ai][1][m][1];
                u32x4 w; w.x = cvtpk(siluf_(g0[0]) * u0[0], siluf_(g0[1]) * u0[1]); w.y = cvtpk(siluf_(g0[2]) * u0[2], siluf_(g0[3]) * u0[3]);
                w.z = cvtpk(siluf_(g1[0]) * u1[0], siluf_(g1[1]) * u1[1]); w.w = cvtpk(siluf_(g1[2]) * u1[2], siluf_(g1[3]) * u1[3]);
                *(u32x4*)rowp = w; }
    }
};
template <class Epi> __device__ __forceinline__ void gemm_fast(LAS unsigned char* lds, const bf16_t* A, const bf16_t* Bt, int M, int N, int K, const Epi& E) {
    pg8::Gemm g; g.A = A; g.Bt = Bt; g.M = M; g.N = N; g.K = K;
    pg8::StaticOrder so; so.init(M, N, (int)gridDim.x, obid());
    pg8::gemm_phase<Epi, pg8::StaticOrder>(lds, g, so, E);
    __syncthreads();
}

template <int DIR> __device__ __forceinline__ void lru_dir(const Params& p, int l, int n, int h, int lane, LAS bf16_t* XC, LAS float* STA, LAS float* STU) {
    const int c = lane & 15, q = lane >> 4, j = lane, t0 = n * 64;
    unsigned char* ws = p.ws;
    bf16_t* y = (bf16_t*)(ws + WS_H); bf16_t* PB = (bf16_t*)(ws + WS_PB);
    const bf16_t* LW = (const bf16_t*)(ws + WS_LRUW);
    float* Aprod = (float*)(ws + WS_AP); float* Hend = (float*)(ws + WS_HE);
    const float* lam = p.in[10] + (size_t)(l * 2 + DIR) * 512 + 64 * h; const float* b_a = p.in[7] + (size_t)(l * 2 + DIR) * 512 + 64 * h; const float* b_x = p.in[9] + (size_t)(l * 2 + DIR) * 512 + 64 * h;
    const bf16_t* LWa = LW + ((size_t)(DIR * 2 + 0) * 8 + h) * 4096 + c * 64 + 8 * q; const bf16_t* LWx = LW + ((size_t)(DIR * 2 + 1) * 8 + h) * 4096 + c * 64 + 8 * q;
    bf16x8 wa[4][2], wx[4][2]; f32x4 sp4[4], ba4[4], bx4[4];
#pragma unroll
    for (int nf = 0; nf < 4; ++nf) {
#pragma unroll
        for (int ks = 0; ks < 2; ++ks) { wa[nf][ks] = *(const bf16x8*)(LWa + nf * 1024 + 32 * ks); wx[nf][ks] = *(const bf16x8*)(LWx + nf * 1024 + 32 * ks); }
        const f32x4 lam4 = *(const f32x4*)(lam + 16 * nf + 4 * q); ba4[nf] = *(const f32x4*)(b_a + 16 * nf + 4 * q); bx4[nf] = *(const f32x4*)(b_x + 16 * nf + 4 * q);
#pragma unroll
        for (int r = 0; r < 4; ++r) { const float e = __expf(-lam4[r]); const float l1p = e < 0.05f ? e * (1.0f - e * (0.5f - e * (0.33333334f - e * 0.25f))) : __logf(1.0f + e); sp4[nf][r] = -8.0f * l1p; }
    }
    float hcar = 0.f, P = 1.f;
#pragma unroll 1
    for (int g = 0; g < 4; ++g) {
        const int mi = DIR == 0 ? g : 3 - g;
        bf16_t hfp[16];
        if (DIR == 1) {
#pragma unroll
            for (int s = 0; s < 16; ++s) hfp[s] = y[(size_t)(t0 + 16 * mi + s) * D + 64 * h + j];
        }
        bf16x8 xf[2];
#pragma unroll
        for (int ks = 0; ks < 2; ++ks) xf[ks] = *(const LAS bf16x8*)(XC + (16 * mi + c) * 520 + 64 * h + 32 * ks + 8 * q);
        f32x4 za[4], zx[4];
#pragma unroll
        for (int nf = 0; nf < 4; ++nf) { za[nf] = (f32x4){0.f, 0.f, 0.f, 0.f}; zx[nf] = za[nf];
            za[nf] = mfma16(wa[nf][0], xf[0], za[nf]); za[nf] = mfma16(wa[nf][1], xf[1], za[nf]);
            zx[nf] = mfma16(wx[nf][0], xf[0], zx[nf]); zx[nf] = mfma16(wx[nf][1], xf[1], zx[nf]); }
#pragma unroll
        for (int nf = 0; nf < 4; ++nf) {
            const int jo = 16 * nf + 4 * q;
            const bf16x4 xc4 = *(const LAS bf16x4*)(XC + (16 * mi + c) * 520 + 64 * h + jo);
            const f32x4 zav = za[nf] + ba4[nf], zxv = zx[nf] + bx4[nf];
            f32x4 av, uv;
#pragma unroll
            for (int r = 0; r < 4; ++r) {
                const float ra = sigmoidf_(zav[r]), ix = sigmoidf_(zxv[r]);
                const float la = ra * sp4[nf][r];
                av[r] = __expf(la);
                const float x2 = 2.0f * la;
                const float om = -x2 * (1.0f + x2 * (0.5f + x2 * (0.16666667f + x2 * (0.041666668f + x2 * (0.0083333338f + x2 * (0.0013888889f + x2 * 0.0001984127f))))));
                uv[r] = bf2f((bf16_t)xc4[r]) * ix * __builtin_amdgcn_sqrtf(fmaxf(om, 0.f));
            }
            *(LAS f32x4*)(STA + c * 68 + jo) = av; *(LAS f32x4*)(STU + c * 68 + jo) = uv;
        }
        LDS_FENCE();
        float aa[16], uu[16];
#pragma unroll
        for (int s = 0; s < 16; ++s) { aa[s] = STA[s * 68 + j]; uu[s] = STU[s * 68 + j]; }
        LDS_FENCE();
#pragma unroll
        for (int s = 0; s < 16; ++s) {
            const int tl = DIR == 0 ? s : 15 - s;
            hcar = aa[tl] * hcar + uu[tl]; P *= aa[tl];
            const size_t row = (size_t)(t0 + 16 * mi + tl);
            if (DIR == 0) { const unsigned w = cvtpk(hcar, P); y[row * D + 64 * h + j] = (bf16_t)(w & 0xffffu); y[row * D + 512 + 64 * h + j] = (bf16_t)(w >> 16); }
            else { const unsigned w = cvtpk(bf2f(hfp[tl]) + hcar, P); y[row * D + 64 * h + j] = (bf16_t)(w & 0xffffu); PB[row * 512 + 64 * h + j] = (bf16_t)(w >> 16); }
        }
    }
    Aprod[(size_t)(DIR * NCH + n) * 512 + 64 * h + j] = P; Hend[(size_t)(DIR * NCH + n) * 512 + 64 * h + j] = hcar;
}

template <int MODE> __device__ void mixer_lru(const Params& p, int l, int n, LAS unsigned char* lds) {
    const int tid = otid(), lane = tid & 63, wave = tid >> 6;
    unsigned char* ws = p.ws;
    const bf16_t* proj = (const bf16_t*)(ws + WS_PROJ); bf16_t* y = (bf16_t*)(ws + WS_H);
    LAS bf16_t* XC = (LAS bf16_t*)lds;
    const int t0 = n * 64;
    if (MODE == 0) {
        LAS float* STA = (LAS float*)(lds + 66560 + wave * 8704);
        LAS float* STU = STA + 16 * 68;
        {
            const int ch = tid;
            const float cw0 = p.in[4][(size_t)(l * 4 + 0) * 512 + ch], cw1 = p.in[4][(size_t)(l * 4 + 1) * 512 + ch], cw2 = p.in[4][(size_t)(l * 4 + 2) * 512 + ch], cw3 = p.in[4][(size_t)(l * 4 + 3) * 512 + ch];
            const float cb = p.in[5][(size_t)l * 512 + ch];
            bf16_t xs[67];
#pragma unroll
            for (int i = 0; i < 67; ++i) { const int s_ = t0 - 2 + i; const int sc = s_ < 0 ? 0 : (s_ >= S ? S - 1 : s_); const bf16_t v = proj[(size_t)sc * DINP + ch]; xs[i] = s_ == sc ? v : (bf16_t)0; }
#pragma unroll
            for (int t = 0; t < 64; ++t) { const float xc = cb + cw0 * bf2f(xs[t]) + cw1 * bf2f(xs[t + 1]) + cw2 * bf2f(xs[t + 2]) + cw3 * bf2f(xs[t + 3]); XC[t * 520 + ch] = f2bf(xc); }
        }
        __syncthreads();
        lru_dir<0>(p, l, n, wave, lane, XC, STA, STU);
        lru_dir<1>(p, l, n, wave, lane, XC, STA, STU);
        __syncthreads();
    } else {
        const bf16_t* PB = (const bf16_t*)(ws + WS_PB); const float* carry = (const float*)(ws + WS_CA);
        const int ch0 = 8 * lane;
        const float* cfp = carry + (size_t)(0 * NCH + n) * 512 + ch0; const float* cbp = carry + (size_t)(1 * NCH + n) * 512 + ch0; const float* gnp = p.in[11] + (size_t)l * 512 + ch0;
        const f32x4 cf0 = *(const f32x4*)cfp, cf1 = *(const f32x4*)(cfp + 4), cb0 = *(const f32x4*)cbp, cb1 = *(const f32x4*)(cbp + 4), g0 = *(const f32x4*)gnp, g1 = *(const f32x4*)(gnp + 4);
        const float cf[8] = {cf0[0], cf0[1], cf0[2], cf0[3], cf1[0], cf1[1], cf1[2], cf1[3]}, cb[8] = {cb0[0], cb0[1], cb0[2], cb0[3], cb1[0], cb1[1], cb1[2], cb1[3]};
        const float gg[8] = {g0[0], g0[1], g0[2], g0[3], g1[0], g1[1], g1[2], g1[3]};
#pragma unroll 1
        for (int half = 0; half < 2; ++half) {
            bf16x8 h0[4], pf[4], pb[4], gt[4];
#pragma unroll
            for (int i = 0; i < 4; ++i) { const size_t row = (size_t)(t0 + wave * 8 + half * 4 + i);
                h0[i] = *(const bf16x8*)(y + row * D + ch0); pf[i] = *(const bf16x8*)(y + row * D + 512 + ch0); pb[i] = *(const bf16x8*)(PB + row * 512 + ch0); gt[i] = *(const bf16x8*)(proj + row * DINP + 512 + ch0); }
#pragma unroll
            for (int i = 0; i < 4; ++i) { const size_t row = (size_t)(t0 + wave * 8 + half * 4 + i);
                float v[8]; float ss = 0.f;
#pragma unroll
                for (int k = 0; k < 8; ++k) { v[k] = (bf2f((bf16_t)h0[i][k]) + bf2f((bf16_t)pf[i][k]) * cf[k] + bf2f((bf16_t)pb[i][k]) * cb[k]) * geluf_(bf2f((bf16_t)gt[i][k])); ss += v[k] * v[k]; }
#pragma unroll
                for (int o = 32; o >= 1; o >>= 1) ss += __shfl_xor(ss, o);
                const float rs = rsqrtf(ss * (1.0f / 512.0f) + EPS);
                *(u32x4*)(y + row * D + ch0) = (u32x4){cvtpk(v[0] * rs * gg[0], v[1] * rs * gg[1]), cvtpk(v[2] * rs * gg[2], v[3] * rs * gg[3]), cvtpk(v[4] * rs * gg[4], v[5] * rs * gg[5]), cvtpk(v[6] * rs * gg[6], v[7] * rs * gg[7])}; }
        }
        __syncthreads();
    }
}

__device__ __forceinline__ bf16x8 pack8(const f32x4 a, const f32x4 b) {
    const u32x4 w = (u32x4){cvtpk(a[0], a[1]), cvtpk(a[2], a[3]), cvtpk(b[0], b[1]), cvtpk(b[2], b[3])}; return __builtin_bit_cast(bf16x8, w); }
#define SLOT(ks, q, jj) (32 * (ks) + 16 * ((jj) >> 2) + 4 * (q) + ((jj) & 3))

template <int MODE> __device__ void mixer_gla(const Params& p, int l, int n, LAS unsigned char* lds) {
    const int tid = otid(), lane = tid & 63, wave = tid >> 6, c = lane & 15, q = lane >> 4;
    const int h = wave >> 1, vh = wave & 1;
    unsigned char* ws = p.ws;
    const bf16_t* proj = (const bf16_t*)(ws + WS_PROJ); bf16_t* y = (bf16_t*)(ws + WS_H); const bf16_t* GW = (const bf16_t*)(ws + WS_GW);
    bf16_t* uT = (bf16_t*)(ws + WS_M); const bf16_t* spT = (const bf16_t*)(ws + WS_M + (size_t)S * D * 2); float* dec = (float*)(ws + WS_DEC);
    LAS bf16_t* VTw = (LAS bf16_t*)(lds + 66560 + wave * 9216);
    LAS float* SSQ = (LAS float*)(lds + 66560 + 8 * 9216);
    const int t0 = n * 64;
    const f32x4 zero4 = (f32x4){0.f, 0.f, 0.f, 0.f};
    {
        unsigned wv[32];
#pragma unroll
        for (int i = 0; i < 32; ++i) { const bf16_t* vp = proj + (size_t)(t0 + 2 * i) * DINP + 1536 + 128 * h + 64 * vh + lane; wv[i] = (unsigned)vp[0] | ((unsigned)vp[DINP] << 16); }
#pragma unroll
        for (int g = 0; g < 8; ++g) *(LAS u32x4*)(VTw + lane * 72 + 8 * g) = (u32x4){wv[4 * g], wv[4 * g + 1], wv[4 * g + 2], wv[4 * g + 3]};
    }
    LDS_FENCE();
    f32x4 acc[4][4];
#pragma unroll
    for (int a = 0; a < 4; ++a)
#pragma unroll
        for (int b = 0; b < 4; ++b) acc[a][b] = zero4;
#pragma unroll 1
    for (int dir = 0; dir < 2; ++dir) {
        bf16x8 laop[4][2]; float tot[4];
        {
            bf16x8 lrf[4], gwf[4]; float bgv[4];
#pragma unroll
            for (int tt = 0; tt < 4; ++tt) { lrf[tt] = (bf16x8){0, 0, 0, 0, 0, 0, 0, 0}; if (q < 2) lrf[tt] = *(const bf16x8*)(proj + (size_t)(t0 + 16 * tt + c) * DINP + 2560 + dir * 16 + 8 * q); }
#pragma unroll
            for (int ef = 0; ef < 4; ++ef) { gwf[ef] = *(const bf16x8*)(GW + (size_t)(dir * 256 + 64 * h + 16 * ef + c) * 32 + 8 * q); bgv[ef] = p.in[13][(size_t)(l * 2 + dir) * 256 + 64 * h + 16 * ef + c]; }
#pragma unroll
            for (int ef = 0; ef < 4; ++ef) { tot[ef] = 0.f;
#pragma unroll
                for (int ks = 0; ks < 2; ++ks) { f32x4 la2[2];
#pragma unroll
                    for (int t2 = 0; t2 < 2; ++t2) { const f32x4 z = mfma16(lrf[2 * ks + t2], gwf[ef], zero4);
#pragma unroll
                        for (int r = 0; r < 4; ++r) { const float zz = z[r] + bgv[ef]; const float la = (fminf(zz, 0.f) - __logf(1.0f + __expf(-fabsf(zz)))) * (1.0f / 16.0f); la2[t2][r] = la; tot[ef] += la; } }
                    laop[ef][ks] = pack8(la2[0], la2[1]); __builtin_amdgcn_sched_barrier(0); } }
        }
        if (MODE == 1) {
            bf16x8 QEop[4][2], KEop[4][2];
            bf16x4 qv[4][4], kv[4][4];
#pragma unroll
            for (int tj = 0; tj < 4; ++tj)
#pragma unroll
                for (int ef = 0; ef < 4; ++ef) { const bf16_t* rp = proj + (size_t)(t0 + 16 * tj + c) * DINP + 64 * h + 4 * q + 16 * ef; qv[tj][ef] = *(const bf16x4*)(rp + 1024); kv[tj][ef] = *(const bf16x4*)(rp + 1280); }
            __builtin_amdgcn_sched_barrier(0);
#pragma unroll
            for (int tj = 0; tj < 4; ++tj) {
                const int t = 16 * tj + c;
                bf16x8 mk[2];
#pragma unroll
                for (int ks = 0; ks < 2; ++ks)
#pragma unroll
                    for (int jj = 0; jj < 8; ++jj) { const int sidx = SLOT(ks, q, jj); const bool on = dir == 0 ? sidx <= t : sidx >= t; mk[ks][jj] = on ? (short)0x3F80 : (short)0; }
#pragma unroll
                for (int ks2 = 0; ks2 < 2; ++ks2) { f32x4 qe2[2], ke2[2];
#pragma unroll
                    for (int e2 = 0; e2 < 2; ++e2) { const int ef = 2 * ks2 + e2;
                        f32x4 b = mfma16(laop[ef][0], mk[0], zero4); b = mfma16(laop[ef][1], mk[1], b);
#pragma unroll
                        for (int r = 0; r < 4; ++r) { qe2[e2][r] = bf2f((bf16_t)qv[tj][ef][r]) * 0.125f * __expf(b[r]); ke2[e2][r] = bf2f((bf16_t)kv[tj][ef][r]) * __expf(-b[r]); } }
                    QEop[tj][ks2] = pack8(qe2[0], qe2[1]); KEop[tj][ks2] = pack8(ke2[0], ke2[1]); }
                __builtin_amdgcn_sched_barrier(0);
            }
            const bf16_t* SP = spT + ((size_t)(dir * NCH + n) * 4 + h) * 8192 + (size_t)(64 * vh) * 64;
            bf16x8 spf[4][2];
#pragma unroll
            for (int vf = 0; vf < 4; ++vf)
#pragma unroll
                for (int ks = 0; ks < 2; ++ks) { const u32x2 s0 = *(const u32x2*)(SP + (16 * vf + c) * 64 + 32 * ks + 4 * q), s1 = *(const u32x2*)(SP + (16 * vf + c) * 64 + 32 * ks + 16 + 4 * q);
                    spf[vf][ks] = __builtin_bit_cast(bf16x8, (u32x4){s0.x, s0.y, s1.x, s1.y}); }
            __builtin_amdgcn_sched_barrier(0);
            bf16x8 Pop[4][2];
#pragma unroll
            for (int ti = 0; ti < 4; ++ti)
#pragma unroll
                for (int ksp = 0; ksp < 2; ++ksp) { f32x4 pm[2];
#pragma unroll
                    for (int j2 = 0; j2 < 2; ++j2) { const int tjj = 2 * ksp + j2;
                        f32x4 sc = mfma16(KEop[tjj][0], QEop[ti][0], zero4); sc = mfma16(KEop[tjj][1], QEop[ti][1], sc);
#pragma unroll
                        for (int r = 0; r < 4; ++r) { const int j = 16 * tjj + 4 * q + r, i = 16 * ti + c; const bool keep = dir == 0 ? j <= i : j >= i; pm[j2][r] = keep ? sc[r] : 0.f; } }
                    Pop[ti][ksp] = pack8(pm[0], pm[1]); __builtin_amdgcn_sched_barrier(0); }
#pragma unroll
            for (int vf = 0; vf < 4; ++vf)
#pragma unroll
                for (int ks = 0; ks < 2; ++ks) {
                    const u32x2 v0 = *(const LAS u32x2*)(VTw + (16 * vf + c) * 72 + 32 * ks + 4 * q), v1 = *(const LAS u32x2*)(VTw + (16 * vf + c) * 72 + 32 * ks + 16 + 4 * q);
                    const bf16x8 vtf = __builtin_bit_cast(bf16x8, (u32x4){v0.x, v0.y, v1.x, v1.y});
#pragma unroll
                    for (int ti = 0; ti < 4; ++ti) { acc[vf][ti] = mfma16(vtf, Pop[ti][ks], acc[vf][ti]); acc[vf][ti] = mfma16(spf[vf][ks], QEop[ti][ks], acc[vf][ti]); }
                    __builtin_amdgcn_sched_barrier(0);
                }
        } else {
#pragma unroll
            for (int ef = 0; ef < 4; ++ef) { float tt = tot[ef]; tt += __shfl_xor(tt, 16); tt += __shfl_xor(tt, 32);
                if (vh == 0 && q == 0) dec[((size_t)(dir * NCH + n) * 4 + h) * 64 + 16 * ef + c] = __expf(tt); }
            bf16x8 kn[4][2];
#pragma unroll
            for (int tj = 0; tj < 4; ++tj)
#pragma unroll
                for (int ks = 0; ks < 2; ++ks) kn[tj][ks] = *(const bf16x8*)(proj + (size_t)(t0 + 16 * tj + c) * DINP + 1280 + 64 * h + 32 * ks + 8 * q);
            bf16x8 ident[2];
#pragma unroll
            for (int e1 = 0; e1 < 2; ++e1)
#pragma unroll
                for (int jj = 0; jj < 8; ++jj) ident[e1][jj] = (8 * q + jj == 16 * e1 + c) ? (short)0x3F80 : (short)0;
            bf16x8 kdop[4][2];
#pragma unroll
            for (int ks = 0; ks < 2; ++ks) {
                bf16x8 mk[2][2];
#pragma unroll
                for (int t2 = 0; t2 < 2; ++t2)
#pragma unroll
                    for (int k2 = 0; k2 < 2; ++k2)
#pragma unroll
                        for (int jj = 0; jj < 8; ++jj) { const int tp = 16 * (2 * ks + t2) + c, sidx = SLOT(k2, q, jj); const bool on = dir == 0 ? sidx > tp : sidx < tp; mk[t2][k2][jj] = on ? (short)0x3F80 : (short)0; }
#pragma unroll
                for (int ef = 0; ef < 4; ++ef) { f32x4 kd2[2];
#pragma unroll
                    for (int t2 = 0; t2 < 2; ++t2) { const int tj = 2 * ks + t2;
                        f32x4 E = mfma16(mk[t2][0], laop[ef][0], zero4); E = mfma16(mk[t2][1], laop[ef][1], E);
                        const f32x4 kR = mfma16(kn[tj][ef >> 1], ident[ef & 1], zero4);
#pragma unroll
                        for (int r = 0; r < 4; ++r) kd2[t2][r] = kR[r] * __expf(E[r]); }
                    kdop[ef][ks] = pack8(kd2[0], kd2[1]); __builtin_amdgcn_sched_barrier(0); }
            }
            bf16_t* U = uT + ((size_t)(dir * NCH + n) * 4 + h) * 8192 + (size_t)(64 * vh) * 64;
#pragma unroll
            for (int vf = 0; vf < 4; ++vf) { bf16x8 vtf[2];
#pragma unroll
                for (int ks = 0; ks < 2; ++ks) { const u32x2 v0 = *(const LAS u32x2*)(VTw + (16 * vf + c) * 72 + 32 * ks + 4 * q), v1 = *(const LAS u32x2*)(VTw + (16 * vf + c) * 72 + 32 * ks + 16 + 4 * q);
                    vtf[ks] = __builtin_bit_cast(bf16x8, (u32x4){v0.x, v0.y, v1.x, v1.y}); }
#pragma unroll
                for (int ef = 0; ef < 4; ++ef) { f32x4 u = mfma16(kdop[ef][0], vtf[0], zero4); u = mfma16(kdop[ef][1], vtf[1], u);
                    *(u32x2*)(U + (16 * vf + c) * 64 + 16 * ef + 4 * q) = (u32x2){cvtpk(u[0], u[1]), cvtpk(u[2], u[3])}; } }
        }
    }
    if (MODE == 1) {
#pragma unroll
        for (int ti = 0; ti < 4; ++ti) { float ss = 0.f;
#pragma unroll
            for (int vf = 0; vf < 4; ++vf) ss += acc[vf][ti][0] * acc[vf][ti][0] + acc[vf][ti][1] * acc[vf][ti][1] + acc[vf][ti][2] * acc[vf][ti][2] + acc[vf][ti][3] * acc[vf][ti][3];
            ss += __shfl_xor(ss, 16); ss += __shfl_xor(ss, 32);
            if (q == 0) SSQ[(h * 64 + 16 * ti + c) * 2 + vh] = ss; }
        __syncthreads();
        const float* gn = p.in[14] + (size_t)l * 128;
#pragma unroll
        for (int ti = 0; ti < 4; ++ti) { const int t = 16 * ti + c; const float rs = rsqrtf((SSQ[(h * 64 + t) * 2] + SSQ[(h * 64 + t) * 2 + 1]) * (1.0f / 128.0f) + EPS);
#pragma unroll
            for (int vf = 0; vf < 4; ++vf) { const int v = 64 * vh + 16 * vf + 4 * q; const f32x4 g4 = *(const f32x4*)(gn + v);
                const bf16x4 gg = *(const bf16x4*)(proj + (size_t)(t0 + t) * DINP + 2048 + 128 * h + v); float o[4];
#pragma unroll
                for (int r = 0; r < 4; ++r) o[r] = acc[vf][ti][r] * rs * g4[r] * siluf_(bf2f((bf16_t)gg[r]));
                *(u32x2*)(y + (size_t)(t0 + t) * D + 512 + 128 * h + v) = (u32x2){pk2(o[0], o[1]), pk2(o[2], o[3])}; } }
    }
    __syncthreads();
}

__device__ void phase_scan(const Params& p) {
    unsigned char* ws = p.ws; const int tid = otid();
    if (tid < 256) {
        const bf16_t* __restrict__ uT = (const bf16_t*)(ws + WS_M); bf16_t* __restrict__ spT = (bf16_t*)(ws + WS_M + (size_t)S * D * 2); const float* __restrict__ dec = (const float*)(ws + WS_DEC);
        for (int gid = obid() * 256 + tid; gid < 65536; gid += gridDim.x * 256) {
            const int dir = gid >> 15, rem = gid & 32767, h = rem >> 13, vd = rem & 8191, d = vd & 63;
            float s = 0.f;
            const long step = dir ? -1 : 1; const int nfirst = dir ? NCH - 1 : 0;
            const bf16_t* up = uT + ((size_t)(dir * NCH + nfirst) * 4 + h) * 8192 + vd; bf16_t* sp = spT + ((size_t)(dir * NCH + nfirst) * 4 + h) * 8192 + vd;
            const float* dp = dec + ((size_t)(dir * NCH + nfirst) * 4 + h) * 64 + d;
#pragma unroll 1
            for (int st = 0; st < NCH; st += 64) {
                bf16_t ub[64]; float db[64];
#pragma unroll
                for (int i = 0; i < 64; ++i) { ub[i] = up[(long)(st + i) * step * 32768]; db[i] = dp[(long)(st + i) * step * 256]; }
#pragma unroll
                for (int i = 0; i < 64; ++i) { sp[(long)(st + i) * step * 32768] = f2bf(s); s = db[i] * s + bf2f(ub[i]); }
            }
        }
    } else if (tid < 384 && obid() < 8) {
        const float* __restrict__ Aprod = (const float*)(ws + WS_AP); const float* __restrict__ Hend = (const float*)(ws + WS_HE); float* __restrict__ carry = (float*)(ws + WS_CA);
        const int gid = obid() * 128 + (tid - 256); const int dir = gid >> 9, ch = gid & 511;
        float hc = 0.f;
        const long step = dir ? -1 : 1; const size_t base = (size_t)(dir * NCH + (dir ? NCH - 1 : 0)) * 512 + ch;
#pragma unroll 1
        for (int st = 0; st < NCH; st += 64) {
            float ab[64], hb[64];
#pragma unroll
            for (int i = 0; i < 64; ++i) { ab[i] = Aprod[base + (long)(st + i) * step * 512]; hb[i] = Hend[base + (long)(st + i) * step * 512]; }
#pragma unroll
            for (int i = 0; i < 64; ++i) { carry[base + (long)(st + i) * step * 512] = hc; hc = ab[i] * hc + hb[i]; }
        }
    }
}

#define XB_TMO      128
#define XB_XCNT(j)  (256  + 64 * (j))
#define XB_XSUB(j)  (1280 + 64 * (j))
#define XB_XGEN(j)  (2304 + 64 * (j))
#define XB_TOP      3328
#define XB_TOPGEN   3392
#define XCD_BAR_WORDS 3456
#define XB_SPIN_CAP (1u << 18)

__device__ __forceinline__ unsigned xb_ld(unsigned* p)              { return __hip_atomic_load(p, __ATOMIC_RELAXED, __HIP_MEMORY_SCOPE_AGENT); }
__device__ __forceinline__ unsigned xb_add(unsigned* p, unsigned v) { return __hip_atomic_fetch_add(p, v, __ATOMIC_RELAXED, __HIP_MEMORY_SCOPE_AGENT); }
__device__ __forceinline__ unsigned xb_xcc_id() { return (unsigned)__builtin_amdgcn_s_getreg((3 << 11) | 20) & 0xFu; }
#define XB_SPIN(cond, bar) do { unsigned _sp = 0; while (cond) { __builtin_amdgcn_s_sleep(1); \
    if ((++_sp & 255u) == 0u) { if (xb_ld(&(bar)[XB_TMO])) break; if (_sp > XB_SPIN_CAP) { atomicAdd(&(bar)[XB_TMO], 1u); break; } } } } while (0)

struct XcdBarrier {
    unsigned* bar; unsigned x;
    volatile LAS unsigned* st;
};

__device__ __forceinline__ XcdBarrier xcd_barrier_post(unsigned* bar, volatile LAS unsigned* st) {
    XcdBarrier b; b.bar = bar; b.x = xb_xcc_id(); b.st = st;
    if (threadIdx.x == 0) (void)xb_add(&bar[XB_XCNT(b.x)], 1u);
    return b;
}
__device__ __forceinline__ void xcd_barrier_complete(unsigned* bar, unsigned x, unsigned& nloc, unsigned& nx) {
    const unsigned G = gridDim.x * gridDim.y * gridDim.z;
    unsigned sum, cnt, mine, sp = 0u;
    for (;;) {
        sum = 0u; cnt = 0u; mine = 0u;
#pragma unroll
        for (unsigned j = 0; j < 16; ++j) { const unsigned c = xb_ld(&bar[XB_XCNT(j)]); sum += c; cnt += (c > 0u) ? 1u : 0u; mine = (j == x) ? c : mine; }
        if (sum == G) break;
        __builtin_amdgcn_s_sleep(1);
        if ((++sp & 255u) == 0u) { if (xb_ld(&bar[XB_TMO])) break; if (sp > XB_SPIN_CAP) { atomicAdd(&bar[XB_TMO], 1u); break; } }
    }
    nloc = mine > 0u ? mine : 1u; nx = cnt > 0u ? cnt : 1u;
}

__device__ __forceinline__ void xcd_barrier(const XcdBarrier& b) {
    asm volatile("s_waitcnt vmcnt(0)" ::: "memory");
    __syncthreads();
    if (threadIdx.x == 0) {
        unsigned* bar = b.bar;
        __builtin_amdgcn_s_waitcnt(0);
        unsigned nloc = b.st[0], nx = b.st[1];
        if (nloc == 0u) { xcd_barrier_complete(bar, b.x, nloc, nx); b.st[0] = nloc; b.st[1] = nx; }
        const unsigned old = xb_add(&bar[XB_XSUB(b.x)], 1u);
        const unsigned gen = old / nloc;
        if (old + 1u == (gen + 1u) * nloc) {
            __builtin_amdgcn_fence(__ATOMIC_RELEASE, "agent");
            asm volatile("s_waitcnt vmcnt(0)" ::: "memory");
            const unsigned og = xb_add(&bar[XB_TOP], 1u);
            const unsigned tg = og / nx;
            if (og + 1u == (tg + 1u) * nx) xb_add(&bar[XB_TOPGEN], 1u);
            else XB_SPIN(xb_ld(&bar[XB_TOPGEN]) == tg, bar);
            __builtin_amdgcn_fence(__ATOMIC_ACQUIRE, "agent");
            xb_add(&bar[XB_XGEN(b.x)], 1u);
            asm volatile("s_waitcnt vmcnt(0)" ::: "memory");
        } else {
            XB_SPIN(xb_ld(&bar[XB_XGEN(b.x)]) == gen, bar);
            __builtin_amdgcn_fence(__ATOMIC_ACQUIRE, "agent");
            asm volatile("s_waitcnt vmcnt(0)" ::: "memory");
        }
    }
    __syncthreads();
}

__global__ void __launch_bounds__(NTHR, 2) mk_fwd(Params p) {
    extern __shared__ __attribute__((aligned(16))) unsigned char lds_raw[];
    LAS unsigned char* lds = (LAS unsigned char*)lds_raw;
    unsigned char* ws = p.ws;
    bf16_t* WinT = (bf16_t*)(ws + WS_WIN); bf16_t* WoutT = (bf16_t*)(ws + WS_WOUT); bf16_t* WguT = (bf16_t*)(ws + WS_WGU); bf16_t* WdT = (bf16_t*)(ws + WS_WD);
    bf16_t* Hb = (bf16_t*)(ws + WS_H); bf16_t* PROJ = (bf16_t*)(ws + WS_PROJ); float* Mb = (float*)(ws + WS_M);
    const float* xin = p.in[0]; float* out = p.out;
    volatile LAS unsigned* bst = (volatile LAS unsigned*)(lds + LDS_BYTES - 16);
    if (threadIdx.x == 0) { bst[0] = 0u; bst[1] = 0u; }
    __syncthreads();
    XcdBarrier bar = xcd_barrier_post((unsigned*)(ws + WS_CTL), bst);
    for (int ph = p.ph_lo; ph < p.ph_hi; ++ph) {
        if (ph == p.ph_lo + 1) cg::this_grid().sync();
        else if (ph > p.ph_lo) xcd_barrier(bar);
        if (ph == 9 * NL) { phase_rowprep(out, (const bf16_t*)Mb, p.in[17] + (size_t)(NL - 1) * D, out, nullptr, nullptr); continue; }
        const int l = ph / 9, s = ph % 9;
        switch (s) {
        case 0: phase_weights(p, l, lds);
                if (l == 0) phase_rowprep(xin, nullptr, nullptr, nullptr, p.in[1], Hb);
                else phase_rowprep(out, (const bf16_t*)Mb, p.in[17] + (size_t)(l - 1) * D, out, p.in[1] + (size_t)l * D, Hb);
                break;
        case 1: gemm_fast(lds, Hb, WinT, S, DINP, D, EpiB16{PROJ, DINP}); break;
        case 2: for (int n = obid(); n < NCH; n += gridDim.x) mixer_lru<0>(p, l, n, lds);
                for (int n = obid(); n < NCH; n += gridDim.x) mixer_gla<0>(p, l, n, lds); break;
        case 3: phase_scan(p); break;
        case 4: for (int n = obid(); n < NCH; n += gridDim.x) mixer_lru<1>(p, l, n, lds);
                for (int n = obid(); n < NCH; n += gridDim.x) mixer_gla<1>(p, l, n, lds); break;
        case 5: gemm_fast(lds, Hb, WoutT, S, D, D, EpiB16{(bf16_t*)Mb, D}); break;
        case 6: phase_rowprep(l == 0 ? xin : out, (const bf16_t*)Mb, p.in[2] + (size_t)l * D, out, p.in[16] + (size_t)l * D, Hb); break;
        case 7: gemm_fast(lds, Hb, WguT, S, 2 * DFF, D, EpiSwiglu{PROJ, DFF}); break;
        case 8: gemm_fast(lds, PROJ, WdT, S, D, DFF, EpiB16{(bf16_t*)Mb, D}); break;
        }
    }
}

extern "C" void kernel_launch(void* const* d_in, const int* in_sizes, int n_in, void* d_out, int out_size, void* d_ws, size_t ws_size, hipStream_t stream) {
    static int grid = 0;
    if (grid == 0) {
        if (n_in != 21 || out_size != S * D || ws_size < WS_END) { fprintf(stderr, "kernel_launch: unexpected shapes: n_in %d out %d ws %zu (need %zu)\n", n_in, out_size, ws_size, (size_t)WS_END); grid = -1; return; }
        int dev = 0, cus = 0, per_cu = 0;
        (void)hipGetDevice(&dev); (void)hipDeviceGetAttribute(&cus, hipDeviceAttributeMultiprocessorCount, dev);
        if (hipFuncSetAttribute((const void*)mk_fwd, hipFuncAttributeMaxDynamicSharedMemorySize, LDS_BYTES) != hipSuccess) { fprintf(stderr, "kernel_launch: hipFuncSetAttribute failed\n"); grid = -1; return; }
        if (hipOccupancyMaxActiveBlocksPerMultiprocessor(&per_cu, (const void*)mk_fwd, NTHR, LDS_BYTES) != hipSuccess || per_cu < 1) { fprintf(stderr, "kernel_launch: occupancy query says %d\n", per_cu); per_cu = 1; }
        (void)hipGetLastError();
        grid = cus;
    }
    if (grid < 0) return;
    Params p{};
    for (int i = 0; i < 21; ++i) p.in[i] = (const float*)d_in[i];
    p.out = (float*)d_out; p.ws = (unsigned char*)d_ws;
    (void)hipMemsetAsync((unsigned char*)d_ws + WS_CTL, 0, 16384, stream);
#if ONE_LAUNCH
    p.ph_lo = 0; p.ph_hi = 9 * NL + 1;
    void* args[] = {&p};
    hipError_t e = hipLaunchCooperativeKernel((const void*)mk_fwd, dim3(grid), dim3(NTHR), args, LDS_BYTES, stream);
    if (e != hipSuccess) fprintf(stderr, "cooperative launch failed: %s (grid %d)\n", hipGetErrorString(e), grid);
#else
    for (int ph = 0; ph < 9 * NL + 1; ++ph) { p.ph_lo = ph; p.ph_hi = ph + 1; hipLaunchKernelGGL(mk_fwd, dim3(grid), dim3(NTHR), LDS_BYTES, stream, p); }
#endif
}
```

```cpp
#include <hip/hip_runtime.h>
#include <hip/hip_cooperative_groups.h>
#include <cstdio>
namespace cg = cooperative_groups;

#ifndef ONE_LAUNCH
#define ONE_LAUNCH 1
#endif

#define LAS __attribute__((address_space(3)))
typedef unsigned short bf16_t;
typedef short bf16x8 __attribute__((ext_vector_type(8)));
typedef short bf16x4 __attribute__((ext_vector_type(4)));
typedef float f32x4 __attribute__((ext_vector_type(4)));
typedef unsigned u32x4 __attribute__((ext_vector_type(4)));
typedef unsigned u32x2 __attribute__((ext_vector_type(2)));
typedef float f32x2 __attribute__((ext_vector_type(2)));
typedef __bf16 bf16v2 __attribute__((ext_vector_type(2)));

constexpr int S = 16384, D = 1024, DIN = 2592, DINP = 2816, DFF = 2816, NL = 4, NCH = 256;
constexpr int NTHR = 512;
constexpr int LDS_BYTES = 147456;
constexpr float EPS = 1e-6f;

constexpr size_t WS_CTL = 0;
constexpr size_t WS_WIN = 65536;
constexpr size_t WS_WOUT = WS_WIN + (size_t)DINP * D * 2;
constexpr size_t WS_WGU = WS_WOUT + (size_t)D * D * 2;
constexpr size_t WS_WD = WS_WGU + (size_t)2 * DFF * D * 2;
constexpr size_t WS_LRUW = WS_WD + (size_t)D * DFF * 2;
constexpr size_t WS_GW = WS_LRUW + (size_t)2 * 2 * 8 * 64 * 64 * 2;
constexpr size_t WS_H = WS_GW + (size_t)2 * 256 * 32 * 2;
constexpr size_t WS_PROJ = WS_H + (size_t)S * D * 2;
constexpr size_t WS_M = WS_PROJ + (size_t)S * DINP * 2;
constexpr size_t WS_AP = WS_M + (size_t)S * D * 4;
constexpr size_t WS_HE = WS_AP + (size_t)2 * NCH * 512 * 4;
constexpr size_t WS_CA = WS_HE + (size_t)2 * NCH * 512 * 4;
constexpr size_t WS_DEC = WS_CA + (size_t)2 * NCH * 512 * 4;
constexpr size_t WS_PB = WS_DEC + (size_t)2 * NCH * 4 * 64 * 4;
constexpr size_t WS_END = WS_PB + (size_t)S * 512 * 2;

struct Params { const float* in[21]; float* out; unsigned char* ws; int ph_lo, ph_hi; };

__device__ __forceinline__ float bf2f(bf16_t b) { return __uint_as_float(((unsigned)b) << 16); }
__device__ __forceinline__ bf16_t f2bf(float f) { unsigned u = __float_as_uint(f); return (bf16_t)((u + 0x7fffu + ((u >> 16) & 1u)) >> 16); }
__device__ __forceinline__ unsigned pk2(float lo, float hi) { return (unsigned)f2bf(lo) | ((unsigned)f2bf(hi) << 16); }
__device__ __forceinline__ unsigned cvtpk(float lo, float hi) { const f32x2 v = (f32x2){lo, hi}; const bf16v2 b = __builtin_convertvector(v, bf16v2); return __builtin_bit_cast(unsigned, b); }
__device__ __forceinline__ float sigmoidf_(float x) { return __builtin_amdgcn_rcpf(1.0f + __expf(-x)); }
__device__ __forceinline__ float siluf_(float x) { return x * sigmoidf_(x); }
__device__ __forceinline__ float geluf_(float x) { const float y = 0.7978845608028654f * (x + 0.044715f * x * x * x); const float t = 1.0f - 2.0f * __builtin_amdgcn_rcpf(__expf(2.0f * y) + 1.0f); return 0.5f * x * (1.0f + t); }
__device__ __forceinline__ f32x4 mfma16(bf16x8 a, bf16x8 b, f32x4 c) { return __builtin_amdgcn_mfma_f32_16x16x32_bf16(a, b, c, 0, 0, 0); }
__device__ __forceinline__ int otid() { int t = threadIdx.x; asm volatile("" : "+v"(t)); return t; }
__device__ __forceinline__ int obid() { int t = blockIdx.x; asm volatile("" : "+s"(t)); return t; }
#define LDS_FENCE() asm volatile("s_waitcnt lgkmcnt(0)" ::: "memory")

struct WDesc { const float* src; bf16_t* dst; int ldsrc, c0, nvalid, k0, lddst, r0; };
__device__ __forceinline__ WDesc wdesc(const Params& p, int l, int u) {
    unsigned char* ws = p.ws;
    constexpr int T_IN = 44 * 16, T_OUT = 16 * 16, T_GU = 88 * 16, T_D = 16 * 44;
    WDesc d; int v = u;
    if (v < T_IN) { const int rt = v / 16, kt = v % 16; int nv = DIN - rt * 64; nv = nv > 64 ? 64 : (nv < 0 ? 0 : nv);
        d.src = p.in[3] + (size_t)l * D * DIN; d.ldsrc = DIN; d.c0 = nv > 0 ? rt * 64 : 0; d.nvalid = nv; d.k0 = kt * 64; d.dst = (bf16_t*)(ws + WS_WIN); d.lddst = D; d.r0 = rt * 64; return d; }
    v -= T_IN;
    if (v < T_OUT) { const int rt = v / 16, kt = v % 16; d.src = p.in[15] + (size_t)l * D * D; d.ldsrc = D; d.c0 = rt * 64; d.nvalid = 64; d.k0 = kt * 64; d.dst = (bf16_t*)(ws + WS_WOUT); d.lddst = D; d.r0 = rt * 64; return d; }
    v -= T_OUT;
    if (v < T_GU) { const int rt = v / 16, kt = v % 16; const int r0 = rt * 64, j = r0 / 256, within = r0 % 256;
        d.src = (within < 128 ? p.in[18] : p.in[19]) + (size_t)l * D * DFF; d.ldsrc = DFF; d.c0 = j * 128 + (within & 127); d.nvalid = 64; d.k0 = kt * 64; d.dst = (bf16_t*)(ws + WS_WGU); d.lddst = D; d.r0 = r0; return d; }
    v -= T_GU;
    if (v < T_D) { const int rt = v / 44, kt = v % 44; d.src = p.in[20] + (size_t)l * DFF * D; d.ldsrc = D; d.c0 = rt * 64; d.nvalid = 64; d.k0 = kt * 64; d.dst = (bf16_t*)(ws + WS_WD); d.lddst = DFF; d.r0 = rt * 64; return d; }
    v -= T_D;
    { const int dir = v / 16, gate = (v / 8) % 2, h = v % 8; d.src = (gate ? p.in[8] : p.in[6]) + ((size_t)(l * 2 + dir) * 8 + h) * 4096; d.ldsrc = 64; d.c0 = 0; d.nvalid = 64; d.k0 = 0;
      d.dst = (bf16_t*)(ws + WS_LRUW) + ((size_t)(dir * 2 + gate) * 8 + h) * 4096; d.lddst = 64; d.r0 = 0; return d; }
}

__device__ void phase_weights(const Params& p, int l, LAS unsigned char* lds) {
    LAS float* T = (LAS float*)lds;
    unsigned char* ws = p.ws;
    constexpr int TOT = 44 * 16 + 16 * 16 + 88 * 16 + 16 * 44 + 32;
    const int tid = otid(), G = gridDim.x;
    for (int u0 = obid(); u0 < TOT; u0 += 4 * G) {
        f32x4 v[4][2];
        { const int k = tid >> 3, cg8 = (tid & 7) * 8;
#pragma unroll
          for (int j = 0; j < 4; ++j) { const int u = u0 + j * G; v[j][0] = (f32x4){0.f, 0.f, 0.f, 0.f}; v[j][1] = v[j][0];
              if (u < TOT) { const WDesc d = wdesc(p, l, u); const float* sp = d.src + (size_t)(d.k0 + k) * d.ldsrc + d.c0 + cg8;
                  if (cg8 + 3 < d.nvalid) v[j][0] = *(const f32x4*)sp; if (cg8 + 7 < d.nvalid) v[j][1] = *(const f32x4*)(sp + 4); } }
#pragma unroll
          for (int j = 0; j < 4; ++j)
#pragma unroll
              for (int i = 0; i < 2; ++i) { LAS float* Tj = T + j * 4160 + k * 65 + cg8 + 4 * i; Tj[0] = v[j][i][0]; Tj[1] = v[j][i][1]; Tj[2] = v[j][i][2]; Tj[3] = v[j][i][3]; } }
        __syncthreads();
        { const int r = tid >> 3, kg = (tid & 7) * 8;
#pragma unroll
          for (int j = 0; j < 4; ++j) { const int u = u0 + j * G;
              if (u < TOT) { const WDesc d = wdesc(p, l, u); const LAS float* Tj = T + j * 4160; u32x4 w;
                  w.x = cvtpk(Tj[(kg + 0) * 65 + r], Tj[(kg + 1) * 65 + r]); w.y = cvtpk(Tj[(kg + 2) * 65 + r], Tj[(kg + 3) * 65 + r]);
                  w.z = cvtpk(Tj[(kg + 4) * 65 + r], Tj[(kg + 5) * 65 + r]); w.w = cvtpk(Tj[(kg + 6) * 65 + r], Tj[(kg + 7) * 65 + r]);
                  *(u32x4*)(d.dst + (size_t)(d.r0 + r) * d.lddst + d.k0 + kg) = w; } } }
        __syncthreads();
    }
    { bf16_t* GW = (bf16_t*)(ws + WS_GW); const float* wg = p.in[12] + (size_t)l * 2 * 16 * 256;
      for (int idx = obid() * NTHR + otid(); idx < 2 * 256 * 32; idx += gridDim.x * NTHR) { const int dir = idx >> 13, e = (idx >> 5) & 255, r = idx & 31;
          GW[idx] = r < 16 ? f2bf(wg[(size_t)(dir * 16 + r) * 256 + e]) : (bf16_t)0; } }
}

__device__ void phase_rowprep(const float* __restrict__ xsrc, const bf16_t* __restrict__ m, const float* __restrict__ gpost, float* __restrict__ xdst, const float* __restrict__ gpre, bf16_t* __restrict__ hdst) {
    const int tid = otid(); const int lane = tid & 63, wave = tid >> 6;
    for (int row = obid() * 8 + wave; row < S; row += gridDim.x * 8) {
        f32x4 xv[4];
#pragma unroll
        for (int i = 0; i < 4; ++i) xv[i] = *(const f32x4*)(xsrc + (size_t)row * D + i * 256 + lane * 4);
        if (m) {
            f32x4 mv[4]; float ss = 0.f;
#pragma unroll
            for (int i = 0; i < 4; ++i) { const bf16x4 mb = *(const bf16x4*)(m + (size_t)row * D + i * 256 + lane * 4); mv[i] = (f32x4){bf2f((bf16_t)mb[0]), bf2f((bf16_t)mb[1]), bf2f((bf16_t)mb[2]), bf2f((bf16_t)mb[3])}; ss += mv[i][0] * mv[i][0] + mv[i][1] * mv[i][1] + mv[i][2] * mv[i][2] + mv[i][3] * mv[i][3]; }
#pragma unroll
            for (int o = 32; o >= 1; o >>= 1) ss += __shfl_xor(ss, o);
            const float rs = rsqrtf(ss * (1.0f / D) + EPS);
#pragma unroll
            for (int i = 0; i < 4; ++i) { const f32x4 g = *(const f32x4*)(gpost + i * 256 + lane * 4); xv[i] += mv[i] * rs * g; }
        }
        if (xdst) {
#pragma unroll
            for (int i = 0; i < 4; ++i) *(f32x4*)(xdst + (size_t)row * D + i * 256 + lane * 4) = xv[i];
        }
        if (hdst) {
            float ss = 0.f;
#pragma unroll
            for (int i = 0; i < 4; ++i) ss += xv[i][0] * xv[i][0] + xv[i][1] * xv[i][1] + xv[i][2] * xv[i][2] + xv[i][3] * xv[i][3];
#pragma unroll
            for (int o = 32; o >= 1; o >>= 1) ss += __shfl_xor(ss, o);
            const float rs = rsqrtf(ss * (1.0f / D) + EPS);
#pragma unroll
            for (int i = 0; i < 4; ++i) { const f32x4 g = *(const f32x4*)(gpre + i * 256 + lane * 4); const f32x4 hv = xv[i] * rs * g; u32x2 w; w.x = pk2(hv[0], hv[1]); w.y = pk2(hv[2], hv[3]);
                *(u32x2*)(hdst + (size_t)row * D + i * 256 + lane * 4) = w; }
        }
    }
}

namespace pg8 {
#define PG8_LAS __attribute__((address_space(3)))
constexpr int BM = 256, BK = 64, HALF = 128, HTB = HALF * BK * 2  , STAGE_BYTES = 8 * HTB, NXCD = 8, WGM = 8;
__host__ __device__ __forceinline__ int lds_byte(int r, int c) { const int st = (r >> 4) * 2 + (c >> 5), rr = r & 15, cc = c & 31, ob = rr * 64 + cc * 2; return st * 1024 + (ob ^ (((ob >> 9) & 1) << 5)); }
__host__ __device__ __forceinline__ void stage_rc(int b, int& R, int& C) { const int st = b / 1024, sb = b % 1024, swz = sb ^ (((sb >> 9) & 1) << 5); R = (st >> 1) * 16 + swz / 64; C = (st & 1) * 32 + (swz % 64) / 2; }
__host__ __device__ __forceinline__ int perm32(int rho) { const int n = rho >> 4, i = rho & 15; return 8 * (i >> 2) + 4 * n + (i & 3); }
struct Unit { int pm, pn; };
struct Gemm { const bf16_t* A; const bf16_t* Bt; int M, N, K; };
struct StaticOrder {
    int nM, nN, nwg, G, c;
    __host__ __device__ void init(int M, int N, int G_, int c_) { nM = M / BM; nN = N / BM; nwg = nM * nN; G = G_; c = c_; }
    __host__ __device__ bool next(int i, Unit& u) const {
        const long L = (long)i * G + c; if (L >= nwg) return false;
        int wgid = (int)L; { const int q = nwg / NXCD, r = nwg % NXCD, xcd = wgid % NXCD, off = wgid / NXCD; wgid = (xcd < r ? xcd * (q + 1) : r * (q + 1) + (xcd - r) * q) + off; }
        const int nig = WGM * nN, gid = wgid / nig, fm = gid * WGM, gsz = (nM - fm) < WGM ? (nM - fm) : WGM;
        u.pm = fm + ((wgid % nig) % gsz); u.pn = (wgid % nig) / gsz; return true;
    }
    __device__ __forceinline__ void a_ready(const Unit&) const {}
    __device__ __forceinline__ void done(const Unit&) const {}
};
__device__ __forceinline__ unsigned cvt_pk_bf16(float lo, float hi) { unsigned r; asm volatile("v_cvt_pk_bf16_f32 %0, %1, %2" : "=v"(r) : "v"(lo), "v"(hi)); return r; }
template <class Epi, class Sched>
__device__ __forceinline__ void gemm_phase(PG8_LAS unsigned char* lds, const Gemm g, const Sched& S, const Epi& E) {
    const int tid = otid(), wid = __builtin_amdgcn_readfirstlane(tid >> 6), lane = tid & 63, wr = wid >> 2, wc = wid & 3, fr = lane & 15, fq = lane >> 4;
    const int K = g.K, nt = K / BK;
    unsigned voffA[2], voffB[2];
#pragma unroll
    for (int i = 0; i < 2; ++i) { int R, C; stage_rc(tid * 16 + i * 8192, R, C); const int Rb = Epi::PERM ? ((R & ~31) + perm32(R & 31)) : R;
        voffA[i] = (unsigned)(R * K + C) * 2u; voffB[i] = (unsigned)(Rb * K + C) * 2u; }
    const size_t kstep = (size_t)(BK * 2);
    const size_t hstep = (size_t)HALF * K * 2;
    const size_t tstep = 2 * hstep;
    const unsigned ldsw = (unsigned)wid * 1024u;
    const int aoff = lds_byte(wr * 64 + fr, fq * 8), boff = lds_byte(wc * 32 + fr, fq * 8);
#define PG8_SA(b, h) (((b) * 2 + (h)) * HTB)
#define PG8_SB(b, h) ((4 + (b) * 2 + (h)) * HTB)
#define PG8_STAGE(bufoff, gbase, voff) do { _Pragma("unroll") for (int _i = 0; _i < 2; ++_i) \
        __builtin_amdgcn_global_load_lds((const unsigned*)((const char*)(gbase) + (voff)[_i]), (PG8_LAS unsigned*)(lds + (bufoff) + ldsw + _i * 8192), 16, 0, 0); } while (0)
#define PG8_LDA(dst, b, h) do { _Pragma("unroll") for (int m = 0; m < 4; ++m) _Pragma("unroll") for (int k = 0; k < 2; ++k) dst[m][k] = *(const PG8_LAS bf16x8*)(lds + PG8_SA(b, h) + aoff + m * 2048 + k * 1024); } while (0)
#define PG8_LDB(dst, b, h) do { _Pragma("unroll") for (int n = 0; n < 2; ++n) _Pragma("unroll") for (int k = 0; k < 2; ++k) dst[n][k] = *(const PG8_LAS bf16x8*)(lds + PG8_SB(b, h) + boff + n * 2048 + k * 1024); } while (0)
#define PG8_MMA(ai, bj, At, Bt) do { __builtin_amdgcn_s_setprio(1); _Pragma("unroll") for (int m = 0; m < 4; ++m) _Pragma("unroll") for (int n = 0; n < 2; ++n) _Pragma("unroll") for (int k = 0; k < 2; ++k) \
        acc[ai][bj][m][n] = __builtin_amdgcn_mfma_f32_16x16x32_bf16(Bt[n][k], At[m][k], acc[ai][bj][m][n], 0, 0, 0); __builtin_amdgcn_s_setprio(0); } while (0)
#define PG8_WAIT_V(n) asm volatile("s_waitcnt vmcnt(" #n ")" ::: "memory")
#define PG8_WAIT_L(n) asm volatile("s_waitcnt lgkmcnt(" #n ")" ::: "memory")
#define PG8_BAR __builtin_amdgcn_s_barrier()
#define PG8_SCHED __builtin_amdgcn_sched_barrier(0)
    Unit cur, nxt; int ui = 0;
    if (!S.next(0, cur)) return;
    f32x4 acc[2][2][4][2];
#pragma unroll
    for (int a = 0; a < 2; ++a)
#pragma unroll
        for (int b = 0; b < 2; ++b)
#pragma unroll
            for (int m = 0; m < 4; ++m)
#pragma unroll
                for (int n = 0; n < 2; ++n) acc[a][b][m][n] = (f32x4){0.f, 0.f, 0.f, 0.f};
    bf16x8 At[4][2], B0[2][2], B1[2][2];
    const char* cA = (const char*)g.A + (size_t)cur.pm * tstep; const char* cB = (const char*)g.Bt + (size_t)cur.pn * tstep;
    S.a_ready(cur);
    PG8_STAGE(PG8_SB(0, 0), cB, voffB); PG8_STAGE(PG8_SA(0, 0), cA, voffA); PG8_STAGE(PG8_SB(0, 1), cB + hstep, voffB); PG8_STAGE(PG8_SA(0, 1), cA + hstep, voffA);
    if (wr == 1) PG8_BAR;
    PG8_WAIT_V(4); PG8_BAR;
    PG8_STAGE(PG8_SB(1, 0), cB + kstep, voffB); PG8_STAGE(PG8_SA(1, 0), cA + kstep, voffA); PG8_STAGE(PG8_SB(1, 1), cB + hstep + kstep, voffB);
    PG8_WAIT_V(6); PG8_BAR;
    for (;;) {
        const bool has_next = S.next(ui + 1, nxt);
        const char* nA = has_next ? (const char*)g.A + (size_t)nxt.pm * tstep : cA; const char* nB = has_next ? (const char*)g.Bt + (size_t)nxt.pn * tstep : cB;
        for (int t = 0; t < nt; t += 2) {
            const bool last = (t == nt - 2);
            const char* a1 = cA + (size_t)(t + 1) * kstep;
            const char* a2 = last ? nA : cA + (size_t)(t + 2) * kstep; const char* b2 = last ? nB : cB + (size_t)(t + 2) * kstep;
            const char* a3 = a2 + kstep; const char* b3 = b2 + kstep;
            if (last && has_next) S.a_ready(nxt);
            PG8_LDB(B0, 0, 0); PG8_SCHED; PG8_LDA(At, 0, 0); PG8_STAGE(PG8_SA(1, 1), a1 + hstep, voffA);
            PG8_WAIT_L(8); PG8_BAR; PG8_WAIT_L(0); PG8_MMA(0, 0, At, B0); PG8_BAR; PG8_SCHED;
            PG8_LDB(B1, 0, 1); PG8_STAGE(PG8_SB(0, 0), b2, voffB);
            PG8_BAR; PG8_WAIT_L(0); PG8_MMA(0, 1, At, B1); PG8_BAR;
            PG8_LDA(At, 0, 1); PG8_STAGE(PG8_SA(0, 0), a2, voffA);
            PG8_BAR; PG8_WAIT_L(0); PG8_MMA(1, 0, At, B0); PG8_BAR; PG8_SCHED;
            PG8_STAGE(PG8_SB(0, 1), b2 + hstep, voffB);
            PG8_WAIT_V(6); PG8_BAR; PG8_MMA(1, 1, At, B1); PG8_BAR;
            PG8_LDB(B0, 1, 0); PG8_SCHED; PG8_LDA(At, 1, 0); PG8_STAGE(PG8_SA(0, 1), a2 + hstep, voffA);
            PG8_WAIT_L(8); PG8_BAR; PG8_WAIT_L(0); PG8_MMA(0, 0, At, B0); PG8_BAR; PG8_SCHED;
            PG8_LDB(B1, 1, 1); PG8_STAGE(PG8_SB(1, 0), b3, voffB);
            PG8_BAR; PG8_WAIT_L(0); PG8_MMA(0, 1, At, B1); PG8_BAR;
            PG8_LDA(At, 1, 1); PG8_STAGE(PG8_SA(1, 0), a3, voffA);
            PG8_BAR; PG8_WAIT_L(0); PG8_MMA(1, 0, At, B0); PG8_BAR; PG8_SCHED;
            PG8_STAGE(PG8_SB(1, 1), b3 + hstep, voffB);
            PG8_WAIT_V(6); PG8_BAR; PG8_MMA(1, 1, At, B1); PG8_BAR;
        }
        if constexpr (!Epi::AFTER_DRAIN) { E(acc, cur, wr, wc, fr, fq); S.done(cur); }
        if (!has_next) break;
#pragma unroll
        for (int a = 0; a < 2; ++a)
#pragma unroll
            for (int b = 0; b < 2; ++b)
#pragma unroll
                for (int m = 0; m < 4; ++m)
#pragma unroll
                    for (int n = 0; n < 2; ++n) acc[a][b][m][n] = (f32x4){0.f, 0.f, 0.f, 0.f};
        cur = nxt; cA = nA; cB = nB; ++ui;
    }
    PG8_WAIT_V(0);
    if (wr == 0) PG8_BAR;
    PG8_BAR;
    if constexpr (Epi::AFTER_DRAIN) { E.fused(acc, cur, wr, wc, fr, fq, lds, wid, lane); S.done(cur); }
#undef PG8_SA
#undef PG8_SB
#undef PG8_STAGE
#undef PG8_LDA
#undef PG8_LDB
#undef PG8_MMA
#undef PG8_WAIT_V
#undef PG8_WAIT_L
#undef PG8_BAR
#undef PG8_SCHED
}
}

struct EpiB16 {
    static constexpr bool PERM = true, AFTER_DRAIN = false;
    bf16_t* O; int ldc;
    __device__ __forceinline__ void operator()(const f32x4 (&acc)[2][2][4][2], const pg8::Unit& u, int wr, int wc, int fr, int fq) const {
        const int row0 = u.pm * 256 + wr * 64 + fr, col0 = u.pn * 256 + wc * 32 + 8 * fq;
#pragma unroll
        for (int ai = 0; ai < 2; ++ai)
#pragma unroll
            for (int m = 0; m < 4; ++m) { bf16_t* rowp = O + (size_t)(row0 + ai * 128 + m * 16) * ldc + col0;
#pragma unroll
                for (int bj = 0; bj < 2; ++bj) { const f32x4 v0 = acc[ai][bj][m][0], v1 = acc[ai][bj][m][1];
                    u32x4 w; w.x = cvtpk(v0[0], v0[1]); w.y = cvtpk(v0[2], v0[3]); w.z = cvtpk(v1[0], v1[1]); w.w = cvtpk(v1[2], v1[3]);
                    *(u32x4*)(rowp + bj * 128) = w; } }
    }
};
struct EpiSwiglu {
    static constexpr bool PERM = true, AFTER_DRAIN = false;
    bf16_t* O; int ldc;
    __device__ __forceinline__ void operator()(const f32x4 (&acc)[2][2][4][2], const pg8::Unit& u, int wr, int wc, int fr, int fq) const {
        const int row0 = u.pm * 256 + wr * 64 + fr, col0 = u.pn * 128 + wc * 32 + 8 * fq;
#pragma unroll
        for (int ai = 0; ai < 2; ++ai)
#pragma unroll
            for (int m = 0; m < 4; ++m) { bf16_t* rowp = O + (size_t)(row0 + ai * 128 + m * 16) * ldc + col0;
                const f32x4 g0 = acc[ai][0][m][0], g1 = acc[ai][0][m][1], u0 = acc[ai][1][m][0], u1 = acc[ai][1][m][1];
                u32x4 w; w.x = cvtpk(siluf_(g0[0]) * u0[0], siluf_(g0[1]) * u0[1]); w.y = cvtpk(siluf_(g0[2]) * u0[2], siluf_(g0[3]) * u0[3]);
                w.z = cvtpk(siluf_(g1[0]) * u1[0], siluf_(g1[1]) * u1[1]); w.w = cvtpk(siluf_(g1[2]) * u1[2], siluf_(g1[3]) * u1[3]);
                *(u32x4*)rowp = w; }
    }
};
template <class Epi> __device__ __forceinline__ void gemm_fast(LAS unsigned char* lds, const bf16_t* A, const bf16_t* Bt, int M, int N, int K, const Epi& E) {
    pg8::Gemm g; g.A = A; g.Bt = Bt; g.M = M; g.N = N; g.K = K;
    pg8::StaticOrder so; so.init(M, N, (int)gridDim.x, obid());
    pg8::gemm_phase<Epi, pg8::StaticOrder>(lds, g, so, E);
    __syncthreads();
}

template <int DIR> __device__ __forceinline__ void lru_dir(const Params& p, int l, int n, int h, int lane, LAS bf16_t* XC, LAS float* STA, LAS float* STU) {
    const int c = lane & 15, q = lane >> 4, j = lane, t0 = n * 64;
    unsigned char* ws = p.ws;
    bf16_t* y = (bf16_t*)(ws + WS_H); bf16_t* PB = (bf16_t*)(ws + WS_PB);
    const bf16_t* LW = (const bf16_t*)(ws + WS_LRUW);
    float* Aprod = (float*)(ws + WS_AP); float* Hend = (float*)(ws + WS_HE);
    const float* lam = p.in[10] + (size_t)(l * 2 + DIR) * 512 + 64 * h; const float* b_a = p.in[7] + (size_t)(l * 2 + DIR) * 512 + 64 * h; const float* b_x = p.in[9] + (size_t)(l * 2 + DIR) * 512 + 64 * h;
    const bf16_t* LWa = LW + ((size_t)(DIR * 2 + 0) * 8 + h) * 4096 + c * 64 + 8 * q; const bf16_t* LWx = LW + ((size_t)(DIR * 2 + 1) * 8 + h) * 4096 + c * 64 + 8 * q;
    bf16x8 wa[4][2], wx[4][2]; f32x4 sp4[4], ba4[4], bx4[4];
#pragma unroll
    for (int nf = 0; nf < 4; ++nf) {
#pragma unroll
        for (int ks = 0; ks < 2; ++ks) { wa[nf][ks] = *(const bf16x8*)(LWa + nf * 1024 + 32 * ks); wx[nf][ks] = *(const bf16x8*)(LWx + nf * 1024 + 32 * ks); }
        const f32x4 lam4 = *(const f32x4*)(lam + 16 * nf + 4 * q); ba4[nf] = *(const f32x4*)(b_a + 16 * nf + 4 * q); bx4[nf] = *(const f32x4*)(b_x + 16 * nf + 4 * q);
#pragma unroll
        for (int r = 0; r < 4; ++r) { const float e = __expf(-lam4[r]); const float l1p = e < 0.05f ? e * (1.0f - e * (0.5f - e * (0.33333334f - e * 0.25f))) : __logf(1.0f + e); sp4[nf][r] = -8.0f * l1p; }
    }
    float hcar = 0.f, P = 1.f;
#pragma unroll 1
    for (int g = 0; g < 4; ++g) {
        const int mi = DIR == 0 ? g : 3 - g;
        bf16_t hfp[16];
        if (DIR == 1) {
#pragma unroll
            for (int s = 0; s < 16; ++s) hfp[s] = y[(size_t)(t0 + 16 * mi + s) * D + 64 * h + j];
        }
        bf16x8 xf[2];
#pragma unroll
        for (int ks = 0; ks < 2; ++ks) xf[ks] = *(const LAS bf16x8*)(XC + (16 * mi + c) * 520 + 64 * h + 32 * ks + 8 * q);
        f32x4 za[4], zx[4];
#pragma unroll
        for (int nf = 0; nf < 4; ++nf) { za[nf] = (f32x4){0.f, 0.f, 0.f, 0.f}; zx[nf] = za[nf];
            za[nf] = mfma16(wa[nf][0], xf[0], za[nf]); za[nf] = mfma16(wa[nf][1], xf[1], za[nf]);
            zx[nf] = mfma16(wx[nf][0], xf[0], zx[nf]); zx[nf] = mfma16(wx[nf][1], xf[1], zx[nf]); }
#pragma unroll
        for (int nf = 0; nf < 4; ++nf) {
            const int jo = 16 * nf + 4 * q;
            const bf16x4 xc4 = *(const LAS bf16x4*)(XC + (16 * mi + c) * 520 + 64 * h + jo);
            const f32x4 zav = za[nf] + ba4[nf], zxv = zx[nf] + bx4[nf];
            f32x4 av, uv;
#pragma unroll
            for (int r = 0; r < 4; ++r) {
                const float ra = sigmoidf_(zav[r]), ix = sigmoidf_(zxv[r]);
                const float la = ra * sp4[nf][r];
                av[r] = __expf(la);
                const float x2 = 2.0f * la;
                const float om = -x2 * (1.0f + x2 * (0.5f + x2 * (0.16666667f + x2 * (0.041666668f + x2 * (0.0083333338f + x2 * (0.0013888889f + x2 * 0.0001984127f))))));
                uv[r] = bf2f((bf16_t)xc4[r]) * ix * __builtin_amdgcn_sqrtf(fmaxf(om, 0.f));
            }
            *(LAS f32x4*)(STA + c * 68 + jo) = av; *(LAS f32x4*)(STU + c * 68 + jo) = uv;
        }
        LDS_FENCE();
        float aa[16], uu[16];
#pragma unroll
        for (int s = 0; s < 16; ++s) { aa[s] = STA[s * 68 + j]; uu[s] = STU[s * 68 + j]; }
        LDS_FENCE();
#pragma unroll
        for (int s = 0; s < 16; ++s) {
            const int tl = DIR == 0 ? s : 15 - s;
            hcar = aa[tl] * hcar + uu[tl]; P *= aa[tl];
            const size_t row = (size_t)(t0 + 16 * mi + tl);
            if (DIR == 0) { const unsigned w = cvtpk(hcar, P); y[row * D + 64 * h + j] = (bf16_t)(w & 0xffffu); y[row * D + 512 + 64 * h + j] = (bf16_t)(w >> 16); }
            else { const unsigned w = cvtpk(bf2f(hfp[tl]) + hcar, P); y[row * D + 64 * h + j] = (bf16_t)(w & 0xffffu); PB[row * 512 + 64 * h + j] = (bf16_t)(w >> 16); }
        }
    }
    Aprod[(size_t)(DIR * NCH + n) * 512 + 64 * h + j] = P; Hend[(size_t)(DIR * NCH + n) * 512 + 64 * h + j] = hcar;
}

template <int MODE> __device__ void mixer_lru(const Params& p, int l, int n, LAS unsigned char* lds) {
    const int tid = otid(), lane = tid & 63, wave = tid >> 6;
    unsigned char* ws = p.ws;
    const bf16_t* proj = (const bf16_t*)(ws + WS_PROJ); bf16_t* y = (bf16_t*)(ws + WS_H);
    LAS bf16_t* XC = (LAS bf16_t*)lds;
    const int t0 = n * 64;
    if (MODE == 0) {
        LAS float* STA = (LAS float*)(lds + 66560 + wave * 8704);
        LAS float* STU = STA + 16 * 68;
        {
            const int ch = tid;
            const float cw0 = p.in[4][(size_t)(l * 4 + 0) * 512 + ch], cw1 = p.in[4][(size_t)(l * 4 + 1) * 512 + ch], cw2 = p.in[4][(size_t)(l * 4 + 2) * 512 + ch], cw3 = p.in[4][(size_t)(l * 4 + 3) * 512 + ch];
            const float cb = p.in[5][(size_t)l * 512 + ch];
            bf16_t xs[67];
#pragma unroll
            for (int i = 0; i < 67; ++i) { const int s_ = t0 - 2 + i; const int sc = s_ < 0 ? 0 : (s_ >= S ? S - 1 : s_); const bf16_t v = proj[(size_t)sc * DINP + ch]; xs[i] = s_ == sc ? v : (bf16_t)0; }
#pragma unroll
            for (int t = 0; t < 64; ++t) { const float xc = cb + cw0 * bf2f(xs[t]) + cw1 * bf2f(xs[t + 1]) + cw2 * bf2f(xs[t + 2]) + cw3 * bf2f(xs[t + 3]); XC[t * 520 + ch] = f2bf(xc); }
        }
        __syncthreads();
        lru_dir<0>(p, l, n, wave, lane, XC, STA, STU);
        lru_dir<1>(p, l, n, wave, lane, XC, STA, STU);
        __syncthreads();
    } else {
        const bf16_t* PB = (const bf16_t*)(ws + WS_PB); const float* carry = (const float*)(ws + WS_CA);
        const int ch0 = 8 * lane;
        const float* cfp = carry + (size_t)(0 * NCH + n) * 512 + ch0; const float* cbp = carry + (size_t)(1 * NCH + n) * 512 + ch0; const float* gnp = p.in[11] + (size_t)l * 512 + ch0;
        const f32x4 cf0 = *(const f32x4*)cfp, cf1 = *(const f32x4*)(cfp + 4), cb0 = *(const f32x4*)cbp, cb1 = *(const f32x4*)(cbp + 4), g0 = *(const f32x4*)gnp, g1 = *(const f32x4*)(gnp + 4);
        const float cf[8] = {cf0[0], cf0[1], cf0[2], cf0[3], cf1[0], cf1[1], cf1[2], cf1[3]}, cb[8] = {cb0[0], cb0[1], cb0[2], cb0[3], cb1[0], cb1[1], cb1[2], cb1[3]};
        const float gg[8] = {g0[0], g0[1], g0[2], g0[3], g1[0], g1[1], g1[2], g1[3]};
        {
            bf16x8 h0[8], pf[8], pb[8], gt[8];
#pragma unroll
            for (int i = 0; i < 8; ++i) { const size_t row = (size_t)(t0 + wave * 8 + i);
                h0[i] = *(const bf16x8*)(y + row * D + ch0); pf[i] = *(const bf16x8*)(y + row * D + 512 + ch0); pb[i] = *(const bf16x8*)(PB + row * 512 + ch0); gt[i] = *(const bf16x8*)(proj + row * DINP + 512 + ch0); }
#pragma unroll
            for (int i = 0; i < 8; ++i) { const size_t row = (size_t)(t0 + wave * 8 + i);
                float v[8]; float ss = 0.f;
#pragma unroll
                for (int k = 0; k < 8; ++k) { v[k] = (bf2f((bf16_t)h0[i][k]) + bf2f((bf16_t)pf[i][k]) * cf[k] + bf2f((bf16_t)pb[i][k]) * cb[k]) * geluf_(bf2f((bf16_t)gt[i][k])); ss += v[k] * v[k]; }
#pragma unroll
                for (int o = 32; o >= 1; o >>= 1) ss += __shfl_xor(ss, o);
                const float rs = rsqrtf(ss * (1.0f / 512.0f) + EPS);
                *(u32x4*)(y + row * D + ch0) = (u32x4){cvtpk(v[0] * rs * gg[0], v[1] * rs * gg[1]), cvtpk(v[2] * rs * gg[2], v[3] * rs * gg[3]), cvtpk(v[4] * rs * gg[4], v[5] * rs * gg[5]), cvtpk(v[6] * rs * gg[6], v[7] * rs * gg[7])}; }
        }
        __syncthreads();
    }
}

__device__ __forceinline__ bf16x8 pack8(const f32x4 a, const f32x4 b) {
    const u32x4 w = (u32x4){cvtpk(a[0], a[1]), cvtpk(a[2], a[3]), cvtpk(b[0], b[1]), cvtpk(b[2], b[3])}; return __builtin_bit_cast(bf16x8, w); }
#define SLOT(ks, q, jj) (32 * (ks) + 16 * ((jj) >> 2) + 4 * (q) + ((jj) & 3))

template <int MODE> __device__ void mixer_gla(const Params& p, int l, int n, LAS unsigned char* lds) {
    const int tid = otid(), lane = tid & 63, wave = tid >> 6, c = lane & 15, q = lane >> 4;
    const int h = wave >> 1, vh = wave & 1;
    unsigned char* ws = p.ws;
    const bf16_t* proj = (const bf16_t*)(ws + WS_PROJ); bf16_t* y = (bf16_t*)(ws + WS_H); const bf16_t* GW = (const bf16_t*)(ws + WS_GW);
    bf16_t* uT = (bf16_t*)(ws + WS_M); const bf16_t* spT = (const bf16_t*)(ws + WS_M + (size_t)S * D * 2); float* dec = (float*)(ws + WS_DEC);
    LAS bf16_t* VTw = (LAS bf16_t*)(lds + 66560 + wave * 9216);
    LAS float* SSQ = (LAS float*)(lds + 66560 + 8 * 9216);
    const int t0 = n * 64;
    const f32x4 zero4 = (f32x4){0.f, 0.f, 0.f, 0.f};
    {
        bf16x8 vn[4][2], identv[2];
#pragma unroll
        for (int tt = 0; tt < 4; ++tt)
#pragma unroll
            for (int kv = 0; kv < 2; ++kv) vn[tt][kv] = *(const bf16x8*)(proj + (size_t)(t0 + 16 * tt + c) * DINP + 1536 + 128 * h + 64 * vh + 32 * kv + 8 * q);
#pragma unroll
        for (int e1 = 0; e1 < 2; ++e1)
#pragma unroll
            for (int jj = 0; jj < 8; ++jj) identv[e1][jj] = (8 * q + jj == 16 * e1 + c) ? (short)0x3F80 : (short)0;
#pragma unroll
        for (int vf = 0; vf < 4; ++vf)
#pragma unroll
            for (int tt = 0; tt < 4; ++tt) { const f32x4 d = mfma16(vn[tt][vf >> 1], identv[vf & 1], zero4);
                *(LAS u32x2*)(VTw + (16 * vf + c) * 72 + 16 * tt + 4 * q) = (u32x2){cvtpk(d[0], d[1]), cvtpk(d[2], d[3])}; }
    }
    LDS_FENCE();
    f32x4 acc[4][4];
#pragma unroll
    for (int a = 0; a < 4; ++a)
#pragma unroll
        for (int b = 0; b < 4; ++b) acc[a][b] = zero4;
#pragma unroll 1
    for (int dir = 0; dir < 2; ++dir) {
        bf16x8 laop[4][2]; float tot[4];
        {
            bf16x8 lrf[4], gwf[4]; float bgv[4];
#pragma unroll
            for (int tt = 0; tt < 4; ++tt) { lrf[tt] = (bf16x8){0, 0, 0, 0, 0, 0, 0, 0}; if (q < 2) lrf[tt] = *(const bf16x8*)(proj + (size_t)(t0 + 16 * tt + c) * DINP + 2560 + dir * 16 + 8 * q); }
#pragma unroll
            for (int ef = 0; ef < 4; ++ef) { gwf[ef] = *(const bf16x8*)(GW + (size_t)(dir * 256 + 64 * h + 16 * ef + c) * 32 + 8 * q); bgv[ef] = p.in[13][(size_t)(l * 2 + dir) * 256 + 64 * h + 16 * ef + c]; }
#pragma unroll
            for (int ef = 0; ef < 4; ++ef) { tot[ef] = 0.f;
#pragma unroll
                for (int ks = 0; ks < 2; ++ks) { f32x4 la2[2];
#pragma unroll
                    for (int t2 = 0; t2 < 2; ++t2) { const f32x4 z = mfma16(lrf[2 * ks + t2], gwf[ef], zero4);
#pragma unroll
                        for (int r = 0; r < 4; ++r) { const float zz = z[r] + bgv[ef]; const float la = (fminf(zz, 0.f) - __logf(1.0f + __expf(-fabsf(zz)))) * (1.0f / 16.0f); la2[t2][r] = la; tot[ef] += la; } }
                    laop[ef][ks] = pack8(la2[0], la2[1]); __builtin_amdgcn_sched_barrier(0); } }
        }
        if (MODE == 1) {
            bf16x8 QEop[4][2], KEop[4][2];
            bf16x4 qv[4][4], kv[4][4];
#pragma unroll
            for (int tj = 0; tj < 4; ++tj)
#pragma unroll
                for (int ef = 0; ef < 4; ++ef) { const bf16_t* rp = proj + (size_t)(t0 + 16 * tj + c) * DINP + 64 * h + 4 * q + 16 * ef; qv[tj][ef] = *(const bf16x4*)(rp + 1024); kv[tj][ef] = *(const bf16x4*)(rp + 1280); }
            __builtin_amdgcn_sched_barrier(0);
#pragma unroll
            for (int tj = 0; tj < 4; ++tj) {
                const int t = 16 * tj + c;
                bf16x8 mk[2];
#pragma unroll
                for (int ks = 0; ks < 2; ++ks)
#pragma unroll
                    for (int jj = 0; jj < 8; ++jj) { const int sidx = SLOT(ks, q, jj); const bool on = dir == 0 ? sidx <= t : sidx >= t; mk[ks][jj] = on ? (short)0x3F80 : (short)0; }
#pragma unroll
                for (int ks2 = 0; ks2 < 2; ++ks2) { f32x4 qe2[2], ke2[2];
#pragma unroll
                    for (int e2 = 0; e2 < 2; ++e2) { const int ef = 2 * ks2 + e2;
                        f32x4 b = mfma16(laop[ef][0], mk[0], zero4); b = mfma16(laop[ef][1], mk[1], b);
#pragma unroll
                        for (int r = 0; r < 4; ++r) { qe2[e2][r] = bf2f((bf16_t)qv[tj][ef][r]) * 0.125f * __expf(b[r]); ke2[e2][r] = bf2f((bf16_t)kv[tj][ef][r]) * __expf(-b[r]); } }
                    QEop[tj][ks2] = pack8(qe2[0], qe2[1]); KEop[tj][ks2] = pack8(ke2[0], ke2[1]); }
                __builtin_amdgcn_sched_barrier(0);
            }
            const bf16_t* SP = spT + ((size_t)(dir * NCH + n) * 4 + h) * 8192 + (size_t)(64 * vh) * 64;
            bf16x8 spf[4][2];
#pragma unroll
            for (int vf = 0; vf < 4; ++vf)
#pragma unroll
                for (int ks = 0; ks < 2; ++ks) { const u32x2 s0 = *(const u32x2*)(SP + (16 * vf + c) * 64 + 32 * ks + 4 * q), s1 = *(const u32x2*)(SP + (16 * vf + c) * 64 + 32 * ks + 16 + 4 * q);
                    spf[vf][ks] = __builtin_bit_cast(bf16x8, (u32x4){s0.x, s0.y, s1.x, s1.y}); }
            __builtin_amdgcn_sched_barrier(0);
            bf16x8 Pop[4][2];
#pragma unroll
            for (int ti = 0; ti < 4; ++ti)
#pragma unroll
                for (int ksp = 0; ksp < 2; ++ksp) { f32x4 pm[2];
#pragma unroll
                    for (int j2 = 0; j2 < 2; ++j2) { const int tjj = 2 * ksp + j2;
                        f32x4 sc = mfma16(KEop[tjj][0], QEop[ti][0], zero4); sc = mfma16(KEop[tjj][1], QEop[ti][1], sc);
#pragma unroll
                        for (int r = 0; r < 4; ++r) { const int j = 16 * tjj + 4 * q + r, i = 16 * ti + c; const bool keep = dir == 0 ? j <= i : j >= i; pm[j2][r] = keep ? sc[r] : 0.f; } }
                    Pop[ti][ksp] = pack8(pm[0], pm[1]); __builtin_amdgcn_sched_barrier(0); }
#pragma unroll
            for (int vf = 0; vf < 4; ++vf)
#pragma unroll
                for (int ks = 0; ks < 2; ++ks) {
                    const u32x2 v0 = *(const LAS u32x2*)(VTw + (16 * vf + c) * 72 + 32 * ks + 4 * q), v1 = *(const LAS u32x2*)(VTw + (16 * vf + c) * 72 + 32 * ks + 16 + 4 * q);
                    const bf16x8 vtf = __builtin_bit_cast(bf16x8, (u32x4){v0.x, v0.y, v1.x, v1.y});
#pragma unroll
                    for (int ti = 0; ti < 4; ++ti) { acc[vf][ti] = mfma16(vtf, Pop[ti][ks], acc[vf][ti]); acc[vf][ti] = mfma16(spf[vf][ks], QEop[ti][ks], acc[vf][ti]); }
                    __builtin_amdgcn_sched_barrier(0);
                }
        } else {
#pragma unroll
            for (int ef = 0; ef < 4; ++ef) { float tt = tot[ef]; tt += __shfl_xor(tt, 16); tt += __shfl_xor(tt, 32);
                if (vh == 0 && q == 0) dec[((size_t)(dir * NCH + n) * 4 + h) * 64 + 16 * ef + c] = __expf(tt); }
            bf16x8 kn[4][2];
#pragma unroll
            for (int tj = 0; tj < 4; ++tj)
#pragma unroll
                for (int ks = 0; ks < 2; ++ks) kn[tj][ks] = *(const bf16x8*)(proj + (size_t)(t0 + 16 * tj + c) * DINP + 1280 + 64 * h + 32 * ks + 8 * q);
            bf16x8 ident[2];
#pragma unroll
            for (int e1 = 0; e1 < 2; ++e1)
#pragma unroll
                for (int jj = 0; jj < 8; ++jj) ident[e1][jj] = (8 * q + jj == 16 * e1 + c) ? (short)0x3F80 : (short)0;
            bf16x8 kdop[4][2];
#pragma unroll
            for (int ks = 0; ks < 2; ++ks) {
                bf16x8 mk[2][2];
#pragma unroll
                for (int t2 = 0; t2 < 2; ++t2)
#pragma unroll
                    for (int k2 = 0; k2 < 2; ++k2)
#pragma unroll
                        for (int jj = 0; jj < 8; ++jj) { const int tp = 16 * (2 * ks + t2) + c, sidx = SLOT(k2, q, jj); const bool on = dir == 0 ? sidx > tp : sidx < tp; mk[t2][k2][jj] = on ? (short)0x3F80 : (short)0; }
#pragma unroll
                for (int ef = 0; ef < 4; ++ef) { f32x4 kd2[2];
#pragma unroll
                    for (int t2 = 0; t2 < 2; ++t2) { const int tj = 2 * ks + t2;
                        f32x4 E = mfma16(mk[t2][0], laop[ef][0], zero4); E = mfma16(mk[t2][1], laop[ef][1], E);
                        const f32x4 kR = mfma16(kn[tj][ef >> 1], ident[ef & 1], zero4);
#pragma unroll
                        for (int r = 0; r < 4; ++r) kd2[t2][r] = kR[r] * __expf(E[r]); }
                    kdop[ef][ks] = pack8(kd2[0], kd2[1]); __builtin_amdgcn_sched_barrier(0); }
            }
            bf16_t* U = uT + ((size_t)(dir * NCH + n) * 4 + h) * 8192 + (size_t)(64 * vh) * 64;
#pragma unroll
            for (int vf = 0; vf < 4; ++vf) { bf16x8 vtf[2];
#pragma unroll
                for (int ks = 0; ks < 2; ++ks) { const u32x2 v0 = *(const LAS u32x2*)(VTw + (16 * vf + c) * 72 + 32 * ks + 4 * q), v1 = *(const LAS u32x2*)(VTw + (16 * vf + c) * 72 + 32 * ks + 16 + 4 * q);
                    vtf[ks] = __builtin_bit_cast(bf16x8, (u32x4){v0.x, v0.y, v1.x, v1.y}); }
#pragma unroll
                for (int ef = 0; ef < 4; ++ef) { f32x4 u = mfma16(kdop[ef][0], vtf[0], zero4); u = mfma16(kdop[ef][1], vtf[1], u);
                    *(u32x2*)(U + (16 * vf + c) * 64 + 16 * ef + 4 * q) = (u32x2){cvtpk(u[0], u[1]), cvtpk(u[2], u[3])}; } }
        }
    }
    if (MODE == 1) {
        bf16x4 ggp[4][4];
#pragma unroll
        for (int ti = 0; ti < 4; ++ti)
#pragma unroll
            for (int vf = 0; vf < 4; ++vf) ggp[ti][vf] = *(const bf16x4*)(proj + (size_t)(t0 + 16 * ti + c) * DINP + 2048 + 128 * h + 64 * vh + 16 * vf + 4 * q);
#pragma unroll
        for (int ti = 0; ti < 4; ++ti) { float ss = 0.f;
#pragma unroll
            for (int vf = 0; vf < 4; ++vf) ss += acc[vf][ti][0] * acc[vf][ti][0] + acc[vf][ti][1] * acc[vf][ti][1] + acc[vf][ti][2] * acc[vf][ti][2] + acc[vf][ti][3] * acc[vf][ti][3];
            ss += __shfl_xor(ss, 16); ss += __shfl_xor(ss, 32);
            if (q == 0) SSQ[(h * 64 + 16 * ti + c) * 2 + vh] = ss; }
        __syncthreads();
        const float* gn = p.in[14] + (size_t)l * 128;
#pragma unroll
        for (int ti = 0; ti < 4; ++ti) { const int t = 16 * ti + c; const float rs = rsqrtf((SSQ[(h * 64 + t) * 2] + SSQ[(h * 64 + t) * 2 + 1]) * (1.0f / 128.0f) + EPS);
#pragma unroll
            for (int vf = 0; vf < 4; ++vf) { const int v = 64 * vh + 16 * vf + 4 * q; const f32x4 g4 = *(const f32x4*)(gn + v);
                float o[4];
#pragma unroll
                for (int r = 0; r < 4; ++r) o[r] = acc[vf][ti][r] * rs * g4[r] * siluf_(bf2f((bf16_t)ggp[ti][vf][r]));
                *(u32x2*)(y + (size_t)(t0 + t) * D + 512 + 128 * h + v) = (u32x2){cvtpk(o[0], o[1]), cvtpk(o[2], o[3])}; } }
    }
    __syncthreads();
}

__device__ void phase_scan(const Params& p) {
    unsigned char* ws = p.ws; const int tid = otid();
    if (tid < 256) {
        const bf16_t* __restrict__ uT = (const bf16_t*)(ws + WS_M); bf16_t* __restrict__ spT = (bf16_t*)(ws + WS_M + (size_t)S * D * 2); const float* __restrict__ dec = (const float*)(ws + WS_DEC);
        for (int gid = obid() * 256 + tid; gid < 65536; gid += gridDim.x * 256) {
            const int dir = gid >> 15, rem = gid & 32767, h = rem >> 13, vd = rem & 8191, d = vd & 63;
            float s = 0.f;
            const long step = dir ? -1 : 1; const int nfirst = dir ? NCH - 1 : 0;
            const bf16_t* up = uT + ((size_t)(dir * NCH + nfirst) * 4 + h) * 8192 + vd; bf16_t* sp = spT + ((size_t)(dir * NCH + nfirst) * 4 + h) * 8192 + vd;
            const float* dp = dec + ((size_t)(dir * NCH + nfirst) * 4 + h) * 64 + d;
#pragma unroll 1
            for (int st = 0; st < NCH; st += 64) {
                bf16_t ub[64]; float db[64];
#pragma unroll
                for (int i = 0; i < 64; ++i) { ub[i] = up[(long)(st + i) * step * 32768]; db[i] = dp[(long)(st + i) * step * 256]; }
#pragma unroll
                for (int i = 0; i < 64; ++i) { sp[(long)(st + i) * step * 32768] = f2bf(s); s = db[i] * s + bf2f(ub[i]); }
            }
        }
    } else if (tid < 384 && obid() < 8) {
        const float* __restrict__ Aprod = (const float*)(ws + WS_AP); const float* __restrict__ Hend = (const float*)(ws + WS_HE); float* __restrict__ carry = (float*)(ws + WS_CA);
        const int gid = obid() * 128 + (tid - 256); const int dir = gid >> 9, ch = gid & 511;
        float hc = 0.f;
        const long step = dir ? -1 : 1; const size_t base = (size_t)(dir * NCH + (dir ? NCH - 1 : 0)) * 512 + ch;
#pragma unroll 1
        for (int st = 0; st < NCH; st += 64) {
            float ab[64], hb[64];
#pragma unroll
            for (int i = 0; i < 64; ++i) { ab[i] = Aprod[base + (long)(st + i) * step * 512]; hb[i] = Hend[base + (long)(st + i) * step * 512]; }
#pragma unroll
            for (int i = 0; i < 64; ++i) { carry[base + (long)(st + i) * step * 512] = hc; hc = ab[i] * hc + hb[i]; }
        }
    }
}

#define XB_TMO      128
#define XB_XCNT(j)  (256  + 64 * (j))
#define XB_XSUB(j)  (1280 + 64 * (j))
#define XB_XGEN(j)  (2304 + 64 * (j))
#define XB_TOP      3328
#define XB_TOPGEN   3392
#define XCD_BAR_WORDS 3456
#define XB_SPIN_CAP (1u << 18)

__device__ __forceinline__ unsigned xb_ld(unsigned* p)              { return __hip_atomic_load(p, __ATOMIC_RELAXED, __HIP_MEMORY_SCOPE_AGENT); }
__device__ __forceinline__ unsigned xb_add(unsigned* p, unsigned v) { return __hip_atomic_fetch_add(p, v, __ATOMIC_RELAXED, __HIP_MEMORY_SCOPE_AGENT); }
__device__ __forceinline__ unsigned xb_xcc_id() { return (unsigned)__builtin_amdgcn_s_getreg((3 << 11) | 20) & 0xFu; }
#define XB_SPIN(cond, bar) do { unsigned _sp = 0; while (cond) { __builtin_amdgcn_s_sleep(1); \
    if ((++_sp & 255u) == 0u) { if (xb_ld(&(bar)[XB_TMO])) break; if (_sp > XB_SPIN_CAP) { atomicAdd(&(bar)[XB_TMO], 1u); break; } } } } while (0)

struct XcdBarrier {
    unsigned* bar; unsigned x;
    volatile LAS unsigned* st;
};

__device__ __forceinline__ XcdBarrier xcd_barrier_post(unsigned* bar, volatile LAS unsigned* st) {
    XcdBarrier b; b.bar = bar; b.x = xb_xcc_id(); b.st = st;
    if (threadIdx.x == 0) (void)xb_add(&bar[XB_XCNT(b.x)], 1u);
    return b;
}
__device__ __forceinline__ void xcd_barrier_complete(unsigned* bar, unsigned x, unsigned& nloc, unsigned& nx) {
    const unsigned G = gridDim.x * gridDim.y * gridDim.z;
    unsigned sum, cnt, mine, sp = 0u;
    for (;;) {
        sum = 0u; cnt = 0u; mine = 0u;
#pragma unroll
        for (unsigned j = 0; j < 16; ++j) { const unsigned c = xb_ld(&bar[XB_XCNT(j)]); sum += c; cnt += (c > 0u) ? 1u : 0u; mine = (j == x) ? c : mine; }
        if (sum == G) break;
        __builtin_amdgcn_s_sleep(1);
        if ((++sp & 255u) == 0u) { if (xb_ld(&bar[XB_TMO])) break; if (sp > XB_SPIN_CAP) { atomicAdd(&bar[XB_TMO], 1u); break; } }
    }
    nloc = mine > 0u ? mine : 1u; nx = cnt > 0u ? cnt : 1u;
}

__device__ __forceinline__ void xcd_barrier(const XcdBarrier& b) {
    asm volatile("s_waitcnt vmcnt(0)" ::: "memory");
    __syncthreads();
    if (threadIdx.x == 0) {
        unsigned* bar = b.bar;
        __builtin_amdgcn_s_waitcnt(0);
        unsigned nloc = b.st[0], nx = b.st[1];
        if (nloc == 0u) { xcd_barrier_complete(bar, b.x, nloc, nx); b.st[0] = nloc; b.st[1] = nx; }
        const unsigned old = xb_add(&bar[XB_XSUB(b.x)], 1u);
        const unsigned gen = old / nloc;
        if (old + 1u == (gen + 1u) * nloc) {
            __builtin_amdgcn_fence(__ATOMIC_RELEASE, "agent");
            asm volatile("s_waitcnt vmcnt(0)" ::: "memory");
            const unsigned og = xb_add(&bar[XB_TOP], 1u);
            const unsigned tg = og / nx;
            if (og + 1u == (tg + 1u) * nx) xb_add(&bar[XB_TOPGEN], 1u);
            else XB_SPIN(xb_ld(&bar[XB_TOPGEN]) == tg, bar);
            __builtin_amdgcn_fence(__ATOMIC_ACQUIRE, "agent");
            xb_add(&bar[XB_XGEN(b.x)], 1u);
            asm volatile("s_waitcnt vmcnt(0)" ::: "memory");
        } else {
            XB_SPIN(xb_ld(&bar[XB_XGEN(b.x)]) == gen, bar);
            __builtin_amdgcn_fence(__ATOMIC_ACQUIRE, "agent");
            asm volatile("s_waitcnt vmcnt(0)" ::: "memory");
        }
    }
    __syncthreads();
}

__global__ void __launch_bounds__(NTHR, 2) mk_fwd(Params p) {
    extern __shared__ __attribute__((aligned(16))) unsigned char lds_raw[];
    LAS unsigned char* lds = (LAS unsigned char*)lds_raw;
    unsigned char* ws = p.ws;
    bf16_t* WinT = (bf16_t*)(ws + WS_WIN); bf16_t* WoutT = (bf16_t*)(ws + WS_WOUT); bf16_t* WguT = (bf16_t*)(ws + WS_WGU); bf16_t* WdT = (bf16_t*)(ws + WS_WD);
    bf16_t* Hb = (bf16_t*)(ws + WS_H); bf16_t* PROJ = (bf16_t*)(ws + WS_PROJ); float* Mb = (float*)(ws + WS_M);
    const float* xin = p.in[0]; float* out = p.out;
    volatile LAS unsigned* bst = (volatile LAS unsigned*)(lds + LDS_BYTES - 16);
    if (threadIdx.x == 0) { bst[0] = 0u; bst[1] = 0u; }
    __syncthreads();
    XcdBarrier bar = xcd_barrier_post((unsigned*)(ws + WS_CTL), bst);
    for (int ph = p.ph_lo; ph < p.ph_hi; ++ph) {
        if (ph == p.ph_lo + 1) cg::this_grid().sync();
        else if (ph > p.ph_lo) xcd_barrier(bar);
        if (ph == 9 * NL) { phase_rowprep(out, (const bf16_t*)Mb, p.in[17] + (size_t)(NL - 1) * D, out, nullptr, nullptr); continue; }
        const int l = ph / 9, s = ph % 9;
        switch (s) {
        case 0: phase_weights(p, l, lds);
                if (l == 0) phase_rowprep(xin, nullptr, nullptr, nullptr, p.in[1], Hb);
                else phase_rowprep(out, (const bf16_t*)Mb, p.in[17] + (size_t)(l - 1) * D, out, p.in[1] + (size_t)l * D, Hb);
                break;
        case 1: gemm_fast(lds, Hb, WinT, S, DINP, D, EpiB16{PROJ, DINP}); break;
        case 2: for (int n = obid(); n < NCH; n += gridDim.x) mixer_lru<0>(p, l, n, lds);
                for (int n = obid(); n < NCH; n += gridDim.x) mixer_gla<0>(p, l, n, lds); break;
        case 3: phase_scan(p); break;
        case 4: for (int n = obid(); n < NCH; n += gridDim.x) mixer_lru<1>(p, l, n, lds);
                for (int n = obid(); n < NCH; n += gridDim.x) mixer_gla<1>(p, l, n, lds); break;
        case 5: gemm_fast(lds, Hb, WoutT, S, D, D, EpiB16{(bf16_t*)Mb, D}); break;
        case 6: phase_rowprep(l == 0 ? xin : out, (const bf16_t*)Mb, p.in[2] + (size_t)l * D, out, p.in[16] + (size_t)l * D, Hb); break;
        case 7: gemm_fast(lds, Hb, WguT, S, 2 * DFF, D, EpiSwiglu{PROJ, DFF}); break;
        case 8: gemm_fast(lds, PROJ, WdT, S, D, DFF, EpiB16{(bf16_t*)Mb, D}); break;
        }
    }
}

extern "C" void kernel_launch(void* const* d_in, const int* in_sizes, int n_in, void* d_out, int out_size, void* d_ws, size_t ws_size, hipStream_t stream) {
    static int grid = 0;
    if (grid == 0) {
        if (n_in != 21 || out_size != S * D || ws_size < WS_END) { fprintf(stderr, "kernel_launch: unexpected shapes: n_in %d out %d ws %zu (need %zu)\n", n_in, out_size, ws_size, (size_t)WS_END); grid = -1; return; }
        int dev = 0, cus = 0, per_cu = 0;
        (void)hipGetDevice(&dev); (void)hipDeviceGetAttribute(&cus, hipDeviceAttributeMultiprocessorCount, dev);
        if (hipFuncSetAttribute((const void*)mk_fwd, hipFuncAttributeMaxDynamicSharedMemorySize, LDS_BYTES) != hipSuccess) { fprintf(stderr, "kernel_launch: hipFuncSetAttribute failed\n"); grid = -1; return; }
        if (hipOccupancyMaxActiveBlocksPerMultiprocessor(&per_cu, (const void*)mk_fwd, NTHR, LDS_BYTES) != hipSuccess || per_cu < 1) { fprintf(stderr, "kernel_launch: occupancy query says %d\n", per_cu); per_cu = 1; }
        (void)hipGetLastError();
        grid = cus;
    }
    if (grid < 0) return;
    Params p{};
    for (int i = 0; i < 21; ++i) p.in[i] = (const float*)d_in[i];
    p.out = (float*)d_out; p.ws = (unsigned char*)d_ws;
    (void)hipMemsetAsync((unsigned char*)d_ws + WS_CTL, 0, 16384, stream);
#if ONE_LAUNCH
    p.ph_lo = 0; p.ph_hi = 9 * NL + 1;
    void* args[] = {&p};
    hipError_t e = hipLaunchCooperativeKernel((const void*)mk_fwd, dim3(grid), dim3(NTHR), args, LDS_BYTES, stream);
    if (e != hipSuccess) fprintf(stderr, "cooperative launch failed: %s (grid %d)\n", hipGetErrorString(e), grid);
#else
    for (int ph = 0; ph < 9 * NL + 1; ++ph) { p.ph_lo = ph; p.ph_hi = ph + 1; hipLaunchKernelGGL(mk_fwd, dim3(grid), dim3(NTHR), LDS_BYTES, stream, p); }
#endif
}
```

```cpp
#include <hip/hip_runtime.h>
#include <hip/hip_cooperative_groups.h>
#include <cstdio>
namespace cg = cooperative_groups;

#ifndef ONE_LAUNCH
#define ONE_LAUNCH 1
#endif

#define LAS __attribute__((address_space(3)))
typedef unsigned short bf16_t;
typedef short bf16x8 __attribute__((ext_vector_type(8)));
typedef short bf16x4 __attribute__((ext_vector_type(4)));
typedef float f32x4 __attribute__((ext_vector_type(4)));
typedef unsigned u32x4 __attribute__((ext_vector_type(4)));
typedef unsigned u32x2 __attribute__((ext_vector_type(2)));
typedef float f32x2 __attribute__((ext_vector_type(2)));
typedef __bf16 bf16v2 __attribute__((ext_vector_type(2)));

constexpr int S = 16384, D = 1024, DIN = 2592, DINP = 2816, DFF = 2816, NL = 4, NCH = 256;
constexpr int NTHR = 512;
constexpr int LDS_BYTES = 147456;
constexpr float EPS = 1e-6f;

constexpr size_t WS_CTL = 0;
constexpr size_t WS_WIN = 65536;
constexpr size_t WS_WOUT = WS_WIN + (size_t)DINP * D * 2;
constexpr size_t WS_WGU = WS_WOUT + (size_t)D * D * 2;
constexpr size_t WS_WD = WS_WGU + (size_t)2 * DFF * D * 2;
constexpr size_t WS_LRUW = WS_WD + (size_t)D * DFF * 2;
constexpr size_t WS_GW = WS_LRUW + (size_t)2 * 2 * 8 * 64 * 64 * 2;
constexpr size_t WS_H = WS_GW + (size_t)2 * 256 * 32 * 2;
constexpr size_t WS_PROJ = WS_H + (size_t)S * D * 2;
constexpr size_t WS_M = WS_PROJ + (size_t)S * DINP * 2;
constexpr size_t WS_AP = WS_M + (size_t)S * D * 4;
constexpr size_t WS_HE = WS_AP + (size_t)2 * NCH * 512 * 4;
constexpr size_t WS_CA = WS_HE + (size_t)2 * NCH * 512 * 4;
constexpr size_t WS_DEC = WS_CA + (size_t)2 * NCH * 512 * 4;
constexpr size_t WS_PB = WS_DEC + (size_t)2 * NCH * 4 * 64 * 4;
constexpr size_t WS_END = WS_PB + (size_t)S * 512 * 2;

struct Params { const float* in[21]; float* out; unsigned char* ws; int ph_lo, ph_hi; };

__device__ __forceinline__ float bf2f(bf16_t b) { return __uint_as_float(((unsigned)b) << 16); }
__device__ __forceinline__ bf16_t f2bf(float f) { unsigned u = __float_as_uint(f); return (bf16_t)((u + 0x7fffu + ((u >> 16) & 1u)) >> 16); }
__device__ __forceinline__ unsigned pk2(float lo, float hi) { return (unsigned)f2bf(lo) | ((unsigned)f2bf(hi) << 16); }
__device__ __forceinline__ unsigned cvtpk(float lo, float hi) { const f32x2 v = (f32x2){lo, hi}; const bf16v2 b = __builtin_convertvector(v, bf16v2); return __builtin_bit_cast(unsigned, b); }
__device__ __forceinline__ float sigmoidf_(float x) { return __builtin_amdgcn_rcpf(1.0f + __expf(-x)); }
__device__ __forceinline__ float siluf_(float x) { return x * sigmoidf_(x); }
__device__ __forceinline__ float geluf_(float x) { const float y = 0.7978845608028654f * (x + 0.044715f * x * x * x); const float t = 1.0f - 2.0f * __builtin_amdgcn_rcpf(__expf(2.0f * y) + 1.0f); return 0.5f * x * (1.0f + t); }
__device__ __forceinline__ f32x4 mfma16(bf16x8 a, bf16x8 b, f32x4 c) { return __builtin_amdgcn_mfma_f32_16x16x32_bf16(a, b, c, 0, 0, 0); }
__device__ __forceinline__ int otid() { int t = threadIdx.x; asm volatile("" : "+v"(t)); return t; }
__device__ __forceinline__ int obid() { int t = blockIdx.x; asm volatile("" : "+s"(t)); return t; }
#define LDS_FENCE() asm volatile("s_waitcnt lgkmcnt(0)" ::: "memory")

struct WDesc { const float* src; bf16_t* dst; int ldsrc, c0, nvalid, k0, lddst, r0; };
__device__ __forceinline__ WDesc wdesc(const Params& p, int l, int u) {
    unsigned char* ws = p.ws;
    constexpr int T_IN = 44 * 16, T_OUT = 16 * 16, T_GU = 88 * 16, T_D = 16 * 44;
    WDesc d; int v = u;
    if (v < T_IN) { const int rt = v / 16, kt = v % 16; int nv = DIN - rt * 64; nv = nv > 64 ? 64 : (nv < 0 ? 0 : nv);
        d.src = p.in[3] + (size_t)l * D * DIN; d.ldsrc = DIN; d.c0 = nv > 0 ? rt * 64 : 0; d.nvalid = nv; d.k0 = kt * 64; d.dst = (bf16_t*)(ws + WS_WIN); d.lddst = D; d.r0 = rt * 64; return d; }
    v -= T_IN;
    if (v < T_OUT) { const int rt = v / 16, kt = v % 16; d.src = p.in[15] + (size_t)l * D * D; d.ldsrc = D; d.c0 = rt * 64; d.nvalid = 64; d.k0 = kt * 64; d.dst = (bf16_t*)(ws + WS_WOUT); d.lddst = D; d.r0 = rt * 64; return d; }
    v -= T_OUT;
    if (v < T_GU) { const int rt = v / 16, kt = v % 16; const int r0 = rt * 64, j = r0 / 256, within = r0 % 256;
        d.src = (within < 128 ? p.in[18] : p.in[19]) + (size_t)l * D * DFF; d.ldsrc = DFF; d.c0 = j * 128 + (within & 127); d.nvalid = 64; d.k0 = kt * 64; d.dst = (bf16_t*)(ws + WS_WGU); d.lddst = D; d.r0 = r0; return d; }
    v -= T_GU;
    if (v < T_D) { const int rt = v / 44, kt = v % 44; d.src = p.in[20] + (size_t)l * DFF * D; d.ldsrc = D; d.c0 = rt * 64; d.nvalid = 64; d.k0 = kt * 64; d.dst = (bf16_t*)(ws + WS_WD); d.lddst = DFF; d.r0 = rt * 64; return d; }
    v -= T_D;
    { const int dir = v / 16, gate = (v / 8) % 2, h = v % 8; d.src = (gate ? p.in[8] : p.in[6]) + ((size_t)(l * 2 + dir) * 8 + h) * 4096; d.ldsrc = 64; d.c0 = 0; d.nvalid = 64; d.k0 = 0;
      d.dst = (bf16_t*)(ws + WS_LRUW) + ((size_t)(dir * 2 + gate) * 8 + h) * 4096; d.lddst = 64; d.r0 = 0; return d; }
}

__device__ void phase_weights(const Params& p, int l, LAS unsigned char* lds) {
    LAS float* T = (LAS float*)lds;
    unsigned char* ws = p.ws;
    constexpr int TOT = 44 * 16 + 16 * 16 + 88 * 16 + 16 * 44 + 32;
    const int tid = otid(), G = gridDim.x;
    for (int u0 = obid(); u0 < TOT; u0 += 4 * G) {
        f32x4 v[4][2];
        { const int k = tid >> 3, cg8 = (tid & 7) * 8;
#pragma unroll
          for (int j = 0; j < 4; ++j) { const int u = u0 + j * G; v[j][0] = (f32x4){0.f, 0.f, 0.f, 0.f}; v[j][1] = v[j][0];
              if (u < TOT) { const WDesc d = wdesc(p, l, u); const float* sp = d.src + (size_t)(d.k0 + k) * d.ldsrc + d.c0 + cg8;
                  if (cg8 + 3 < d.nvalid) v[j][0] = *(const f32x4*)sp; if (cg8 + 7 < d.nvalid) v[j][1] = *(const f32x4*)(sp + 4); } }
#pragma unroll
          for (int j = 0; j < 4; ++j)
#pragma unroll
              for (int i = 0; i < 2; ++i) { LAS float* Tj = T + j * 4160 + k * 65 + cg8 + 4 * i; Tj[0] = v[j][i][0]; Tj[1] = v[j][i][1]; Tj[2] = v[j][i][2]; Tj[3] = v[j][i][3]; } }
        __syncthreads();
        { const int r = tid >> 3, kg = (tid & 7) * 8;
#pragma unroll
          for (int j = 0; j < 4; ++j) { const int u = u0 + j * G;
              if (u < TOT) { const WDesc d = wdesc(p, l, u); const LAS float* Tj = T + j * 4160; u32x4 w;
                  w.x = cvtpk(Tj[(kg + 0) * 65 + r], Tj[(kg + 1) * 65 + r]); w.y = cvtpk(Tj[(kg + 2) * 65 + r], Tj[(kg + 3) * 65 + r]);
                  w.z = cvtpk(Tj[(kg + 4) * 65 + r], Tj[(kg + 5) * 65 + r]); w.w = cvtpk(Tj[(kg + 6) * 65 + r], Tj[(kg + 7) * 65 + r]);
                  *(u32x4*)(d.dst + (size_t)(d.r0 + r) * d.lddst + d.k0 + kg) = w; } } }
        __syncthreads();
    }
    { bf16_t* GW = (bf16_t*)(ws + WS_GW); const float* wg = p.in[12] + (size_t)l * 2 * 16 * 256;
      for (int idx = obid() * NTHR + otid(); idx < 2 * 256 * 32; idx += gridDim.x * NTHR) { const int dir = idx >> 13, e = (idx >> 5) & 255, r = idx & 31;
          GW[idx] = r < 16 ? f2bf(wg[(size_t)(dir * 16 + r) * 256 + e]) : (bf16_t)0; } }
}

__device__ void phase_rowprep(const float* __restrict__ xsrc, const bf16_t* __restrict__ m, const float* __restrict__ gpost, float* __restrict__ xdst, const float* __restrict__ gpre, bf16_t* __restrict__ hdst) {
    const int tid = otid(); const int lane = tid & 63, wave = tid >> 6;
    for (int row = obid() * 8 + wave; row < S; row += gridDim.x * 8) {
        f32x4 xv[4];
#pragma unroll
        for (int i = 0; i < 4; ++i) xv[i] = *(const f32x4*)(xsrc + (size_t)row * D + i * 256 + lane * 4);
        if (m) {
            f32x4 mv[4]; float ss = 0.f;
#pragma unroll
            for (int i = 0; i < 4; ++i) { const bf16x4 mb = *(const bf16x4*)(m + (size_t)row * D + i * 256 + lane * 4); mv[i] = (f32x4){bf2f((bf16_t)mb[0]), bf2f((bf16_t)mb[1]), bf2f((bf16_t)mb[2]), bf2f((bf16_t)mb[3])}; ss += mv[i][0] * mv[i][0] + mv[i][1] * mv[i][1] + mv[i][2] * mv[i][2] + mv[i][3] * mv[i][3]; }
#pragma unroll
            for (int o = 32; o >= 1; o >>= 1) ss += __shfl_xor(ss, o);
            const float rs = rsqrtf(ss * (1.0f / D) + EPS);
#pragma unroll
            for (int i = 0; i < 4; ++i) { const f32x4 g = *(const f32x4*)(gpost + i * 256 + lane * 4); xv[i] += mv[i] * rs * g; }
        }
        if (xdst) {
#pragma unroll
            for (int i = 0; i < 4; ++i) *(f32x4*)(xdst + (size_t)row * D + i * 256 + lane * 4) = xv[i];
        }
        if (hdst) {
            float ss = 0.f;
#pragma unroll
            for (int i = 0; i < 4; ++i) ss += xv[i][0] * xv[i][0] + xv[i][1] * xv[i][1] + xv[i][2] * xv[i][2] + xv[i][3] * xv[i][3];
#pragma unroll
            for (int o = 32; o >= 1; o >>= 1) ss += __shfl_xor(ss, o);
            const float rs = rsqrtf(ss * (1.0f / D) + EPS);
#pragma unroll
            for (int i = 0; i < 4; ++i) { const f32x4 g = *(const f32x4*)(gpre + i * 256 + lane * 4); const f32x4 hv = xv[i] * rs * g; u32x2 w; w.x = pk2(hv[0], hv[1]); w.y = pk2(hv[2], hv[3]);
                *(u32x2*)(hdst + (size_t)row * D + i * 256 + lane * 4) = w; }
        }
    }
}

namespace pg8 {
#define PG8_LAS __attribute__((address_space(3)))
constexpr int BM = 256, BK = 64, HALF = 128, HTB = HALF * BK * 2  , STAGE_BYTES = 8 * HTB, NXCD = 8, WGM = 8;
__host__ __device__ __forceinline__ int lds_byte(int r, int c) { const int st = (r >> 4) * 2 + (c >> 5), rr = r & 15, cc = c & 31, ob = rr * 64 + cc * 2; return st * 1024 + (ob ^ (((ob >> 9) & 1) << 5)); }
__host__ __device__ __forceinline__ void stage_rc(int b, int& R, int& C) { const int st = b / 1024, sb = b % 1024, swz = sb ^ (((sb >> 9) & 1) << 5); R = (st >> 1) * 16 + swz / 64; C = (st & 1) * 32 + (swz % 64) / 2; }
__host__ __device__ __forceinline__ int perm32(int rho) { const int n = rho >> 4, i = rho & 15; return 8 * (i >> 2) + 4 * n + (i & 3); }
struct Unit { int pm, pn; };
struct Gemm { const bf16_t* A; const bf16_t* Bt; int M, N, K; };
struct StaticOrder {
    int nM, nN, nwg, G, c;
    __host__ __device__ void init(int M, int N, int G_, int c_) { nM = M / BM; nN = N / BM; nwg = nM * nN; G = G_; c = c_; }
    __host__ __device__ bool next(int i, Unit& u) const {
        const long L = (long)i * G + c; if (L >= nwg) return false;
        int wgid = (int)L; { const int q = nwg / NXCD, r = nwg % NXCD, xcd = wgid % NXCD, off = wgid / NXCD; wgid = (xcd < r ? xcd * (q + 1) : r * (q + 1) + (xcd - r) * q) + off; }
        const int nig = WGM * nN, gid = wgid / nig, fm = gid * WGM, gsz = (nM - fm) < WGM ? (nM - fm) : WGM;
        u.pm = fm + ((wgid % nig) % gsz); u.pn = (wgid % nig) / gsz; return true;
    }
    __device__ __forceinline__ void a_ready(const Unit&) const {}
    __device__ __forceinline__ void done(const Unit&) const {}
};
__device__ __forceinline__ unsigned cvt_pk_bf16(float lo, float hi) { unsigned r; asm volatile("v_cvt_pk_bf16_f32 %0, %1, %2" : "=v"(r) : "v"(lo), "v"(hi)); return r; }
template <class Epi, class Sched>
__device__ __forceinline__ void gemm_phase(PG8_LAS unsigned char* lds, const Gemm g, const Sched& S, const Epi& E) {
    const int tid = otid(), wid = __builtin_amdgcn_readfirstlane(tid >> 6), lane = tid & 63, wr = wid >> 2, wc = wid & 3, fr = lane & 15, fq = lane >> 4;
    const int K = g.K, nt = K / BK;
    unsigned voffA[2], voffB[2];
#pragma unroll
    for (int i = 0; i < 2; ++i) { int R, C; stage_rc(tid * 16 + i * 8192, R, C); const int Rb = Epi::PERM ? ((R & ~31) + perm32(R & 31)) : R;
        voffA[i] = (unsigned)(R * K + C) * 2u; voffB[i] = (unsigned)(Rb * K + C) * 2u; }
    const size_t kstep = (size_t)(BK * 2);
    const size_t hstep = (size_t)HALF * K * 2;
    const size_t tstep = 2 * hstep;
    const unsigned ldsw = (unsigned)wid * 1024u;
    const int aoff = lds_byte(wr * 64 + fr, fq * 8), boff = lds_byte(wc * 32 + fr, fq * 8);
#define PG8_SA(b, h) (((b) * 2 + (h)) * HTB)
#define PG8_SB(b, h) ((4 + (b) * 2 + (h)) * HTB)
#define PG8_STAGE(bufoff, gbase, voff) do { _Pragma("unroll") for (int _i = 0; _i < 2; ++_i) \
        __builtin_amdgcn_global_load_lds((const unsigned*)((const char*)(gbase) + (voff)[_i]), (PG8_LAS unsigned*)(lds + (bufoff) + ldsw + _i * 8192), 16, 0, 0); } while (0)
#define PG8_LDA(dst, b, h) do { _Pragma("unroll") for (int m = 0; m < 4; ++m) _Pragma("unroll") for (int k = 0; k < 2; ++k) dst[m][k] = *(const PG8_LAS bf16x8*)(lds + PG8_SA(b, h) + aoff + m * 2048 + k * 1024); } while (0)
#define PG8_LDB(dst, b, h) do { _Pragma("unroll") for (int n = 0; n < 2; ++n) _Pragma("unroll") for (int k = 0; k < 2; ++k) dst[n][k] = *(const PG8_LAS bf16x8*)(lds + PG8_SB(b, h) + boff + n * 2048 + k * 1024); } while (0)
#define PG8_MMA(ai, bj, At, Bt) do { __builtin_amdgcn_s_setprio(1); _Pragma("unroll") for (int m = 0; m < 4; ++m) _Pragma("unroll") for (int n = 0; n < 2; ++n) _Pragma("unroll") for (int k = 0; k < 2; ++k) \
        acc[ai][bj][m][n] = __builtin_amdgcn_mfma_f32_16x16x32_bf16(Bt[n][k], At[m][k], acc[ai][bj][m][n], 0, 0, 0); __builtin_amdgcn_s_setprio(0); } while (0)
#define PG8_WAIT_V(n) asm volatile("s_waitcnt vmcnt(" #n ")" ::: "memory")
#define PG8_WAIT_L(n) asm volatile("s_waitcnt lgkmcnt(" #n ")" ::: "memory")
#define PG8_BAR __builtin_amdgcn_s_barrier()
#define PG8_SCHED __builtin_amdgcn_sched_barrier(0)
    Unit cur, nxt; int ui = 0;
    if (!S.next(0, cur)) return;
    f32x4 acc[2][2][4][2];
#pragma unroll
    for (int a = 0; a < 2; ++a)
#pragma unroll
        for (int b = 0; b < 2; ++b)
#pragma unroll
            for (int m = 0; m < 4; ++m)
#pragma unroll
                for (int n = 0; n < 2; ++n) acc[a][b][m][n] = (f32x4){0.f, 0.f, 0.f, 0.f};
    bf16x8 At[4][2], B0[2][2], B1[2][2];
    const char* cA = (const char*)g.A + (size_t)cur.pm * tstep; const char* cB = (const char*)g.Bt + (size_t)cur.pn * tstep;
    S.a_ready(cur);
    PG8_STAGE(PG8_SB(0, 0), cB, voffB); PG8_STAGE(PG8_SA(0, 0), cA, voffA); PG8_STAGE(PG8_SB(0, 1), cB + hstep, voffB); PG8_STAGE(PG8_SA(0, 1), cA + hstep, voffA);
    if (wr == 1) PG8_BAR;
    PG8_WAIT_V(4); PG8_BAR;
    PG8_STAGE(PG8_SB(1, 0), cB + kstep, voffB); PG8_STAGE(PG8_SA(1, 0), cA + kstep, voffA); PG8_STAGE(PG8_SB(1, 1), cB + hstep + kstep, voffB);
    PG8_WAIT_V(6); PG8_BAR;
    for (;;) {
        const bool has_next = S.next(ui + 1, nxt);
        const char* nA = has_next ? (const char*)g.A + (size_t)nxt.pm * tstep : cA; const char* nB = has_next ? (const char*)g.Bt + (size_t)nxt.pn * tstep : cB;
        for (int t = 0; t < nt; t += 2) {
            const bool last = (t == nt - 2);
            const char* a1 = cA + (size_t)(t + 1) * kstep;
            const char* a2 = last ? nA : cA + (size_t)(t + 2) * kstep; const char* b2 = last ? nB : cB + (size_t)(t + 2) * kstep;
            const char* a3 = a2 + kstep; const char* b3 = b2 + kstep;
            if (last && has_next) S.a_ready(nxt);
            PG8_LDB(B0, 0, 0); PG8_SCHED; PG8_LDA(At, 0, 0); PG8_STAGE(PG8_SA(1, 1), a1 + hstep, voffA);
            PG8_WAIT_L(8); PG8_BAR; PG8_WAIT_L(0); PG8_MMA(0, 0, At, B0); PG8_BAR; PG8_SCHED;
            PG8_LDB(B1, 0, 1); PG8_STAGE(PG8_SB(0, 0), b2, voffB);
            PG8_BAR; PG8_WAIT_L(0); PG8_MMA(0, 1, At, B1); PG8_BAR;
            PG8_LDA(At, 0, 1); PG8_STAGE(PG8_SA(0, 0), a2, voffA);
            PG8_BAR; PG8_WAIT_L(0); PG8_MMA(1, 0, At, B0); PG8_BAR; PG8_SCHED;
            PG8_STAGE(PG8_SB(0, 1), b2 + hstep, voffB);
            PG8_WAIT_V(6); PG8_BAR; PG8_MMA(1, 1, At, B1); PG8_BAR;
            PG8_LDB(B0, 1, 0); PG8_SCHED; PG8_LDA(At, 1, 0); PG8_STAGE(PG8_SA(0, 1), a2 + hstep, voffA);
            PG8_WAIT_L(8); PG8_BAR; PG8_WAIT_L(0); PG8_MMA(0, 0, At, B0); PG8_BAR; PG8_SCHED;
            PG8_LDB(B1, 1, 1); PG8_STAGE(PG8_SB(1, 0), b3, voffB);
            PG8_BAR; PG8_WAIT_L(0); PG8_MMA(0, 1, At, B1); PG8_BAR;
            PG8_LDA(At, 1, 1); PG8_STAGE(PG8_SA(1, 0), a3, voffA);
            PG8_BAR; PG8_WAIT_L(0); PG8_MMA(1, 0, At, B0); PG8_BAR; PG8_SCHED;
            PG8_STAGE(PG8_SB(1, 1), b3 + hstep, voffB);
            PG8_WAIT_V(6); PG8_BAR; PG8_MMA(1, 1, At, B1); PG8_BAR;
        }
        if constexpr (!Epi::AFTER_DRAIN) { E(acc, cur, wr, wc, fr, fq); S.done(cur); }
        if (!has_next) break;
#pragma unroll
        for (int a = 0; a < 2; ++a)
#pragma unroll
            for (int b = 0; b < 2; ++b)
#pragma unroll
                for (int m = 0; m < 4; ++m)
#pragma unroll
                    for (int n = 0; n < 2; ++n) acc[a][b][m][n] = (f32x4){0.f, 0.f, 0.f, 0.f};
        cur = nxt; cA = nA; cB = nB; ++ui;
    }
    PG8_WAIT_V(0);
    if (wr == 0) PG8_BAR;
    PG8_BAR;
    if constexpr (Epi::AFTER_DRAIN) { E.fused(acc, cur, wr, wc, fr, fq, lds, wid, lane); S.done(cur); }
#undef PG8_SA
#undef PG8_SB
#undef PG8_STAGE
#undef PG8_LDA
#undef PG8_LDB
#undef PG8_MMA
#undef PG8_WAIT_V
#undef PG8_WAIT_L
#undef PG8_BAR
#undef PG8_SCHED
}
}

struct EpiB16 {
    static constexpr bool PERM = true, AFTER_DRAIN = false;
    bf16_t* O; int ldc;
    __device__ __forceinline__ void operator()(const f32x4 (&acc)[2][2][4][2], const pg8::Unit& u, int wr, int wc, int fr, int fq) const {
        const int row0 = u.pm * 256 + wr * 64 + fr, col0 = u.pn * 256 + wc * 32 + 8 * fq;
#pragma unroll
        for (int ai = 0; ai < 2; ++ai)
#pragma unroll
            for (int m = 0; m < 4; ++m) { bf16_t* rowp = O + (size_t)(row0 + ai * 128 + m * 16) * ldc + col0;
#pragma unroll
                for (int bj = 0; bj < 2; ++bj) { const f32x4 v0 = acc[ai][bj][m][0], v1 = acc[ai][bj][m][1];
                    u32x4 w; w.x = cvtpk(v0[0], v0[1]); w.y = cvtpk(v0[2], v0[3]); w.z = cvtpk(v1[0], v1[1]); w.w = cvtpk(v1[2], v1[3]);
                    *(u32x4*)(rowp + bj * 128) = w; } }
    }
};
struct EpiSwiglu {
    static constexpr bool PERM = true, AFTER_DRAIN = false;
    bf16_t* O; int ldc;
    __device__ __forceinline__ void operator()(const f32x4 (&acc)[2][2][4][2], const pg8::Unit& u, int wr, int wc, int fr, int fq) const {
        const int row0 = u.pm * 256 + wr * 64 + fr, col0 = u.pn * 128 + wc * 32 + 8 * fq;
#pragma unroll
        for (int ai = 0; ai < 2; ++ai)
#pragma unroll
            for (int m = 0; m < 4; ++m) { bf16_t* rowp = O + (size_t)(row0 + ai * 128 + m * 16) * ldc + col0;
                const f32x4 g0 = acc[ai][0][m][0], g1 = acc[ai][0][m][1], u0 = acc[ai][1][m][0], u1 = acc[ai][1][m][1];
                u32x4 w; w.x = cvtpk(siluf_(g0[0]) * u0[0], siluf_(g0[1]) * u0[1]); w.y = cvtpk(siluf_(g0[2]) * u0[2], siluf_(g0[3]) * u0[3]);
                w.z = cvtpk(siluf_(g1[0]) * u1[0], siluf_(g1[1]) * u1[1]); w.w = cvtpk(siluf_(g1[2]) * u1[2], siluf_(g1[3]) * u1[3]);
                *(u32x4*)rowp = w; }
    }
};
template <class Epi> __device__ __forceinline__ void gemm_fast(LAS unsigned char* lds, const bf16_t* A, const bf16_t* Bt, int M, int N, int K, const Epi& E) {
    pg8::Gemm g; g.A = A; g.Bt = Bt; g.M = M; g.N = N; g.K = K;
    pg8::StaticOrder so; so.init(M, N, (int)gridDim.x, obid());
    pg8::gemm_phase<Epi, pg8::StaticOrder>(lds, g, so, E);
    __syncthreads();
}

template <int DIR> __device__ __forceinline__ void lru_dir(const Params& p, int l, int n, int h, int lane, LAS bf16_t* XC, LAS float* STA, LAS float* STU) {
    const int c = lane & 15, q = lane >> 4, j = lane, t0 = n * 64;
    unsigned char* ws = p.ws;
    bf16_t* y = (bf16_t*)(ws + WS_H); bf16_t* PB = (bf16_t*)(ws + WS_PB);
    const bf16_t* LW = (const bf16_t*)(ws + WS_LRUW);
    float* Aprod = (float*)(ws + WS_AP); float* Hend = (float*)(ws + WS_HE);
    const float* lam = p.in[10] + (size_t)(l * 2 + DIR) * 512 + 64 * h; const float* b_a = p.in[7] + (size_t)(l * 2 + DIR) * 512 + 64 * h; const float* b_x = p.in[9] + (size_t)(l * 2 + DIR) * 512 + 64 * h;
    const bf16_t* LWa = LW + ((size_t)(DIR * 2 + 0) * 8 + h) * 4096 + c * 64 + 8 * q; const bf16_t* LWx = LW + ((size_t)(DIR * 2 + 1) * 8 + h) * 4096 + c * 64 + 8 * q;
    bf16x8 wa[4][2], wx[4][2]; f32x4 sp4[4], ba4[4], bx4[4];
#pragma unroll
    for (int nf = 0; nf < 4; ++nf) {
#pragma unroll
        for (int ks = 0; ks < 2; ++ks) { wa[nf][ks] = *(const bf16x8*)(LWa + nf * 1024 + 32 * ks); wx[nf][ks] = *(const bf16x8*)(LWx + nf * 1024 + 32 * ks); }
        const f32x4 lam4 = *(const f32x4*)(lam + 16 * nf + 4 * q); ba4[nf] = *(const f32x4*)(b_a + 16 * nf + 4 * q); bx4[nf] = *(const f32x4*)(b_x + 16 * nf + 4 * q);
#pragma unroll
        for (int r = 0; r < 4; ++r) { const float e = __expf(-lam4[r]); const float l1p = e < 0.05f ? e * (1.0f - e * (0.5f - e * (0.33333334f - e * 0.25f))) : __logf(1.0f + e); sp4[nf][r] = -8.0f * l1p; }
    }
    float hcar = 0.f, P = 1.f;
#pragma unroll 1
    for (int g = 0; g < 4; ++g) {
        const int mi = DIR == 0 ? g : 3 - g;
        bf16_t hfp[16];
        if (DIR == 1) {
#pragma unroll
            for (int s = 0; s < 16; ++s) hfp[s] = y[(size_t)(t0 + 16 * mi + s) * D + 64 * h + j];
        }
        bf16x8 xf[2];
#pragma unroll
        for (int ks = 0; ks < 2; ++ks) xf[ks] = *(const LAS bf16x8*)(XC + (16 * mi + c) * 520 + 64 * h + 32 * ks + 8 * q);
        f32x4 za[4], zx[4];
#pragma unroll
        for (int nf = 0; nf < 4; ++nf) { za[nf] = (f32x4){0.f, 0.f, 0.f, 0.f}; zx[nf] = za[nf];
            za[nf] = mfma16(wa[nf][0], xf[0], za[nf]); za[nf] = mfma16(wa[nf][1], xf[1], za[nf]);
            zx[nf] = mfma16(wx[nf][0], xf[0], zx[nf]); zx[nf] = mfma16(wx[nf][1], xf[1], zx[nf]); }
#pragma unroll
        for (int nf = 0; nf < 4; ++nf) {
            const int jo = 16 * nf + 4 * q;
            const bf16x4 xc4 = *(const LAS bf16x4*)(XC + (16 * mi + c) * 520 + 64 * h + jo);
            const f32x4 zav = za[nf] + ba4[nf], zxv = zx[nf] + bx4[nf];
            f32x4 av, uv;
#pragma unroll
            for (int r = 0; r < 4; ++r) {
                const float ra = sigmoidf_(zav[r]), ix = sigmoidf_(zxv[r]);
                const float la = ra * sp4[nf][r];
                av[r] = __expf(la);
                const float x2 = 2.0f * la;
                const float om = -x2 * (1.0f + x2 * (0.5f + x2 * (0.16666667f + x2 * (0.041666668f + x2 * (0.0083333338f + x2 * (0.0013888889f + x2 * 0.0001984127f))))));
                uv[r] = bf2f((bf16_t)xc4[r]) * ix * __builtin_amdgcn_sqrtf(fmaxf(om, 0.f));
            }
            *(LAS f32x4*)(STA + c * 68 + jo) = av; *(LAS f32x4*)(STU + c * 68 + jo) = uv;
        }
        LDS_FENCE();
        float aa[16], uu[16];
#pragma unroll
        for (int s = 0; s < 16; ++s) { aa[s] = STA[s * 68 + j]; uu[s] = STU[s * 68 + j]; }
        LDS_FENCE();
#pragma unroll
        for (int s = 0; s < 16; ++s) {
            const int tl = DIR == 0 ? s : 15 - s;
            hcar = aa[tl] * hcar + uu[tl]; P *= aa[tl];
            const size_t row = (size_t)(t0 + 16 * mi + tl);
            if (DIR == 0) { const unsigned w = cvtpk(hcar, P); y[row * D + 64 * h + j] = (bf16_t)(w & 0xffffu); y[row * D + 512 + 64 * h + j] = (bf16_t)(w >> 16); }
            else { const unsigned w = cvtpk(bf2f(hfp[tl]) + hcar, P); y[row * D + 64 * h + j] = (bf16_t)(w & 0xffffu); PB[row * 512 + 64 * h + j] = (bf16_t)(w >> 16); }
        }
    }
    Aprod[(size_t)(DIR * NCH + n) * 512 + 64 * h + j] = P; Hend[(size_t)(DIR * NCH + n) * 512 + 64 * h + j] = hcar;
}

template <int MODE> __device__ void mixer_lru(const Params& p, int l, int n, LAS unsigned char* lds) {
    const int tid = otid(), lane = tid & 63, wave = tid >> 6;
    unsigned char* ws = p.ws;
    const bf16_t* proj = (const bf16_t*)(ws + WS_PROJ); bf16_t* y = (bf16_t*)(ws + WS_H);
    LAS bf16_t* XC = (LAS bf16_t*)lds;
    const int t0 = n * 64;
    if (MODE == 0) {
        LAS float* STA = (LAS float*)(lds + 66560 + wave * 8704);
        LAS float* STU = STA + 16 * 68;
        {
            const int ch = tid;
            const float cw0 = p.in[4][(size_t)(l * 4 + 0) * 512 + ch], cw1 = p.in[4][(size_t)(l * 4 + 1) * 512 + ch], cw2 = p.in[4][(size_t)(l * 4 + 2) * 512 + ch], cw3 = p.in[4][(size_t)(l * 4 + 3) * 512 + ch];
            const float cb = p.in[5][(size_t)l * 512 + ch];
            bf16_t xs[67];
#pragma unroll
            for (int i = 0; i < 67; ++i) { const int s_ = t0 - 2 + i; const int sc = s_ < 0 ? 0 : (s_ >= S ? S - 1 : s_); const bf16_t v = proj[(size_t)sc * DINP + ch]; xs[i] = s_ == sc ? v : (bf16_t)0; }
#pragma unroll
            for (int t = 0; t < 64; ++t) { const float xc = cb + cw0 * bf2f(xs[t]) + cw1 * bf2f(xs[t + 1]) + cw2 * bf2f(xs[t + 2]) + cw3 * bf2f(xs[t + 3]); XC[t * 520 + ch] = f2bf(xc); }
        }
        __syncthreads();
        lru_dir<0>(p, l, n, wave, lane, XC, STA, STU);
        lru_dir<1>(p, l, n, wave, lane, XC, STA, STU);
        __syncthreads();
    } else {
        const bf16_t* PB = (const bf16_t*)(ws + WS_PB); const float* carry = (const float*)(ws + WS_CA);
        const int ch0 = 8 * lane;
        const float* cfp = carry + (size_t)(0 * NCH + n) * 512 + ch0; const float* cbp = carry + (size_t)(1 * NCH + n) * 512 + ch0; const float* gnp = p.in[11] + (size_t)l * 512 + ch0;
        const f32x4 cf0 = *(const f32x4*)cfp, cf1 = *(const f32x4*)(cfp + 4), cb0 = *(const f32x4*)cbp, cb1 = *(const f32x4*)(cbp + 4), g0 = *(const f32x4*)gnp, g1 = *(const f32x4*)(gnp + 4);
        const float cf[8] = {cf0[0], cf0[1], cf0[2], cf0[3], cf1[0], cf1[1], cf1[2], cf1[3]}, cb[8] = {cb0[0], cb0[1], cb0[2], cb0[3], cb1[0], cb1[1], cb1[2], cb1[3]};
        const float gg[8] = {g0[0], g0[1], g0[2], g0[3], g1[0], g1[1], g1[2], g1[3]};
        {
            bf16x8 h0[8], pf[8], pb[8], gt[8];
#pragma unroll
            for (int i = 0; i < 8; ++i) { const size_t row = (size_t)(t0 + wave * 8 + i);
                h0[i] = *(const bf16x8*)(y + row * D + ch0); pf[i] = *(const bf16x8*)(y + row * D + 512 + ch0); pb[i] = *(const bf16x8*)(PB + row * 512 + ch0); gt[i] = *(const bf16x8*)(proj + row * DINP + 512 + ch0); }
#pragma unroll
            for (int i = 0; i < 8; ++i) { const size_t row = (size_t)(t0 + wave * 8 + i);
                float v[8]; float ss = 0.f;
#pragma unroll
                for (int k = 0; k < 8; ++k) { v[k] = (bf2f((bf16_t)h0[i][k]) + bf2f((bf16_t)pf[i][k]) * cf[k] + bf2f((bf16_t)pb[i][k]) * cb[k]) * geluf_(bf2f((bf16_t)gt[i][k])); ss += v[k] * v[k]; }
#pragma unroll
                for (int o = 32; o >= 1; o >>= 1) ss += __shfl_xor(ss, o);
                const float rs = rsqrtf(ss * (1.0f / 512.0f) + EPS);
                *(u32x4*)(y + row * D + ch0) = (u32x4){cvtpk(v[0] * rs * gg[0], v[1] * rs * gg[1]), cvtpk(v[2] * rs * gg[2], v[3] * rs * gg[3]), cvtpk(v[4] * rs * gg[4], v[5] * rs * gg[5]), cvtpk(v[6] * rs * gg[6], v[7] * rs * gg[7])}; }
        }
        __syncthreads();
    }
}

__device__ __forceinline__ bf16x8 pack8(const f32x4 a, const f32x4 b) {
    const u32x4 w = (u32x4){cvtpk(a[0], a[1]), cvtpk(a[2], a[3]), cvtpk(b[0], b[1]), cvtpk(b[2], b[3])}; return __builtin_bit_cast(bf16x8, w); }
#define SIGC(ef, c) (32 * ((ef) >> 1) + 8 * ((c) >> 2) + 4 * ((ef) & 1) + ((c) & 3))
#define SLOT(ks, q, jj) (32 * (ks) + 16 * ((jj) >> 2) + 4 * (q) + ((jj) & 3))

template <int MODE> __device__ void mixer_gla(const Params& p, int l, int n, LAS unsigned char* lds) {
    const int tid = otid(), lane = tid & 63, wave = tid >> 6, c = lane & 15, q = lane >> 4;
    const int h = wave >> 1, vh = wave & 1;
    unsigned char* ws = p.ws;
    const bf16_t* proj = (const bf16_t*)(ws + WS_PROJ); bf16_t* y = (bf16_t*)(ws + WS_H); const bf16_t* GW = (const bf16_t*)(ws + WS_GW);
    bf16_t* uT = (bf16_t*)(ws + WS_M); const bf16_t* spT = (const bf16_t*)(ws + WS_M + (size_t)S * D * 2); float* dec = (float*)(ws + WS_DEC);
    LAS bf16_t* VTw = (LAS bf16_t*)(lds + 66560 + wave * 9216);
    LAS float* SSQ = (LAS float*)(lds + 66560 + 8 * 9216);
    const int t0 = n * 64;
    const f32x4 zero4 = (f32x4){0.f, 0.f, 0.f, 0.f};
    {
        bf16x8 vn[4][2], identv[2];
#pragma unroll
        for (int tt = 0; tt < 4; ++tt)
#pragma unroll
            for (int kv = 0; kv < 2; ++kv) vn[tt][kv] = *(const bf16x8*)(proj + (size_t)(t0 + 16 * tt + c) * DINP + 1536 + 128 * h + 64 * vh + 32 * kv + 8 * q);
#pragma unroll
        for (int e1 = 0; e1 < 2; ++e1)
#pragma unroll
            for (int jj = 0; jj < 8; ++jj) identv[e1][jj] = (8 * q + jj == 16 * e1 + c) ? (short)0x3F80 : (short)0;
#pragma unroll
        for (int vf = 0; vf < 4; ++vf)
#pragma unroll
            for (int tt = 0; tt < 4; ++tt) { const f32x4 d = mfma16(vn[tt][vf >> 1], identv[vf & 1], zero4);
                *(LAS u32x2*)(VTw + (16 * vf + c) * 72 + 16 * tt + 4 * q) = (u32x2){cvtpk(d[0], d[1]), cvtpk(d[2], d[3])}; }
    }
    LDS_FENCE();
    f32x4 acc[4][4];
#pragma unroll
    for (int a = 0; a < 4; ++a)
#pragma unroll
        for (int b = 0; b < 4; ++b) acc[a][b] = zero4;
#pragma unroll 1
    for (int dir = 0; dir < 2; ++dir) {
        bf16x8 laop[4][2]; float tot[4];
        {
            bf16x8 lrf[4], gwf[4]; float bgv[4];
#pragma unroll
            for (int tt = 0; tt < 4; ++tt) { lrf[tt] = (bf16x8){0, 0, 0, 0, 0, 0, 0, 0}; if (q < 2) lrf[tt] = *(const bf16x8*)(proj + (size_t)(t0 + 16 * tt + c) * DINP + 2560 + dir * 16 + 8 * q); }
#pragma unroll
            for (int ef = 0; ef < 4; ++ef) { gwf[ef] = *(const bf16x8*)(GW + (size_t)(dir * 256 + 64 * h + SIGC(ef, c)) * 32 + 8 * q); bgv[ef] = p.in[13][(size_t)(l * 2 + dir) * 256 + 64 * h + SIGC(ef, c)]; }
#pragma unroll
            for (int ef = 0; ef < 4; ++ef) { tot[ef] = 0.f;
#pragma unroll
                for (int ks = 0; ks < 2; ++ks) { f32x4 la2[2];
#pragma unroll
                    for (int t2 = 0; t2 < 2; ++t2) { const f32x4 z = mfma16(lrf[2 * ks + t2], gwf[ef], zero4);
#pragma unroll
                        for (int r = 0; r < 4; ++r) { const float zz = z[r] + bgv[ef]; const float la = (fminf(zz, 0.f) - __logf(1.0f + __expf(-fabsf(zz)))) * (1.0f / 16.0f); la2[t2][r] = la; tot[ef] += la; } }
                    laop[ef][ks] = pack8(la2[0], la2[1]); __builtin_amdgcn_sched_barrier(0); } }
        }
        if (MODE == 1) {
            bf16x8 QEop[4][2], KEop[4][2];
            bf16x8 qn[4][2], kn1[4][2];
#pragma unroll
            for (int tj = 0; tj < 4; ++tj)
#pragma unroll
                for (int ks = 0; ks < 2; ++ks) { const bf16_t* rp = proj + (size_t)(t0 + 16 * tj + c) * DINP + 64 * h + 32 * ks + 8 * q; qn[tj][ks] = *(const bf16x8*)(rp + 1024); kn1[tj][ks] = *(const bf16x8*)(rp + 1280); }
            __builtin_amdgcn_sched_barrier(0);
#pragma unroll
            for (int tj = 0; tj < 4; ++tj) {
                const int t = 16 * tj + c;
                bf16x8 mk[2];
#pragma unroll
                for (int ks = 0; ks < 2; ++ks)
#pragma unroll
                    for (int jj = 0; jj < 8; ++jj) { const int sidx = SLOT(ks, q, jj); const bool on = dir == 0 ? sidx <= t : sidx >= t; mk[ks][jj] = on ? (short)0x3F80 : (short)0; }
#pragma unroll
                for (int ks2 = 0; ks2 < 2; ++ks2) { f32x4 qe2[2], ke2[2];
#pragma unroll
                    for (int e2 = 0; e2 < 2; ++e2) { const int ef = 2 * ks2 + e2;
                        f32x4 b = mfma16(laop[ef][0], mk[0], zero4); b = mfma16(laop[ef][1], mk[1], b);
#pragma unroll
                        for (int r = 0; r < 4; ++r) { qe2[e2][r] = bf2f((bf16_t)qn[tj][ks2][4 * e2 + r]) * 0.125f * __expf(b[r]); ke2[e2][r] = bf2f((bf16_t)kn1[tj][ks2][4 * e2 + r]) * __expf(-b[r]); } }
                    QEop[tj][ks2] = pack8(qe2[0], qe2[1]); KEop[tj][ks2] = pack8(ke2[0], ke2[1]); }
                __builtin_amdgcn_sched_barrier(0);
            }
            const bf16_t* SP = spT + ((size_t)(dir * NCH + n) * 4 + h) * 8192 + (size_t)(64 * vh) * 64;
            bf16x8 spf[4][2];
#pragma unroll
            for (int vf = 0; vf < 4; ++vf)
#pragma unroll
                for (int ks = 0; ks < 2; ++ks) spf[vf][ks] = *(const bf16x8*)(SP + (16 * vf + c) * 64 + 32 * ks + 8 * q);
            __builtin_amdgcn_sched_barrier(0);
            bf16x8 Pop[4][2];
#pragma unroll
            for (int ti = 0; ti < 4; ++ti)
#pragma unroll
                for (int ksp = 0; ksp < 2; ++ksp) { f32x4 pm[2];
#pragma unroll
                    for (int j2 = 0; j2 < 2; ++j2) { const int tjj = 2 * ksp + j2;
                        f32x4 sc = mfma16(KEop[tjj][0], QEop[ti][0], zero4); sc = mfma16(KEop[tjj][1], QEop[ti][1], sc);
#pragma unroll
                        for (int r = 0; r < 4; ++r) { const int j = 16 * tjj + 4 * q + r, i = 16 * ti + c; const bool keep = dir == 0 ? j <= i : j >= i; pm[j2][r] = keep ? sc[r] : 0.f; } }
                    Pop[ti][ksp] = pack8(pm[0], pm[1]); __builtin_amdgcn_sched_barrier(0); }
#pragma unroll
            for (int vf = 0; vf < 4; ++vf)
#pragma unroll
                for (int ks = 0; ks < 2; ++ks) {
                    const u32x2 v0 = *(const LAS u32x2*)(VTw + (16 * vf + c) * 72 + 32 * ks + 4 * q), v1 = *(const LAS u32x2*)(VTw + (16 * vf + c) * 72 + 32 * ks + 16 + 4 * q);
                    const bf16x8 vtf = __builtin_bit_cast(bf16x8, (u32x4){v0.x, v0.y, v1.x, v1.y});
#pragma unroll
                    for (int ti = 0; ti < 4; ++ti) { acc[vf][ti] = mfma16(vtf, Pop[ti][ks], acc[vf][ti]); acc[vf][ti] = mfma16(spf[vf][ks], QEop[ti][ks], acc[vf][ti]); }
                    __builtin_amdgcn_sched_barrier(0);
                }
        } else {
#pragma unroll
            for (int ef = 0; ef < 4; ++ef) { float tt = tot[ef]; tt += __shfl_xor(tt, 16); tt += __shfl_xor(tt, 32);
                if (vh == 0 && q == 0) dec[((size_t)(dir * NCH + n) * 4 + h) * 64 + SIGC(ef, c)] = __expf(tt); }
            bf16x8 kn[4][2];
#pragma unroll
            for (int tj = 0; tj < 4; ++tj)
#pragma unroll
                for (int ks = 0; ks < 2; ++ks) kn[tj][ks] = *(const bf16x8*)(proj + (size_t)(t0 + 16 * tj + c) * DINP + 1280 + 64 * h + 32 * ks + 8 * q);
            bf16x8 ident[2];
#pragma unroll
            for (int e1 = 0; e1 < 2; ++e1)
#pragma unroll
                for (int jj = 0; jj < 8; ++jj) ident[e1][jj] = (8 * q + jj == 8 * (c >> 2) + 4 * e1 + (c & 3)) ? (short)0x3F80 : (short)0;
            bf16x8 kdop[4][2];
#pragma unroll
            for (int ks = 0; ks < 2; ++ks) {
                bf16x8 mk[2][2];
#pragma unroll
                for (int t2 = 0; t2 < 2; ++t2)
#pragma unroll
                    for (int k2 = 0; k2 < 2; ++k2)
#pragma unroll
                        for (int jj = 0; jj < 8; ++jj) { const int tp = 16 * (2 * ks + t2) + c, sidx = SLOT(k2, q, jj); const bool on = dir == 0 ? sidx > tp : sidx < tp; mk[t2][k2][jj] = on ? (short)0x3F80 : (short)0; }
#pragma unroll
                for (int ef = 0; ef < 4; ++ef) { f32x4 kd2[2];
#pragma unroll
                    for (int t2 = 0; t2 < 2; ++t2) { const int tj = 2 * ks + t2;
                        f32x4 E = mfma16(mk[t2][0], laop[ef][0], zero4); E = mfma16(mk[t2][1], laop[ef][1], E);
                        const f32x4 kR = mfma16(kn[tj][ef >> 1], ident[ef & 1], zero4);
#pragma unroll
                        for (int r = 0; r < 4; ++r) kd2[t2][r] = kR[r] * __expf(E[r]); }
                    kdop[ef][ks] = pack8(kd2[0], kd2[1]); __builtin_amdgcn_sched_barrier(0); }
            }
            bf16_t* U = uT + ((size_t)(dir * NCH + n) * 4 + h) * 8192 + (size_t)(64 * vh) * 64;
#pragma unroll
            for (int vf = 0; vf < 4; ++vf) { bf16x8 vtf[2];
#pragma unroll
                for (int ks = 0; ks < 2; ++ks) { const u32x2 v0 = *(const LAS u32x2*)(VTw + (16 * vf + c) * 72 + 32 * ks + 4 * q), v1 = *(const LAS u32x2*)(VTw + (16 * vf + c) * 72 + 32 * ks + 16 + 4 * q);
                    vtf[ks] = __builtin_bit_cast(bf16x8, (u32x4){v0.x, v0.y, v1.x, v1.y}); }
#pragma unroll
                for (int ef = 0; ef < 4; ++ef) { f32x4 u = mfma16(kdop[ef][0], vtf[0], zero4); u = mfma16(kdop[ef][1], vtf[1], u);
                    *(u32x2*)(U + (16 * vf + c) * 64 + 32 * (ef >> 1) + 8 * q + 4 * (ef & 1)) = (u32x2){cvtpk(u[0], u[1]), cvtpk(u[2], u[3])}; } }
        }
    }
    if (MODE == 1) {
        bf16x4 ggp[4][4];
#pragma unroll
        for (int ti = 0; ti < 4; ++ti)
#pragma unroll
            for (int vf = 0; vf < 4; ++vf) ggp[ti][vf] = *(const bf16x4*)(proj + (size_t)(t0 + 16 * ti + c) * DINP + 2048 + 128 * h + 64 * vh + 16 * vf + 4 * q);
#pragma unroll
        for (int ti = 0; ti < 4; ++ti) { float ss = 0.f;
#pragma unroll
            for (int vf = 0; vf < 4; ++vf) ss += acc[vf][ti][0] * acc[vf][ti][0] + acc[vf][ti][1] * acc[vf][ti][1] + acc[vf][ti][2] * acc[vf][ti][2] + acc[vf][ti][3] * acc[vf][ti][3];
            ss += __shfl_xor(ss, 16); ss += __shfl_xor(ss, 32);
            if (q == 0) SSQ[(h * 64 + 16 * ti + c) * 2 + vh] = ss; }
        __syncthreads();
        const float* gn = p.in[14] + (size_t)l * 128;
#pragma unroll
        for (int ti = 0; ti < 4; ++ti) { const int t = 16 * ti + c; const float rs = rsqrtf((SSQ[(h * 64 + t) * 2] + SSQ[(h * 64 + t) * 2 + 1]) * (1.0f / 128.0f) + EPS);
#pragma unroll
            for (int vf = 0; vf < 4; ++vf) { const int v = 64 * vh + 16 * vf + 4 * q; const f32x4 g4 = *(const f32x4*)(gn + v);
                float o[4];
#pragma unroll
                for (int r = 0; r < 4; ++r) o[r] = acc[vf][ti][r] * rs * g4[r] * siluf_(bf2f((bf16_t)ggp[ti][vf][r]));
                *(u32x2*)(y + (size_t)(t0 + t) * D + 512 + 128 * h + v) = (u32x2){cvtpk(o[0], o[1]), cvtpk(o[2], o[3])}; } }
    }
    __syncthreads();
}

__device__ void phase_scan(const Params& p) {
    unsigned char* ws = p.ws; const int tid = otid();
    if (tid < 256) {
        const bf16_t* __restrict__ uT = (const bf16_t*)(ws + WS_M); bf16_t* __restrict__ spT = (bf16_t*)(ws + WS_M + (size_t)S * D * 2); const float* __restrict__ dec = (const float*)(ws + WS_DEC);
        for (int gid = obid() * 256 + tid; gid < 65536; gid += gridDim.x * 256) {
            const int dir = gid >> 15, rem = gid & 32767, h = rem >> 13, vd = rem & 8191, d = vd & 63;
            float s = 0.f;
            const long step = dir ? -1 : 1; const int nfirst = dir ? NCH - 1 : 0;
            const bf16_t* up = uT + ((size_t)(dir * NCH + nfirst) * 4 + h) * 8192 + vd; bf16_t* sp = spT + ((size_t)(dir * NCH + nfirst) * 4 + h) * 8192 + vd;
            const float* dp = dec + ((size_t)(dir * NCH + nfirst) * 4 + h) * 64 + d;
#pragma unroll 1
            for (int st = 0; st < NCH; st += 64) {
                bf16_t ub[64]; float db[64];
#pragma unroll
                for (int i = 0; i < 64; ++i) { ub[i] = up[(long)(st + i) * step * 32768]; db[i] = dp[(long)(st + i) * step * 256]; }
#pragma unroll
                for (int i = 0; i < 64; ++i) { sp[(long)(st + i) * step * 32768] = f2bf(s); s = db[i] * s + bf2f(ub[i]); }
            }
        }
    } else if (tid < 384 && obid() < 8) {
        const float* __restrict__ Aprod = (const float*)(ws + WS_AP); const float* __restrict__ Hend = (const float*)(ws + WS_HE); float* __restrict__ carry = (float*)(ws + WS_CA);
        const int gid = obid() * 128 + (tid - 256); const int dir = gid >> 9, ch = gid & 511;
        float hc = 0.f;
        const long step = dir ? -1 : 1; const size_t base = (size_t)(dir * NCH + (dir ? NCH - 1 : 0)) * 512 + ch;
#pragma unroll 1
        for (int st = 0; st < NCH; st += 64) {
            float ab[64], hb[64];
#pragma unroll
            for (int i = 0; i < 64; ++i) { ab[i] = Aprod[base + (long)(st + i) * step * 512]; hb[i] = Hend[base + (long)(st + i) * step * 512]; }
#pragma unroll
            for (int i = 0; i < 64; ++i) { carry[base + (long)(st + i) * step * 512] = hc; hc = ab[i] * hc + hb[i]; }
        }
    }
}

#define XB_TMO      128
#define XB_XCNT(j)  (256  + 64 * (j))
#define XB_XSUB(j)  (1280 + 64 * (j))
#define XB_XGEN(j)  (2304 + 64 * (j))
#define XB_TOP      3328
#define XB_TOPGEN   3392
#define XCD_BAR_WORDS 3456
#define XB_SPIN_CAP (1u << 18)

__device__ __forceinline__ unsigned xb_ld(unsigned* p)              { return __hip_atomic_load(p, __ATOMIC_RELAXED, __HIP_MEMORY_SCOPE_AGENT); }
__device__ __forceinline__ unsigned xb_add(unsigned* p, unsigned v) { return __hip_atomic_fetch_add(p, v, __ATOMIC_RELAXED, __HIP_MEMORY_SCOPE_AGENT); }
__device__ __forceinline__ unsigned xb_xcc_id() { return (unsigned)__builtin_amdgcn_s_getreg((3 << 11) | 20) & 0xFu; }
#define XB_SPIN(cond, bar) do { unsigned _sp = 0; while (cond) { __builtin_amdgcn_s_sleep(1); \
    if ((++_sp & 255u) == 0u) { if (xb_ld(&(bar)[XB_TMO])) break; if (_sp > XB_SPIN_CAP) { atomicAdd(&(bar)[XB_TMO], 1u); break; } } } } while (0)

struct XcdBarrier {
    unsigned* bar; unsigned x;
    volatile LAS unsigned* st;
};

__device__ __forceinline__ XcdBarrier xcd_barrier_post(unsigned* bar, volatile LAS unsigned* st) {
    XcdBarrier b; b.bar = bar; b.x = xb_xcc_id(); b.st = st;
    if (threadIdx.x == 0) (void)xb_add(&bar[XB_XCNT(b.x)], 1u);
    return b;
}
__device__ __forceinline__ void xcd_barrier_complete(unsigned* bar, unsigned x, unsigned& nloc, unsigned& nx) {
    const unsigned G = gridDim.x * gridDim.y * gridDim.z;
    unsigned sum, cnt, mine, sp = 0u;
    for (;;) {
        sum = 0u; cnt = 0u; mine = 0u;
#pragma unroll
        for (unsigned j = 0; j < 16; ++j) { const unsigned c = xb_ld(&bar[XB_XCNT(j)]); sum += c; cnt += (c > 0u) ? 1u : 0u; mine = (j == x) ? c : mine; }
        if (sum == G) break;
        __builtin_amdgcn_s_sleep(1);
        if ((++sp & 255u) == 0u) { if (xb_ld(&bar[XB_TMO])) break; if (sp > XB_SPIN_CAP) { atomicAdd(&bar[XB_TMO], 1u); break; } }
    }
    nloc = mine > 0u ? mine : 1u; nx = cnt > 0u ? cnt : 1u;
}

__device__ __forceinline__ void xcd_barrier(const XcdBarrier& b) {
    asm volatile("s_waitcnt vmcnt(0)" ::: "memory");
    __syncthreads();
    if (threadIdx.x == 0) {
        unsigned* bar = b.bar;
        __builtin_amdgcn_s_waitcnt(0);
        unsigned nloc = b.st[0], nx = b.st[1];
        if (nloc == 0u) { xcd_barrier_complete(bar, b.x, nloc, nx); b.st[0] = nloc; b.st[1] = nx; }
        const unsigned old = xb_add(&bar[XB_XSUB(b.x)], 1u);
        const unsigned gen = old / nloc;
        if (old + 1u == (gen + 1u) * nloc) {
            __builtin_amdgcn_fence(__ATOMIC_RELEASE, "agent");
            asm volatile("s_waitcnt vmcnt(0)" ::: "memory");
            const unsigned og = xb_add(&bar[XB_TOP], 1u);
            const unsigned tg = og / nx;
            if (og + 1u == (tg + 1u) * nx) xb_add(&bar[XB_TOPGEN], 1u);
            else XB_SPIN(xb_ld(&bar[XB_TOPGEN]) == tg, bar);
            __builtin_amdgcn_fence(__ATOMIC_ACQUIRE, "agent");
            xb_add(&bar[XB_XGEN(b.x)], 1u);
            asm volatile("s_waitcnt vmcnt(0)" ::: "memory");
        } else {
            XB_SPIN(xb_ld(&bar[XB_XGEN(b.x)]) == gen, bar);
            __builtin_amdgcn_fence(__ATOMIC_ACQUIRE, "agent");
            asm volatile("s_waitcnt vmcnt(0)" ::: "memory");
        }
    }
    __syncthreads();
}

__global__ void __launch_bounds__(NTHR, 2) mk_fwd(Params p) {
    extern __shared__ __attribute__((aligned(16))) unsigned char lds_raw[];
    LAS unsigned char* lds = (LAS unsigned char*)lds_raw;
    unsigned char* ws = p.ws;
    bf16_t* WinT = (bf16_t*)(ws + WS_WIN); bf16_t* WoutT = (bf16_t*)(ws + WS_WOUT); bf16_t* WguT = (bf16_t*)(ws + WS_WGU); bf16_t* WdT = (bf16_t*)(ws + WS_WD);
    bf16_t* Hb = (bf16_t*)(ws + WS_H); bf16_t* PROJ = (bf16_t*)(ws + WS_PROJ); float* Mb = (float*)(ws + WS_M);
    const float* xin = p.in[0]; float* out = p.out;
    volatile LAS unsigned* bst = (volatile LAS unsigned*)(lds + LDS_BYTES - 16);
    if (threadIdx.x == 0) { bst[0] = 0u; bst[1] = 0u; }
    __syncthreads();
    XcdBarrier bar = xcd_barrier_post((unsigned*)(ws + WS_CTL), bst);
    for (int ph = p.ph_lo; ph < p.ph_hi; ++ph) {
        if (ph == p.ph_lo + 1) cg::this_grid().sync();
        else if (ph > p.ph_lo) xcd_barrier(bar);
        if (ph == 9 * NL) { phase_rowprep(out, (const bf16_t*)Mb, p.in[17] + (size_t)(NL - 1) * D, out, nullptr, nullptr); continue; }
        const int l = ph / 9, s = ph % 9;
        switch (s) {
        case 0: phase_weights(p, l, lds);
                if (l == 0) phase_rowprep(xin, nullptr, nullptr, nullptr, p.in[1], Hb);
                else phase_rowprep(out, (const bf16_t*)Mb, p.in[17] + (size_t)(l - 1) * D, out, p.in[1] + (size_t)l * D, Hb);
                break;
        case 1: gemm_fast(lds, Hb, WinT, S, DINP, D, EpiB16{PROJ, DINP}); break;
        case 2: for (int n = obid(); n < NCH; n += gridDim.x) mixer_lru<0>(p, l, n, lds);
                for (int n = obid(); n < NCH; n += gridDim.x) mixer_gla<0>(p, l, n, lds); break;
        case 3: phase_scan(p); break;
        case 4: for (int n = obid(); n < NCH; n += gridDim.x) mixer_lru<1>(p, l, n, lds);
                for (int n = obid(); n < NCH; n += gridDim.x) mixer_gla<1>(p, l, n, lds); break;
        case 5: gemm_fast(lds, Hb, WoutT, S, D, D, EpiB16{(bf16_t*)Mb, D}); break;
        case 6: phase_rowprep(l == 0 ? xin : out, (const bf16_t*)Mb, p.in[2] + (size_t)l * D, out, p.in[16] + (size_t)l * D, Hb); break;
        case 7: gemm_fast(lds, Hb, WguT, S, 2 * DFF, D, EpiSwiglu{PROJ, DFF}); break;
        case 8: gemm_fast(lds, PROJ, WdT, S, D, DFF, EpiB16{(bf16_t*)Mb, D}); break;
        }
    }
}

extern "C" void kernel_launch(void* const* d_in, const int* in_sizes, int n_in, void* d_out, int out_size, void* d_ws, size_t ws_size, hipStream_t stream) {
    static int grid = 0;
    if (grid == 0) {
        if (n_in != 21 || out_size != S * D || ws_size < WS_END) { fprintf(stderr, "kernel_launch: unexpected shapes: n_in %d out %d ws %zu (need %zu)\n", n_in, out_size, ws_size, (size_t)WS_END); grid = -1; return; }
        int dev = 0, cus = 0, per_cu = 0;
        (void)hipGetDevice(&dev); (void)hipDeviceGetAttribute(&cus, hipDeviceAttributeMultiprocessorCount, dev);
        if (hipFuncSetAttribute((const void*)mk_fwd, hipFuncAttributeMaxDynamicSharedMemorySize, LDS_BYTES) != hipSuccess) { fprintf(stderr, "kernel_launch: hipFuncSetAttribute failed\n"); grid = -1; return; }
        if (hipOccupancyMaxActiveBlocksPerMultiprocessor(&per_cu, (const void*)mk_fwd, NTHR, LDS_BYTES) != hipSuccess || per_cu < 1) { fprintf(stderr, "kernel_launch: occupancy query says %d\n", per_cu); per_cu = 1; }
        (void)hipGetLastError();
        grid = cus;
    }
    if (grid < 0) return;
    Params p{};
    for (int i = 0; i < 21; ++i) p.in[i] = (const float*)d_in[i];
    p.out = (float*)d_out; p.ws = (unsigned char*)d_ws;
    (void)hipMemsetAsync((unsigned char*)d_ws + WS_CTL, 0, 16384, stream);
#if ONE_LAUNCH
    p.ph_lo = 0; p.ph_hi = 9 * NL + 1;
    void* args[] = {&p};
    hipError_t e = hipLaunchCooperativeKernel((const void*)mk_fwd, dim3(grid), dim3(NTHR), args, LDS_BYTES, stream);
    if (e != hipSuccess) fprintf(stderr, "cooperative launch failed: %s (grid %d)\n", hipGetErrorString(e), grid);
#else
    for (int ph = 0; ph < 9 * NL + 1; ++ph) { p.ph_lo = ph; p.ph_hi = ph + 1; hipLaunchKernelGGL(mk_fwd, dim3(grid), dim3(NTHR), LDS_BYTES, stream, p); }
#endif
}
```

```cpp
#include <hip/hip_runtime.h>
#include <hip/hip_cooperative_groups.h>
#include <cstdio>
namespace cg = cooperative_groups;

#ifndef ONE_LAUNCH
#define ONE_LAUNCH 1
#endif

#define LAS __attribute__((address_space(3)))
typedef unsigned short bf16_t;
typedef short bf16x8 __attribute__((ext_vector_type(8)));
typedef short bf16x4 __attribute__((ext_vector_type(4)));
typedef float f32x4 __attribute__((ext_vector_type(4)));
typedef unsigned u32x4 __attribute__((ext_vector_type(4)));
typedef unsigned u32x2 __attribute__((ext_vector_type(2)));
typedef float f32x2 __attribute__((ext_vector_type(2)));
typedef __bf16 bf16v2 __attribute__((ext_vector_type(2)));

constexpr int S = 16384, D = 1024, DIN = 2592, DINP = 2816, DFF = 2816, NL = 4, NCH = 256;
constexpr int NTHR = 512;
constexpr int LDS_BYTES = 147456;
constexpr float EPS = 1e-6f;

constexpr size_t WS_CTL = 0;
constexpr size_t WS_WIN = 65536;
constexpr size_t WS_WOUT = WS_WIN + (size_t)DINP * D * 2;
constexpr size_t WS_WGU = WS_WOUT + (size_t)D * D * 2;
constexpr size_t WS_WD = WS_WGU + (size_t)2 * DFF * D * 2;
constexpr size_t WS_LRUW = WS_WD + (size_t)D * DFF * 2;
constexpr size_t WS_GW = WS_LRUW + (size_t)2 * 2 * 8 * 64 * 64 * 2;
constexpr size_t WS_H = WS_GW + (size_t)2 * 256 * 32 * 2;
constexpr size_t WS_PROJ = WS_H + (size_t)S * D * 2;
constexpr size_t WS_M = WS_PROJ + (size_t)S * DINP * 2;
constexpr size_t WS_AP = WS_M + (size_t)S * D * 4;
constexpr size_t WS_HE = WS_AP + (size_t)2 * NCH * 512 * 4;
constexpr size_t WS_CA = WS_HE + (size_t)2 * NCH * 512 * 4;
constexpr size_t WS_DEC = WS_CA + (size_t)2 * NCH * 512 * 4;
constexpr size_t WS_PB = WS_DEC + (size_t)2 * NCH * 4 * 64 * 4;
constexpr size_t WS_END = WS_PB + (size_t)S * 512 * 2;

struct Params { const float* in[21]; float* out; unsigned char* ws; int ph_lo, ph_hi; };

__device__ __forceinline__ float bf2f(bf16_t b) { return __uint_as_float(((unsigned)b) << 16); }
__device__ __forceinline__ bf16_t f2bf(float f) { unsigned u = __float_as_uint(f); return (bf16_t)((u + 0x7fffu + ((u >> 16) & 1u)) >> 16); }
__device__ __forceinline__ unsigned pk2(float lo, float hi) { return (unsigned)f2bf(lo) | ((unsigned)f2bf(hi) << 16); }
__device__ __forceinline__ unsigned cvtpk(float lo, float hi) { const f32x2 v = (f32x2){lo, hi}; const bf16v2 b = __builtin_convertvector(v, bf16v2); return __builtin_bit_cast(unsigned, b); }
__device__ __forceinline__ float sigmoidf_(float x) { return __builtin_amdgcn_rcpf(1.0f + __expf(-x)); }
__device__ __forceinline__ float siluf_(float x) { return x * sigmoidf_(x); }
__device__ __forceinline__ float geluf_(float x) { const float y = 0.7978845608028654f * (x + 0.044715f * x * x * x); const float t = 1.0f - 2.0f * __builtin_amdgcn_rcpf(__expf(2.0f * y) + 1.0f); return 0.5f * x * (1.0f + t); }
__device__ __forceinline__ f32x4 mfma16(bf16x8 a, bf16x8 b, f32x4 c) { return __builtin_amdgcn_mfma_f32_16x16x32_bf16(a, b, c, 0, 0, 0); }
__device__ __forceinline__ int otid() { int t = threadIdx.x; asm volatile("" : "+v"(t)); return t; }
__device__ __forceinline__ int obid() { int t = blockIdx.x; asm volatile("" : "+s"(t)); return t; }
#define LDS_FENCE() asm volatile("s_waitcnt lgkmcnt(0)" ::: "memory")

struct WDesc { const float* src; bf16_t* dst; int ldsrc, c0, nvalid, k0, lddst, r0; };
__device__ __forceinline__ WDesc wdesc(const Params& p, int l, int u) {
    unsigned char* ws = p.ws;
    constexpr int T_IN = 44 * 16, T_OUT = 16 * 16, T_GU = 88 * 16, T_D = 16 * 44;
    WDesc d; int v = u;
    if (v < T_IN) { const int rt = v / 16, kt = v % 16; int nv = DIN - rt * 64; nv = nv > 64 ? 64 : (nv < 0 ? 0 : nv);
        d.src = p.in[3] + (size_t)l * D * DIN; d.ldsrc = DIN; d.c0 = nv > 0 ? rt * 64 : 0; d.nvalid = nv; d.k0 = kt * 64; d.dst = (bf16_t*)(ws + WS_WIN); d.lddst = D; d.r0 = rt * 64; return d; }
    v -= T_IN;
    if (v < T_OUT) { const int rt = v / 16, kt = v % 16; d.src = p.in[15] + (size_t)l * D * D; d.ldsrc = D; d.c0 = rt * 64; d.nvalid = 64; d.k0 = kt * 64; d.dst = (bf16_t*)(ws + WS_WOUT); d.lddst = D; d.r0 = rt * 64; return d; }
    v -= T_OUT;
    if (v < T_GU) { const int rt = v / 16, kt = v % 16; const int r0 = rt * 64, j = r0 / 256, within = r0 % 256;
        d.src = (within < 128 ? p.in[18] : p.in[19]) + (size_t)l * D * DFF; d.ldsrc = DFF; d.c0 = j * 128 + (within & 127); d.nvalid = 64; d.k0 = kt * 64; d.dst = (bf16_t*)(ws + WS_WGU); d.lddst = D; d.r0 = r0; return d; }
    v -= T_GU;
    if (v < T_D) { const int rt = v / 44, kt = v % 44; d.src = p.in[20] + (size_t)l * DFF * D; d.ldsrc = D; d.c0 = rt * 64; d.nvalid = 64; d.k0 = kt * 64; d.dst = (bf16_t*)(ws + WS_WD); d.lddst = DFF; d.r0 = rt * 64; return d; }
    v -= T_D;
    { const int dir = v / 16, gate = (v / 8) % 2, h = v % 8; d.src = (gate ? p.in[8] : p.in[6]) + ((size_t)(l * 2 + dir) * 8 + h) * 4096; d.ldsrc = 64; d.c0 = 0; d.nvalid = 64; d.k0 = 0;
      d.dst = (bf16_t*)(ws + WS_LRUW) + ((size_t)(dir * 2 + gate) * 8 + h) * 4096; d.lddst = 64; d.r0 = 0; return d; }
}

__device__ void phase_weights(const Params& p, int l, LAS unsigned char* lds) {
    LAS float* T = (LAS float*)lds;
    unsigned char* ws = p.ws;
    constexpr int TOT = 44 * 16 + 16 * 16 + 88 * 16 + 16 * 44 + 32;
    const int tid = otid(), G = gridDim.x;
    for (int u0 = obid(); u0 < TOT; u0 += 4 * G) {
        f32x4 v[4][2];
        { const int k = tid >> 3, cg8 = (tid & 7) * 8;
#pragma unroll
          for (int j = 0; j < 4; ++j) { const int u = u0 + j * G; v[j][0] = (f32x4){0.f, 0.f, 0.f, 0.f}; v[j][1] = v[j][0];
              if (u < TOT) { const WDesc d = wdesc(p, l, u); const float* sp = d.src + (size_t)(d.k0 + k) * d.ldsrc + d.c0 + cg8;
                  if (cg8 + 3 < d.nvalid) v[j][0] = *(const f32x4*)sp; if (cg8 + 7 < d.nvalid) v[j][1] = *(const f32x4*)(sp + 4); } }
#pragma unroll
          for (int j = 0; j < 4; ++j)
#pragma unroll
              for (int i = 0; i < 2; ++i) { LAS float* Tj = T + j * 4160 + k * 65 + cg8 + 4 * i; Tj[0] = v[j][i][0]; Tj[1] = v[j][i][1]; Tj[2] = v[j][i][2]; Tj[3] = v[j][i][3]; } }
        __syncthreads();
        { const int r = tid >> 3, kg = (tid & 7) * 8;
#pragma unroll
          for (int j = 0; j < 4; ++j) { const int u = u0 + j * G;
              if (u < TOT) { const WDesc d = wdesc(p, l, u); const LAS float* Tj = T + j * 4160; u32x4 w;
                  w.x = cvtpk(Tj[(kg + 0) * 65 + r], Tj[(kg + 1) * 65 + r]); w.y = cvtpk(Tj[(kg + 2) * 65 + r], Tj[(kg + 3) * 65 + r]);
                  w.z = cvtpk(Tj[(kg + 4) * 65 + r], Tj[(kg + 5) * 65 + r]); w.w = cvtpk(Tj[(kg + 6) * 65 + r], Tj[(kg + 7) * 65 + r]);
                  *(u32x4*)(d.dst + (size_t)(d.r0 + r) * d.lddst + d.k0 + kg) = w; } } }
        __syncthreads();
    }
    { bf16_t* GW = (bf16_t*)(ws + WS_GW); const float* wg = p.in[12] + (size_t)l * 2 * 16 * 256;
      for (int idx = obid() * NTHR + otid(); idx < 2 * 256 * 32; idx += gridDim.x * NTHR) { const int dir = idx >> 13, e = (idx >> 5) & 255, r = idx & 31;
          GW[idx] = r < 16 ? f2bf(wg[(size_t)(dir * 16 + r) * 256 + e]) : (bf16_t)0; } }
}

__device__ void phase_rowprep(const float* xsrc, const bf16_t* __restrict__ m, const float* __restrict__ gpost, float* xdst, const float* __restrict__ gpre, bf16_t* __restrict__ hdst) {
    const int tid = otid(); const int lane = tid & 63, wave = tid >> 6;
    const int stride = gridDim.x * 8;
    f32x4 gp[4], gq[4];
#pragma unroll
    for (int i = 0; i < 4; ++i) { gp[i] = m ? *(const f32x4*)(gpost + i * 256 + lane * 4) : (f32x4){0.f, 0.f, 0.f, 0.f}; gq[i] = hdst ? *(const f32x4*)(gpre + i * 256 + lane * 4) : (f32x4){0.f, 0.f, 0.f, 0.f}; }
    int row = obid() * 8 + wave;
    f32x4 xn[4]; bf16x4 mn[4];
    if (row < S) {
#pragma unroll
        for (int i = 0; i < 4; ++i) { xn[i] = *(const f32x4*)(xsrc + (size_t)row * D + i * 256 + lane * 4); mn[i] = m ? *(const bf16x4*)(m + (size_t)row * D + i * 256 + lane * 4) : (bf16x4){0, 0, 0, 0}; }
    }
    while (row < S) {
        f32x4 xv[4]; bf16x4 mb[4];
#pragma unroll
        for (int i = 0; i < 4; ++i) { xv[i] = xn[i]; mb[i] = mn[i]; }
        const int nrow = row + stride;
        if (nrow < S) {
#pragma unroll
            for (int i = 0; i < 4; ++i) { xn[i] = *(const f32x4*)(xsrc + (size_t)nrow * D + i * 256 + lane * 4); mn[i] = m ? *(const bf16x4*)(m + (size_t)nrow * D + i * 256 + lane * 4) : (bf16x4){0, 0, 0, 0}; }
        }
        if (m) {
            f32x4 mv[4]; float ss = 0.f;
#pragma unroll
            for (int i = 0; i < 4; ++i) { mv[i] = (f32x4){bf2f((bf16_t)mb[i][0]), bf2f((bf16_t)mb[i][1]), bf2f((bf16_t)mb[i][2]), bf2f((bf16_t)mb[i][3])}; ss += mv[i][0] * mv[i][0] + mv[i][1] * mv[i][1] + mv[i][2] * mv[i][2] + mv[i][3] * mv[i][3]; }
#pragma unroll
            for (int o = 32; o >= 1; o >>= 1) ss += __shfl_xor(ss, o);
            const float rs = rsqrtf(ss * (1.0f / D) + EPS);
#pragma unroll
            for (int i = 0; i < 4; ++i) xv[i] += mv[i] * rs * gp[i];
        }
        if (xdst) {
#pragma unroll
            for (int i = 0; i < 4; ++i) *(f32x4*)(xdst + (size_t)row * D + i * 256 + lane * 4) = xv[i];
        }
        if (hdst) {
            float ss = 0.f;
#pragma unroll
            for (int i = 0; i < 4; ++i) ss += xv[i][0] * xv[i][0] + xv[i][1] * xv[i][1] + xv[i][2] * xv[i][2] + xv[i][3] * xv[i][3];
#pragma unroll
            for (int o = 32; o >= 1; o >>= 1) ss += __shfl_xor(ss, o);
            const float rs = rsqrtf(ss * (1.0f / D) + EPS);
#pragma unroll
            for (int i = 0; i < 4; ++i) { const f32x4 hv = xv[i] * rs * gq[i]; *(u32x2*)(hdst + (size_t)row * D + i * 256 + lane * 4) = (u32x2){cvtpk(hv[0], hv[1]), cvtpk(hv[2], hv[3])}; }
        }
        row = nrow;
    }
}

namespace pg8 {
#define PG8_LAS __attribute__((address_space(3)))
constexpr int BM = 256, BK = 64, HALF = 128, HTB = HALF * BK * 2  , STAGE_BYTES = 8 * HTB, NXCD = 8, WGM = 8;
__host__ __device__ __forceinline__ int lds_byte(int r, int c) { const int st = (r >> 4) * 2 + (c >> 5), rr = r & 15, cc = c & 31, ob = rr * 64 + cc * 2; return st * 1024 + (ob ^ (((ob >> 9) & 1) << 5)); }
__host__ __device__ __forceinline__ void stage_rc(int b, int& R, int& C) { const int st = b / 1024, sb = b % 1024, swz = sb ^ (((sb >> 9) & 1) << 5); R = (st >> 1) * 16 + swz / 64; C = (st & 1) * 32 + (swz % 64) / 2; }
__host__ __device__ __forceinline__ int perm32(int rho) { const int n = rho >> 4, i = rho & 15; return 8 * (i >> 2) + 4 * n + (i & 3); }
struct Unit { int pm, pn; };
struct Gemm { const bf16_t* A; const bf16_t* Bt; int M, N, K; };
struct StaticOrder {
    int nM, nN, nwg, G, c;
    __host__ __device__ void init(int M, int N, int G_, int c_) { nM = M / BM; nN = N / BM; nwg = nM * nN; G = G_; c = c_; }
    __host__ __device__ bool next(int i, Unit& u) const {
        const long L = (long)i * G + c; if (L >= nwg) return false;
        int wgid = (int)L; { const int q = nwg / NXCD, r = nwg % NXCD, xcd = wgid % NXCD, off = wgid / NXCD; wgid = (xcd < r ? xcd * (q + 1) : r * (q + 1) + (xcd - r) * q) + off; }
        const int nig = WGM * nN, gid = wgid / nig, fm = gid * WGM, gsz = (nM - fm) < WGM ? (nM - fm) : WGM;
        u.pm = fm + ((wgid % nig) % gsz); u.pn = (wgid % nig) / gsz; return true;
    }
    __device__ __forceinline__ void a_ready(const Unit&) const {}
    __device__ __forceinline__ void done(const Unit&) const {}
};
__device__ __forceinline__ unsigned cvt_pk_bf16(float lo, float hi) { unsigned r; asm volatile("v_cvt_pk_bf16_f32 %0, %1, %2" : "=v"(r) : "v"(lo), "v"(hi)); return r; }
template <class Epi, class Sched>
__device__ __forceinline__ void gemm_phase(PG8_LAS unsigned char* lds, const Gemm g, const Sched& S, const Epi& E) {
    const int tid = otid(), wid = __builtin_amdgcn_readfirstlane(tid >> 6), lane = tid & 63, wr = wid >> 2, wc = wid & 3, fr = lane & 15, fq = lane >> 4;
    const int K = g.K, nt = K / BK;
    unsigned voffA[2], voffB[2];
#pragma unroll
    for (int i = 0; i < 2; ++i) { int R, C; stage_rc(tid * 16 + i * 8192, R, C); const int Rb = Epi::PERM ? ((R & ~31) + perm32(R & 31)) : R;
        voffA[i] = (unsigned)(R * K + C) * 2u; voffB[i] = (unsigned)(Rb * K + C) * 2u; }
    const size_t kstep = (size_t)(BK * 2);
    const size_t hstep = (size_t)HALF * K * 2;
    const size_t tstep = 2 * hstep;
    const unsigned ldsw = (unsigned)wid * 1024u;
    const int aoff = lds_byte(wr * 64 + fr, fq * 8), boff = lds_byte(wc * 32 + fr, fq * 8);
#define PG8_SA(b, h) (((b) * 2 + (h)) * HTB)
#define PG8_SB(b, h) ((4 + (b) * 2 + (h)) * HTB)
#define PG8_STAGE(bufoff, gbase, voff) do { _Pragma("unroll") for (int _i = 0; _i < 2; ++_i) \
        __builtin_amdgcn_global_load_lds((const unsigned*)((const char*)(gbase) + (voff)[_i]), (PG8_LAS unsigned*)(lds + (bufoff) + ldsw + _i * 8192), 16, 0, 0); } while (0)
#define PG8_LDA(dst, b, h) do { _Pragma("unroll") for (int m = 0; m < 4; ++m) _Pragma("unroll") for (int k = 0; k < 2; ++k) dst[m][k] = *(const PG8_LAS bf16x8*)(lds + PG8_SA(b, h) + aoff + m * 2048 + k * 1024); } while (0)
#define PG8_LDB(dst, b, h) do { _Pragma("unroll") for (int n = 0; n < 2; ++n) _Pragma("unroll") for (int k = 0; k < 2; ++k) dst[n][k] = *(const PG8_LAS bf16x8*)(lds + PG8_SB(b, h) + boff + n * 2048 + k * 1024); } while (0)
#define PG8_MMA(ai, bj, At, Bt) do { __builtin_amdgcn_s_setprio(1); _Pragma("unroll") for (int m = 0; m < 4; ++m) _Pragma("unroll") for (int n = 0; n < 2; ++n) _Pragma("unroll") for (int k = 0; k < 2; ++k) \
        acc[ai][bj][m][n] = __builtin_amdgcn_mfma_f32_16x16x32_bf16(Bt[n][k], At[m][k], acc[ai][bj][m][n], 0, 0, 0); __builtin_amdgcn_s_setprio(0); } while (0)
#define PG8_WAIT_V(n) asm volatile("s_waitcnt vmcnt(" #n ")" ::: "memory")
#define PG8_WAIT_L(n) asm volatile("s_waitcnt lgkmcnt(" #n ")" ::: "memory")
#define PG8_BAR __builtin_amdgcn_s_barrier()
#define PG8_SCHED __builtin_amdgcn_sched_barrier(0)
    Unit cur, nxt; int ui = 0;
    if (!S.next(0, cur)) return;
    f32x4 acc[2][2][4][2];
#pragma unroll
    for (int a = 0; a < 2; ++a)
#pragma unroll
        for (int b = 0; b < 2; ++b)
#pragma unroll
            for (int m = 0; m < 4; ++m)
#pragma unroll
                for (int n = 0; n < 2; ++n) acc[a][b][m][n] = (f32x4){0.f, 0.f, 0.f, 0.f};
    bf16x8 At[4][2], B0[2][2], B1[2][2];
    const char* cA = (const char*)g.A + (size_t)cur.pm * tstep; const char* cB = (const char*)g.Bt + (size_t)cur.pn * tstep;
    S.a_ready(cur);
    PG8_STAGE(PG8_SB(0, 0), cB, voffB); PG8_STAGE(PG8_SA(0, 0), cA, voffA); PG8_STAGE(PG8_SB(0, 1), cB + hstep, voffB); PG8_STAGE(PG8_SA(0, 1), cA + hstep, voffA);
    if (wr == 1) PG8_BAR;
    PG8_WAIT_V(4); PG8_BAR;
    PG8_STAGE(PG8_SB(1, 0), cB + kstep, voffB); PG8_STAGE(PG8_SA(1, 0), cA + kstep, voffA); PG8_STAGE(PG8_SB(1, 1), cB + hstep + kstep, voffB);
    PG8_WAIT_V(6); PG8_BAR;
    for (;;) {
        const bool has_next = S.next(ui + 1, nxt);
        const char* nA = has_next ? (const char*)g.A + (size_t)nxt.pm * tstep : cA; const char* nB = has_next ? (const char*)g.Bt + (size_t)nxt.pn * tstep : cB;
        for (int t = 0; t < nt; t += 2) {
            const bool last = (t == nt - 2);
            const char* a1 = cA + (size_t)(t + 1) * kstep;
            const char* a2 = last ? nA : cA + (size_t)(t + 2) * kstep; const char* b2 = last ? nB : cB + (size_t)(t + 2) * kstep;
            const char* a3 = a2 + kstep; const char* b3 = b2 + kstep;
            if (last && has_next) S.a_ready(nxt);
            PG8_LDB(B0, 0, 0); PG8_SCHED; PG8_LDA(At, 0, 0); PG8_STAGE(PG8_SA(1, 1), a1 + hstep, voffA);
            PG8_WAIT_L(8); PG8_BAR; PG8_WAIT_L(0); PG8_MMA(0, 0, At, B0); PG8_BAR; PG8_SCHED;
            PG8_LDB(B1, 0, 1); PG8_STAGE(PG8_SB(0, 0), b2, voffB);
            PG8_BAR; PG8_WAIT_L(0); PG8_MMA(0, 1, At, B1); PG8_BAR;
            PG8_LDA(At, 0, 1); PG8_STAGE(PG8_SA(0, 0), a2, voffA);
            PG8_BAR; PG8_WAIT_L(0); PG8_MMA(1, 0, At, B0); PG8_BAR; PG8_SCHED;
            PG8_STAGE(PG8_SB(0, 1), b2 + hstep, voffB);
            PG8_WAIT_V(6); PG8_BAR; PG8_MMA(1, 1, At, B1); PG8_BAR;
            PG8_LDB(B0, 1, 0); PG8_SCHED; PG8_LDA(At, 1, 0); PG8_STAGE(PG8_SA(0, 1), a2 + hstep, voffA);
            PG8_WAIT_L(8); PG8_BAR; PG8_WAIT_L(0); PG8_MMA(0, 0, At, B0); PG8_BAR; PG8_SCHED;
            PG8_LDB(B1, 1, 1); PG8_STAGE(PG8_SB(1, 0), b3, voffB);
            PG8_BAR; PG8_WAIT_L(0); PG8_MMA(0, 1, At, B1); PG8_BAR;
            PG8_LDA(At, 1, 1); PG8_STAGE(PG8_SA(1, 0), a3, voffA);
            PG8_BAR; PG8_WAIT_L(0); PG8_MMA(1, 0, At, B0); PG8_BAR; PG8_SCHED;
            PG8_STAGE(PG8_SB(1, 1), b3 + hstep, voffB);
            PG8_WAIT_V(6); PG8_BAR; PG8_MMA(1, 1, At, B1); PG8_BAR;
        }
        if constexpr (!Epi::AFTER_DRAIN) { E(acc, cur, wr, wc, fr, fq); S.done(cur); }
        if (!has_next) break;
#pragma unroll
        for (int a = 0; a < 2; ++a)
#pragma unroll
            for (int b = 0; b < 2; ++b)
#pragma unroll
                for (int m = 0; m < 4; ++m)
#pragma unroll
                    for (int n = 0; n < 2; ++n) acc[a][b][m][n] = (f32x4){0.f, 0.f, 0.f, 0.f};
        cur = nxt; cA = nA; cB = nB; ++ui;
    }
    PG8_WAIT_V(0);
    if (wr == 0) PG8_BAR;
    PG8_BAR;
    if constexpr (Epi::AFTER_DRAIN) { E.fused(acc, cur, wr, wc, fr, fq, lds, wid, lane); S.done(cur); }
#undef PG8_SA
#undef PG8_SB
#undef PG8_STAGE
#undef PG8_LDA
#undef PG8_LDB
#undef PG8_MMA
#undef PG8_WAIT_V
#undef PG8_WAIT_L
#undef PG8_BAR
#undef PG8_SCHED
}
}

struct EpiB16 {
    static constexpr bool PERM = true, AFTER_DRAIN = false;
    bf16_t* O; int ldc;
    __device__ __forceinline__ void operator()(const f32x4 (&acc)[2][2][4][2], const pg8::Unit& u, int wr, int wc, int fr, int fq) const {
        const int row0 = u.pm * 256 + wr * 64 + fr, col0 = u.pn * 256 + wc * 32 + 8 * fq;
#pragma unroll
        for (int ai = 0; ai < 2; ++ai)
#pragma unroll
            for (int m = 0; m < 4; ++m) { bf16_t* rowp = O + (size_t)(row0 + ai * 128 + m * 16) * ldc + col0;
#pragma unroll
                for (int bj = 0; bj < 2; ++bj) { const f32x4 v0 = acc[ai][bj][m][0], v1 = acc[ai][bj][m][1];
                    u32x4 w; w.x = cvtpk(v0[0], v0[1]); w.y = cvtpk(v0[2], v0[3]); w.z = cvtpk(v1[0], v1[1]); w.w = cvtpk(v1[2], v1[3]);
                    *(u32x4*)(rowp + bj * 128) = w; } }
    }
};
struct EpiSwiglu {
    static constexpr bool PERM = true, AFTER_DRAIN = false;
    bf16_t* O; int ldc;
    __device__ __forceinline__ void operator()(const f32x4 (&acc)[2][2][4][2], const pg8::Unit& u, int wr, int wc, int fr, int fq) const {
        const int row0 = u.pm * 256 + wr * 64 + fr, col0 = u.pn * 128 + wc * 32 + 8 * fq;
#pragma unroll
        for (int ai = 0; ai < 2; ++ai)
#pragma unroll
            for (int m = 0; m < 4; ++m) { bf16_t* rowp = O + (size_t)(row0 + ai * 128 + m * 16) * ldc + col0;
                const f32x4 g0 = acc[ai][0][m][0], g1 = acc[ai][0][m][1], u0 = acc[ai][1][m][0], u1 = acc[ai][1][m][1];
                u32x4 w; w.x = cvtpk(siluf_(g0[0]) * u0[0], siluf_(g0[1]) * u0[1]); w.y = cvtpk(siluf_(g0[2]) * u0[2], siluf_(g0[3]) * u0[3]);
                w.z = cvtpk(siluf_(g1[0]) * u1[0], siluf_(g1[1]) * u1[1]); w.w = cvtpk(siluf_(g1[2]) * u1[2], siluf_(g1[3]) * u1[3]);
                *(u32x4*)rowp = w; }
    }
};
template <class Epi> __device__ __forceinline__ void gemm_fast(LAS unsigned char* lds, const bf16_t* A, const bf16_t* Bt, int M, int N, int K, const Epi& E) {
    pg8::Gemm g; g.A = A; g.Bt = Bt; g.M = M; g.N = N; g.K = K;
    pg8::StaticOrder so; so.init(M, N, (int)gridDim.x, obid());
    pg8::gemm_phase<Epi, pg8::StaticOrder>(lds, g, so, E);
    __syncthreads();
}

template <int DIR> __device__ __forceinline__ void lru_dir(const Params& p, int l, int n, int h, int lane, LAS bf16_t* XC, LAS float* STA, LAS float* STU) {
    const int c = lane & 15, q = lane >> 4, j = lane, t0 = n * 64;
    unsigned char* ws = p.ws;
    bf16_t* y = (bf16_t*)(ws + WS_H); bf16_t* PB = (bf16_t*)(ws + WS_PB);
    const bf16_t* LW = (const bf16_t*)(ws + WS_LRUW);
    float* Aprod = (float*)(ws + WS_AP); float* Hend = (float*)(ws + WS_HE);
    const float* lam = p.in[10] + (size_t)(l * 2 + DIR) * 512 + 64 * h; const float* b_a = p.in[7] + (size_t)(l * 2 + DIR) * 512 + 64 * h; const float* b_x = p.in[9] + (size_t)(l * 2 + DIR) * 512 + 64 * h;
    const bf16_t* LWa = LW + ((size_t)(DIR * 2 + 0) * 8 + h) * 4096 + c * 64 + 8 * q; const bf16_t* LWx = LW + ((size_t)(DIR * 2 + 1) * 8 + h) * 4096 + c * 64 + 8 * q;
    bf16x8 wa[4][2], wx[4][2]; f32x4 sp4[4], ba4[4], bx4[4];
#pragma unroll
    for (int nf = 0; nf < 4; ++nf) {
#pragma unroll
        for (int ks = 0; ks < 2; ++ks) { wa[nf][ks] = *(const bf16x8*)(LWa + nf * 1024 + 32 * ks); wx[nf][ks] = *(const bf16x8*)(LWx + nf * 1024 + 32 * ks); }
        const f32x4 lam4 = *(const f32x4*)(lam + 16 * nf + 4 * q); ba4[nf] = *(const f32x4*)(b_a + 16 * nf + 4 * q); bx4[nf] = *(const f32x4*)(b_x + 16 * nf + 4 * q);
#pragma unroll
        for (int r = 0; r < 4; ++r) { const float e = __expf(-lam4[r]); const float l1p = e < 0.05f ? e * (1.0f - e * (0.5f - e * (0.33333334f - e * 0.25f))) : __logf(1.0f + e); sp4[nf][r] = -8.0f * l1p; }
    }
    float hcar = 0.f, P = 1.f;
#pragma unroll 1
    for (int g = 0; g < 4; ++g) {
        const int mi = DIR == 0 ? g : 3 - g;
        bf16_t hfp[16];
        if (DIR == 1) {
#pragma unroll
            for (int s = 0; s < 16; ++s) hfp[s] = y[(size_t)(t0 + 16 * mi + s) * D + 64 * h + j];
        }
        bf16x8 xf[2];
#pragma unroll
        for (int ks = 0; ks < 2; ++ks) xf[ks] = *(const LAS bf16x8*)(XC + (16 * mi + c) * 520 + 64 * h + 32 * ks + 8 * q);
        f32x4 za[4], zx[4];
#pragma unroll
        for (int nf = 0; nf < 4; ++nf) { za[nf] = (f32x4){0.f, 0.f, 0.f, 0.f}; zx[nf] = za[nf];
            za[nf] = mfma16(wa[nf][0], xf[0], za[nf]); za[nf] = mfma16(wa[nf][1], xf[1], za[nf]);
            zx[nf] = mfma16(wx[nf][0], xf[0], zx[nf]); zx[nf] = mfma16(wx[nf][1], xf[1], zx[nf]); }
#pragma unroll
        for (int nf = 0; nf < 4; ++nf) {
            const int jo = 16 * nf + 4 * q;
            const bf16x4 xc4 = *(const LAS bf16x4*)(XC + (16 * mi + c) * 520 + 64 * h + jo);
            const f32x4 zav = za[nf] + ba4[nf], zxv = zx[nf] + bx4[nf];
            f32x4 av, uv;
#pragma unroll
            for (int r = 0; r < 4; ++r) {
                const float ra = sigmoidf_(zav[r]), ix = sigmoidf_(zxv[r]);
                const float la = ra * sp4[nf][r];
                av[r] = __expf(la);
                const float x2 = 2.0f * la;
                const float om = -x2 * (1.0f + x2 * (0.5f + x2 * (0.16666667f + x2 * (0.041666668f + x2 * (0.0083333338f + x2 * (0.0013888889f + x2 * 0.0001984127f))))));
                uv[r] = bf2f((bf16_t)xc4[r]) * ix * __builtin_amdgcn_sqrtf(fmaxf(om, 0.f));
            }
            *(LAS f32x4*)(STA + c * 68 + jo) = av; *(LAS f32x4*)(STU + c * 68 + jo) = uv;
        }
        LDS_FENCE();
        float aa[16], uu[16];
#pragma unroll
        for (int s = 0; s < 16; ++s) { aa[s] = STA[s * 68 + j]; uu[s] = STU[s * 68 + j]; }
        LDS_FENCE();
#pragma unroll
        for (int s = 0; s < 16; ++s) {
            const int tl = DIR == 0 ? s : 15 - s;
            hcar = aa[tl] * hcar + uu[tl]; P *= aa[tl];
            const size_t row = (size_t)(t0 + 16 * mi + tl);
            if (DIR == 0) { const unsigned w = cvtpk(hcar, P); y[row * D + 64 * h + j] = (bf16_t)(w & 0xffffu); y[row * D + 512 + 64 * h + j] = (bf16_t)(w >> 16); }
            else { const unsigned w = cvtpk(bf2f(hfp[tl]) + hcar, P); y[row * D + 64 * h + j] = (bf16_t)(w & 0xffffu); PB[row * 512 + 64 * h + j] = (bf16_t)(w >> 16); }
        }
    }
    Aprod[(size_t)(DIR * NCH + n) * 512 + 64 * h + j] = P; Hend[(size_t)(DIR * NCH + n) * 512 + 64 * h + j] = hcar;
}

template <int MODE> __device__ void mixer_lru(const Params& p, int l, int n, LAS unsigned char* lds) {
    const int tid = otid(), lane = tid & 63, wave = tid >> 6;
    unsigned char* ws = p.ws;
    const bf16_t* proj = (const bf16_t*)(ws + WS_PROJ); bf16_t* y = (bf16_t*)(ws + WS_H);
    LAS bf16_t* XC = (LAS bf16_t*)lds;
    const int t0 = n * 64;
    if (MODE == 0) {
        LAS float* STA = (LAS float*)(lds + 66560 + wave * 8704);
        LAS float* STU = STA + 16 * 68;
        {
            const int ch = tid;
            const float cw0 = p.in[4][(size_t)(l * 4 + 0) * 512 + ch], cw1 = p.in[4][(size_t)(l * 4 + 1) * 512 + ch], cw2 = p.in[4][(size_t)(l * 4 + 2) * 512 + ch], cw3 = p.in[4][(size_t)(l * 4 + 3) * 512 + ch];
            const float cb = p.in[5][(size_t)l * 512 + ch];
            bf16_t xs[67];
#pragma unroll
            for (int i = 0; i < 67; ++i) { const int s_ = t0 - 2 + i; const int sc = s_ < 0 ? 0 : (s_ >= S ? S - 1 : s_); const bf16_t v = proj[(size_t)sc * DINP + ch]; xs[i] = s_ == sc ? v : (bf16_t)0; }
#pragma unroll
            for (int t = 0; t < 64; ++t) { const float xc = cb + cw0 * bf2f(xs[t]) + cw1 * bf2f(xs[t + 1]) + cw2 * bf2f(xs[t + 2]) + cw3 * bf2f(xs[t + 3]); XC[t * 520 + ch] = f2bf(xc); }
        }
        __syncthreads();
        lru_dir<0>(p, l, n, wave, lane, XC, STA, STU);
        lru_dir<1>(p, l, n, wave, lane, XC, STA, STU);
        __syncthreads();
    } else {
        const bf16_t* PB = (const bf16_t*)(ws + WS_PB); const float* carry = (const float*)(ws + WS_CA);
        const int ch0 = 8 * lane;
        const float* cfp = carry + (size_t)(0 * NCH + n) * 512 + ch0; const float* cbp = carry + (size_t)(1 * NCH + n) * 512 + ch0; const float* gnp = p.in[11] + (size_t)l * 512 + ch0;
        const f32x4 cf0 = *(const f32x4*)cfp, cf1 = *(const f32x4*)(cfp + 4), cb0 = *(const f32x4*)cbp, cb1 = *(const f32x4*)(cbp + 4), g0 = *(const f32x4*)gnp, g1 = *(const f32x4*)(gnp + 4);
        const float cf[8] = {cf0[0], cf0[1], cf0[2], cf0[3], cf1[0], cf1[1], cf1[2], cf1[3]}, cb[8] = {cb0[0], cb0[1], cb0[2], cb0[3], cb1[0], cb1[1], cb1[2], cb1[3]};
        const float gg[8] = {g0[0], g0[1], g0[2], g0[3], g1[0], g1[1], g1[2], g1[3]};
        {
            bf16x8 h0[8], pf[8], pb[8], gt[8];
#pragma unroll
            for (int i = 0; i < 8; ++i) { const size_t row = (size_t)(t0 + wave * 8 + i);
                h0[i] = *(const bf16x8*)(y + row * D + ch0); pf[i] = *(const bf16x8*)(y + row * D + 512 + ch0); pb[i] = *(const bf16x8*)(PB + row * 512 + ch0); gt[i] = *(const bf16x8*)(proj + row * DINP + 512 + ch0); }
#pragma unroll
            for (int i = 0; i < 8; ++i) { const size_t row = (size_t)(t0 + wave * 8 + i);
                float v[8]; float ss = 0.f;
#pragma unroll
                for (int k = 0; k < 8; ++k) { v[k] = (bf2f((bf16_t)h0[i][k]) + bf2f((bf16_t)pf[i][k]) * cf[k] + bf2f((bf16_t)pb[i][k]) * cb[k]) * geluf_(bf2f((bf16_t)gt[i][k])); ss += v[k] * v[k]; }
#pragma unroll
                for (int o = 32; o >= 1; o >>= 1) ss += __shfl_xor(ss, o);
                const float rs = rsqrtf(ss * (1.0f / 512.0f) + EPS);
                *(u32x4*)(y + row * D + ch0) = (u32x4){cvtpk(v[0] * rs * gg[0], v[1] * rs * gg[1]), cvtpk(v[2] * rs * gg[2], v[3] * rs * gg[3]), cvtpk(v[4] * rs * gg[4], v[5] * rs * gg[5]), cvtpk(v[6] * rs * gg[6], v[7] * rs * gg[7])}; }
        }
        __syncthreads();
    }
}

__device__ __forceinline__ bf16x8 pack8(const f32x4 a, const f32x4 b) {
    const u32x4 w = (u32x4){cvtpk(a[0], a[1]), cvtpk(a[2], a[3]), cvtpk(b[0], b[1]), cvtpk(b[2], b[3])}; return __builtin_bit_cast(bf16x8, w); }
#define SIGC(ef, c) (32 * ((ef) >> 1) + 8 * ((c) >> 2) + 4 * ((ef) & 1) + ((c) & 3))
#define SLOT(ks, q, jj) (32 * (ks) + 16 * ((jj) >> 2) + 4 * (q) + ((jj) & 3))

template <int MODE> __device__ void mixer_gla(const Params& p, int l, int n, LAS unsigned char* lds) {
    const int tid = otid(), lane = tid & 63, wave = tid >> 6, c = lane & 15, q = lane >> 4;
    const int h = wave >> 1, vh = wave & 1;
    unsigned char* ws = p.ws;
    const bf16_t* proj = (const bf16_t*)(ws + WS_PROJ); bf16_t* y = (bf16_t*)(ws + WS_H); const bf16_t* GW = (const bf16_t*)(ws + WS_GW);
    bf16_t* uT = (bf16_t*)(ws + WS_M); const bf16_t* spT = (const bf16_t*)(ws + WS_M + (size_t)S * D * 2); float* dec = (float*)(ws + WS_DEC);
    LAS bf16_t* VTw = (LAS bf16_t*)(lds + 66560 + wave * 9216);
    LAS float* SSQ = (LAS float*)(lds + 66560 + 8 * 9216);
    const int t0 = n * 64;
    const f32x4 zero4 = (f32x4){0.f, 0.f, 0.f, 0.f};
    {
        bf16x8 vn[4][2], identv[2];
#pragma unroll
        for (int tt = 0; tt < 4; ++tt)
#pragma unroll
            for (int kv = 0; kv < 2; ++kv) vn[tt][kv] = *(const bf16x8*)(proj + (size_t)(t0 + 16 * tt + c) * DINP + 1536 + 128 * h + 64 * vh + 32 * kv + 8 * q);
#pragma unroll
        for (int e1 = 0; e1 < 2; ++e1)
#pragma unroll
            for (int jj = 0; jj < 8; ++jj) identv[e1][jj] = (8 * q + jj == 16 * e1 + c) ? (short)0x3F80 : (short)0;
#pragma unroll
        for (int vf = 0; vf < 4; ++vf)
#pragma unroll
            for (int tt = 0; tt < 4; ++tt) { const f32x4 d = mfma16(vn[tt][vf >> 1], identv[vf & 1], zero4);
                *(LAS u32x2*)(VTw + (16 * vf + c) * 72 + 16 * tt + 4 * q) = (u32x2){cvtpk(d[0], d[1]), cvtpk(d[2], d[3])}; }
    }
    LDS_FENCE();
    f32x4 acc[4][4];
#pragma unroll
    for (int a = 0; a < 4; ++a)
#pragma unroll
        for (int b = 0; b < 4; ++b) acc[a][b] = zero4;
#pragma unroll 1
    for (int dir = 0; dir < 2; ++dir) {
        bf16x8 laop[4][2]; float tot[4];
        {
            bf16x8 lrf[4], gwf[4]; float bgv[4];
#pragma unroll
            for (int tt = 0; tt < 4; ++tt) { lrf[tt] = (bf16x8){0, 0, 0, 0, 0, 0, 0, 0}; if (q < 2) lrf[tt] = *(const bf16x8*)(proj + (size_t)(t0 + 16 * tt + c) * DINP + 2560 + dir * 16 + 8 * q); }
#pragma unroll
            for (int ef = 0; ef < 4; ++ef) { gwf[ef] = *(const bf16x8*)(GW + (size_t)(dir * 256 + 64 * h + SIGC(ef, c)) * 32 + 8 * q); bgv[ef] = p.in[13][(size_t)(l * 2 + dir) * 256 + 64 * h + SIGC(ef, c)]; }
#pragma unroll
            for (int ef = 0; ef < 4; ++ef) { tot[ef] = 0.f;
#pragma unroll
                for (int ks = 0; ks < 2; ++ks) { f32x4 la2[2];
#pragma unroll
                    for (int t2 = 0; t2 < 2; ++t2) { const f32x4 z = mfma16(lrf[2 * ks + t2], gwf[ef], zero4);
#pragma unroll
                        for (int r = 0; r < 4; ++r) { const float zz = z[r] + bgv[ef]; const float la = (fminf(zz, 0.f) - __logf(1.0f + __expf(-fabsf(zz)))) * (1.0f / 16.0f); la2[t2][r] = la; tot[ef] += la; } }
                    laop[ef][ks] = pack8(la2[0], la2[1]); __builtin_amdgcn_sched_barrier(0); } }
        }
        if (MODE == 1) {
            bf16x8 QEop[4][2], KEop[4][2];
            bf16x8 qn[4][2], kn1[4][2];
#pragma unroll
            for (int tj = 0; tj < 4; ++tj)
#pragma unroll
                for (int ks = 0; ks < 2; ++ks) { const bf16_t* rp = proj + (size_t)(t0 + 16 * tj + c) * DINP + 64 * h + 32 * ks + 8 * q; qn[tj][ks] = *(const bf16x8*)(rp + 1024); kn1[tj][ks] = *(const bf16x8*)(rp + 1280); }
            __builtin_amdgcn_sched_barrier(0);
#pragma unroll
            for (int tj = 0; tj < 4; ++tj) {
                const int t = 16 * tj + c;
                bf16x8 mk[2];
#pragma unroll
                for (int ks = 0; ks < 2; ++ks)
#pragma unroll
                    for (int jj = 0; jj < 8; ++jj) { const int sidx = SLOT(ks, q, jj); const bool on = dir == 0 ? sidx <= t : sidx >= t; mk[ks][jj] = on ? (short)0x3F80 : (short)0; }
#pragma unroll
                for (int ks2 = 0; ks2 < 2; ++ks2) { f32x4 qe2[2], ke2[2];
#pragma unroll
                    for (int e2 = 0; e2 < 2; ++e2) { const int ef = 2 * ks2 + e2;
                        f32x4 b = mfma16(laop[ef][0], mk[0], zero4); b = mfma16(laop[ef][1], mk[1], b);
#pragma unroll
                        for (int r = 0; r < 4; ++r) { qe2[e2][r] = bf2f((bf16_t)qn[tj][ks2][4 * e2 + r]) * 0.125f * __expf(b[r]); ke2[e2][r] = bf2f((bf16_t)kn1[tj][ks2][4 * e2 + r]) * __expf(-b[r]); } }
                    QEop[tj][ks2] = pack8(qe2[0], qe2[1]); KEop[tj][ks2] = pack8(ke2[0], ke2[1]); }
                __builtin_amdgcn_sched_barrier(0);
            }
            const bf16_t* SP = spT + ((size_t)(dir * NCH + n) * 4 + h) * 8192 + (size_t)(64 * vh) * 64;
            bf16x8 spf[4][2];
#pragma unroll
            for (int vf = 0; vf < 4; ++vf)
#pragma unroll
                for (int ks = 0; ks < 2; ++ks) spf[vf][ks] = *(const bf16x8*)(SP + (16 * vf + c) * 64 + 32 * ks + 8 * q);
            __builtin_amdgcn_sched_barrier(0);
            bf16x8 Pop[4][2];
#pragma unroll
            for (int ti = 0; ti < 4; ++ti)
#pragma unroll
                for (int ksp = 0; ksp < 2; ++ksp) { f32x4 pm[2];
#pragma unroll
                    for (int j2 = 0; j2 < 2; ++j2) { const int tjj = 2 * ksp + j2;
                        f32x4 sc = mfma16(KEop[tjj][0], QEop[ti][0], zero4); sc = mfma16(KEop[tjj][1], QEop[ti][1], sc);
#pragma unroll
                        for (int r = 0; r < 4; ++r) { const int j = 16 * tjj + 4 * q + r, i = 16 * ti + c; const bool keep = dir == 0 ? j <= i : j >= i; pm[j2][r] = keep ? sc[r] : 0.f; } }
                    Pop[ti][ksp] = pack8(pm[0], pm[1]); __builtin_amdgcn_sched_barrier(0); }
#pragma unroll
            for (int vf = 0; vf < 4; ++vf)
#pragma unroll
                for (int ks = 0; ks < 2; ++ks) {
                    const u32x2 v0 = *(const LAS u32x2*)(VTw + (16 * vf + c) * 72 + 32 * ks + 4 * q), v1 = *(const LAS u32x2*)(VTw + (16 * vf + c) * 72 + 32 * ks + 16 + 4 * q);
                    const bf16x8 vtf = __builtin_bit_cast(bf16x8, (u32x4){v0.x, v0.y, v1.x, v1.y});
#pragma unroll
                    for (int ti = 0; ti < 4; ++ti) { acc[vf][ti] = mfma16(vtf, Pop[ti][ks], acc[vf][ti]); acc[vf][ti] = mfma16(spf[vf][ks], QEop[ti][ks], acc[vf][ti]); }
                    __builtin_amdgcn_sched_barrier(0);
                }
        } else {
#pragma unroll
            for (int ef = 0; ef < 4; ++ef) { float tt = tot[ef]; tt += __shfl_xor(tt, 16); tt += __shfl_xor(tt, 32);
                if (vh == 0 && q == 0) dec[((size_t)(dir * NCH + n) * 4 + h) * 64 + SIGC(ef, c)] = __expf(tt); }
            bf16x8 kn[4][2];
#pragma unroll
            for (int tj = 0; tj < 4; ++tj)
#pragma unroll
                for (int ks = 0; ks < 2; ++ks) kn[tj][ks] = *(const bf16x8*)(proj + (size_t)(t0 + 16 * tj + c) * DINP + 1280 + 64 * h + 32 * ks + 8 * q);
            bf16x8 ident[2];
#pragma unroll
            for (int e1 = 0; e1 < 2; ++e1)
#pragma unroll
                for (int jj = 0; jj < 8; ++jj) ident[e1][jj] = (8 * q + jj == 8 * (c >> 2) + 4 * e1 + (c & 3)) ? (short)0x3F80 : (short)0;
            bf16x8 kdop[4][2];
#pragma unroll
            for (int ks = 0; ks < 2; ++ks) {
                bf16x8 mk[2][2];
#pragma unroll
                for (int t2 = 0; t2 < 2; ++t2)
#pragma unroll
                    for (int k2 = 0; k2 < 2; ++k2)
#pragma unroll
                        for (int jj = 0; jj < 8; ++jj) { const int tp = 16 * (2 * ks + t2) + c, sidx = SLOT(k2, q, jj); const bool on = dir == 0 ? sidx > tp : sidx < tp; mk[t2][k2][jj] = on ? (short)0x3F80 : (short)0; }
#pragma unroll
                for (int ef = 0; ef < 4; ++ef) { f32x4 kd2[2];
#pragma unroll
                    for (int t2 = 0; t2 < 2; ++t2) { const int tj = 2 * ks + t2;
                        f32x4 E = mfma16(mk[t2][0], laop[ef][0], zero4); E = mfma16(mk[t2][1], laop[ef][1], E);
                        const f32x4 kR = mfma16(kn[tj][ef >> 1], ident[ef & 1], zero4);
#pragma unroll
                        for (int r = 0; r < 4; ++r) kd2[t2][r] = kR[r] * __expf(E[r]); }
                    kdop[ef][ks] = pack8(kd2[0], kd2[1]); __builtin_amdgcn_sched_barrier(0); }
            }
            bf16_t* U = uT + ((size_t)(dir * NCH + n) * 4 + h) * 8192 + (size_t)(64 * vh) * 64;
#pragma unroll
            for (int vf = 0; vf < 4; ++vf) { bf16x8 vtf[2];
#pragma unroll
                for (int ks = 0; ks < 2; ++ks) { const u32x2 v0 = *(const LAS u32x2*)(VTw + (16 * vf + c) * 72 + 32 * ks + 4 * q), v1 = *(const LAS u32x2*)(VTw + (16 * vf + c) * 72 + 32 * ks + 16 + 4 * q);
                    vtf[ks] = __builtin_bit_cast(bf16x8, (u32x4){v0.x, v0.y, v1.x, v1.y}); }
#pragma unroll
                for (int ef = 0; ef < 4; ++ef) { f32x4 u = mfma16(kdop[ef][0], vtf[0], zero4); u = mfma16(kdop[ef][1], vtf[1], u);
                    *(u32x2*)(U + (16 * vf + c) * 64 + 32 * (ef >> 1) + 8 * q + 4 * (ef & 1)) = (u32x2){cvtpk(u[0], u[1]), cvtpk(u[2], u[3])}; } }
        }
    }
    if (MODE == 1) {
        bf16x4 ggp[4][4];
#pragma unroll
        for (int ti = 0; ti < 4; ++ti)
#pragma unroll
            for (int vf = 0; vf < 4; ++vf) ggp[ti][vf] = *(const bf16x4*)(proj + (size_t)(t0 + 16 * ti + c) * DINP + 2048 + 128 * h + 64 * vh + 16 * vf + 4 * q);
#pragma unroll
        for (int ti = 0; ti < 4; ++ti) { float ss = 0.f;
#pragma unroll
            for (int vf = 0; vf < 4; ++vf) ss += acc[vf][ti][0] * acc[vf][ti][0] + acc[vf][ti][1] * acc[vf][ti][1] + acc[vf][ti][2] * acc[vf][ti][2] + acc[vf][ti][3] * acc[vf][ti][3];
            ss += __shfl_xor(ss, 16); ss += __shfl_xor(ss, 32);
            if (q == 0) SSQ[(h * 64 + 16 * ti + c) * 2 + vh] = ss; }
        __syncthreads();
        const float* gn = p.in[14] + (size_t)l * 128;
#pragma unroll
        for (int ti = 0; ti < 4; ++ti) { const int t = 16 * ti + c; const float rs = rsqrtf((SSQ[(h * 64 + t) * 2] + SSQ[(h * 64 + t) * 2 + 1]) * (1.0f / 128.0f) + EPS);
#pragma unroll
            for (int vf = 0; vf < 4; ++vf) { const int v = 64 * vh + 16 * vf + 4 * q; const f32x4 g4 = *(const f32x4*)(gn + v);
                float o[4];
#pragma unroll
                for (int r = 0; r < 4; ++r) o[r] = acc[vf][ti][r] * rs * g4[r] * siluf_(bf2f((bf16_t)ggp[ti][vf][r]));
                *(u32x2*)(y + (size_t)(t0 + t) * D + 512 + 128 * h + v) = (u32x2){cvtpk(o[0], o[1]), cvtpk(o[2], o[3])}; } }
    }
    __syncthreads();
}

__device__ void phase_scan(const Params& p) {
    unsigned char* ws = p.ws; const int tid = otid();
    if (tid < 256) {
        const bf16_t* __restrict__ uT = (const bf16_t*)(ws + WS_M); bf16_t* __restrict__ spT = (bf16_t*)(ws + WS_M + (size_t)S * D * 2); const float* __restrict__ dec = (const float*)(ws + WS_DEC);
        for (int gid = obid() * 256 + tid; gid < 65536; gid += gridDim.x * 256) {
            const int dir = gid >> 15, rem = gid & 32767, h = rem >> 13, vd = rem & 8191, d = vd & 63;
            float s = 0.f;
            const long step = dir ? -1 : 1; const int nfirst = dir ? NCH - 1 : 0;
            const bf16_t* up = uT + ((size_t)(dir * NCH + nfirst) * 4 + h) * 8192 + vd; bf16_t* sp = spT + ((size_t)(dir * NCH + nfirst) * 4 + h) * 8192 + vd;
            const float* dp = dec + ((size_t)(dir * NCH + nfirst) * 4 + h) * 64 + d;
#pragma unroll 1
            for (int st = 0; st < NCH; st += 64) {
                bf16_t ub[64]; float db[64];
#pragma unroll
                for (int i = 0; i < 64; ++i) { ub[i] = up[(long)(st + i) * step * 32768]; db[i] = dp[(long)(st + i) * step * 256]; }
#pragma unroll
                for (int i = 0; i < 64; ++i) { sp[(long)(st + i) * step * 32768] = f2bf(s); s = db[i] * s + bf2f(ub[i]); }
            }
        }
    } else if (tid < 384 && obid() < 8) {
        const float* __restrict__ Aprod = (const float*)(ws + WS_AP); const float* __restrict__ Hend = (const float*)(ws + WS_HE); float* __restrict__ carry = (float*)(ws + WS_CA);
        const int gid = obid() * 128 + (tid - 256); const int dir = gid >> 9, ch = gid & 511;
        float hc = 0.f;
        const long step = dir ? -1 : 1; const size_t base = (size_t)(dir * NCH + (dir ? NCH - 1 : 0)) * 512 + ch;
#pragma unroll 1
        for (int st = 0; st < NCH; st += 64) {
            float ab[64], hb[64];
#pragma unroll
            for (int i = 0; i < 64; ++i) { ab[i] = Aprod[base + (long)(st + i) * step * 512]; hb[i] = Hend[base + (long)(st + i) * step * 512]; }
#pragma unroll
            for (int i = 0; i < 64; ++i) { carry[base + (long)(st + i) * step * 512] = hc; hc = ab[i] * hc + hb[i]; }
        }
    }
}

#define XB_TMO      128
#define XB_XCNT(j)  (256  + 64 * (j))
#define XB_XSUB(j)  (1280 + 64 * (j))
#define XB_XGEN(j)  (2304 + 64 * (j))
#define XB_TOP      3328
#define XB_TOPGEN   3392
#define XCD_BAR_WORDS 3456
#define XB_SPIN_CAP (1u << 18)

__device__ __forceinline__ unsigned xb_ld(unsigned* p)              { return __hip_atomic_load(p, __ATOMIC_RELAXED, __HIP_MEMORY_SCOPE_AGENT); }
__device__ __forceinline__ unsigned xb_add(unsigned* p, unsigned v) { return __hip_atomic_fetch_add(p, v, __ATOMIC_RELAXED, __HIP_MEMORY_SCOPE_AGENT); }
__device__ __forceinline__ unsigned xb_xcc_id() { return (unsigned)__builtin_amdgcn_s_getreg((3 << 11) | 20) & 0xFu; }
#define XB_SPIN(cond, bar) do { unsigned _sp = 0; while (cond) { __builtin_amdgcn_s_sleep(1); \
    if ((++_sp & 255u) == 0u) { if (xb_ld(&(bar)[XB_TMO])) break; if (_sp > XB_SPIN_CAP) { atomicAdd(&(bar)[XB_TMO], 1u); break; } } } } while (0)

struct XcdBarrier {
    unsigned* bar; unsigned x;
    volatile LAS unsigned* st;
};

__device__ __forceinline__ XcdBarrier xcd_barrier_post(unsigned* bar, volatile LAS unsigned* st) {
    XcdBarrier b; b.bar = bar; b.x = xb_xcc_id(); b.st = st;
    if (threadIdx.x == 0) (void)xb_add(&bar[XB_XCNT(b.x)], 1u);
    return b;
}
__device__ __forceinline__ void xcd_barrier_complete(unsigned* bar, unsigned x, unsigned& nloc, unsigned& nx) {
    const unsigned G = gridDim.x * gridDim.y * gridDim.z;
    unsigned sum, cnt, mine, sp = 0u;
    for (;;) {
        sum = 0u; cnt = 0u; mine = 0u;
#pragma unroll
        for (unsigned j = 0; j < 16; ++j) { const unsigned c = xb_ld(&bar[XB_XCNT(j)]); sum += c; cnt += (c > 0u) ? 1u : 0u; mine = (j == x) ? c : mine; }
        if (sum == G) break;
        __builtin_amdgcn_s_sleep(1);
        if ((++sp & 255u) == 0u) { if (xb_ld(&bar[XB_TMO])) break; if (sp > XB_SPIN_CAP) { atomicAdd(&bar[XB_TMO], 1u); break; } }
    }
    nloc = mine > 0u ? mine : 1u; nx = cnt > 0u ? cnt : 1u;
}

__device__ __forceinline__ void xcd_barrier(const XcdBarrier& b) {
    asm volatile("s_waitcnt vmcnt(0)" ::: "memory");
    __syncthreads();
    if (threadIdx.x == 0) {
        unsigned* bar = b.bar;
        __builtin_amdgcn_s_waitcnt(0);
        unsigned nloc = b.st[0], nx = b.st[1];
        if (nloc == 0u) { xcd_barrier_complete(bar, b.x, nloc, nx); b.st[0] = nloc; b.st[1] = nx; }
        const unsigned old = xb_add(&bar[XB_XSUB(b.x)], 1u);
        const unsigned gen = old / nloc;
        if (old + 1u == (gen + 1u) * nloc) {
            __builtin_amdgcn_fence(__ATOMIC_RELEASE, "agent");
            asm volatile("s_waitcnt vmcnt(0)" ::: "memory");
            const unsigned og = xb_add(&bar[XB_TOP], 1u);
            const unsigned tg = og / nx;
            if (og + 1u == (tg + 1u) * nx) xb_add(&bar[XB_TOPGEN], 1u);
            else XB_SPIN(xb_ld(&bar[XB_TOPGEN]) == tg, bar);
            __builtin_amdgcn_fence(__ATOMIC_ACQUIRE, "agent");
            xb_add(&bar[XB_XGEN(b.x)], 1u);
            asm volatile("s_waitcnt vmcnt(0)" ::: "memory");
        } else {
            XB_SPIN(xb_ld(&bar[XB_XGEN(b.x)]) == gen, bar);
            __builtin_amdgcn_fence(__ATOMIC_ACQUIRE, "agent");
            asm volatile("s_waitcnt vmcnt(0)" ::: "memory");
        }
    }
    __syncthreads();
}

__global__ void __launch_bounds__(NTHR, 2) mk_fwd(Params p) {
    extern __shared__ __attribute__((aligned(16))) unsigned char lds_raw[];
    LAS unsigned char* lds = (LAS unsigned char*)lds_raw;
    unsigned char* ws = p.ws;
    bf16_t* WinT = (bf16_t*)(ws + WS_WIN); bf16_t* WoutT = (bf16_t*)(ws + WS_WOUT); bf16_t* WguT = (bf16_t*)(ws + WS_WGU); bf16_t* WdT = (bf16_t*)(ws + WS_WD);
    bf16_t* Hb = (bf16_t*)(ws + WS_H); bf16_t* PROJ = (bf16_t*)(ws + WS_PROJ); float* Mb = (float*)(ws + WS_M);
    const float* xin = p.in[0]; float* out = p.out;
    volatile LAS unsigned* bst = (volatile LAS unsigned*)(lds + LDS_BYTES - 16);
    if (threadIdx.x == 0) { bst[0] = 0u; bst[1] = 0u; }
    __syncthreads();
    XcdBarrier bar = xcd_barrier_post((unsigned*)(ws + WS_CTL), bst);
    for (int ph = p.ph_lo; ph < p.ph_hi; ++ph) {
        if (ph == p.ph_lo + 1) cg::this_grid().sync();
        else if (ph > p.ph_lo) xcd_barrier(bar);
        if (ph == 9 * NL) { phase_rowprep(out, (const bf16_t*)Mb, p.in[17] + (size_t)(NL - 1) * D, out, nullptr, nullptr); continue; }
        const int l = ph / 9, s = ph % 9;
        switch (s) {
        case 0: phase_weights(p, l, lds);
                if (l == 0) phase_rowprep(xin, nullptr, nullptr, nullptr, p.in[1], Hb);
                else phase_rowprep(out, (const bf16_t*)Mb, p.in[17] + (size_t)(l - 1) * D, out, p.in[1] + (size_t)l * D, Hb);
                break;
        case 1: gemm_fast(lds, Hb, WinT, S, DINP, D, EpiB16{PROJ, DINP}); break;
        case 2: for (int n = obid(); n < NCH; n += gridDim.x) mixer_lru<0>(p, l, n, lds);
                for (int n = obid(); n < NCH; n += gridDim.x) mixer_gla<0>(p, l, n, lds); break;
        case 3: phase_scan(p); break;
        case 4: for (int n = obid(); n < NCH; n += gridDim.x) mixer_lru<1>(p, l, n, lds);
                for (int n = obid(); n < NCH; n += gridDim.x) mixer_gla<1>(p, l, n, lds); break;
        case 5: gemm_fast(lds, Hb, WoutT, S, D, D, EpiB16{(bf16_t*)Mb, D}); break;
        case 6: phase_rowprep(l == 0 ? xin : out, (const bf16_t*)Mb, p.in[2] + (size_t)l * D, out, p.in[16] + (size_t)l * D, Hb); break;
        case 7: gemm_fast(lds, Hb, WguT, S, 2 * DFF, D, EpiSwiglu{PROJ, DFF}); break;
        case 8: gemm_fast(lds, PROJ, WdT, S, D, DFF, EpiB16{(bf16_t*)Mb, D}); break;
        }
    }
}

extern "C" void kernel_launch(void* const* d_in, const int* in_sizes, int n_in, void* d_out, int out_size, void* d_ws, size_t ws_size, hipStream_t stream) {
    static int grid = 0;
    if (grid == 0) {
        if (n_in != 21 || out_size != S * D || ws_size < WS_END) { fprintf(stderr, "kernel_launch: unexpected shapes: n_in %d out %d ws %zu (need %zu)\n", n_in, out_size, ws_size, (size_t)WS_END); grid = -1; return; }
        int dev = 0, cus = 0, per_cu = 0;
        (void)hipGetDevice(&dev); (void)hipDeviceGetAttribute(&cus, hipDeviceAttributeMultiprocessorCount, dev);
        if (hipFuncSetAttribute((const void*)mk_fwd, hipFuncAttributeMaxDynamicSharedMemorySize, LDS_BYTES) != hipSuccess) { fprintf(stderr, "kernel_launch: hipFuncSetAttribute failed\n"); grid = -1; return; }
        if (hipOccupancyMaxActiveBlocksPerMultiprocessor(&per_cu, (const void*)mk_fwd, NTHR, LDS_BYTES) != hipSuccess || per_cu < 1) { fprintf(stderr, "kernel_launch: occupancy query says %d\n", per_cu); per_cu = 1; }
        (void)hipGetLastError();
        grid = cus;
    }
    if (grid < 0) return;
    Params p{};
    for (int i = 0; i < 21; ++i) p.in[i] = (const float*)d_in[i];
    p.out = (float*)d_out; p.ws = (unsigned char*)d_ws;
    (void)hipMemsetAsync((unsigned char*)d_ws + WS_CTL, 0, 16384, stream);
#if ONE_LAUNCH
    p.ph_lo = 0; p.ph_hi = 9 * NL + 1;
    void* args[] = {&p};
    hipError_t e = hipLaunchCooperativeKernel((const void*)mk_fwd, dim3(grid), dim3(NTHR), args, LDS_BYTES, stream);
    if (e != hipSuccess) fprintf(stderr, "cooperative launch failed: %s (grid %d)\n", hipGetErrorString(e), grid);
#else
    for (int ph = 0; ph < 9 * NL + 1; ++ph) { p.ph_lo = ph; p.ph_hi = ph + 1; hipLaunchKernelGGL(mk_fwd, dim3(grid), dim3(NTHR), LDS_BYTES, stream, p); }
#endif
}
```

```cpp
#include <hip/hip_runtime.h>
#include <hip/hip_cooperative_groups.h>
#include <cstdio>
namespace cg = cooperative_groups;

#ifndef ONE_LAUNCH
#define ONE_LAUNCH 1
#endif

#define LAS __attribute__((address_space(3)))
typedef unsigned short bf16_t;
typedef short bf16x8 __attribute__((ext_vector_type(8)));
typedef short bf16x4 __attribute__((ext_vector_type(4)));
typedef float f32x4 __attribute__((ext_vector_type(4)));
typedef unsigned u32x4 __attribute__((ext_vector_type(4)));
typedef unsigned u32x2 __attribute__((ext_vector_type(2)));
typedef float f32x2 __attribute__((ext_vector_type(2)));
typedef __bf16 bf16v2 __attribute__((ext_vector_type(2)));

constexpr int S = 16384, D = 1024, DIN = 2592, DINP = 2816, DFF = 2816, NL = 4, NCH = 256;
constexpr int NTHR = 512;
constexpr int LDS_BYTES = 147456;
constexpr float EPS = 1e-6f;

constexpr size_t WS_CTL = 0;
constexpr size_t WS_WIN = 65536;
constexpr size_t WS_WOUT = WS_WIN + (size_t)DINP * D * 2;
constexpr size_t WS_WGU = WS_WOUT + (size_t)D * D * 2;
constexpr size_t WS_WD = WS_WGU + (size_t)2 * DFF * D * 2;
constexpr size_t WS_LRUW = WS_WD + (size_t)D * DFF * 2;
constexpr size_t WS_GW = WS_LRUW + (size_t)2 * 2 * 8 * 64 * 64 * 2;
constexpr size_t WS_H = WS_GW + (size_t)2 * 256 * 32 * 2;
constexpr size_t WS_PROJ = WS_H + (size_t)S * D * 2;
constexpr size_t WS_M = WS_PROJ + (size_t)S * DINP * 2;
constexpr size_t WS_AP = WS_M + (size_t)S * D * 4;
constexpr size_t WS_HE = WS_AP + (size_t)2 * NCH * 512 * 4;
constexpr size_t WS_CA = WS_HE + (size_t)2 * NCH * 512 * 4;
constexpr size_t WS_DEC = WS_CA + (size_t)2 * NCH * 512 * 4;
constexpr size_t WS_PB = WS_DEC + (size_t)2 * NCH * 4 * 64 * 4;
constexpr size_t WS_END = WS_PB + (size_t)S * 512 * 2;

struct Params { const float* in[21]; float* out; unsigned char* ws; int ph_lo, ph_hi; };

__device__ __forceinline__ float bf2f(bf16_t b) { return __uint_as_float(((unsigned)b) << 16); }
__device__ __forceinline__ bf16_t f2bf(float f) { unsigned u = __float_as_uint(f); return (bf16_t)((u + 0x7fffu + ((u >> 16) & 1u)) >> 16); }
__device__ __forceinline__ unsigned pk2(float lo, float hi) { return (unsigned)f2bf(lo) | ((unsigned)f2bf(hi) << 16); }
__device__ __forceinline__ unsigned cvtpk(float lo, float hi) { const f32x2 v = (f32x2){lo, hi}; const bf16v2 b = __builtin_convertvector(v, bf16v2); return __builtin_bit_cast(unsigned, b); }
__device__ __forceinline__ float sigmoidf_(float x) { return __builtin_amdgcn_rcpf(1.0f + __expf(-x)); }
__device__ __forceinline__ float siluf_(float x) { return x * sigmoidf_(x); }
__device__ __forceinline__ float geluf_(float x) { const float y = 0.7978845608028654f * (x + 0.044715f * x * x * x); const float t = 1.0f - 2.0f * __builtin_amdgcn_rcpf(__expf(2.0f * y) + 1.0f); return 0.5f * x * (1.0f + t); }
__device__ __forceinline__ f32x4 mfma16(bf16x8 a, bf16x8 b, f32x4 c) { return __builtin_amdgcn_mfma_f32_16x16x32_bf16(a, b, c, 0, 0, 0); }
__device__ __forceinline__ int otid() { int t = threadIdx.x; asm volatile("" : "+v"(t)); return t; }
__device__ __forceinline__ int obid() { int t = blockIdx.x; asm volatile("" : "+s"(t)); return t; }
#define LDS_FENCE() asm volatile("s_waitcnt lgkmcnt(0)" ::: "memory")

struct WDesc { const float* src; bf16_t* dst; int ldsrc, c0, nvalid, k0, lddst, r0; };
__device__ __forceinline__ WDesc wdesc(const Params& p, int l, int u) {
    unsigned char* ws = p.ws;
    constexpr int T_IN = 44 * 16, T_OUT = 16 * 16, T_GU = 88 * 16, T_D = 16 * 44;
    WDesc d; int v = u;
    if (v < T_IN) { const int rt = v / 16, kt = v % 16; int nv = DIN - rt * 64; nv = nv > 64 ? 64 : (nv < 0 ? 0 : nv);
        d.src = p.in[3] + (size_t)l * D * DIN; d.ldsrc = DIN; d.c0 = nv > 0 ? rt * 64 : 0; d.nvalid = nv; d.k0 = kt * 64; d.dst = (bf16_t*)(ws + WS_WIN); d.lddst = D; d.r0 = rt * 64; return d; }
    v -= T_IN;
    if (v < T_OUT) { const int rt = v / 16, kt = v % 16; d.src = p.in[15] + (size_t)l * D * D; d.ldsrc = D; d.c0 = rt * 64; d.nvalid = 64; d.k0 = kt * 64; d.dst = (bf16_t*)(ws + WS_WOUT); d.lddst = D; d.r0 = rt * 64; return d; }
    v -= T_OUT;
    if (v < T_GU) { const int rt = v / 16, kt = v % 16; const int r0 = rt * 64, j = r0 / 256, within = r0 % 256;
        d.src = (within < 128 ? p.in[18] : p.in[19]) + (size_t)l * D * DFF; d.ldsrc = DFF; d.c0 = j * 128 + (within & 127); d.nvalid = 64; d.k0 = kt * 64; d.dst = (bf16_t*)(ws + WS_WGU); d.lddst = D; d.r0 = r0; return d; }
    v -= T_GU;
    if (v < T_D) { const int rt = v / 44, kt = v % 44; d.src = p.in[20] + (size_t)l * DFF * D; d.ldsrc = D; d.c0 = rt * 64; d.nvalid = 64; d.k0 = kt * 64; d.dst = (bf16_t*)(ws + WS_WD); d.lddst = DFF; d.r0 = rt * 64; return d; }
    v -= T_D;
    { const int dir = v / 16, gate = (v / 8) % 2, h = v % 8; d.src = (gate ? p.in[8] : p.in[6]) + ((size_t)(l * 2 + dir) * 8 + h) * 4096; d.ldsrc = 64; d.c0 = 0; d.nvalid = 64; d.k0 = 0;
      d.dst = (bf16_t*)(ws + WS_LRUW) + ((size_t)(dir * 2 + gate) * 8 + h) * 4096; d.lddst = 64; d.r0 = 0; return d; }
}

__device__ void phase_weights(const Params& p, int l, LAS unsigned char* lds) {
    LAS float* T = (LAS float*)lds;
    unsigned char* ws = p.ws;
    constexpr int TOT = 44 * 16 + 16 * 16 + 88 * 16 + 16 * 44 + 32;
    const int tid = otid(), G = gridDim.x;
    for (int u0 = obid(); u0 < TOT; u0 += 4 * G) {
        f32x4 v[4][2];
        { const int k = tid >> 3, cg8 = (tid & 7) * 8;
#pragma unroll
          for (int j = 0; j < 4; ++j) { const int u = u0 + j * G; v[j][0] = (f32x4){0.f, 0.f, 0.f, 0.f}; v[j][1] = v[j][0];
              if (u < TOT) { const WDesc d = wdesc(p, l, u); const float* sp = d.src + (size_t)(d.k0 + k) * d.ldsrc + d.c0 + cg8;
                  if (cg8 + 3 < d.nvalid) v[j][0] = *(const f32x4*)sp; if (cg8 + 7 < d.nvalid) v[j][1] = *(const f32x4*)(sp + 4); } }
#pragma unroll
          for (int j = 0; j < 4; ++j)
#pragma unroll
              for (int i = 0; i < 2; ++i) { LAS float* Tj = T + j * 4160 + k * 65 + cg8 + 4 * i; Tj[0] = v[j][i][0]; Tj[1] = v[j][i][1]; Tj[2] = v[j][i][2]; Tj[3] = v[j][i][3]; } }
        __syncthreads();
        { const int r = tid >> 3, kg = (tid & 7) * 8;
#pragma unroll
          for (int j = 0; j < 4; ++j) { const int u = u0 + j * G;
              if (u < TOT) { const WDesc d = wdesc(p, l, u); const LAS float* Tj = T + j * 4160; u32x4 w;
                  w.x = cvtpk(Tj[(kg + 0) * 65 + r], Tj[(kg + 1) * 65 + r]); w.y = cvtpk(Tj[(kg + 2) * 65 + r], Tj[(kg + 3) * 65 + r]);
                  w.z = cvtpk(Tj[(kg + 4) * 65 + r], Tj[(kg + 5) * 65 + r]); w.w = cvtpk(Tj[(kg + 6) * 65 + r], Tj[(kg + 7) * 65 + r]);
                  *(u32x4*)(d.dst + (size_t)(d.r0 + r) * d.lddst + d.k0 + kg) = w; } } }
        __syncthreads();
    }
    { bf16_t* GW = (bf16_t*)(ws + WS_GW); const float* wg = p.in[12] + (size_t)l * 2 * 16 * 256;
      for (int idx = obid() * NTHR + otid(); idx < 2 * 256 * 32; idx += gridDim.x * NTHR) { const int dir = idx >> 13, e = (idx >> 5) & 255, r = idx & 31;
          GW[idx] = r < 16 ? f2bf(wg[(size_t)(dir * 16 + r) * 256 + e]) : (bf16_t)0; } }
}

__device__ void phase_rowprep(const float* xsrc, const bf16_t* __restrict__ m, const float* __restrict__ gpost, float* xdst, const float* __restrict__ gpre, bf16_t* __restrict__ hdst) {
    const int tid = otid(); const int lane = tid & 63, wave = tid >> 6;
    const int stride = gridDim.x * 8;
    f32x4 gp[4], gq[4];
#pragma unroll
    for (int i = 0; i < 4; ++i) { gp[i] = m ? *(const f32x4*)(gpost + i * 256 + lane * 4) : (f32x4){0.f, 0.f, 0.f, 0.f}; gq[i] = hdst ? *(const f32x4*)(gpre + i * 256 + lane * 4) : (f32x4){0.f, 0.f, 0.f, 0.f}; }
    int row = obid() * 8 + wave;
    f32x4 xn[4]; bf16x4 mn[4];
    if (row < S) {
#pragma unroll
        for (int i = 0; i < 4; ++i) { xn[i] = *(const f32x4*)(xsrc + (size_t)row * D + i * 256 + lane * 4); mn[i] = m ? *(const bf16x4*)(m + (size_t)row * D + i * 256 + lane * 4) : (bf16x4){0, 0, 0, 0}; }
    }
    while (row < S) {
        f32x4 xv[4]; bf16x4 mb[4];
#pragma unroll
        for (int i = 0; i < 4; ++i) { xv[i] = xn[i]; mb[i] = mn[i]; }
        const int nrow = row + stride;
        if (nrow < S) {
#pragma unroll
            for (int i = 0; i < 4; ++i) { xn[i] = *(const f32x4*)(xsrc + (size_t)nrow * D + i * 256 + lane * 4); mn[i] = m ? *(const bf16x4*)(m + (size_t)nrow * D + i * 256 + lane * 4) : (bf16x4){0, 0, 0, 0}; }
        }
        if (m) {
            f32x4 mv[4]; float ss = 0.f;
#pragma unroll
            for (int i = 0; i < 4; ++i) { mv[i] = (f32x4){bf2f((bf16_t)mb[i][0]), bf2f((bf16_t)mb[i][1]), bf2f((bf16_t)mb[i][2]), bf2f((bf16_t)mb[i][3])}; ss += mv[i][0] * mv[i][0] + mv[i][1] * mv[i][1] + mv[i][2] * mv[i][2] + mv[i][3] * mv[i][3]; }
#pragma unroll
            for (int o = 32; o >= 1; o >>= 1) ss += __shfl_xor(ss, o);
            const float rs = rsqrtf(ss * (1.0f / D) + EPS);
#pragma unroll
            for (int i = 0; i < 4; ++i) xv[i] += mv[i] * rs * gp[i];
        }
        if (xdst) {
#pragma unroll
            for (int i = 0; i < 4; ++i) *(f32x4*)(xdst + (size_t)row * D + i * 256 + lane * 4) = xv[i];
        }
        if (hdst) {
            float ss = 0.f;
#pragma unroll
            for (int i = 0; i < 4; ++i) ss += xv[i][0] * xv[i][0] + xv[i][1] * xv[i][1] + xv[i][2] * xv[i][2] + xv[i][3] * xv[i][3];
#pragma unroll
            for (int o = 32; o >= 1; o >>= 1) ss += __shfl_xor(ss, o);
            const float rs = rsqrtf(ss * (1.0f / D) + EPS);
#pragma unroll
            for (int i = 0; i < 4; ++i) { const f32x4 hv = xv[i] * rs * gq[i]; *(u32x2*)(hdst + (size_t)row * D + i * 256 + lane * 4) = (u32x2){cvtpk(hv[0], hv[1]), cvtpk(hv[2], hv[3])}; }
        }
        row = nrow;
    }
}

namespace pg8 {
#define PG8_LAS __attribute__((address_space(3)))
constexpr int BM = 256, BK = 64, HALF = 128, HTB = HALF * BK * 2  , STAGE_BYTES = 8 * HTB, NXCD = 8, WGM = 8;
__host__ __device__ __forceinline__ int lds_byte(int r, int c) { const int st = (r >> 4) * 2 + (c >> 5), rr = r & 15, cc = c & 31, ob = rr * 64 + cc * 2; return st * 1024 + (ob ^ (((ob >> 9) & 1) << 5)); }
__host__ __device__ __forceinline__ void stage_rc(int b, int& R, int& C) { const int st = b / 1024, sb = b % 1024, swz = sb ^ (((sb >> 9) & 1) << 5); R = (st >> 1) * 16 + swz / 64; C = (st & 1) * 32 + (swz % 64) / 2; }
__host__ __device__ __forceinline__ int perm32(int rho) { const int n = rho >> 4, i = rho & 15; return 8 * (i >> 2) + 4 * n + (i & 3); }
struct Unit { int pm, pn; };
struct Gemm { const bf16_t* A; const bf16_t* Bt; int M, N, K; };
struct StaticOrder {
    int nM, nN, nwg, G, c;
    __host__ __device__ void init(int M, int N, int G_, int c_) { nM = M / BM; nN = N / BM; nwg = nM * nN; G = G_; c = c_; }
    __host__ __device__ bool next(int i, Unit& u) const {
        const long L = (long)i * G + c; if (L >= nwg) return false;
        int wgid = (int)L; { const int q = nwg / NXCD, r = nwg % NXCD, xcd = wgid % NXCD, off = wgid / NXCD; wgid = (xcd < r ? xcd * (q + 1) : r * (q + 1) + (xcd - r) * q) + off; }
        const int nig = WGM * nN, gid = wgid / nig, fm = gid * WGM, gsz = (nM - fm) < WGM ? (nM - fm) : WGM;
        u.pm = fm + ((wgid % nig) % gsz); u.pn = (wgid % nig) / gsz; return true;
    }
    __device__ __forceinline__ void a_ready(const Unit&) const {}
    __device__ __forceinline__ void done(const Unit&) const {}
};
__device__ __forceinline__ unsigned cvt_pk_bf16(float lo, float hi) { unsigned r; asm volatile("v_cvt_pk_bf16_f32 %0, %1, %2" : "=v"(r) : "v"(lo), "v"(hi)); return r; }
template <class Epi, class Sched>
__device__ __forceinline__ void gemm_phase(PG8_LAS unsigned char* lds, const Gemm g, const Sched& S, const Epi& E) {
    const int tid = otid(), wid = __builtin_amdgcn_readfirstlane(tid >> 6), lane = tid & 63, wr = wid >> 2, wc = wid & 3, fr = lane & 15, fq = lane >> 4;
    const int K = g.K, nt = K / BK;
    unsigned voffA[2], voffB[2];
#pragma unroll
    for (int i = 0; i < 2; ++i) { int R, C; stage_rc(tid * 16 + i * 8192, R, C); const int Rb = Epi::PERM ? ((R & ~31) + perm32(R & 31)) : R;
        voffA[i] = (unsigned)(R * K + C) * 2u; voffB[i] = (unsigned)(Rb * K + C) * 2u; }
    const size_t kstep = (size_t)(BK * 2);
    const size_t hstep = (size_t)HALF * K * 2;
    const size_t tstep = 2 * hstep;
    const unsigned ldsw = (unsigned)wid * 1024u;
    const int aoff = lds_byte(wr * 64 + fr, fq * 8), boff = lds_byte(wc * 32 + fr, fq * 8);
#define PG8_SA(b, h) (((b) * 2 + (h)) * HTB)
#define PG8_SB(b, h) ((4 + (b) * 2 + (h)) * HTB)
#define PG8_STAGE(bufoff, gbase, voff) do { _Pragma("unroll") for (int _i = 0; _i < 2; ++_i) \
        __builtin_amdgcn_global_load_lds((const unsigned*)((const char*)(gbase) + (voff)[_i]), (PG8_LAS unsigned*)(lds + (bufoff) + ldsw + _i * 8192), 16, 0, 0); } while (0)
#define PG8_LDA(dst, b, h) do { _Pragma("unroll") for (int m = 0; m < 4; ++m) _Pragma("unroll") for (int k = 0; k < 2; ++k) dst[m][k] = *(const PG8_LAS bf16x8*)(lds + PG8_SA(b, h) + aoff + m * 2048 + k * 1024); } while (0)
#define PG8_LDB(dst, b, h) do { _Pragma("unroll") for (int n = 0; n < 2; ++n) _Pragma("unroll") for (int k = 0; k < 2; ++k) dst[n][k] = *(const PG8_LAS bf16x8*)(lds + PG8_SB(b, h) + boff + n * 2048 + k * 1024); } while (0)
#define PG8_MMA(ai, bj, At, Bt) do { __builtin_amdgcn_s_setprio(1); _Pragma("unroll") for (int m = 0; m < 4; ++m) _Pragma("unroll") for (int n = 0; n < 2; ++n) _Pragma("unroll") for (int k = 0; k < 2; ++k) \
        acc[ai][bj][m][n] = __builtin_amdgcn_mfma_f32_16x16x32_bf16(Bt[n][k], At[m][k], acc[ai][bj][m][n], 0, 0, 0); __builtin_amdgcn_s_setprio(0); } while (0)
#define PG8_WAIT_V(n) asm volatile("s_waitcnt vmcnt(" #n ")" ::: "memory")
#define PG8_WAIT_L(n) asm volatile("s_waitcnt lgkmcnt(" #n ")" ::: "memory")
#define PG8_BAR __builtin_amdgcn_s_barrier()
#define PG8_SCHED __builtin_amdgcn_sched_barrier(0)
    Unit cur, nxt; int ui = 0;
    if (!S.next(0, cur)) return;
    f32x4 acc[2][2][4][2];
#pragma unroll
    for (int a = 0; a < 2; ++a)
#pragma unroll
        for (int b = 0; b < 2; ++b)
#pragma unroll
            for (int m = 0; m < 4; ++m)
#pragma unroll
                for (int n = 0; n < 2; ++n) acc[a][b][m][n] = (f32x4){0.f, 0.f, 0.f, 0.f};
    bf16x8 At[4][2], B0[2][2], B1[2][2];
    const char* cA = (const char*)g.A + (size_t)cur.pm * tstep; const char* cB = (const char*)g.Bt + (size_t)cur.pn * tstep;
    S.a_ready(cur);
    PG8_STAGE(PG8_SB(0, 0), cB, voffB); PG8_STAGE(PG8_SA(0, 0), cA, voffA); PG8_STAGE(PG8_SB(0, 1), cB + hstep, voffB); PG8_STAGE(PG8_SA(0, 1), cA + hstep, voffA);
    if (wr == 1) PG8_BAR;
    PG8_WAIT_V(4); PG8_BAR;
    PG8_STAGE(PG8_SB(1, 0), cB + kstep, voffB); PG8_STAGE(PG8_SA(1, 0), cA + kstep, voffA); PG8_STAGE(PG8_SB(1, 1), cB + hstep + kstep, voffB);
    PG8_WAIT_V(6); PG8_BAR;
    for (;;) {
        const bool has_next = S.next(ui + 1, nxt);
        const char* nA = has_next ? (const char*)g.A + (size_t)nxt.pm * tstep : cA; const char* nB = has_next ? (const char*)g.Bt + (size_t)nxt.pn * tstep : cB;
        for (int t = 0; t < nt; t += 2) {
            const bool last = (t == nt - 2);
            const char* a1 = cA + (size_t)(t + 1) * kstep;
            const char* a2 = last ? nA : cA + (size_t)(t + 2) * kstep; const char* b2 = last ? nB : cB + (size_t)(t + 2) * kstep;
            const char* a3 = a2 + kstep; const char* b3 = b2 + kstep;
            if (last && has_next) S.a_ready(nxt);
            PG8_LDB(B0, 0, 0); PG8_SCHED; PG8_LDA(At, 0, 0); PG8_STAGE(PG8_SA(1, 1), a1 + hstep, voffA);
            PG8_WAIT_L(8); PG8_BAR; PG8_WAIT_L(0); PG8_MMA(0, 0, At, B0); PG8_BAR; PG8_SCHED;
            PG8_LDB(B1, 0, 1); PG8_STAGE(PG8_SB(0, 0), b2, voffB);
            PG8_BAR; PG8_WAIT_L(0); PG8_MMA(0, 1, At, B1); PG8_BAR;
            PG8_LDA(At, 0, 1); PG8_STAGE(PG8_SA(0, 0), a2, voffA);
            PG8_BAR; PG8_WAIT_L(0); PG8_MMA(1, 0, At, B0); PG8_BAR; PG8_SCHED;
            PG8_STAGE(PG8_SB(0, 1), b2 + hstep, voffB);
            PG8_WAIT_V(6); PG8_BAR; PG8_MMA(1, 1, At, B1); PG8_BAR;
            PG8_LDB(B0, 1, 0); PG8_SCHED; PG8_LDA(At, 1, 0); PG8_STAGE(PG8_SA(0, 1), a2 + hstep, voffA);
            PG8_WAIT_L(8); PG8_BAR; PG8_WAIT_L(0); PG8_MMA(0, 0, At, B0); PG8_BAR; PG8_SCHED;
            PG8_LDB(B1, 1, 1); PG8_STAGE(PG8_SB(1, 0), b3, voffB);
            PG8_BAR; PG8_WAIT_L(0); PG8_MMA(0, 1, At, B1); PG8_BAR;
            PG8_LDA(At, 1, 1); PG8_STAGE(PG8_SA(1, 0), a3, voffA);
            PG8_BAR; PG8_WAIT_L(0); PG8_MMA(1, 0, At, B0); PG8_BAR; PG8_SCHED;
            PG8_STAGE(PG8_SB(1, 1), b3 + hstep, voffB);
            PG8_WAIT_V(6); PG8_BAR; PG8_MMA(1, 1, At, B1); PG8_BAR;
        }
        if constexpr (!Epi::AFTER_DRAIN) { E(acc, cur, wr, wc, fr, fq); S.done(cur); }
        if (!has_next) break;
#pragma unroll
        for (int a = 0; a < 2; ++a)
#pragma unroll
            for (int b = 0; b < 2; ++b)
#pragma unroll
                for (int m = 0; m < 4; ++m)
#pragma unroll
                    for (int n = 0; n < 2; ++n) acc[a][b][m][n] = (f32x4){0.f, 0.f, 0.f, 0.f};
        cur = nxt; cA = nA; cB = nB; ++ui;
    }
    PG8_WAIT_V(0);
    if (wr == 0) PG8_BAR;
    PG8_BAR;
    if constexpr (Epi::AFTER_DRAIN) { E.fused(acc, cur, wr, wc, fr, fq, lds, wid, lane); S.done(cur); }
#undef PG8_SA
#undef PG8_SB
#undef PG8_STAGE
#undef PG8_LDA
#undef PG8_LDB
#undef PG8_MMA
#undef PG8_WAIT_V
#undef PG8_WAIT_L
#undef PG8_BAR
#undef PG8_SCHED
}
}

struct EpiB16 {
    static constexpr bool PERM = true, AFTER_DRAIN = false;
    bf16_t* O; int ldc;
    __device__ __forceinline__ void operator()(const f32x4 (&acc)[2][2][4][2], const pg8::Unit& u, int wr, int wc, int fr, int fq) const {
        const int row0 = u.pm * 256 + wr * 64 + fr, col0 = u.pn * 256 + wc * 32 + 8 * fq;
#pragma unroll
        for (int ai = 0; ai < 2; ++ai)
#pragma unroll
            for (int m = 0; m < 4; ++m) { bf16_t* rowp = O + (size_t)(row0 + ai * 128 + m * 16) * ldc + col0;
#pragma unroll
                for (int bj = 0; bj < 2; ++bj) { const f32x4 v0 = acc[ai][bj][m][0], v1 = acc[ai][bj][m][1];
                    u32x4 w; w.x = cvtpk(v0[0], v0[1]); w.y = cvtpk(v0[2], v0[3]); w.z = cvtpk(v1[0], v1[1]); w.w = cvtpk(v1[2], v1[3]);
                    *(u32x4*)(rowp + bj * 128) = w; } }
    }
};
struct EpiSwiglu {
    static constexpr bool PERM = true, AFTER_DRAIN = false;
    bf16_t* O; int ldc;
    __device__ __forceinline__ void operator()(const f32x4 (&acc)[2][2][4][2], const pg8::Unit& u, int wr, int wc, int fr, int fq) const {
        const int row0 = u.pm * 256 + wr * 64 + fr, col0 = u.pn * 128 + wc * 32 + 8 * fq;
#pragma unroll
        for (int ai = 0; ai < 2; ++ai)
#pragma unroll
            for (int m = 0; m < 4; ++m) { bf16_t* rowp = O + (size_t)(row0 + ai * 128 + m * 16) * ldc + col0;
                const f32x4 g0 = acc[ai][0][m][0], g1 = acc[ai][0][m][1], u0 = acc[ai][1][m][0], u1 = acc[ai][1][m][1];
                u32x4 w; w.x = cvtpk(siluf_(g0[0]) * u0[0], siluf_(g0[1]) * u0[1]); w.y = cvtpk(siluf_(g0[2]) * u0[2], siluf_(g0[3]) * u0[3]);
                w.z = cvtpk(siluf_(g1[0]) * u1[0], siluf_(g1[1]) * u1[1]); w.w = cvtpk(siluf_(g1[2]) * u1[2], siluf_(g1[3]) * u1[3]);
                *(u32x4*)rowp = w; }
    }
};
template <class Epi> __device__ __forceinline__ void gemm_fast(LAS unsigned char* lds, const bf16_t* A, const bf16_t* Bt, int M, int N, int K, const Epi& E) {
    pg8::Gemm g; g.A = A; g.Bt = Bt; g.M = M; g.N = N; g.K = K;
    pg8::StaticOrder so; so.init(M, N, (int)gridDim.x, obid());
    pg8::gemm_phase<Epi, pg8::StaticOrder>(lds, g, so, E);
    __syncthreads();
}

template <int DIR> __device__ __forceinline__ void lru_dir(const Params& p, int l, int n, int h, int lane, LAS bf16_t* XC, LAS float* STA, LAS float* STU) {
    const int c = lane & 15, q = lane >> 4, j = lane, t0 = n * 64;
    unsigned char* ws = p.ws;
    bf16_t* y = (bf16_t*)(ws + WS_H); bf16_t* PB = (bf16_t*)(ws + WS_PB);
    const bf16_t* LW = (const bf16_t*)(ws + WS_LRUW);
    float* Aprod = (float*)(ws + WS_AP); float* Hend = (float*)(ws + WS_HE);
    const float* lam = p.in[10] + (size_t)(l * 2 + DIR) * 512 + 64 * h; const float* b_a = p.in[7] + (size_t)(l * 2 + DIR) * 512 + 64 * h; const float* b_x = p.in[9] + (size_t)(l * 2 + DIR) * 512 + 64 * h;
    const bf16_t* LWa = LW + ((size_t)(DIR * 2 + 0) * 8 + h) * 4096 + c * 64 + 8 * q; const bf16_t* LWx = LW + ((size_t)(DIR * 2 + 1) * 8 + h) * 4096 + c * 64 + 8 * q;
    bf16x8 wa[4][2], wx[4][2]; f32x4 sp4[4], ba4[4], bx4[4];
#pragma unroll
    for (int nf = 0; nf < 4; ++nf) {
#pragma unroll
        for (int ks = 0; ks < 2; ++ks) { wa[nf][ks] = *(const bf16x8*)(LWa + nf * 1024 + 32 * ks); wx[nf][ks] = *(const bf16x8*)(LWx + nf * 1024 + 32 * ks); }
        const f32x4 lam4 = *(const f32x4*)(lam + 16 * nf + 4 * q); ba4[nf] = *(const f32x4*)(b_a + 16 * nf + 4 * q); bx4[nf] = *(const f32x4*)(b_x + 16 * nf + 4 * q);
#pragma unroll
        for (int r = 0; r < 4; ++r) { const float e = __expf(-lam4[r]); const float l1p = e < 0.05f ? e * (1.0f - e * (0.5f - e * (0.33333334f - e * 0.25f))) : __logf(1.0f + e); sp4[nf][r] = -8.0f * l1p; }
    }
    float hcar = 0.f, P = 1.f;
#pragma unroll 1
    for (int g = 0; g < 4; ++g) {
        const int mi = DIR == 0 ? g : 3 - g;
        bf16_t hfp[16];
        if (DIR == 1) {
#pragma unroll
            for (int s = 0; s < 16; ++s) hfp[s] = y[(size_t)(t0 + 16 * mi + s) * D + 64 * h + j];
        }
        bf16x8 xf[2];
#pragma unroll
        for (int ks = 0; ks < 2; ++ks) xf[ks] = *(const LAS bf16x8*)(XC + (16 * mi + c) * 520 + 64 * h + 32 * ks + 8 * q);
        f32x4 za[4], zx[4];
#pragma unroll
        for (int nf = 0; nf < 4; ++nf) { za[nf] = (f32x4){0.f, 0.f, 0.f, 0.f}; zx[nf] = za[nf];
            za[nf] = mfma16(wa[nf][0], xf[0], za[nf]); za[nf] = mfma16(wa[nf][1], xf[1], za[nf]);
            zx[nf] = mfma16(wx[nf][0], xf[0], zx[nf]); zx[nf] = mfma16(wx[nf][1], xf[1], zx[nf]); }
#pragma unroll
        for (int nf = 0; nf < 4; ++nf) {
            const int jo = 16 * nf + 4 * q;
            const bf16x4 xc4 = *(const LAS bf16x4*)(XC + (16 * mi + c) * 520 + 64 * h + jo);
            const f32x4 zav = za[nf] + ba4[nf], zxv = zx[nf] + bx4[nf];
            f32x4 av, uv;
#pragma unroll
            for (int r = 0; r < 4; ++r) {
                const float ra = sigmoidf_(zav[r]), ix = sigmoidf_(zxv[r]);
                const float la = ra * sp4[nf][r];
                av[r] = __expf(la);
                const float x2 = 2.0f * la;
                const float om = -x2 * (1.0f + x2 * (0.5f + x2 * (0.16666667f + x2 * (0.041666668f + x2 * (0.0083333338f + x2 * (0.0013888889f + x2 * 0.0001984127f))))));
                uv[r] = bf2f((bf16_t)xc4[r]) * ix * __builtin_amdgcn_sqrtf(fmaxf(om, 0.f));
            }
            *(LAS f32x4*)(STA + c * 68 + jo) = av; *(LAS f32x4*)(STU + c * 68 + jo) = uv;
        }
        LDS_FENCE();
        float aa[16], uu[16];
#pragma unroll
        for (int s = 0; s < 16; ++s) { aa[s] = STA[s * 68 + j]; uu[s] = STU[s * 68 + j]; }
        LDS_FENCE();
#pragma unroll
        for (int s = 0; s < 16; ++s) {
            const int tl = DIR == 0 ? s : 15 - s;
            hcar = aa[tl] * hcar + uu[tl]; P *= aa[tl];
            const size_t row = (size_t)(t0 + 16 * mi + tl);
            if (DIR == 0) { const unsigned w = cvtpk(hcar, P); y[row * D + 64 * h + j] = (bf16_t)(w & 0xffffu); y[row * D + 512 + 64 * h + j] = (bf16_t)(w >> 16); }
            else { const unsigned w = cvtpk(bf2f(hfp[tl]) + hcar, P); y[row * D + 64 * h + j] = (bf16_t)(w & 0xffffu); PB[row * 512 + 64 * h + j] = (bf16_t)(w >> 16); }
        }
    }
    Aprod[(size_t)(DIR * NCH + n) * 512 + 64 * h + j] = P; Hend[(size_t)(DIR * NCH + n) * 512 + 64 * h + j] = hcar;
}

template <int MODE> __device__ void mixer_lru(const Params& p, int l, int n, LAS unsigned char* lds) {
    const int tid = otid(), lane = tid & 63, wave = tid >> 6;
    unsigned char* ws = p.ws;
    const bf16_t* proj = (const bf16_t*)(ws + WS_PROJ); bf16_t* y = (bf16_t*)(ws + WS_H);
    LAS bf16_t* XC = (LAS bf16_t*)lds;
    const int t0 = n * 64;
    if (MODE == 0) {
        LAS float* STA = (LAS float*)(lds + 66560 + wave * 8704);
        LAS float* STU = STA + 16 * 68;
        {
            const int ch = tid;
            const float cw0 = p.in[4][(size_t)(l * 4 + 0) * 512 + ch], cw1 = p.in[4][(size_t)(l * 4 + 1) * 512 + ch], cw2 = p.in[4][(size_t)(l * 4 + 2) * 512 + ch], cw3 = p.in[4][(size_t)(l * 4 + 3) * 512 + ch];
            const float cb = p.in[5][(size_t)l * 512 + ch];
            bf16_t xs[67];
#pragma unroll
            for (int i = 0; i < 67; ++i) { const int s_ = t0 - 2 + i; const int sc = s_ < 0 ? 0 : (s_ >= S ? S - 1 : s_); const bf16_t v = proj[(size_t)sc * DINP + ch]; xs[i] = s_ == sc ? v : (bf16_t)0; }
#pragma unroll
            for (int t = 0; t < 64; ++t) { const float xc = cb + cw0 * bf2f(xs[t]) + cw1 * bf2f(xs[t + 1]) + cw2 * bf2f(xs[t + 2]) + cw3 * bf2f(xs[t + 3]); XC[t * 520 + ch] = f2bf(xc); }
        }
        __syncthreads();
        lru_dir<0>(p, l, n, wave, lane, XC, STA, STU);
        lru_dir<1>(p, l, n, wave, lane, XC, STA, STU);
        __syncthreads();
    } else {
        const bf16_t* PB = (const bf16_t*)(ws + WS_PB); const float* carry = (const float*)(ws + WS_CA);
        const int ch0 = 8 * lane;
        const float* cfp = carry + (size_t)(0 * NCH + n) * 512 + ch0; const float* cbp = carry + (size_t)(1 * NCH + n) * 512 + ch0; const float* gnp = p.in[11] + (size_t)l * 512 + ch0;
        const f32x4 cf0 = *(const f32x4*)cfp, cf1 = *(const f32x4*)(cfp + 4), cb0 = *(const f32x4*)cbp, cb1 = *(const f32x4*)(cbp + 4), g0 = *(const f32x4*)gnp, g1 = *(const f32x4*)(gnp + 4);
        const float cf[8] = {cf0[0], cf0[1], cf0[2], cf0[3], cf1[0], cf1[1], cf1[2], cf1[3]}, cb[8] = {cb0[0], cb0[1], cb0[2], cb0[3], cb1[0], cb1[1], cb1[2], cb1[3]};
        const float gg[8] = {g0[0], g0[1], g0[2], g0[3], g1[0], g1[1], g1[2], g1[3]};
        {
            bf16x8 h0[8], pf[8], pb[8], gt[8];
#pragma unroll
            for (int i = 0; i < 8; ++i) { const size_t row = (size_t)(t0 + wave * 8 + i);
                h0[i] = *(const bf16x8*)(y + row * D + ch0); pf[i] = *(const bf16x8*)(y + row * D + 512 + ch0); pb[i] = *(const bf16x8*)(PB + row * 512 + ch0); gt[i] = *(const bf16x8*)(proj + row * DINP + 512 + ch0); }
#pragma unroll
            for (int i = 0; i < 8; ++i) { const size_t row = (size_t)(t0 + wave * 8 + i);
                float v[8]; float ss = 0.f;
#pragma unroll
                for (int k = 0; k < 8; ++k) { v[k] = (bf2f((bf16_t)h0[i][k]) + bf2f((bf16_t)pf[i][k]) * cf[k] + bf2f((bf16_t)pb[i][k]) * cb[k]) * geluf_(bf2f((bf16_t)gt[i][k])); ss += v[k] * v[k]; }
#pragma unroll
                for (int o = 32; o >= 1; o >>= 1) ss += __shfl_xor(ss, o);
                const float rs = rsqrtf(ss * (1.0f / 512.0f) + EPS);
                *(u32x4*)(y + row * D + ch0) = (u32x4){cvtpk(v[0] * rs * gg[0], v[1] * rs * gg[1]), cvtpk(v[2] * rs * gg[2], v[3] * rs * gg[3]), cvtpk(v[4] * rs * gg[4], v[5] * rs * gg[5]), cvtpk(v[6] * rs * gg[6], v[7] * rs * gg[7])}; }
        }
        __syncthreads();
    }
}

__device__ __forceinline__ bf16x8 pack8(const f32x4 a, const f32x4 b) {
    const u32x4 w = (u32x4){cvtpk(a[0], a[1]), cvtpk(a[2], a[3]), cvtpk(b[0], b[1]), cvtpk(b[2], b[3])}; return __builtin_bit_cast(bf16x8, w); }
#define SIGC(ef, c) (32 * ((ef) >> 1) + 8 * ((c) >> 2) + 4 * ((ef) & 1) + ((c) & 3))
#define SLOT(ks, q, jj) (32 * (ks) + 16 * ((jj) >> 2) + 4 * (q) + ((jj) & 3))

template <int MODE> __device__ void mixer_gla(const Params& p, int l, int n, LAS unsigned char* lds) {
    const int tid = otid(), lane = tid & 63, wave = tid >> 6, c = lane & 15, q = lane >> 4;
    const int h = wave >> 1, vh = wave & 1;
    unsigned char* ws = p.ws;
    const bf16_t* proj = (const bf16_t*)(ws + WS_PROJ); bf16_t* y = (bf16_t*)(ws + WS_H); const bf16_t* GW = (const bf16_t*)(ws + WS_GW);
    bf16_t* uT = (bf16_t*)(ws + WS_M); const bf16_t* spT = (const bf16_t*)(ws + WS_M + (size_t)S * D * 2); float* dec = (float*)(ws + WS_DEC);
    LAS bf16_t* VTw = (LAS bf16_t*)(lds + 66560 + wave * 9216);
    LAS float* SSQ = (LAS float*)(lds + 66560 + 8 * 9216);
    const int t0 = n * 64;
    const f32x4 zero4 = (f32x4){0.f, 0.f, 0.f, 0.f};
    {
        bf16x8 vn[4][2], identv[2];
#pragma unroll
        for (int tt = 0; tt < 4; ++tt)
#pragma unroll
            for (int kv = 0; kv < 2; ++kv) vn[tt][kv] = *(const bf16x8*)(proj + (size_t)(t0 + 16 * tt + c) * DINP + 1536 + 128 * h + 64 * vh + 32 * kv + 8 * q);
#pragma unroll
        for (int e1 = 0; e1 < 2; ++e1)
#pragma unroll
            for (int jj = 0; jj < 8; ++jj) identv[e1][jj] = (8 * q + jj == 16 * e1 + c) ? (short)0x3F80 : (short)0;
#pragma unroll
        for (int vf = 0; vf < 4; ++vf)
#pragma unroll
            for (int tt = 0; tt < 4; ++tt) { const f32x4 d = mfma16(vn[tt][vf >> 1], identv[vf & 1], zero4);
                *(LAS u32x2*)(VTw + (16 * vf + c) * 72 + 16 * tt + 4 * q) = (u32x2){cvtpk(d[0], d[1]), cvtpk(d[2], d[3])}; }
    }
    LDS_FENCE();
    f32x4 acc[4][4];
#pragma unroll
    for (int a = 0; a < 4; ++a)
#pragma unroll
        for (int b = 0; b < 4; ++b) acc[a][b] = zero4;
#pragma unroll 1
    for (int dir = 0; dir < 2; ++dir) {
        bf16x8 laop[4][2]; float tot[4];
        {
            bf16x8 lrf[4], gwf[4]; float bgv[4];
#pragma unroll
            for (int tt = 0; tt < 4; ++tt) { lrf[tt] = (bf16x8){0, 0, 0, 0, 0, 0, 0, 0}; if (q < 2) lrf[tt] = *(const bf16x8*)(proj + (size_t)(t0 + 16 * tt + c) * DINP + 2560 + dir * 16 + 8 * q); }
#pragma unroll
            for (int ef = 0; ef < 4; ++ef) { gwf[ef] = *(const bf16x8*)(GW + (size_t)(dir * 256 + 64 * h + SIGC(ef, c)) * 32 + 8 * q); bgv[ef] = p.in[13][(size_t)(l * 2 + dir) * 256 + 64 * h + SIGC(ef, c)]; }
#pragma unroll
            for (int ef = 0; ef < 4; ++ef) { tot[ef] = 0.f;
#pragma unroll
                for (int ks = 0; ks < 2; ++ks) { f32x4 la2[2];
#pragma unroll
                    for (int t2 = 0; t2 < 2; ++t2) { const f32x4 z = mfma16(lrf[2 * ks + t2], gwf[ef], zero4);
#pragma unroll
                        for (int r = 0; r < 4; ++r) { const float zz = z[r] + bgv[ef]; const float la = (fminf(zz, 0.f) - __logf(1.0f + __expf(-fabsf(zz)))) * (1.0f / 16.0f); la2[t2][r] = la; tot[ef] += la; } }
                    laop[ef][ks] = pack8(la2[0], la2[1]); __builtin_amdgcn_sched_barrier(0); } }
        }
        if (MODE == 1) {
            bf16x8 QEop[4][2], KEop[4][2];
            bf16x8 qn[4][2], kn1[4][2];
#pragma unroll
            for (int tj = 0; tj < 4; ++tj)
#pragma unroll
                for (int ks = 0; ks < 2; ++ks) { const bf16_t* rp = proj + (size_t)(t0 + 16 * tj + c) * DINP + 64 * h + 32 * ks + 8 * q; qn[tj][ks] = *(const bf16x8*)(rp + 1024); kn1[tj][ks] = *(const bf16x8*)(rp + 1280); }
            __builtin_amdgcn_sched_barrier(0);
#pragma unroll
            for (int tj = 0; tj < 4; ++tj) {
                const int t = 16 * tj + c;
                bf16x8 mk[2];
#pragma unroll
                for (int ks = 0; ks < 2; ++ks)
#pragma unroll
                    for (int jj = 0; jj < 8; ++jj) { const int sidx = SLOT(ks, q, jj); const bool on = dir == 0 ? sidx <= t : sidx >= t; mk[ks][jj] = on ? (short)0x3F80 : (short)0; }
#pragma unroll
                for (int ks2 = 0; ks2 < 2; ++ks2) { f32x4 qe2[2], ke2[2];
#pragma unroll
                    for (int e2 = 0; e2 < 2; ++e2) { const int ef = 2 * ks2 + e2;
                        f32x4 b = mfma16(laop[ef][0], mk[0], zero4); b = mfma16(laop[ef][1], mk[1], b);
#pragma unroll
                        for (int r = 0; r < 4; ++r) { qe2[e2][r] = bf2f((bf16_t)qn[tj][ks2][4 * e2 + r]) * 0.125f * __expf(b[r]); ke2[e2][r] = bf2f((bf16_t)kn1[tj][ks2][4 * e2 + r]) * __expf(-b[r]); } }
                    QEop[tj][ks2] = pack8(qe2[0], qe2[1]); KEop[tj][ks2] = pack8(ke2[0], ke2[1]); }
                __builtin_amdgcn_sched_barrier(0);
            }
            const bf16_t* SP = spT + ((size_t)(dir * NCH + n) * 4 + h) * 8192 + (size_t)(64 * vh) * 64;
            bf16x8 spf[4][2];
#pragma unroll
            for (int vf = 0; vf < 4; ++vf)
#pragma unroll
                for (int ks = 0; ks < 2; ++ks) spf[vf][ks] = *(const bf16x8*)(SP + (16 * vf + c) * 64 + 32 * ks + 8 * q);
            __builtin_amdgcn_sched_barrier(0);
            bf16x8 Pop[4][2];
#pragma unroll
            for (int ti = 0; ti < 4; ++ti)
#pragma unroll
                for (int ksp = 0; ksp < 2; ++ksp) { f32x4 pm[2];
#pragma unroll
                    for (int j2 = 0; j2 < 2; ++j2) { const int tjj = 2 * ksp + j2;
                        f32x4 sc = mfma16(KEop[tjj][0], QEop[ti][0], zero4); sc = mfma16(KEop[tjj][1], QEop[ti][1], sc);
#pragma unroll
                        for (int r = 0; r < 4; ++r) { const int j = 16 * tjj + 4 * q + r, i = 16 * ti + c; const bool keep = dir == 0 ? j <= i : j >= i; pm[j2][r] = keep ? sc[r] : 0.f; } }
                    Pop[ti][ksp] = pack8(pm[0], pm[1]); __builtin_amdgcn_sched_barrier(0); }
#pragma unroll
            for (int vf = 0; vf < 4; ++vf)
#pragma unroll
                for (int ks = 0; ks < 2; ++ks) {
                    const u32x2 v0 = *(const LAS u32x2*)(VTw + (16 * vf + c) * 72 + 32 * ks + 4 * q), v1 = *(const LAS u32x2*)(VTw + (16 * vf + c) * 72 + 32 * ks + 16 + 4 * q);
                    const bf16x8 vtf = __builtin_bit_cast(bf16x8, (u32x4){v0.x, v0.y, v1.x, v1.y});
#pragma unroll
                    for (int ti = 0; ti < 4; ++ti) { acc[vf][ti] = mfma16(vtf, Pop[ti][ks], acc[vf][ti]); acc[vf][ti] = mfma16(spf[vf][ks], QEop[ti][ks], acc[vf][ti]); }
                    if (ks == 1 && (vf & 1)) __builtin_amdgcn_sched_barrier(0);
                }
        } else {
#pragma unroll
            for (int ef = 0; ef < 4; ++ef) { float tt = tot[ef]; tt += __shfl_xor(tt, 16); tt += __shfl_xor(tt, 32);
                if (vh == 0 && q == 0) dec[((size_t)(dir * NCH + n) * 4 + h) * 64 + SIGC(ef, c)] = __expf(tt); }
            bf16x8 kn[4][2];
#pragma unroll
            for (int tj = 0; tj < 4; ++tj)
#pragma unroll
                for (int ks = 0; ks < 2; ++ks) kn[tj][ks] = *(const bf16x8*)(proj + (size_t)(t0 + 16 * tj + c) * DINP + 1280 + 64 * h + 32 * ks + 8 * q);
            bf16x8 ident[2];
#pragma unroll
            for (int e1 = 0; e1 < 2; ++e1)
#pragma unroll
                for (int jj = 0; jj < 8; ++jj) ident[e1][jj] = (8 * q + jj == 8 * (c >> 2) + 4 * e1 + (c & 3)) ? (short)0x3F80 : (short)0;
            bf16x8 kdop[4][2];
#pragma unroll
            for (int ks = 0; ks < 2; ++ks) {
                bf16x8 mk[2][2];
#pragma unroll
                for (int t2 = 0; t2 < 2; ++t2)
#pragma unroll
                    for (int k2 = 0; k2 < 2; ++k2)
#pragma unroll
                        for (int jj = 0; jj < 8; ++jj) { const int tp = 16 * (2 * ks + t2) + c, sidx = SLOT(k2, q, jj); const bool on = dir == 0 ? sidx > tp : sidx < tp; mk[t2][k2][jj] = on ? (short)0x3F80 : (short)0; }
#pragma unroll
                for (int ef = 0; ef < 4; ++ef) { f32x4 kd2[2];
#pragma unroll
                    for (int t2 = 0; t2 < 2; ++t2) { const int tj = 2 * ks + t2;
                        f32x4 E = mfma16(mk[t2][0], laop[ef][0], zero4); E = mfma16(mk[t2][1], laop[ef][1], E);
                        const f32x4 kR = mfma16(kn[tj][ef >> 1], ident[ef & 1], zero4);
#pragma unroll
                        for (int r = 0; r < 4; ++r) kd2[t2][r] = kR[r] * __expf(E[r]); }
                    kdop[ef][ks] = pack8(kd2[0], kd2[1]); __builtin_amdgcn_sched_barrier(0); }
            }
            bf16_t* U = uT + ((size_t)(dir * NCH + n) * 4 + h) * 8192 + (size_t)(64 * vh) * 64;
#pragma unroll
            for (int vf = 0; vf < 4; ++vf) { bf16x8 vtf[2];
#pragma unroll
                for (int ks = 0; ks < 2; ++ks) { const u32x2 v0 = *(const LAS u32x2*)(VTw + (16 * vf + c) * 72 + 32 * ks + 4 * q), v1 = *(const LAS u32x2*)(VTw + (16 * vf + c) * 72 + 32 * ks + 16 + 4 * q);
                    vtf[ks] = __builtin_bit_cast(bf16x8, (u32x4){v0.x, v0.y, v1.x, v1.y}); }
#pragma unroll
                for (int ef = 0; ef < 4; ++ef) { f32x4 u = mfma16(kdop[ef][0], vtf[0], zero4); u = mfma16(kdop[ef][1], vtf[1], u);
                    *(u32x2*)(U + (16 * vf + c) * 64 + 32 * (ef >> 1) + 8 * q + 4 * (ef & 1)) = (u32x2){cvtpk(u[0], u[1]), cvtpk(u[2], u[3])}; } }
        }
    }
    if (MODE == 1) {
        bf16x4 ggp[4][4];
#pragma unroll
        for (int ti = 0; ti < 4; ++ti)
#pragma unroll
            for (int vf = 0; vf < 4; ++vf) ggp[ti][vf] = *(const bf16x4*)(proj + (size_t)(t0 + 16 * ti + c) * DINP + 2048 + 128 * h + 64 * vh + 16 * vf + 4 * q);
#pragma unroll
        for (int ti = 0; ti < 4; ++ti) { float ss = 0.f;
#pragma unroll
            for (int vf = 0; vf < 4; ++vf) ss += acc[vf][ti][0] * acc[vf][ti][0] + acc[vf][ti][1] * acc[vf][ti][1] + acc[vf][ti][2] * acc[vf][ti][2] + acc[vf][ti][3] * acc[vf][ti][3];
            ss += __shfl_xor(ss, 16); ss += __shfl_xor(ss, 32);
            if (q == 0) SSQ[(h * 64 + 16 * ti + c) * 2 + vh] = ss; }
        __syncthreads();
        const float* gn = p.in[14] + (size_t)l * 128;
#pragma unroll
        for (int ti = 0; ti < 4; ++ti) { const int t = 16 * ti + c; const float rs = rsqrtf((SSQ[(h * 64 + t) * 2] + SSQ[(h * 64 + t) * 2 + 1]) * (1.0f / 128.0f) + EPS);
#pragma unroll
            for (int vf = 0; vf < 4; ++vf) { const int v = 64 * vh + 16 * vf + 4 * q; const f32x4 g4 = *(const f32x4*)(gn + v);
                float o[4];
#pragma unroll
                for (int r = 0; r < 4; ++r) o[r] = acc[vf][ti][r] * rs * g4[r] * siluf_(bf2f((bf16_t)ggp[ti][vf][r]));
                *(u32x2*)(y + (size_t)(t0 + t) * D + 512 + 128 * h + v) = (u32x2){cvtpk(o[0], o[1]), cvtpk(o[2], o[3])}; } }
    }
    __syncthreads();
}

__device__ void phase_scan(const Params& p) {
    unsigned char* ws = p.ws; const int tid = otid();
    if (tid < 256) {
        const bf16_t* __restrict__ uT = (const bf16_t*)(ws + WS_M); bf16_t* __restrict__ spT = (bf16_t*)(ws + WS_M + (size_t)S * D * 2); const float* __restrict__ dec = (const float*)(ws + WS_DEC);
        for (int gid = obid() * 256 + tid; gid < 65536; gid += gridDim.x * 256) {
            const int dir = gid >> 15, rem = gid & 32767, h = rem >> 13, vd = rem & 8191, d = vd & 63;
            float s = 0.f;
            const long step = dir ? -1 : 1; const int nfirst = dir ? NCH - 1 : 0;
            const bf16_t* up = uT + ((size_t)(dir * NCH + nfirst) * 4 + h) * 8192 + vd; bf16_t* sp = spT + ((size_t)(dir * NCH + nfirst) * 4 + h) * 8192 + vd;
            const float* dp = dec + ((size_t)(dir * NCH + nfirst) * 4 + h) * 64 + d;
#pragma unroll 1
            for (int st = 0; st < NCH; st += 64) {
                bf16_t ub[64]; float db[64];
#pragma unroll
                for (int i = 0; i < 64; ++i) { ub[i] = up[(long)(st + i) * step * 32768]; db[i] = dp[(long)(st + i) * step * 256]; }
#pragma unroll
                for (int i = 0; i < 64; ++i) { sp[(long)(st + i) * step * 32768] = f2bf(s); s = db[i] * s + bf2f(ub[i]); }
            }
        }
    } else if (tid < 384 && obid() < 8) {
        const float* __restrict__ Aprod = (const float*)(ws + WS_AP); const float* __restrict__ Hend = (const float*)(ws + WS_HE); float* __restrict__ carry = (float*)(ws + WS_CA);
        const int gid = obid() * 128 + (tid - 256); const int dir = gid >> 9, ch = gid & 511;
        float hc = 0.f;
        const long step = dir ? -1 : 1; const size_t base = (size_t)(dir * NCH + (dir ? NCH - 1 : 0)) * 512 + ch;
#pragma unroll 1
        for (int st = 0; st < NCH; st += 64) {
            float ab[64], hb[64];
#pragma unroll
            for (int i = 0; i < 64; ++i) { ab[i] = Aprod[base + (long)(st + i) * step * 512]; hb[i] = Hend[base + (long)(st + i) * step * 512]; }
#pragma unroll
            for (int i = 0; i < 64; ++i) { carry[base + (long)(st + i) * step * 512] = hc; hc = ab[i] * hc + hb[i]; }
        }
    }
}

#define XB_TMO      128
#define XB_XCNT(j)  (256  + 64 * (j))
#define XB_XSUB(j)  (1280 + 64 * (j))
#define XB_XGEN(j)  (2304 + 64 * (j))
#define XB_TOP      3328
#define XB_TOPGEN   3392
#define XCD_BAR_WORDS 3456
#define XB_SPIN_CAP (1u << 18)

__device__ __forceinline__ unsigned xb_ld(unsigned* p)              { return __hip_atomic_load(p, __ATOMIC_RELAXED, __HIP_MEMORY_SCOPE_AGENT); }
__device__ __forceinline__ unsigned xb_add(unsigned* p, unsigned v) { return __hip_atomic_fetch_add(p, v, __ATOMIC_RELAXED, __HIP_MEMORY_SCOPE_AGENT); }
__device__ __forceinline__ unsigned xb_xcc_id() { return (unsigned)__builtin_amdgcn_s_getreg((3 << 11) | 20) & 0xFu; }
#define XB_SPIN(cond, bar) do { unsigned _sp = 0; while (cond) { __builtin_amdgcn_s_sleep(1); \
    if ((++_sp & 255u) == 0u) { if (xb_ld(&(bar)[XB_TMO])) break; if (_sp > XB_SPIN_CAP) { atomicAdd(&(bar)[XB_TMO], 1u); break; } } } } while (0)

struct XcdBarrier {
    unsigned* bar; unsigned x;
    volatile LAS unsigned* st;
};

__device__ __forceinline__ XcdBarrier xcd_barrier_post(unsigned* bar, volatile LAS unsigned* st) {
    XcdBarrier b; b.bar = bar; b.x = xb_xcc_id(); b.st = st;
    if (threadIdx.x == 0) (void)xb_add(&bar[XB_XCNT(b.x)], 1u);
    return b;
}
__device__ __forceinline__ void xcd_barrier_complete(unsigned* bar, unsigned x, unsigned& nloc, unsigned& nx) {
    const unsigned G = gridDim.x * gridDim.y * gridDim.z;
    unsigned sum, cnt, mine, sp = 0u;
    for (;;) {
        sum = 0u; cnt = 0u; mine = 0u;
#pragma unroll
        for (unsigned j = 0; j < 16; ++j) { const unsigned c = xb_ld(&bar[XB_XCNT(j)]); sum += c; cnt += (c > 0u) ? 1u : 0u; mine = (j == x) ? c : mine; }
        if (sum == G) break;
        __builtin_amdgcn_s_sleep(1);
        if ((++sp & 255u) == 0u) { if (xb_ld(&bar[XB_TMO])) break; if (sp > XB_SPIN_CAP) { atomicAdd(&bar[XB_TMO], 1u); break; } }
    }
    nloc = mine > 0u ? mine : 1u; nx = cnt > 0u ? cnt : 1u;
}

__device__ __forceinline__ void xcd_barrier(const XcdBarrier& b) {
    asm volatile("s_waitcnt vmcnt(0)" ::: "memory");
    __syncthreads();
    if (threadIdx.x == 0) {
        unsigned* bar = b.bar;
        __builtin_amdgcn_s_waitcnt(0);
        unsigned nloc = b.st[0], nx = b.st[1];
        if (nloc == 0u) { xcd_barrier_complete(bar, b.x, nloc, nx); b.st[0] = nloc; b.st[1] = nx; }
        const unsigned old = xb_add(&bar[XB_XSUB(b.x)], 1u);
        const unsigned gen = old / nloc;
        if (old + 1u == (gen + 1u) * nloc) {
            __builtin_amdgcn_fence(__ATOMIC_RELEASE, "agent");
            asm volatile("s_waitcnt vmcnt(0)" ::: "memory");
            const unsigned og = xb_add(&bar[XB_TOP], 1u);
            const unsigned tg = og / nx;
            if (og + 1u == (tg + 1u) * nx) xb_add(&bar[XB_TOPGEN], 1u);
            else XB_SPIN(xb_ld(&bar[XB_TOPGEN]) == tg, bar);
            __builtin_amdgcn_fence(__ATOMIC_ACQUIRE, "agent");
            xb_add(&bar[XB_XGEN(b.x)], 1u);
            asm volatile("s_waitcnt vmcnt(0)" ::: "memory");
        } else {
            XB_SPIN(xb_ld(&bar[XB_XGEN(b.x)]) == gen, bar);
            __builtin_amdgcn_fence(__ATOMIC_ACQUIRE, "agent");
            asm volatile("s_waitcnt vmcnt(0)" ::: "memory");
        }
    }
    __syncthreads();
}

__global__ void __launch_bounds__(NTHR, 2) mk_fwd(Params p) {
    extern __shared__ __attribute__((aligned(16))) unsigned char lds_raw[];
    LAS unsigned char* lds = (LAS unsigned char*)lds_raw;
    unsigned char* ws = p.ws;
    bf16_t* WinT = (bf16_t*)(ws + WS_WIN); bf16_t* WoutT = (bf16_t*)(ws + WS_WOUT); bf16_t* WguT = (bf16_t*)(ws + WS_WGU); bf16_t* WdT = (bf16_t*)(ws + WS_WD);
    bf16_t* Hb = (bf16_t*)(ws + WS_H); bf16_t* PROJ = (bf16_t*)(ws + WS_PROJ); float* Mb = (float*)(ws + WS_M);
    const float* xin = p.in[0]; float* out = p.out;
    volatile LAS unsigned* bst = (volatile LAS unsigned*)(lds + LDS_BYTES - 16);
    if (threadIdx.x == 0) { bst[0] = 0u; bst[1] = 0u; }
    __syncthreads();
    XcdBarrier bar = xcd_barrier_post((unsigned*)(ws + WS_CTL), bst);
    for (int ph = p.ph_lo; ph < p.ph_hi; ++ph) {
        if (ph == p.ph_lo + 1) cg::this_grid().sync();
        else if (ph > p.ph_lo) xcd_barrier(bar);
        if (ph == 9 * NL) { phase_rowprep(out, (const bf16_t*)Mb, p.in[17] + (size_t)(NL - 1) * D, out, nullptr, nullptr); continue; }
        const int l = ph / 9, s = ph % 9;
        switch (s) {
        case 0: phase_weights(p, l, lds);
                if (l == 0) phase_rowprep(xin, nullptr, nullptr, nullptr, p.in[1], Hb);
                else phase_rowprep(out, (const bf16_t*)Mb, p.in[17] + (size_t)(l - 1) * D, out, p.in[1] + (size_t)l * D, Hb);
                break;
        case 1: gemm_fast(lds, Hb, WinT, S, DINP, D, EpiB16{PROJ, DINP}); break;
        case 2: for (int n = obid(); n < NCH; n += gridDim.x) mixer_lru<0>(p, l, n, lds);
                for (int n = obid(); n < NCH; n += gridDim.x) mixer_gla<0>(p, l, n, lds); break;
        case 3: phase_scan(p); break;
        case 4: for (int n = obid(); n < NCH; n += gridDim.x) mixer_lru<1>(p, l, n, lds);
                for (int n = obid(); n < NCH; n += gridDim.x) mixer_gla<1>(p, l, n, lds); break;
        case 5: gemm_fast(lds, Hb, WoutT, S, D, D, EpiB16{(bf16_t*)Mb, D}); break;
        case 6: phase_rowprep(l == 0 ? xin : out, (const bf16_t*)Mb, p.in[2] + (size_t)l * D, out, p.in[16] + (size_t)l * D, Hb); break;
        case 7: gemm_fast(lds, Hb, WguT, S, 2 * DFF, D, EpiSwiglu{PROJ, DFF}); break;
        case 8: gemm_fast(lds, PROJ, WdT, S, D, DFF, EpiB16{(bf16_t*)Mb, D}); break;
        }
    }
}

extern "C" void kernel_launch(void* const* d_in, const int* in_sizes, int n_in, void* d_out, int out_size, void* d_ws, size_t ws_size, hipStream_t stream) {
    static int grid = 0;
    if (grid == 0) {
        if (n_in != 21 || out_size != S * D || ws_size < WS_END) { fprintf(stderr, "kernel_launch: unexpected shapes: n_in %d out %d ws %zu (need %zu)\n", n_in, out_size, ws_size, (size_t)WS_END); grid = -1; return; }
        int dev = 0, cus = 0, per_cu = 0;
        (void)hipGetDevice(&dev); (void)hipDeviceGetAttribute(&cus, hipDeviceAttributeMultiprocessorCount, dev);
        if (hipFuncSetAttribute((const void*)mk_fwd, hipFuncAttributeMaxDynamicSharedMemorySize, LDS_BYTES) != hipSuccess) { fprintf(stderr, "kernel_launch: hipFuncSetAttribute failed\n"); grid = -1; return; }
        if (hipOccupancyMaxActiveBlocksPerMultiprocessor(&per_cu, (const void*)mk_fwd, NTHR, LDS_BYTES) != hipSuccess || per_cu < 1) { fprintf(stderr, "kernel_launch: occupancy query says %d\n", per_cu); per_cu = 1; }
        (void)hipGetLastError();
        grid = cus;
    }
    if (grid < 0) return;
    Params p{};
    for (int i = 0; i < 21; ++i) p.in[i] = (const float*)d_in[i];
    p.out = (float*)d_out; p.ws = (unsigned char*)d_ws;
    (void)hipMemsetAsync((unsigned char*)d_ws + WS_CTL, 0, 16384, stream);
#if ONE_LAUNCH
    p.ph_lo = 0; p.ph_hi = 9 * NL + 1;
    void* args[] = {&p};
    hipError_t e = hipLaunchCooperativeKernel((const void*)mk_fwd, dim3(grid), dim3(NTHR), args, LDS_BYTES, stream);
    if (e != hipSuccess) fprintf(stderr, "cooperative launch failed: %s (grid %d)\n", hipGetErrorString(e), grid);
#else
    for (int ph = 0; ph < 9 * NL + 1; ++ph) { p.ph_lo = ph; p.ph_hi = ph + 1; hipLaunchKernelGGL(mk_fwd, dim3(grid), dim3(NTHR), LDS_BYTES, stream, p); }
#endif
}
```

```cpp
#include <hip/hip_runtime.h>
#include <hip/hip_cooperative_groups.h>
#include <cstdio>
namespace cg = cooperative_groups;

#ifndef ONE_LAUNCH
#define ONE_LAUNCH 1
#endif

#define LAS __attribute__((address_space(3)))
typedef unsigned short bf16_t;
typedef short bf16x8 __attribute__((ext_vector_type(8)));
typedef short bf16x4 __attribute__((ext_vector_type(4)));
typedef float f32x4 __attribute__((ext_vector_type(4)));
typedef unsigned u32x4 __attribute__((ext_vector_type(4)));
typedef unsigned u32x2 __attribute__((ext_vector_type(2)));
typedef float f32x2 __attribute__((ext_vector_type(2)));
typedef __bf16 bf16v2 __attribute__((ext_vector_type(2)));

constexpr int S = 16384, D = 1024, DIN = 2592, DINP = 2816, DFF = 2816, NL = 4, NCH = 256;
constexpr int NTHR = 512;
constexpr int LDS_BYTES = 147456;
constexpr float EPS = 1e-6f;

constexpr size_t WS_CTL = 0;
constexpr size_t WS_WIN = 65536;
constexpr size_t WS_WOUT = WS_WIN + (size_t)DINP * D * 2;
constexpr size_t WS_WGU = WS_WOUT + (size_t)D * D * 2;
constexpr size_t WS_WD = WS_WGU + (size_t)2 * DFF * D * 2;
constexpr size_t WS_LRUW = WS_WD + (size_t)D * DFF * 2;
constexpr size_t WS_GW = WS_LRUW + (size_t)2 * 2 * 8 * 64 * 64 * 2;
constexpr size_t WS_H = WS_GW + (size_t)2 * 256 * 32 * 2;
constexpr size_t WS_PROJ = WS_H + (size_t)S * D * 2;
constexpr size_t WS_M = WS_PROJ + (size_t)S * DINP * 2;
constexpr size_t WS_AP = WS_M + (size_t)S * D * 4;
constexpr size_t WS_HE = WS_AP + (size_t)2 * NCH * 512 * 4;
constexpr size_t WS_CA = WS_HE + (size_t)2 * NCH * 512 * 4;
constexpr size_t WS_DEC = WS_CA + (size_t)2 * NCH * 512 * 4;
constexpr size_t WS_PB = WS_DEC + (size_t)2 * NCH * 4 * 64 * 4;
constexpr size_t WS_END = WS_PB + (size_t)S * 512 * 2;

struct Params { const float* in[21]; float* out; unsigned char* ws; int ph_lo, ph_hi; };

__device__ __forceinline__ float bf2f(bf16_t b) { return __uint_as_float(((unsigned)b) << 16); }
__device__ __forceinline__ bf16_t f2bf(float f) { unsigned u = __float_as_uint(f); return (bf16_t)((u + 0x7fffu + ((u >> 16) & 1u)) >> 16); }
__device__ __forceinline__ unsigned pk2(float lo, float hi) { return (unsigned)f2bf(lo) | ((unsigned)f2bf(hi) << 16); }
__device__ __forceinline__ unsigned cvtpk(float lo, float hi) { const f32x2 v = (f32x2){lo, hi}; const bf16v2 b = __builtin_convertvector(v, bf16v2); return __builtin_bit_cast(unsigned, b); }
__device__ __forceinline__ float sigmoidf_(float x) { return __builtin_amdgcn_rcpf(1.0f + __expf(-x)); }
__device__ __forceinline__ float siluf_(float x) { return x * sigmoidf_(x); }
__device__ __forceinline__ float geluf_(float x) { const float y = 0.7978845608028654f * (x + 0.044715f * x * x * x); const float t = 1.0f - 2.0f * __builtin_amdgcn_rcpf(__expf(2.0f * y) + 1.0f); return 0.5f * x * (1.0f + t); }
__device__ __forceinline__ f32x4 mfma16(bf16x8 a, bf16x8 b, f32x4 c) { return __builtin_amdgcn_mfma_f32_16x16x32_bf16(a, b, c, 0, 0, 0); }
__device__ __forceinline__ int otid() { int t = threadIdx.x; asm volatile("" : "+v"(t)); return t; }
__device__ __forceinline__ int obid() { int t = blockIdx.x; asm volatile("" : "+s"(t)); return t; }
#define LDS_FENCE() asm volatile("s_waitcnt lgkmcnt(0)" ::: "memory")

struct WDesc { const float* src; bf16_t* dst; int ldsrc, c0, nvalid, k0, lddst, r0; };
__device__ __forceinline__ WDesc wdesc(const Params& p, int l, int u) {
    unsigned char* ws = p.ws;
    constexpr int T_IN = 44 * 16, T_OUT = 16 * 16, T_GU = 88 * 16, T_D = 16 * 44;
    WDesc d; int v = u;
    if (v < T_IN) { const int rt = v / 16, kt = v % 16; int nv = DIN - rt * 64; nv = nv > 64 ? 64 : (nv < 0 ? 0 : nv);
        d.src = p.in[3] + (size_t)l * D * DIN; d.ldsrc = DIN; d.c0 = nv > 0 ? rt * 64 : 0; d.nvalid = nv; d.k0 = kt * 64; d.dst = (bf16_t*)(ws + WS_WIN); d.lddst = D; d.r0 = rt * 64; return d; }
    v -= T_IN;
    if (v < T_OUT) { const int rt = v / 16, kt = v % 16; d.src = p.in[15] + (size_t)l * D * D; d.ldsrc = D; d.c0 = rt * 64; d.nvalid = 64; d.k0 = kt * 64; d.dst = (bf16_t*)(ws + WS_WOUT); d.lddst = D; d.r0 = rt * 64; return d; }
    v -= T_OUT;
    if (v < T_GU) { const int rt = v / 16, kt = v % 16; const int r0 = rt * 64, j = r0 / 256, within = r0 % 256;
        d.src = (within < 128 ? p.in[18] : p.in[19]) + (size_t)l * D * DFF; d.ldsrc = DFF; d.c0 = j * 128 + (within & 127); d.nvalid = 64; d.k0 = kt * 64; d.dst = (bf16_t*)(ws + WS_WGU); d.lddst = D; d.r0 = r0; return d; }
    v -= T_GU;
    if (v < T_D) { const int rt = v / 44, kt = v % 44; d.src = p.in[20] + (size_t)l * DFF * D; d.ldsrc = D; d.c0 = rt * 64; d.nvalid = 64; d.k0 = kt * 64; d.dst = (bf16_t*)(ws + WS_WD); d.lddst = DFF; d.r0 = rt * 64; return d; }
    v -= T_D;
    { const int dir = v / 16, gate = (v / 8) % 2, h = v % 8; d.src = (gate ? p.in[8] : p.in[6]) + ((size_t)(l * 2 + dir) * 8 + h) * 4096; d.ldsrc = 64; d.c0 = 0; d.nvalid = 64; d.k0 = 0;
      d.dst = (bf16_t*)(ws + WS_LRUW) + ((size_t)(dir * 2 + gate) * 8 + h) * 4096; d.lddst = 64; d.r0 = 0; return d; }
}

__device__ void phase_weights(const Params& p, int l, LAS unsigned char* lds) {
    LAS float* T = (LAS float*)lds;
    unsigned char* ws = p.ws;
    constexpr int TOT = 44 * 16 + 16 * 16 + 88 * 16 + 16 * 44 + 32;
    const int tid = otid(), G = gridDim.x;
    for (int u0 = obid(); u0 < TOT; u0 += 4 * G) {
        f32x4 v[4][2];
        { const int k = tid >> 3, cg8 = (tid & 7) * 8;
#pragma unroll
          for (int j = 0; j < 4; ++j) { const int u = u0 + j * G; v[j][0] = (f32x4){0.f, 0.f, 0.f, 0.f}; v[j][1] = v[j][0];
              if (u < TOT) { const WDesc d = wdesc(p, l, u); const float* sp = d.src + (size_t)(d.k0 + k) * d.ldsrc + d.c0 + cg8;
                  if (cg8 + 3 < d.nvalid) v[j][0] = __builtin_nontemporal_load((const f32x4*)sp); if (cg8 + 7 < d.nvalid) v[j][1] = __builtin_nontemporal_load((const f32x4*)(sp + 4)); } }
#pragma unroll
          for (int j = 0; j < 4; ++j)
#pragma unroll
              for (int i = 0; i < 2; ++i) { LAS float* Tj = T + j * 4160 + k * 65 + cg8 + 4 * i; Tj[0] = v[j][i][0]; Tj[1] = v[j][i][1]; Tj[2] = v[j][i][2]; Tj[3] = v[j][i][3]; } }
        __syncthreads();
        { const int r = tid >> 3, kg = (tid & 7) * 8;
#pragma unroll
          for (int j = 0; j < 4; ++j) { const int u = u0 + j * G;
              if (u < TOT) { const WDesc d = wdesc(p, l, u); const LAS float* Tj = T + j * 4160; u32x4 w;
                  w.x = cvtpk(Tj[(kg + 0) * 65 + r], Tj[(kg + 1) * 65 + r]); w.y = cvtpk(Tj[(kg + 2) * 65 + r], Tj[(kg + 3) * 65 + r]);
                  w.z = cvtpk(Tj[(kg + 4) * 65 + r], Tj[(kg + 5) * 65 + r]); w.w = cvtpk(Tj[(kg + 6) * 65 + r], Tj[(kg + 7) * 65 + r]);
                  *(u32x4*)(d.dst + (size_t)(d.r0 + r) * d.lddst + d.k0 + kg) = w; } } }
        __syncthreads();
    }
    { bf16_t* GW = (bf16_t*)(ws + WS_GW); const float* wg = p.in[12] + (size_t)l * 2 * 16 * 256;
      for (int idx = obid() * NTHR + otid(); idx < 2 * 256 * 32; idx += gridDim.x * NTHR) { const int dir = idx >> 13, e = (idx >> 5) & 255, r = idx & 31;
          GW[idx] = r < 16 ? f2bf(wg[(size_t)(dir * 16 + r) * 256 + e]) : (bf16_t)0; } }
}

__device__ void phase_rowprep(const float* xsrc, const bf16_t* __restrict__ m, const float* __restrict__ gpost, float* xdst, const float* __restrict__ gpre, bf16_t* __restrict__ hdst) {
    const int tid = otid(); const int lane = tid & 63, wave = tid >> 6;
    const int stride = gridDim.x * 8;
    f32x4 gp[4], gq[4];
#pragma unroll
    for (int i = 0; i < 4; ++i) { gp[i] = m ? *(const f32x4*)(gpost + i * 256 + lane * 4) : (f32x4){0.f, 0.f, 0.f, 0.f}; gq[i] = hdst ? *(const f32x4*)(gpre + i * 256 + lane * 4) : (f32x4){0.f, 0.f, 0.f, 0.f}; }
    int row = obid() * 8 + wave;
    f32x4 xn[4]; bf16x4 mn[4];
    if (row < S) {
#pragma unroll
        for (int i = 0; i < 4; ++i) { xn[i] = *(const f32x4*)(xsrc + (size_t)row * D + i * 256 + lane * 4); mn[i] = m ? *(const bf16x4*)(m + (size_t)row * D + i * 256 + lane * 4) : (bf16x4){0, 0, 0, 0}; }
    }
    while (row < S) {
        f32x4 xv[4]; bf16x4 mb[4];
#pragma unroll
        for (int i = 0; i < 4; ++i) { xv[i] = xn[i]; mb[i] = mn[i]; }
        const int nrow = row + stride;
        if (nrow < S) {
#pragma unroll
            for (int i = 0; i < 4; ++i) { xn[i] = *(const f32x4*)(xsrc + (size_t)nrow * D + i * 256 + lane * 4); mn[i] = m ? *(const bf16x4*)(m + (size_t)nrow * D + i * 256 + lane * 4) : (bf16x4){0, 0, 0, 0}; }
        }
        if (m) {
            f32x4 mv[4]; float ss = 0.f;
#pragma unroll
            for (int i = 0; i < 4; ++i) { mv[i] = (f32x4){bf2f((bf16_t)mb[i][0]), bf2f((bf16_t)mb[i][1]), bf2f((bf16_t)mb[i][2]), bf2f((bf16_t)mb[i][3])}; ss += mv[i][0] * mv[i][0] + mv[i][1] * mv[i][1] + mv[i][2] * mv[i][2] + mv[i][3] * mv[i][3]; }
#pragma unroll
            for (int o = 32; o >= 1; o >>= 1) ss += __shfl_xor(ss, o);
            const float rs = rsqrtf(ss * (1.0f / D) + EPS);
#pragma unroll
            for (int i = 0; i < 4; ++i) xv[i] += mv[i] * rs * gp[i];
        }
        if (xdst) {
#pragma unroll
            for (int i = 0; i < 4; ++i) *(f32x4*)(xdst + (size_t)row * D + i * 256 + lane * 4) = xv[i];
        }
        if (hdst) {
            float ss = 0.f;
#pragma unroll
            for (int i = 0; i < 4; ++i) ss += xv[i][0] * xv[i][0] + xv[i][1] * xv[i][1] + xv[i][2] * xv[i][2] + xv[i][3] * xv[i][3];
#pragma unroll
            for (int o = 32; o >= 1; o >>= 1) ss += __shfl_xor(ss, o);
            const float rs = rsqrtf(ss * (1.0f / D) + EPS);
#pragma unroll
            for (int i = 0; i < 4; ++i) { const f32x4 hv = xv[i] * rs * gq[i]; *(u32x2*)(hdst + (size_t)row * D + i * 256 + lane * 4) = (u32x2){cvtpk(hv[0], hv[1]), cvtpk(hv[2], hv[3])}; }
        }
        row = nrow;
    }
}

namespace pg8 {
#define PG8_LAS __attribute__((address_space(3)))
constexpr int BM = 256, BK = 64, HALF = 128, HTB = HALF * BK * 2  , STAGE_BYTES = 8 * HTB, NXCD = 8, WGM = 8;
__host__ __device__ __forceinline__ int lds_byte(int r, int c) { const int st = (r >> 4) * 2 + (c >> 5), rr = r & 15, cc = c & 31, ob = rr * 64 + cc * 2; return st * 1024 + (ob ^ (((ob >> 9) & 1) << 5)); }
__host__ __device__ __forceinline__ void stage_rc(int b, int& R, int& C) { const int st = b / 1024, sb = b % 1024, swz = sb ^ (((sb >> 9) & 1) << 5); R = (st >> 1) * 16 + swz / 64; C = (st & 1) * 32 + (swz % 64) / 2; }
__host__ __device__ __forceinline__ int perm32(int rho) { const int n = rho >> 4, i = rho & 15; return 8 * (i >> 2) + 4 * n + (i & 3); }
struct Unit { int pm, pn; };
struct Gemm { const bf16_t* A; const bf16_t* Bt; int M, N, K; };
struct StaticOrder {
    int nM, nN, nwg, G, c;
    __host__ __device__ void init(int M, int N, int G_, int c_) { nM = M / BM; nN = N / BM; nwg = nM * nN; G = G_; c = c_; }
    __host__ __device__ bool next(int i, Unit& u) const {
        const long L = (long)i * G + c; if (L >= nwg) return false;
        int wgid = (int)L; { const int q = nwg / NXCD, r = nwg % NXCD, xcd = wgid % NXCD, off = wgid / NXCD; wgid = (xcd < r ? xcd * (q + 1) : r * (q + 1) + (xcd - r) * q) + off; }
        const int nig = WGM * nN, gid = wgid / nig, fm = gid * WGM, gsz = (nM - fm) < WGM ? (nM - fm) : WGM;
        u.pm = fm + ((wgid % nig) % gsz); u.pn = (wgid % nig) / gsz; return true;
    }
    __device__ __forceinline__ void a_ready(const Unit&) const {}
    __device__ __forceinline__ void done(const Unit&) const {}
};
__device__ __forceinline__ unsigned cvt_pk_bf16(float lo, float hi) { unsigned r; asm volatile("v_cvt_pk_bf16_f32 %0, %1, %2" : "=v"(r) : "v"(lo), "v"(hi)); return r; }
template <class Epi, class Sched>
__device__ __forceinline__ void gemm_phase(PG8_LAS unsigned char* lds, const Gemm g, const Sched& S, const Epi& E) {
    const int tid = otid(), wid = __builtin_amdgcn_readfirstlane(tid >> 6), lane = tid & 63, wr = wid >> 2, wc = wid & 3, fr = lane & 15, fq = lane >> 4;
    const int K = g.K, nt = K / BK;
    unsigned voffA[2], voffB[2];
#pragma unroll
    for (int i = 0; i < 2; ++i) { int R, C; stage_rc(tid * 16 + i * 8192, R, C); const int Rb = Epi::PERM ? ((R & ~31) + perm32(R & 31)) : R;
        voffA[i] = (unsigned)(R * K + C) * 2u; voffB[i] = (unsigned)(Rb * K + C) * 2u; }
    const size_t kstep = (size_t)(BK * 2);
    const size_t hstep = (size_t)HALF * K * 2;
    const size_t tstep = 2 * hstep;
    const unsigned ldsw = (unsigned)wid * 1024u;
    const int aoff = lds_byte(wr * 64 + fr, fq * 8), boff = lds_byte(wc * 32 + fr, fq * 8);
#define PG8_SA(b, h) (((b) * 2 + (h)) * HTB)
#define PG8_SB(b, h) ((4 + (b) * 2 + (h)) * HTB)
#define PG8_STAGE(bufoff, gbase, voff) do { _Pragma("unroll") for (int _i = 0; _i < 2; ++_i) \
        __builtin_amdgcn_global_load_lds((const unsigned*)((const char*)(gbase) + (voff)[_i]), (PG8_LAS unsigned*)(lds + (bufoff) + ldsw + _i * 8192), 16, 0, 0); } while (0)
#define PG8_LDA(dst, b, h) do { _Pragma("unroll") for (int m = 0; m < 4; ++m) _Pragma("unroll") for (int k = 0; k < 2; ++k) dst[m][k] = *(const PG8_LAS bf16x8*)(lds + PG8_SA(b, h) + aoff + m * 2048 + k * 1024); } while (0)
#define PG8_LDB(dst, b, h) do { _Pragma("unroll") for (int n = 0; n < 2; ++n) _Pragma("unroll") for (int k = 0; k < 2; ++k) dst[n][k] = *(const PG8_LAS bf16x8*)(lds + PG8_SB(b, h) + boff + n * 2048 + k * 1024); } while (0)
#define PG8_MMA(ai, bj, At, Bt) do { __builtin_amdgcn_s_setprio(1); _Pragma("unroll") for (int m = 0; m < 4; ++m) _Pragma("unroll") for (int n = 0; n < 2; ++n) _Pragma("unroll") for (int k = 0; k < 2; ++k) \
        acc[ai][bj][m][n] = __builtin_amdgcn_mfma_f32_16x16x32_bf16(Bt[n][k], At[m][k], acc[ai][bj][m][n], 0, 0, 0); __builtin_amdgcn_s_setprio(0); } while (0)
#define PG8_WAIT_V(n) asm volatile("s_waitcnt vmcnt(" #n ")" ::: "memory")
#define PG8_WAIT_L(n) asm volatile("s_waitcnt lgkmcnt(" #n ")" ::: "memory")
#define PG8_BAR __builtin_amdgcn_s_barrier()
#define PG8_SCHED __builtin_amdgcn_sched_barrier(0)
    Unit cur, nxt; int ui = 0;
    if (!S.next(0, cur)) return;
    f32x4 acc[2][2][4][2];
#pragma unroll
    for (int a = 0; a < 2; ++a)
#pragma unroll
        for (int b = 0; b < 2; ++b)
#pragma unroll
            for (int m = 0; m < 4; ++m)
#pragma unroll
                for (int n = 0; n < 2; ++n) acc[a][b][m][n] = (f32x4){0.f, 0.f, 0.f, 0.f};
    bf16x8 At[4][2], B0[2][2], B1[2][2];
    const char* cA = (const char*)g.A + (size_t)cur.pm * tstep; const char* cB = (const char*)g.Bt + (size_t)cur.pn * tstep;
    S.a_ready(cur);
    PG8_STAGE(PG8_SB(0, 0), cB, voffB); PG8_STAGE(PG8_SA(0, 0), cA, voffA); PG8_STAGE(PG8_SB(0, 1), cB + hstep, voffB); PG8_STAGE(PG8_SA(0, 1), cA + hstep, voffA);
    if (wr == 1) PG8_BAR;
    PG8_WAIT_V(4); PG8_BAR;
    PG8_STAGE(PG8_SB(1, 0), cB + kstep, voffB); PG8_STAGE(PG8_SA(1, 0), cA + kstep, voffA); PG8_STAGE(PG8_SB(1, 1), cB + hstep + kstep, voffB);
    PG8_WAIT_V(6); PG8_BAR;
    for (;;) {
        const bool has_next = S.next(ui + 1, nxt);
        const char* nA = has_next ? (const char*)g.A + (size_t)nxt.pm * tstep : cA; const char* nB = has_next ? (const char*)g.Bt + (size_t)nxt.pn * tstep : cB;
        for (int t = 0; t < nt; t += 2) {
            const bool last = (t == nt - 2);
            const char* a1 = cA + (size_t)(t + 1) * kstep;
            const char* a2 = last ? nA : cA + (size_t)(t + 2) * kstep; const char* b2 = last ? nB : cB + (size_t)(t + 2) * kstep;
            const char* a3 = a2 + kstep; const char* b3 = b2 + kstep;
            if (last && has_next) S.a_ready(nxt);
            PG8_LDB(B0, 0, 0); PG8_SCHED; PG8_LDA(At, 0, 0); PG8_STAGE(PG8_SA(1, 1), a1 + hstep, voffA);
            PG8_WAIT_L(8); PG8_BAR; PG8_WAIT_L(0); PG8_MMA(0, 0, At, B0); PG8_BAR; PG8_SCHED;
            PG8_LDB(B1, 0, 1); PG8_STAGE(PG8_SB(0, 0), b2, voffB);
            PG8_BAR; PG8_WAIT_L(0); PG8_MMA(0, 1, At, B1); PG8_BAR;
            PG8_LDA(At, 0, 1); PG8_STAGE(PG8_SA(0, 0), a2, voffA);
            PG8_BAR; PG8_WAIT_L(0); PG8_MMA(1, 0, At, B0); PG8_BAR; PG8_SCHED;
            PG8_STAGE(PG8_SB(0, 1), b2 + hstep, voffB);
            PG8_WAIT_V(6); PG8_BAR; PG8_MMA(1, 1, At, B1); PG8_BAR;
            PG8_LDB(B0, 1, 0); PG8_SCHED; PG8_LDA(At, 1, 0); PG8_STAGE(PG8_SA(0, 1), a2 + hstep, voffA);
            PG8_WAIT_L(8); PG8_BAR; PG8_WAIT_L(0); PG8_MMA(0, 0, At, B0); PG8_BAR; PG8_SCHED;
            PG8_LDB(B1, 1, 1); PG8_STAGE(PG8_SB(1, 0), b3, voffB);
            PG8_BAR; PG8_WAIT_L(0); PG8_MMA(0, 1, At, B1); PG8_BAR;
            PG8_LDA(At, 1, 1); PG8_STAGE(PG8_SA(1, 0), a3, voffA);
            PG8_BAR; PG8_WAIT_L(0); PG8_MMA(1, 0, At, B0); PG8_BAR; PG8_SCHED;
            PG8_STAGE(PG8_SB(1, 1), b3 + hstep, voffB);
            PG8_WAIT_V(6); PG8_BAR; PG8_MMA(1, 1, At, B1); PG8_BAR;
        }
        if constexpr (!Epi::AFTER_DRAIN) { E(acc, cur, wr, wc, fr, fq); S.done(cur); }
        if (!has_next) break;
#pragma unroll
        for (int a = 0; a < 2; ++a)
#pragma unroll
            for (int b = 0; b < 2; ++b)
#pragma unroll
                for (int m = 0; m < 4; ++m)
#pragma unroll
                    for (int n = 0; n < 2; ++n) acc[a][b][m][n] = (f32x4){0.f, 0.f, 0.f, 0.f};
        cur = nxt; cA = nA; cB = nB; ++ui;
    }
    PG8_WAIT_V(0);
    if (wr == 0) PG8_BAR;
    PG8_BAR;
    if constexpr (Epi::AFTER_DRAIN) { E.fused(acc, cur, wr, wc, fr, fq, lds, wid, lane); S.done(cur); }
#undef PG8_SA
#undef PG8_SB
#undef PG8_STAGE
#undef PG8_LDA
#undef PG8_LDB
#undef PG8_MMA
#undef PG8_WAIT_V
#undef PG8_WAIT_L
#undef PG8_BAR
#undef PG8_SCHED
}
}

struct EpiB16 {
    static constexpr bool PERM = true, AFTER_DRAIN = false;
    bf16_t* O; int ldc;
    __device__ __forceinline__ void operator()(const f32x4 (&acc)[2][2][4][2], const pg8::Unit& u, int wr, int wc, int fr, int fq) const {
        const int row0 = u.pm * 256 + wr * 64 + fr, col0 = u.pn * 256 + wc * 32 + 8 * fq;
#pragma unroll
        for (int ai = 0; ai < 2; ++ai)
#pragma unroll
            for (int m = 0; m < 4; ++m) { bf16_t* rowp = O + (size_t)(row0 + ai * 128 + m * 16) * ldc + col0;
#pragma unroll
                for (int bj = 0; bj < 2; ++bj) { const f32x4 v0 = acc[ai][bj][m][0], v1 = acc[ai][bj][m][1];
                    u32x4 w; w.x = cvtpk(v0[0], v0[1]); w.y = cvtpk(v0[2], v0[3]); w.z = cvtpk(v1[0], v1[1]); w.w = cvtpk(v1[2], v1[3]);
                    *(u32x4*)(rowp + bj * 128) = w; } }
    }
};
struct EpiSwiglu {
    static constexpr bool PERM = true, AFTER_DRAIN = false;
    bf16_t* O; int ldc;
    __device__ __forceinline__ void operator()(const f32x4 (&acc)[2][2][4][2], const pg8::Unit& u, int wr, int wc, int fr, int fq) const {
        const int row0 = u.pm * 256 + wr * 64 + fr, col0 = u.pn * 128 + wc * 32 + 8 * fq;
#pragma unroll
        for (int ai = 0; ai < 2; ++ai)
#pragma unroll
            for (int m = 0; m < 4; ++m) { bf16_t* rowp = O + (size_t)(row0 + ai * 128 + m * 16) * ldc + col0;
                const f32x4 g0 = acc[ai][0][m][0], g1 = acc[ai][0][m][1], u0 = acc[ai][1][m][0], u1 = acc[ai][1][m][1];
                u32x4 w; w.x = cvtpk(siluf_(g0[0]) * u0[0], siluf_(g0[1]) * u0[1]); w.y = cvtpk(siluf_(g0[2]) * u0[2], siluf_(g0[3]) * u0[3]);
                w.z = cvtpk(siluf_(g1[0]) * u1[0], siluf_(g1[1]) * u1[1]); w.w = cvtpk(siluf_(g1[2]) * u1[2], siluf_(g1[3]) * u1[3]);
                *(u32x4*)rowp = w; }
    }
};
template <class Epi> __device__ __forceinline__ void gemm_fast(LAS unsigned char* lds, const bf16_t* A, const bf16_t* Bt, int M, int N, int K, const Epi& E) {
    pg8::Gemm g; g.A = A; g.Bt = Bt; g.M = M; g.N = N; g.K = K;
    pg8::StaticOrder so; so.init(M, N, (int)gridDim.x, obid());
    pg8::gemm_phase<Epi, pg8::StaticOrder>(lds, g, so, E);
    __syncthreads();
}

template <int DIR> __device__ __forceinline__ void lru_dir(const Params& p, int l, int n, int h, int lane, LAS bf16_t* XC, LAS float* STA, LAS float* STU) {
    const int c = lane & 15, q = lane >> 4, j = lane, t0 = n * 64;
    unsigned char* ws = p.ws;
    bf16_t* y = (bf16_t*)(ws + WS_H); bf16_t* PB = (bf16_t*)(ws + WS_PB);
    const bf16_t* LW = (const bf16_t*)(ws + WS_LRUW);
    float* Aprod = (float*)(ws + WS_AP); float* Hend = (float*)(ws + WS_HE);
    const float* lam = p.in[10] + (size_t)(l * 2 + DIR) * 512 + 64 * h; const float* b_a = p.in[7] + (size_t)(l * 2 + DIR) * 512 + 64 * h; const float* b_x = p.in[9] + (size_t)(l * 2 + DIR) * 512 + 64 * h;
    const bf16_t* LWa = LW + ((size_t)(DIR * 2 + 0) * 8 + h) * 4096 + c * 64 + 8 * q; const bf16_t* LWx = LW + ((size_t)(DIR * 2 + 1) * 8 + h) * 4096 + c * 64 + 8 * q;
    bf16x8 wa[4][2], wx[4][2]; f32x4 sp4[4], ba4[4], bx4[4];
#pragma unroll
    for (int nf = 0; nf < 4; ++nf) {
#pragma unroll
        for (int ks = 0; ks < 2; ++ks) { wa[nf][ks] = *(const bf16x8*)(LWa + nf * 1024 + 32 * ks); wx[nf][ks] = *(const bf16x8*)(LWx + nf * 1024 + 32 * ks); }
        const f32x4 lam4 = *(const f32x4*)(lam + 16 * nf + 4 * q); ba4[nf] = *(const f32x4*)(b_a + 16 * nf + 4 * q); bx4[nf] = *(const f32x4*)(b_x + 16 * nf + 4 * q);
#pragma unroll
        for (int r = 0; r < 4; ++r) { const float e = __expf(-lam4[r]); const float l1p = e < 0.05f ? e * (1.0f - e * (0.5f - e * (0.33333334f - e * 0.25f))) : __logf(1.0f + e); sp4[nf][r] = -8.0f * l1p; }
    }
    float hcar = 0.f, P = 1.f;
#pragma unroll 1
    for (int g = 0; g < 4; ++g) {
        const int mi = DIR == 0 ? g : 3 - g;
        bf16_t hfp[16];
        if (DIR == 1) {
#pragma unroll
            for (int s = 0; s < 16; ++s) hfp[s] = y[(size_t)(t0 + 16 * mi + s) * D + 64 * h + j];
        }
        bf16x8 xf[2];
#pragma unroll
        for (int ks = 0; ks < 2; ++ks) xf[ks] = *(const LAS bf16x8*)(XC + (16 * mi + c) * 520 + 64 * h + 32 * ks + 8 * q);
        f32x4 za[4], zx[4];
#pragma unroll
        for (int nf = 0; nf < 4; ++nf) { za[nf] = (f32x4){0.f, 0.f, 0.f, 0.f}; zx[nf] = za[nf];
            za[nf] = mfma16(wa[nf][0], xf[0], za[nf]); za[nf] = mfma16(wa[nf][1], xf[1], za[nf]);
            zx[nf] = mfma16(wx[nf][0], xf[0], zx[nf]); zx[nf] = mfma16(wx[nf][1], xf[1], zx[nf]); }
#pragma unroll
        for (int nf = 0; nf < 4; ++nf) {
            const int jo = 16 * nf + 4 * q;
            const bf16x4 xc4 = *(const LAS bf16x4*)(XC + (16 * mi + c) * 520 + 64 * h + jo);
            const f32x4 zav = za[nf] + ba4[nf], zxv = zx[nf] + bx4[nf];
            f32x4 av, uv;
#pragma unroll
            for (int r = 0; r < 4; ++r) {
                const float ra = sigmoidf_(zav[r]), ix = sigmoidf_(zxv[r]);
                const float la = ra * sp4[nf][r];
                av[r] = __expf(la);
                const float x2 = 2.0f * la;
                const float om = -x2 * (1.0f + x2 * (0.5f + x2 * (0.16666667f + x2 * (0.041666668f + x2 * (0.0083333338f + x2 * (0.0013888889f + x2 * 0.0001984127f))))));
                uv[r] = bf2f((bf16_t)xc4[r]) * ix * __builtin_amdgcn_sqrtf(fmaxf(om, 0.f));
            }
            *(LAS f32x4*)(STA + c * 68 + jo) = av; *(LAS f32x4*)(STU + c * 68 + jo) = uv;
        }
        LDS_FENCE();
        float aa[16], uu[16];
#pragma unroll
        for (int s = 0; s < 16; ++s) { aa[s] = STA[s * 68 + j]; uu[s] = STU[s * 68 + j]; }
        LDS_FENCE();
#pragma unroll
        for (int s = 0; s < 16; ++s) {
            const int tl = DIR == 0 ? s : 15 - s;
            hcar = aa[tl] * hcar + uu[tl]; P *= aa[tl];
            const size_t row = (size_t)(t0 + 16 * mi + tl);
            if (DIR == 0) { const unsigned w = cvtpk(hcar, P); y[row * D + 64 * h + j] = (bf16_t)(w & 0xffffu); y[row * D + 512 + 64 * h + j] = (bf16_t)(w >> 16); }
            else { const unsigned w = cvtpk(bf2f(hfp[tl]) + hcar, P); y[row * D + 64 * h + j] = (bf16_t)(w & 0xffffu); PB[row * 512 + 64 * h + j] = (bf16_t)(w >> 16); }
        }
    }
    Aprod[(size_t)(DIR * NCH + n) * 512 + 64 * h + j] = P; Hend[(size_t)(DIR * NCH + n) * 512 + 64 * h + j] = hcar;
}

template <int MODE> __device__ void mixer_lru(const Params& p, int l, int n, LAS unsigned char* lds) {
    const int tid = otid(), lane = tid & 63, wave = tid >> 6;
    unsigned char* ws = p.ws;
    const bf16_t* proj = (const bf16_t*)(ws + WS_PROJ); bf16_t* y = (bf16_t*)(ws + WS_H);
    LAS bf16_t* XC = (LAS bf16_t*)lds;
    const int t0 = n * 64;
    if (MODE == 0) {
        LAS float* STA = (LAS float*)(lds + 66560 + wave * 8704);
        LAS float* STU = STA + 16 * 68;
        {
            const int ch = tid;
            const float cw0 = p.in[4][(size_t)(l * 4 + 0) * 512 + ch], cw1 = p.in[4][(size_t)(l * 4 + 1) * 512 + ch], cw2 = p.in[4][(size_t)(l * 4 + 2) * 512 + ch], cw3 = p.in[4][(size_t)(l * 4 + 3) * 512 + ch];
            const float cb = p.in[5][(size_t)l * 512 + ch];
            bf16_t xs[67];
#pragma unroll
            for (int i = 0; i < 67; ++i) { const int s_ = t0 - 2 + i; const int sc = s_ < 0 ? 0 : (s_ >= S ? S - 1 : s_); const bf16_t v = proj[(size_t)sc * DINP + ch]; xs[i] = s_ == sc ? v : (bf16_t)0; }
#pragma unroll
            for (int t = 0; t < 64; ++t) { const float xc = cb + cw0 * bf2f(xs[t]) + cw1 * bf2f(xs[t + 1]) + cw2 * bf2f(xs[t + 2]) + cw3 * bf2f(xs[t + 3]); XC[t * 520 + ch] = f2bf(xc); }
        }
        __syncthreads();
        lru_dir<0>(p, l, n, wave, lane, XC, STA, STU);
        lru_dir<1>(p, l, n, wave, lane, XC, STA, STU);
        __syncthreads();
    } else {
        const bf16_t* PB = (const bf16_t*)(ws + WS_PB); const float* carry = (const float*)(ws + WS_CA);
        const int ch0 = 8 * lane;
        const float* cfp = carry + (size_t)(0 * NCH + n) * 512 + ch0; const float* cbp = carry + (size_t)(1 * NCH + n) * 512 + ch0; const float* gnp = p.in[11] + (size_t)l * 512 + ch0;
        const f32x4 cf0 = *(const f32x4*)cfp, cf1 = *(const f32x4*)(cfp + 4), cb0 = *(const f32x4*)cbp, cb1 = *(const f32x4*)(cbp + 4), g0 = *(const f32x4*)gnp, g1 = *(const f32x4*)(gnp + 4);
        const float cf[8] = {cf0[0], cf0[1], cf0[2], cf0[3], cf1[0], cf1[1], cf1[2], cf1[3]}, cb[8] = {cb0[0], cb0[1], cb0[2], cb0[3], cb1[0], cb1[1], cb1[2], cb1[3]};
        const float gg[8] = {g0[0], g0[1], g0[2], g0[3], g1[0], g1[1], g1[2], g1[3]};
        {
            bf16x8 h0[8], pf[8], pb[8], gt[8];
#pragma unroll
            for (int i = 0; i < 8; ++i) { const size_t row = (size_t)(t0 + wave * 8 + i);
                h0[i] = *(const bf16x8*)(y + row * D + ch0); pf[i] = *(const bf16x8*)(y + row * D + 512 + ch0); pb[i] = *(const bf16x8*)(PB + row * 512 + ch0); gt[i] = *(const bf16x8*)(proj + row * DINP + 512 + ch0); }
#pragma unroll
            for (int i = 0; i < 8; ++i) { const size_t row = (size_t)(t0 + wave * 8 + i);
                float v[8]; float ss = 0.f;
#pragma unroll
                for (int k = 0; k < 8; ++k) { v[k] = (bf2f((bf16_t)h0[i][k]) + bf2f((bf16_t)pf[i][k]) * cf[k] + bf2f((bf16_t)pb[i][k]) * cb[k]) * geluf_(bf2f((bf16_t)gt[i][k])); ss += v[k] * v[k]; }
#pragma unroll
                for (int o = 32; o >= 1; o >>= 1) ss += __shfl_xor(ss, o);
                const float rs = rsqrtf(ss * (1.0f / 512.0f) + EPS);
                *(u32x4*)(y + row * D + ch0) = (u32x4){cvtpk(v[0] * rs * gg[0], v[1] * rs * gg[1]), cvtpk(v[2] * rs * gg[2], v[3] * rs * gg[3]), cvtpk(v[4] * rs * gg[4], v[5] * rs * gg[5]), cvtpk(v[6] * rs * gg[6], v[7] * rs * gg[7])}; }
        }
        __syncthreads();
    }
}

__device__ __forceinline__ bf16x8 pack8(const f32x4 a, const f32x4 b) {
    const u32x4 w = (u32x4){cvtpk(a[0], a[1]), cvtpk(a[2], a[3]), cvtpk(b[0], b[1]), cvtpk(b[2], b[3])}; return __builtin_bit_cast(bf16x8, w); }
#define SIGC(ef, c) (32 * ((ef) >> 1) + 8 * ((c) >> 2) + 4 * ((ef) & 1) + ((c) & 3))
#define SLOT(ks, q, jj) (32 * (ks) + 16 * ((jj) >> 2) + 4 * (q) + ((jj) & 3))

template <int MODE> __device__ void mixer_gla(const Params& p, int l, int n, LAS unsigned char* lds) {
    const int tid = otid(), lane = tid & 63, wave = tid >> 6, c = lane & 15, q = lane >> 4;
    const int h = wave >> 1, vh = wave & 1;
    unsigned char* ws = p.ws;
    const bf16_t* proj = (const bf16_t*)(ws + WS_PROJ); bf16_t* y = (bf16_t*)(ws + WS_H); const bf16_t* GW = (const bf16_t*)(ws + WS_GW);
    bf16_t* uT = (bf16_t*)(ws + WS_M); const bf16_t* spT = (const bf16_t*)(ws + WS_M + (size_t)S * D * 2); float* dec = (float*)(ws + WS_DEC);
    LAS bf16_t* VTw = (LAS bf16_t*)(lds + 66560 + wave * 9216);
    LAS float* SSQ = (LAS float*)(lds + 66560 + 8 * 9216);
    const int t0 = n * 64;
    const f32x4 zero4 = (f32x4){0.f, 0.f, 0.f, 0.f};
    {
        bf16x8 vn[4][2], identv[2];
#pragma unroll
        for (int tt = 0; tt < 4; ++tt)
#pragma unroll
            for (int kv = 0; kv < 2; ++kv) vn[tt][kv] = *(const bf16x8*)(proj + (size_t)(t0 + 16 * tt + c) * DINP + 1536 + 128 * h + 64 * vh + 32 * kv + 8 * q);
#pragma unroll
        for (int e1 = 0; e1 < 2; ++e1)
#pragma unroll
            for (int jj = 0; jj < 8; ++jj) identv[e1][jj] = (8 * q + jj == 16 * e1 + c) ? (short)0x3F80 : (short)0;
#pragma unroll
        for (int vf = 0; vf < 4; ++vf)
#pragma unroll
            for (int tt = 0; tt < 4; ++tt) { const f32x4 d = mfma16(vn[tt][vf >> 1], identv[vf & 1], zero4);
                *(LAS u32x2*)(VTw + (16 * vf + c) * 72 + 16 * tt + 4 * q) = (u32x2){cvtpk(d[0], d[1]), cvtpk(d[2], d[3])}; }
    }
    LDS_FENCE();
    f32x4 acc[4][4];
#pragma unroll
    for (int a = 0; a < 4; ++a)
#pragma unroll
        for (int b = 0; b < 4; ++b) acc[a][b] = zero4;
#pragma unroll 1
    for (int dir = 0; dir < 2; ++dir) {
        bf16x8 laop[4][2]; float tot[4];
        {
            bf16x8 lrf[4], gwf[4]; float bgv[4];
#pragma unroll
            for (int tt = 0; tt < 4; ++tt) { lrf[tt] = (bf16x8){0, 0, 0, 0, 0, 0, 0, 0}; if (q < 2) lrf[tt] = *(const bf16x8*)(proj + (size_t)(t0 + 16 * tt + c) * DINP + 2560 + dir * 16 + 8 * q); }
#pragma unroll
            for (int ef = 0; ef < 4; ++ef) { gwf[ef] = *(const bf16x8*)(GW + (size_t)(dir * 256 + 64 * h + SIGC(ef, c)) * 32 + 8 * q); bgv[ef] = p.in[13][(size_t)(l * 2 + dir) * 256 + 64 * h + SIGC(ef, c)]; }
#pragma unroll
            for (int ef = 0; ef < 4; ++ef) { tot[ef] = 0.f;
#pragma unroll
                for (int ks = 0; ks < 2; ++ks) { f32x4 la2[2];
#pragma unroll
                    for (int t2 = 0; t2 < 2; ++t2) { const f32x4 z = mfma16(lrf[2 * ks + t2], gwf[ef], zero4);
#pragma unroll
                        for (int r = 0; r < 4; ++r) { const float zz = z[r] + bgv[ef]; const float la = (fminf(zz, 0.f) - __logf(1.0f + __expf(-fabsf(zz)))) * (1.0f / 16.0f); la2[t2][r] = la; tot[ef] += la; } }
                    laop[ef][ks] = pack8(la2[0], la2[1]); __builtin_amdgcn_sched_barrier(0); } }
        }
        if (MODE == 1) {
            bf16x8 QEop[4][2], KEop[4][2];
            bf16x8 qn[4][2], kn1[4][2];
#pragma unroll
            for (int tj = 0; tj < 4; ++tj)
#pragma unroll
                for (int ks = 0; ks < 2; ++ks) { const bf16_t* rp = proj + (size_t)(t0 + 16 * tj + c) * DINP + 64 * h + 32 * ks + 8 * q; qn[tj][ks] = *(const bf16x8*)(rp + 1024); kn1[tj][ks] = *(const bf16x8*)(rp + 1280); }
            __builtin_amdgcn_sched_barrier(0);
#pragma unroll
            for (int tj = 0; tj < 4; ++tj) {
                const int t = 16 * tj + c;
                bf16x8 mk[2];
#pragma unroll
                for (int ks = 0; ks < 2; ++ks)
#pragma unroll
                    for (int jj = 0; jj < 8; ++jj) { const int sidx = SLOT(ks, q, jj); const bool on = dir == 0 ? sidx <= t : sidx >= t; mk[ks][jj] = on ? (short)0x3F80 : (short)0; }
#pragma unroll
                for (int ks2 = 0; ks2 < 2; ++ks2) { f32x4 qe2[2], ke2[2];
#pragma unroll
                    for (int e2 = 0; e2 < 2; ++e2) { const int ef = 2 * ks2 + e2;
                        f32x4 b = mfma16(laop[ef][0], mk[0], zero4); b = mfma16(laop[ef][1], mk[1], b);
#pragma unroll
                        for (int r = 0; r < 4; ++r) { qe2[e2][r] = bf2f((bf16_t)qn[tj][ks2][4 * e2 + r]) * 0.125f * __expf(b[r]); ke2[e2][r] = bf2f((bf16_t)kn1[tj][ks2][4 * e2 + r]) * __expf(-b[r]); } }
                    QEop[tj][ks2] = pack8(qe2[0], qe2[1]); KEop[tj][ks2] = pack8(ke2[0], ke2[1]); }
                __builtin_amdgcn_sched_barrier(0);
            }
            const bf16_t* SP = spT + ((size_t)(dir * NCH + n) * 4 + h) * 8192 + (size_t)(64 * vh) * 64;
            bf16x8 spf[4][2];
#pragma unroll
            for (int vf = 0; vf < 4; ++vf)
#pragma unroll
                for (int ks = 0; ks < 2; ++ks) spf[vf][ks] = *(const bf16x8*)(SP + (16 * vf + c) * 64 + 32 * ks + 8 * q);
            __builtin_amdgcn_sched_barrier(0);
            bf16x8 Pop[4][2];
#pragma unroll
            for (int ti = 0; ti < 4; ++ti)
#pragma unroll
                for (int ksp = 0; ksp < 2; ++ksp) { f32x4 pm[2];
#pragma unroll
                    for (int j2 = 0; j2 < 2; ++j2) { const int tjj = 2 * ksp + j2;
                        f32x4 sc = mfma16(KEop[tjj][0], QEop[ti][0], zero4); sc = mfma16(KEop[tjj][1], QEop[ti][1], sc);
#pragma unroll
                        for (int r = 0; r < 4; ++r) { const int j = 16 * tjj + 4 * q + r, i = 16 * ti + c; const bool keep = dir == 0 ? j <= i : j >= i; pm[j2][r] = keep ? sc[r] : 0.f; } }
                    Pop[ti][ksp] = pack8(pm[0], pm[1]); __builtin_amdgcn_sched_barrier(0); }
#pragma unroll
            for (int vf = 0; vf < 4; ++vf)
#pragma unroll
                for (int ks = 0; ks < 2; ++ks) {
                    const u32x2 v0 = *(const LAS u32x2*)(VTw + (16 * vf + c) * 72 + 32 * ks + 4 * q), v1 = *(const LAS u32x2*)(VTw + (16 * vf + c) * 72 + 32 * ks + 16 + 4 * q);
                    const bf16x8 vtf = __builtin_bit_cast(bf16x8, (u32x4){v0.x, v0.y, v1.x, v1.y});
#pragma unroll
                    for (int ti = 0; ti < 4; ++ti) { acc[vf][ti] = mfma16(vtf, Pop[ti][ks], acc[vf][ti]); acc[vf][ti] = mfma16(spf[vf][ks], QEop[ti][ks], acc[vf][ti]); }
                    if (ks == 1 && (vf & 1)) __builtin_amdgcn_sched_barrier(0);
                }
        } else {
#pragma unroll
            for (int ef = 0; ef < 4; ++ef) { float tt = tot[ef]; tt += __shfl_xor(tt, 16); tt += __shfl_xor(tt, 32);
                if (vh == 0 && q == 0) dec[((size_t)(dir * NCH + n) * 4 + h) * 64 + SIGC(ef, c)] = __expf(tt); }
            bf16x8 kn[4][2];
#pragma unroll
            for (int tj = 0; tj < 4; ++tj)
#pragma unroll
                for (int ks = 0; ks < 2; ++ks) kn[tj][ks] = *(const bf16x8*)(proj + (size_t)(t0 + 16 * tj + c) * DINP + 1280 + 64 * h + 32 * ks + 8 * q);
            bf16x8 ident[2];
#pragma unroll
            for (int e1 = 0; e1 < 2; ++e1)
#pragma unroll
                for (int jj = 0; jj < 8; ++jj) ident[e1][jj] = (8 * q + jj == 8 * (c >> 2) + 4 * e1 + (c & 3)) ? (short)0x3F80 : (short)0;
            bf16x8 kdop[4][2];
#pragma unroll
            for (int ks = 0; ks < 2; ++ks) {
                bf16x8 mk[2][2];
#pragma unroll
                for (int t2 = 0; t2 < 2; ++t2)
#pragma unroll
                    for (int k2 = 0; k2 < 2; ++k2)
#pragma unroll
                        for (int jj = 0; jj < 8; ++jj) { const int tp = 16 * (2 * ks + t2) + c, sidx = SLOT(k2, q, jj); const bool on = dir == 0 ? sidx > tp : sidx < tp; mk[t2][k2][jj] = on ? (short)0x3F80 : (short)0; }
#pragma unroll
                for (int ef = 0; ef < 4; ++ef) { f32x4 kd2[2];
#pragma unroll
                    for (int t2 = 0; t2 < 2; ++t2) { const int tj = 2 * ks + t2;
                        f32x4 E = mfma16(mk[t2][0], laop[ef][0], zero4); E = mfma16(mk[t2][1], laop[ef][1], E);
                        const f32x4 kR = mfma16(kn[tj][ef >> 1], ident[ef & 1], zero4);
#pragma unroll
                        for (int r = 0; r < 4; ++r) kd2[t2][r] = kR[r] * __expf(E[r]); }
                    kdop[ef][ks] = pack8(kd2[0], kd2[1]); __builtin_amdgcn_sched_barrier(0); }
            }
            bf16_t* U = uT + ((size_t)(dir * NCH + n) * 4 + h) * 8192 + (size_t)(64 * vh) * 64;
#pragma unroll
            for (int vf = 0; vf < 4; ++vf) { bf16x8 vtf[2];
#pragma unroll
                for (int ks = 0; ks < 2; ++ks) { const u32x2 v0 = *(const LAS u32x2*)(VTw + (16 * vf + c) * 72 + 32 * ks + 4 * q), v1 = *(const LAS u32x2*)(VTw + (16 * vf + c) * 72 + 32 * ks + 16 + 4 * q);
                    vtf[ks] = __builtin_bit_cast(bf16x8, (u32x4){v0.x, v0.y, v1.x, v1.y}); }
#pragma unroll
                for (int ef = 0; ef < 4; ++ef) { f32x4 u = mfma16(kdop[ef][0], vtf[0], zero4); u = mfma16(kdop[ef][1], vtf[1], u);
                    *(u32x2*)(U + (16 * vf + c) * 64 + 32 * (ef >> 1) + 8 * q + 4 * (ef & 1)) = (u32x2){cvtpk(u[0], u[1]), cvtpk(u[2], u[3])}; } }
        }
    }
    if (MODE == 1) {
        bf16x4 ggp[4][4];
#pragma unroll
        for (int ti = 0; ti < 4; ++ti)
#pragma unroll
            for (int vf = 0; vf < 4; ++vf) ggp[ti][vf] = *(const bf16x4*)(proj + (size_t)(t0 + 16 * ti + c) * DINP + 2048 + 128 * h + 64 * vh + 16 * vf + 4 * q);
#pragma unroll
        for (int ti = 0; ti < 4; ++ti) { float ss = 0.f;
#pragma unroll
            for (int vf = 0; vf < 4; ++vf) ss += acc[vf][ti][0] * acc[vf][ti][0] + acc[vf][ti][1] * acc[vf][ti][1] + acc[vf][ti][2] * acc[vf][ti][2] + acc[vf][ti][3] * acc[vf][ti][3];
            ss += __shfl_xor(ss, 16); ss += __shfl_xor(ss, 32);
            if (q == 0) SSQ[(h * 64 + 16 * ti + c) * 2 + vh] = ss; }
        __syncthreads();
        const float* gn = p.in[14] + (size_t)l * 128;
#pragma unroll
        for (int ti = 0; ti < 4; ++ti) { const int t = 16 * ti + c; const float rs = rsqrtf((SSQ[(h * 64 + t) * 2] + SSQ[(h * 64 + t) * 2 + 1]) * (1.0f / 128.0f) + EPS);
#pragma unroll
            for (int vf = 0; vf < 4; ++vf) { const int v = 64 * vh + 16 * vf + 4 * q; const f32x4 g4 = *(const f32x4*)(gn + v);
                float o[4];
#pragma unroll
                for (int r = 0; r < 4; ++r) o[r] = acc[vf][ti][r] * rs * g4[r] * siluf_(bf2f((bf16_t)ggp[ti][vf][r]));
                *(u32x2*)(y + (size_t)(t0 + t) * D + 512 + 128 * h + v) = (u32x2){cvtpk(o[0], o[1]), cvtpk(o[2], o[3])}; } }
    }
    __syncthreads();
}

__device__ void phase_scan(const Params& p) {
    unsigned char* ws = p.ws; const int tid = otid();
    if (tid < 256) {
        const bf16_t* __restrict__ uT = (const bf16_t*)(ws + WS_M); bf16_t* __restrict__ spT = (bf16_t*)(ws + WS_M + (size_t)S * D * 2); const float* __restrict__ dec = (const float*)(ws + WS_DEC);
        for (int gid = obid() * 256 + tid; gid < 65536; gid += gridDim.x * 256) {
            const int dir = gid >> 15, rem = gid & 32767, h = rem >> 13, vd = rem & 8191, d = vd & 63;
            float s = 0.f;
            const long step = dir ? -1 : 1; const int nfirst = dir ? NCH - 1 : 0;
            const bf16_t* up = uT + ((size_t)(dir * NCH + nfirst) * 4 + h) * 8192 + vd; bf16_t* sp = spT + ((size_t)(dir * NCH + nfirst) * 4 + h) * 8192 + vd;
            const float* dp = dec + ((size_t)(dir * NCH + nfirst) * 4 + h) * 64 + d;
#pragma unroll 1
            for (int st = 0; st < NCH; st += 64) {
                bf16_t ub[64]; float db[64];
#pragma unroll
                for (int i = 0; i < 64; ++i) { ub[i] = up[(long)(st + i) * step * 32768]; db[i] = dp[(long)(st + i) * step * 256]; }
#pragma unroll
                for (int i = 0; i < 64; ++i) { sp[(long)(st + i) * step * 32768] = f2bf(s); s = db[i] * s + bf2f(ub[i]); }
            }
        }
    } else if (tid < 384 && obid() < 8) {
        const float* __restrict__ Aprod = (const float*)(ws + WS_AP); const float* __restrict__ Hend = (const float*)(ws + WS_HE); float* __restrict__ carry = (float*)(ws + WS_CA);
        const int gid = obid() * 128 + (tid - 256); const int dir = gid >> 9, ch = gid & 511;
        float hc = 0.f;
        const long step = dir ? -1 : 1; const size_t base = (size_t)(dir * NCH + (dir ? NCH - 1 : 0)) * 512 + ch;
#pragma unroll 1
        for (int st = 0; st < NCH; st += 64) {
            float ab[64], hb[64];
#pragma unroll
            for (int i = 0; i < 64; ++i) { ab[i] = Aprod[base + (long)(st + i) * step * 512]; hb[i] = Hend[base + (long)(st + i) * step * 512]; }
#pragma unroll
            for (int i = 0; i < 64; ++i) { carry[base + (long)(st + i) * step * 512] = hc; hc = ab[i] * hc + hb[i]; }
        }
    }
}

#define XB_TMO      128
#define XB_XCNT(j)  (256  + 64 * (j))
#define XB_XSUB(j)  (1280 + 64 * (j))
#define XB_XGEN(j)  (2304 + 64 * (j))
#define XB_TOP      3328
#define XB_TOPGEN   3392
#define XCD_BAR_WORDS 3456
#define XB_SPIN_CAP (1u << 18)

__device__ __forceinline__ unsigned xb_ld(unsigned* p)              { return __hip_atomic_load(p, __ATOMIC_RELAXED, __HIP_MEMORY_SCOPE_AGENT); }
__device__ __forceinline__ unsigned xb_add(unsigned* p, unsigned v) { return __hip_atomic_fetch_add(p, v, __ATOMIC_RELAXED, __HIP_MEMORY_SCOPE_AGENT); }
__device__ __forceinline__ unsigned xb_xcc_id() { return (unsigned)__builtin_amdgcn_s_getreg((3 << 11) | 20) & 0xFu; }
#define XB_SPIN(cond, bar) do { unsigned _sp = 0; while (cond) { __builtin_amdgcn_s_sleep(1); \
    if ((++_sp & 255u) == 0u) { if (xb_ld(&(bar)[XB_TMO])) break; if (_sp > XB_SPIN_CAP) { atomicAdd(&(bar)[XB_TMO], 1u); break; } } } } while (0)

struct XcdBarrier {
    unsigned* bar; unsigned x;
    volatile LAS unsigned* st;
};

__device__ __forceinline__ XcdBarrier xcd_barrier_post(unsigned* bar, volatile LAS unsigned* st) {
    XcdBarrier b; b.bar = bar; b.x = xb_xcc_id(); b.st = st;
    if (threadIdx.x == 0) (void)xb_add(&bar[XB_XCNT(b.x)], 1u);
    return b;
}
__device__ __forceinline__ void xcd_barrier_complete(unsigned* bar, unsigned x, unsigned& nloc, unsigned& nx) {
    const unsigned G = gridDim.x * gridDim.y * gridDim.z;
    unsigned sum, cnt, mine, sp = 0u;
    for (;;) {
        sum = 0u; cnt = 0u; mine = 0u;
#pragma unroll
        for (unsigned j = 0; j < 16; ++j) { const unsigned c = xb_ld(&bar[XB_XCNT(j)]); sum += c; cnt += (c > 0u) ? 1u : 0u; mine = (j == x) ? c : mine; }
        if (sum == G) break;
        __builtin_amdgcn_s_sleep(1);
        if ((++sp & 255u) == 0u) { if (xb_ld(&bar[XB_TMO])) break; if (sp > XB_SPIN_CAP) { atomicAdd(&bar[XB_TMO], 1u); break; } }
    }
    nloc = mine > 0u ? mine : 1u; nx = cnt > 0u ? cnt : 1u;
}

__device__ __forceinline__ void xcd_barrier(const XcdBarrier& b) {
    asm volatile("s_waitcnt vmcnt(0)" ::: "memory");
    __syncthreads();
    if (threadIdx.x == 0) {
        unsigned* bar = b.bar;
        __builtin_amdgcn_s_waitcnt(0);
        unsigned nloc = b.st[0], nx = b.st[1];
        if (nloc == 0u) { xcd_barrier_complete(bar, b.x, nloc, nx); b.st[0] = nloc; b.st[1] = nx; }
        const unsigned old = xb_add(&bar[XB_XSUB(b.x)], 1u);
        const unsigned gen = old / nloc;
        if (old + 1u == (gen + 1u) * nloc) {
            __builtin_amdgcn_fence(__ATOMIC_RELEASE, "agent");
            asm volatile("s_waitcnt vmcnt(0)" ::: "memory");
            const unsigned og = xb_add(&bar[XB_TOP], 1u);
            const unsigned tg = og / nx;
            if (og + 1u == (tg + 1u) * nx) xb_add(&bar[XB_TOPGEN], 1u);
            else XB_SPIN(xb_ld(&bar[XB_TOPGEN]) == tg, bar);
            __builtin_amdgcn_fence(__ATOMIC_ACQUIRE, "agent");
            xb_add(&bar[XB_XGEN(b.x)], 1u);
            asm volatile("s_waitcnt vmcnt(0)" ::: "memory");
        } else {
            XB_SPIN(xb_ld(&bar[XB_XGEN(b.x)]) == gen, bar);
            __builtin_amdgcn_fence(__ATOMIC_ACQUIRE, "agent");
            asm volatile("s_waitcnt vmcnt(0)" ::: "memory");
        }
    }
    __syncthreads();
}

__global__ void __launch_bounds__(NTHR, 2) mk_fwd(Params p) {
    extern __shared__ __attribute__((aligned(16))) unsigned char lds_raw[];
    LAS unsigned char* lds = (LAS unsigned char*)lds_raw;
    unsigned char* ws = p.ws;
    bf16_t* WinT = (bf16_t*)(ws + WS_WIN); bf16_t* WoutT = (bf16_t*)(ws + WS_WOUT); bf16_t* WguT = (bf16_t*)(ws + WS_WGU); bf16_t* WdT = (bf16_t*)(ws + WS_WD);
    bf16_t* Hb = (bf16_t*)(ws + WS_H); bf16_t* PROJ = (bf16_t*)(ws + WS_PROJ); float* Mb = (float*)(ws + WS_M);
    const float* xin = p.in[0]; float* out = p.out;
    volatile LAS unsigned* bst = (volatile LAS unsigned*)(lds + LDS_BYTES - 16);
    if (threadIdx.x == 0) { bst[0] = 0u; bst[1] = 0u; }
    __syncthreads();
    XcdBarrier bar = xcd_barrier_post((unsigned*)(ws + WS_CTL), bst);
    for (int ph = p.ph_lo; ph < p.ph_hi; ++ph) {
        if (ph == p.ph_lo + 1) cg::this_grid().sync();
        else if (ph > p.ph_lo) xcd_barrier(bar);
        if (ph == 9 * NL) { phase_rowprep(out, (const bf16_t*)Mb, p.in[17] + (size_t)(NL - 1) * D, out, nullptr, nullptr); continue; }
        const int l = ph / 9, s = ph % 9;
        switch (s) {
        case 0: phase_weights(p, l, lds);
                if (l == 0) phase_rowprep(xin, nullptr, nullptr, nullptr, p.in[1], Hb);
                else phase_rowprep(out, (const bf16_t*)Mb, p.in[17] + (size_t)(l - 1) * D, out, p.in[1] + (size_t)l * D, Hb);
                break;
        case 1: gemm_fast(lds, Hb, WinT, S, DINP, D, EpiB16{PROJ, DINP}); break;
        case 2: for (int n = obid(); n < NCH; n += gridDim.x) mixer_lru<0>(p, l, n, lds);
                for (int n = obid(); n < NCH; n += gridDim.x) mixer_gla<0>(p, l, n, lds); break;
        case 3: phase_scan(p); break;
        case 4: for (int n = obid(); n < NCH; n += gridDim.x) mixer_lru<1>(p, l, n, lds);
                for (int n = obid(); n < NCH; n += gridDim.x) mixer_gla<1>(p, l, n, lds); break;
        case 5: gemm_fast(lds, Hb, WoutT, S, D, D, EpiB16{(bf16_t*)Mb, D}); break;
        case 6: phase_rowprep(l == 0 ? xin : out, (const bf16_t*)Mb, p.in[2] + (size_t)l * D, out, p.in[16] + (size_t)l * D, Hb); break;
        case 7: gemm_fast(lds, Hb, WguT, S, 2 * DFF, D, EpiSwiglu{PROJ, DFF}); break;
        case 8: gemm_fast(lds, PROJ, WdT, S, D, DFF, EpiB16{(bf16_t*)Mb, D}); break;
        }
    }
}

extern "C" void kernel_launch(void* const* d_in, const int* in_sizes, int n_in, void* d_out, int out_size, void* d_ws, size_t ws_size, hipStream_t stream) {
    static int grid = 0;
    if (grid == 0) {
        if (n_in != 21 || out_size != S * D || ws_size < WS_END) { fprintf(stderr, "kernel_launch: unexpected shapes: n_in %d out %d ws %zu (need %zu)\n", n_in, out_size, ws_size, (size_t)WS_END); grid = -1; return; }
        int dev = 0, cus = 0, per_cu = 0;
        (void)hipGetDevice(&dev); (void)hipDeviceGetAttribute(&cus, hipDeviceAttributeMultiprocessorCount, dev);
        if (hipFuncSetAttribute((const void*)mk_fwd, hipFuncAttributeMaxDynamicSharedMemorySize, LDS_BYTES) != hipSuccess) { fprintf(stderr, "kernel_launch: hipFuncSetAttribute failed\n"); grid = -1; return; }
        if (hipOccupancyMaxActiveBlocksPerMultiprocessor(&per_cu, (const void*)mk_fwd, NTHR, LDS_BYTES) != hipSuccess || per_cu < 1) { fprintf(stderr, "kernel_launch: occupancy query says %d\n", per_cu); per_cu = 1; }
        (void)hipGetLastError();
        grid = cus;
    }
    if (grid < 0) return;
    Params p{};
    for (int i = 0; i < 21; ++i) p.in[i] = (const float*)d_in[i];
    p.out = (float*)d_out; p.ws = (unsigned char*)d_ws;
    (void)hipMemsetAsync((unsigned char*)d_ws + WS_CTL, 0, 16384, stream);
#if ONE_LAUNCH
    p.ph_lo = 0; p.ph_hi = 9 * NL + 1;
    void* args[] = {&p};
    hipError_t e = hipLaunchCooperativeKernel((const void*)mk_fwd, dim3(grid), dim3(NTHR), args, LDS_BYTES, stream);
    if (e != hipSuccess) fprintf(stderr, "cooperative launch failed: %s (grid %d)\n", hipGetErrorString(e), grid);
#else
    for (int ph = 0; ph < 9 * NL + 1; ++ph) { p.ph_lo = ph; p.ph_hi = ph + 1; hipLaunchKernelGGL(mk_fwd, dim3(grid), dim3(NTHR), LDS_BYTES, stream, p); }
#endif
}
```

```cpp
#include <hip/hip_runtime.h>
#include <hip/hip_cooperative_groups.h>
#include <cstdio>
namespace cg = cooperative_groups;

#ifndef ONE_LAUNCH
#define ONE_LAUNCH 1
#endif

#define LAS __attribute__((address_space(3)))
typedef unsigned short bf16_t;
typedef short bf16x8 __attribute__((ext_vector_type(8)));
typedef short bf16x4 __attribute__((ext_vector_type(4)));
typedef float f32x4 __attribute__((ext_vector_type(4)));
typedef unsigned u32x4 __attribute__((ext_vector_type(4)));
typedef unsigned u32x2 __attribute__((ext_vector_type(2)));
typedef float f32x2 __attribute__((ext_vector_type(2)));
typedef __bf16 bf16v2 __attribute__((ext_vector_type(2)));

constexpr int S = 16384, D = 1024, DIN = 2592, DINP = 2816, DFF = 2816, NL = 4, NCH = 256;
constexpr int NTHR = 512;
constexpr int LDS_BYTES = 147456;
constexpr float EPS = 1e-6f;

constexpr size_t WS_CTL = 0;
constexpr size_t WS_WIN = 65536;
constexpr size_t WS_WOUT = WS_WIN + (size_t)DINP * D * 2;
constexpr size_t WS_WGU = WS_WOUT + (size_t)D * D * 2;
constexpr size_t WS_WD = WS_WGU + (size_t)2 * DFF * D * 2;
constexpr size_t WS_LRUW = WS_WD + (size_t)D * DFF * 2;
constexpr size_t WS_GW = WS_LRUW + (size_t)2 * 2 * 8 * 64 * 64 * 2;
constexpr size_t WS_H = WS_GW + (size_t)2 * 256 * 32 * 2;
constexpr size_t WS_PROJ = WS_H + (size_t)S * D * 2;
constexpr size_t WS_M = WS_PROJ + (size_t)S * DINP * 2;
constexpr size_t WS_AP = WS_M + (size_t)S * D * 4;
constexpr size_t WS_HE = WS_AP + (size_t)2 * NCH * 512 * 4;
constexpr size_t WS_CA = WS_HE + (size_t)2 * NCH * 512 * 4;
constexpr size_t WS_DEC = WS_CA + (size_t)2 * NCH * 512 * 4;
constexpr size_t WS_PB = WS_DEC + (size_t)2 * NCH * 4 * 64 * 4;
constexpr size_t WS_END = WS_PB + (size_t)S * 512 * 2;

struct Params { const float* in[21]; float* out; unsigned char* ws; int ph_lo, ph_hi; };

__device__ __forceinline__ float bf2f(bf16_t b) { return __uint_as_float(((unsigned)b) << 16); }
__device__ __forceinline__ bf16_t f2bf(float f) { unsigned u = __float_as_uint(f); return (bf16_t)((u + 0x7fffu + ((u >> 16) & 1u)) >> 16); }
__device__ __forceinline__ unsigned pk2(float lo, float hi) { return (unsigned)f2bf(lo) | ((unsigned)f2bf(hi) << 16); }
__device__ __forceinline__ unsigned cvtpk(float lo, float hi) { const f32x2 v = (f32x2){lo, hi}; const bf16v2 b = __builtin_convertvector(v, bf16v2); return __builtin_bit_cast(unsigned, b); }
__device__ __forceinline__ float sigmoidf_(float x) { return __builtin_amdgcn_rcpf(1.0f + __expf(-x)); }
__device__ __forceinline__ float siluf_(float x) { return x * sigmoidf_(x); }
__device__ __forceinline__ float geluf_(float x) { const float y = 0.7978845608028654f * (x + 0.044715f * x * x * x); const float t = 1.0f - 2.0f * __builtin_amdgcn_rcpf(__expf(2.0f * y) + 1.0f); return 0.5f * x * (1.0f + t); }
__device__ __forceinline__ f32x4 mfma16(bf16x8 a, bf16x8 b, f32x4 c) { return __builtin_amdgcn_mfma_f32_16x16x32_bf16(a, b, c, 0, 0, 0); }
__device__ __forceinline__ int otid() { int t = threadIdx.x; asm volatile("" : "+v"(t)); return t; }
__device__ __forceinline__ int obid() { int t = blockIdx.x; asm volatile("" : "+s"(t)); return t; }
#define LDS_FENCE() asm volatile("s_waitcnt lgkmcnt(0)" ::: "memory")

struct WDesc { const float* src; bf16_t* dst; int ldsrc, c0, nvalid, k0, lddst, r0; };
__device__ __forceinline__ WDesc wdesc(const Params& p, int l, int u) {
    unsigned char* ws = p.ws;
    constexpr int T_IN = 44 * 16, T_OUT = 16 * 16, T_GU = 88 * 16, T_D = 16 * 44;
    WDesc d; int v = u;
    if (v < T_IN) { const int rt = v / 16, kt = v % 16; int nv = DIN - rt * 64; nv = nv > 64 ? 64 : (nv < 0 ? 0 : nv);
        d.src = p.in[3] + (size_t)l * D * DIN; d.ldsrc = DIN; d.c0 = nv > 0 ? rt * 64 : 0; d.nvalid = nv; d.k0 = kt * 64; d.dst = (bf16_t*)(ws + WS_WIN); d.lddst = D; d.r0 = rt * 64; return d; }
    v -= T_IN;
    if (v < T_OUT) { const int rt = v / 16, kt = v % 16; d.src = p.in[15] + (size_t)l * D * D; d.ldsrc = D; d.c0 = rt * 64; d.nvalid = 64; d.k0 = kt * 64; d.dst = (bf16_t*)(ws + WS_WOUT); d.lddst = D; d.r0 = rt * 64; return d; }
    v -= T_OUT;
    if (v < T_GU) { const int rt = v / 16, kt = v % 16; const int r0 = rt * 64, j = r0 / 256, within = r0 % 256;
        d.src = (within < 128 ? p.in[18] : p.in[19]) + (size_t)l * D * DFF; d.ldsrc = DFF; d.c0 = j * 128 + (within & 127); d.nvalid = 64; d.k0 = kt * 64; d.dst = (bf16_t*)(ws + WS_WGU); d.lddst = D; d.r0 = r0; return d; }
    v -= T_GU;
    if (v < T_D) { const int rt = v / 44, kt = v % 44; d.src = p.in[20] + (size_t)l * DFF * D; d.ldsrc = D; d.c0 = rt * 64; d.nvalid = 64; d.k0 = kt * 64; d.dst = (bf16_t*)(ws + WS_WD); d.lddst = DFF; d.r0 = rt * 64; return d; }
    v -= T_D;
    { const int dir = v / 16, gate = (v / 8) % 2, h = v % 8; d.src = (gate ? p.in[8] : p.in[6]) + ((size_t)(l * 2 + dir) * 8 + h) * 4096; d.ldsrc = 64; d.c0 = 0; d.nvalid = 64; d.k0 = 0;
      d.dst = (bf16_t*)(ws + WS_LRUW) + ((size_t)(dir * 2 + gate) * 8 + h) * 4096; d.lddst = 64; d.r0 = 0; return d; }
}

__device__ void phase_weights(const Params& p, int l, LAS unsigned char* lds) {
    LAS float* T = (LAS float*)lds;
    unsigned char* ws = p.ws;
    constexpr int TOT = 44 * 16 + 16 * 16 + 88 * 16 + 16 * 44 + 32;
    const int tid = otid(), G = gridDim.x;
    for (int u0 = obid(); u0 < TOT; u0 += 4 * G) {
        f32x4 v[4][2];
        { const int k = tid >> 3, cg8 = (tid & 7) * 8;
#pragma unroll
          for (int j = 0; j < 4; ++j) { const int u = u0 + j * G; v[j][0] = (f32x4){0.f, 0.f, 0.f, 0.f}; v[j][1] = v[j][0];
              if (u < TOT) { const WDesc d = wdesc(p, l, u); const float* sp = d.src + (size_t)(d.k0 + k) * d.ldsrc + d.c0 + cg8;
                  if (cg8 + 3 < d.nvalid) v[j][0] = __builtin_nontemporal_load((const f32x4*)sp); if (cg8 + 7 < d.nvalid) v[j][1] = __builtin_nontemporal_load((const f32x4*)(sp + 4)); } }
#pragma unroll
          for (int j = 0; j < 4; ++j)
#pragma unroll
              for (int i = 0; i < 2; ++i) { LAS float* Tj = T + j * 4160 + k * 65 + cg8 + 4 * i; Tj[0] = v[j][i][0]; Tj[1] = v[j][i][1]; Tj[2] = v[j][i][2]; Tj[3] = v[j][i][3]; } }
        __syncthreads();
        { const int r = tid >> 3, kg = (tid & 7) * 8;
#pragma unroll
          for (int j = 0; j < 4; ++j) { const int u = u0 + j * G;
              if (u < TOT) { const WDesc d = wdesc(p, l, u); const LAS float* Tj = T + j * 4160; u32x4 w;
                  w.x = cvtpk(Tj[(kg + 0) * 65 + r], Tj[(kg + 1) * 65 + r]); w.y = cvtpk(Tj[(kg + 2) * 65 + r], Tj[(kg + 3) * 65 + r]);
                  w.z = cvtpk(Tj[(kg + 4) * 65 + r], Tj[(kg + 5) * 65 + r]); w.w = cvtpk(Tj[(kg + 6) * 65 + r], Tj[(kg + 7) * 65 + r]);
                  *(u32x4*)(d.dst + (size_t)(d.r0 + r) * d.lddst + d.k0 + kg) = w; } } }
        __syncthreads();
    }
    { bf16_t* GW = (bf16_t*)(ws + WS_GW); const float* wg = p.in[12] + (size_t)l * 2 * 16 * 256;
      for (int idx = obid() * NTHR + otid(); idx < 2 * 256 * 32; idx += gridDim.x * NTHR) { const int dir = idx >> 13, e = (idx >> 5) & 255, r = idx & 31;
          GW[idx] = r < 16 ? f2bf(wg[(size_t)(dir * 16 + r) * 256 + e]) : (bf16_t)0; } }
}

__device__ void phase_rowprep(const float* xsrc, const bf16_t* __restrict__ m, const float* __restrict__ gpost, float* xdst, const float* __restrict__ gpre, bf16_t* __restrict__ hdst) {
    const int tid = otid(); const int lane = tid & 63, wave = tid >> 6;
    const int stride = gridDim.x * 8;
    f32x4 gp[4], gq[4];
#pragma unroll
    for (int i = 0; i < 4; ++i) { gp[i] = m ? *(const f32x4*)(gpost + i * 256 + lane * 4) : (f32x4){0.f, 0.f, 0.f, 0.f}; gq[i] = hdst ? *(const f32x4*)(gpre + i * 256 + lane * 4) : (f32x4){0.f, 0.f, 0.f, 0.f}; }
    int row = obid() * 8 + wave;
    f32x4 xn[4]; bf16x4 mn[4];
    if (row < S) {
#pragma unroll
        for (int i = 0; i < 4; ++i) { xn[i] = *(const f32x4*)(xsrc + (size_t)row * D + i * 256 + lane * 4); mn[i] = m ? *(const bf16x4*)(m + (size_t)row * D + i * 256 + lane * 4) : (bf16x4){0, 0, 0, 0}; }
    }
    while (row < S) {
        f32x4 xv[4]; bf16x4 mb[4];
#pragma unroll
        for (int i = 0; i < 4; ++i) { xv[i] = xn[i]; mb[i] = mn[i]; }
        const int nrow = row + stride;
        if (nrow < S) {
#pragma unroll
            for (int i = 0; i < 4; ++i) { xn[i] = *(const f32x4*)(xsrc + (size_t)nrow * D + i * 256 + lane * 4); mn[i] = m ? *(const bf16x4*)(m + (size_t)nrow * D + i * 256 + lane * 4) : (bf16x4){0, 0, 0, 0}; }
        }
        if (m) {
            f32x4 mv[4]; float ss = 0.f;
#pragma unroll
            for (int i = 0; i < 4; ++i) { mv[i] = (f32x4){bf2f((bf16_t)mb[i][0]), bf2f((bf16_t)mb[i][1]), bf2f((bf16_t)mb[i][2]), bf2f((bf16_t)mb[i][3])}; ss += mv[i][0] * mv[i][0] + mv[i][1] * mv[i][1] + mv[i][2] * mv[i][2] + mv[i][3] * mv[i][3]; }
#pragma unroll
            for (int o = 32; o >= 1; o >>= 1) ss += __shfl_xor(ss, o);
            const float rs = rsqrtf(ss * (1.0f / D) + EPS);
#pragma unroll
            for (int i = 0; i < 4; ++i) xv[i] += mv[i] * rs * gp[i];
        }
        if (xdst) {
#pragma unroll
            for (int i = 0; i < 4; ++i) __builtin_nontemporal_store(xv[i], (f32x4*)(xdst + (size_t)row * D + i * 256 + lane * 4));
        }
        if (hdst) {
            float ss = 0.f;
#pragma unroll
            for (int i = 0; i < 4; ++i) ss += xv[i][0] * xv[i][0] + xv[i][1] * xv[i][1] + xv[i][2] * xv[i][2] + xv[i][3] * xv[i][3];
#pragma unroll
            for (int o = 32; o >= 1; o >>= 1) ss += __shfl_xor(ss, o);
            const float rs = rsqrtf(ss * (1.0f / D) + EPS);
#pragma unroll
            for (int i = 0; i < 4; ++i) { const f32x4 hv = xv[i] * rs * gq[i]; *(u32x2*)(hdst + (size_t)row * D + i * 256 + lane * 4) = (u32x2){cvtpk(hv[0], hv[1]), cvtpk(hv[2], hv[3])}; }
        }
        row = nrow;
    }
}

namespace pg8 {
#define PG8_LAS __attribute__((address_space(3)))
constexpr int BM = 256, BK = 64, HALF = 128, HTB = HALF * BK * 2  , STAGE_BYTES = 8 * HTB, NXCD = 8, WGM = 8;
__host__ __device__ __forceinline__ int lds_byte(int r, int c) { const int st = (r >> 4) * 2 + (c >> 5), rr = r & 15, cc = c & 31, ob = rr * 64 + cc * 2; return st * 1024 + (ob ^ (((ob >> 9) & 1) << 5)); }
__host__ __device__ __forceinline__ void stage_rc(int b, int& R, int& C) { const int st = b / 1024, sb = b % 1024, swz = sb ^ (((sb >> 9) & 1) << 5); R = (st >> 1) * 16 + swz / 64; C = (st & 1) * 32 + (swz % 64) / 2; }
__host__ __device__ __forceinline__ int perm32(int rho) { const int n = rho >> 4, i = rho & 15; return 8 * (i >> 2) + 4 * n + (i & 3); }
struct Unit { int pm, pn; };
struct Gemm { const bf16_t* A; const bf16_t* Bt; int M, N, K; };
struct StaticOrder {
    int nM, nN, nwg, G, c;
    __host__ __device__ void init(int M, int N, int G_, int c_) { nM = M / BM; nN = N / BM; nwg = nM * nN; G = G_; c = c_; }
    __host__ __device__ bool next(int i, Unit& u) const {
        const long L = (long)i * G + c; if (L >= nwg) return false;
        int wgid = (int)L; { const int q = nwg / NXCD, r = nwg % NXCD, xcd = wgid % NXCD, off = wgid / NXCD; wgid = (xcd < r ? xcd * (q + 1) : r * (q + 1) + (xcd - r) * q) + off; }
        const int nig = WGM * nN, gid = wgid / nig, fm = gid * WGM, gsz = (nM - fm) < WGM ? (nM - fm) : WGM;
        u.pm = fm + ((wgid % nig) % gsz); u.pn = (wgid % nig) / gsz; return true;
    }
    __device__ __forceinline__ void a_ready(const Unit&) const {}
    __device__ __forceinline__ void done(const Unit&) const {}
};
__device__ __forceinline__ unsigned cvt_pk_bf16(float lo, float hi) { unsigned r; asm volatile("v_cvt_pk_bf16_f32 %0, %1, %2" : "=v"(r) : "v"(lo), "v"(hi)); return r; }
template <class Epi, class Sched>
__device__ __forceinline__ void gemm_phase(PG8_LAS unsigned char* lds, const Gemm g, const Sched& S, const Epi& E) {
    const int tid = otid(), wid = __builtin_amdgcn_readfirstlane(tid >> 6), lane = tid & 63, wr = wid >> 2, wc = wid & 3, fr = lane & 15, fq = lane >> 4;
    const int K = g.K, nt = K / BK;
    unsigned voffA[2], voffB[2];
#pragma unroll
    for (int i = 0; i < 2; ++i) { int R, C; stage_rc(tid * 16 + i * 8192, R, C); const int Rb = Epi::PERM ? ((R & ~31) + perm32(R & 31)) : R;
        voffA[i] = (unsigned)(R * K + C) * 2u; voffB[i] = (unsigned)(Rb * K + C) * 2u; }
    const size_t kstep = (size_t)(BK * 2);
    const size_t hstep = (size_t)HALF * K * 2;
    const size_t tstep = 2 * hstep;
    const unsigned ldsw = (unsigned)wid * 1024u;
    const int aoff = lds_byte(wr * 64 + fr, fq * 8), boff = lds_byte(wc * 32 + fr, fq * 8);
#define PG8_SA(b, h) (((b) * 2 + (h)) * HTB)
#define PG8_SB(b, h) ((4 + (b) * 2 + (h)) * HTB)
#define PG8_STAGE(bufoff, gbase, voff) do { _Pragma("unroll") for (int _i = 0; _i < 2; ++_i) \
        __builtin_amdgcn_global_load_lds((const unsigned*)((const char*)(gbase) + (voff)[_i]), (PG8_LAS unsigned*)(lds + (bufoff) + ldsw + _i * 8192), 16, 0, 0); } while (0)
#define PG8_LDA(dst, b, h) do { _Pragma("unroll") for (int m = 0; m < 4; ++m) _Pragma("unroll") for (int k = 0; k < 2; ++k) dst[m][k] = *(const PG8_LAS bf16x8*)(lds + PG8_SA(b, h) + aoff + m * 2048 + k * 1024); } while (0)
#define PG8_LDB(dst, b, h) do { _Pragma("unroll") for (int n = 0; n < 2; ++n) _Pragma("unroll") for (int k = 0; k < 2; ++k) dst[n][k] = *(const PG8_LAS bf16x8*)(lds + PG8_SB(b, h) + boff + n * 2048 + k * 1024); } while (0)
#define PG8_MMA(ai, bj, At, Bt) do { __builtin_amdgcn_s_setprio(1); _Pragma("unroll") for (int m = 0; m < 4; ++m) _Pragma("unroll") for (int n = 0; n < 2; ++n) _Pragma("unroll") for (int k = 0; k < 2; ++k) \
        acc[ai][bj][m][n] = __builtin_amdgcn_mfma_f32_16x16x32_bf16(Bt[n][k], At[m][k], acc[ai][bj][m][n], 0, 0, 0); __builtin_amdgcn_s_setprio(0); } while (0)
#define PG8_WAIT_V(n) asm volatile("s_waitcnt vmcnt(" #n ")" ::: "memory")
#define PG8_WAIT_L(n) asm volatile("s_waitcnt lgkmcnt(" #n ")" ::: "memory")
#define PG8_BAR __builtin_amdgcn_s_barrier()
#define PG8_SCHED __builtin_amdgcn_sched_barrier(0)
    Unit cur, nxt; int ui = 0;
    if (!S.next(0, cur)) return;
    f32x4 acc[2][2][4][2];
#pragma unroll
    for (int a = 0; a < 2; ++a)
#pragma unroll
        for (int b = 0; b < 2; ++b)
#pragma unroll
            for (int m = 0; m < 4; ++m)
#pragma unroll
                for (int n = 0; n < 2; ++n) acc[a][b][m][n] = (f32x4){0.f, 0.f, 0.f, 0.f};
    bf16x8 At[4][2], B0[2][2], B1[2][2];
    const char* cA = (const char*)g.A + (size_t)cur.pm * tstep; const char* cB = (const char*)g.Bt + (size_t)cur.pn * tstep;
    S.a_ready(cur);
    PG8_STAGE(PG8_SB(0, 0), cB, voffB); PG8_STAGE(PG8_SA(0, 0), cA, voffA); PG8_STAGE(PG8_SB(0, 1), cB + hstep, voffB); PG8_STAGE(PG8_SA(0, 1), cA + hstep, voffA);
    if (wr == 1) PG8_BAR;
    PG8_WAIT_V(4); PG8_BAR;
    PG8_STAGE(PG8_SB(1, 0), cB + kstep, voffB); PG8_STAGE(PG8_SA(1, 0), cA + kstep, voffA); PG8_STAGE(PG8_SB(1, 1), cB + hstep + kstep, voffB);
    PG8_WAIT_V(6); PG8_BAR;
    for (;;) {
        const bool has_next = S.next(ui + 1, nxt);
        const char* nA = has_next ? (const char*)g.A + (size_t)nxt.pm * tstep : cA; const char* nB = has_next ? (const char*)g.Bt + (size_t)nxt.pn * tstep : cB;
        for (int t = 0; t < nt; t += 2) {
            const bool last = (t == nt - 2);
            const char* a1 = cA + (size_t)(t + 1) * kstep;
            const char* a2 = last ? nA : cA + (size_t)(t + 2) * kstep; const char* b2 = last ? nB : cB + (size_t)(t + 2) * kstep;
            const char* a3 = a2 + kstep; const char* b3 = b2 + kstep;
            if (last && has_next) S.a_ready(nxt);
            PG8_LDB(B0, 0, 0); PG8_SCHED; PG8_LDA(At, 0, 0); PG8_STAGE(PG8_SA(1, 1), a1 + hstep, voffA);
            PG8_WAIT_L(8); PG8_BAR; PG8_WAIT_L(0); PG8_MMA(0, 0, At, B0); PG8_BAR; PG8_SCHED;
            PG8_LDB(B1, 0, 1); PG8_STAGE(PG8_SB(0, 0), b2, voffB);
            PG8_BAR; PG8_WAIT_L(0); PG8_MMA(0, 1, At, B1); PG8_BAR;
            PG8_LDA(At, 0, 1); PG8_STAGE(PG8_SA(0, 0), a2, voffA);
            PG8_BAR; PG8_WAIT_L(0); PG8_MMA(1, 0, At, B0); PG8_BAR; PG8_SCHED;
            PG8_STAGE(PG8_SB(0, 1), b2 + hstep, voffB);
            PG8_WAIT_V(6); PG8_BAR; PG8_MMA(1, 1, At, B1); PG8_BAR;
            PG8_LDB(B0, 1, 0); PG8_SCHED; PG8_LDA(At, 1, 0); PG8_STAGE(PG8_SA(0, 1), a2 + hstep, voffA);
            PG8_WAIT_L(8); PG8_BAR; PG8_WAIT_L(0); PG8_MMA(0, 0, At, B0); PG8_BAR; PG8_SCHED;
            PG8_LDB(B1, 1, 1); PG8_STAGE(PG8_SB(1, 0), b3, voffB);
            PG8_BAR; PG8_WAIT_L(0); PG8_MMA(0, 1, At, B1); PG8_BAR;
            PG8_LDA(At, 1, 1); PG8_STAGE(PG8_SA(1, 0), a3, voffA);
            PG8_BAR; PG8_WAIT_L(0); PG8_MMA(1, 0, At, B0); PG8_BAR; PG8_SCHED;
            PG8_STAGE(PG8_SB(1, 1), b3 + hstep, voffB);
            PG8_WAIT_V(6); PG8_BAR; PG8_MMA(1, 1, At, B1); PG8_BAR;
        }
        if constexpr (!Epi::AFTER_DRAIN) { E(acc, cur, wr, wc, fr, fq); S.done(cur); }
        if (!has_next) break;
#pragma unroll
        for (int a = 0; a < 2; ++a)
#pragma unroll
            for (int b = 0; b < 2; ++b)
#pragma unroll
                for (int m = 0; m < 4; ++m)
#pragma unroll
                    for (int n = 0; n < 2; ++n) acc[a][b][m][n] = (f32x4){0.f, 0.f, 0.f, 0.f};
        cur = nxt; cA = nA; cB = nB; ++ui;
    }
    PG8_WAIT_V(0);
    if (wr == 0) PG8_BAR;
    PG8_BAR;
    if constexpr (Epi::AFTER_DRAIN) { E.fused(acc, cur, wr, wc, fr, fq, lds, wid, lane); S.done(cur); }
#undef PG8_SA
#undef PG8_SB
#undef PG8_STAGE
#undef PG8_LDA
#undef PG8_LDB
#undef PG8_MMA
#undef PG8_WAIT_V
#undef PG8_WAIT_L
#undef PG8_BAR
#undef PG8_SCHED
}
}

struct EpiB16 {
    static constexpr bool PERM = true, AFTER_DRAIN = false;
    bf16_t* O; int ldc;
    __device__ __forceinline__ void operator()(const f32x4 (&acc)[2][2][4][2], const pg8::Unit& u, int wr, int wc, int fr, int fq) const {
        const int row0 = u.pm * 256 + wr * 64 + fr, col0 = u.pn * 256 + wc * 32 + 8 * fq;
#pragma unroll
        for (int ai = 0; ai < 2; ++ai)
#pragma unroll
            for (int m = 0; m < 4; ++m) { bf16_t* rowp = O + (size_t)(row0 + ai * 128 + m * 16) * ldc + col0;
#pragma unroll
                for (int bj = 0; bj < 2; ++bj) { const f32x4 v0 = acc[ai][bj][m][0], v1 = acc[ai][bj][m][1];
                    u32x4 w; w.x = cvtpk(v0[0], v0[1]); w.y = cvtpk(v0[2], v0[3]); w.z = cvtpk(v1[0], v1[1]); w.w = cvtpk(v1[2], v1[3]);
                    *(u32x4*)(rowp + bj * 128) = w; } }
    }
};
struct EpiSwiglu {
    static constexpr bool PERM = true, AFTER_DRAIN = false;
    bf16_t* O; int ldc;
    __device__ __forceinline__ void operator()(const f32x4 (&acc)[2][2][4][2], const pg8::Unit& u, int wr, int wc, int fr, int fq) const {
        const int row0 = u.pm * 256 + wr * 64 + fr, col0 = u.pn * 128 + wc * 32 + 8 * fq;
#pragma unroll
        for (int ai = 0; ai < 2; ++ai)
#pragma unroll
            for (int m = 0; m < 4; ++m) { bf16_t* rowp = O + (size_t)(row0 + ai * 128 + m * 16) * ldc + col0;
                const f32x4 g0 = acc[ai][0][m][0], g1 = acc[ai][0][m][1], u0 = acc[ai][1][m][0], u1 = acc[ai][1][m][1];
                u32x4 w; w.x = cvtpk(siluf_(g0[0]) * u0[0], siluf_(g0[1]) * u0[1]); w.y = cvtpk(siluf_(g0[2]) * u0[2], siluf_(g0[3]) * u0[3]);
                w.z = cvtpk(siluf_(g1[0]) * u1[0], siluf_(g1[1]) * u1[1]); w.w = cvtpk(siluf_(g1[2]) * u1[2], siluf_(g1[3]) * u1[3]);
                *(u32x4*)rowp = w; }
    }
};
template <class Epi> __device__ __forceinline__ void gemm_fast(LAS unsigned char* lds, const bf16_t* A, const bf16_t* Bt, int M, int N, int K, const Epi& E) {
    pg8::Gemm g; g.A = A; g.Bt = Bt; g.M = M; g.N = N; g.K = K;
    pg8::StaticOrder so; so.init(M, N, (int)gridDim.x, obid());
    pg8::gemm_phase<Epi, pg8::StaticOrder>(lds, g, so, E);
    __syncthreads();
}

template <int DIR> __device__ __forceinline__ void lru_dir(const Params& p, int l, int n, int h, int lane, LAS bf16_t* XC, LAS float* STA, LAS float* STU) {
    const int c = lane & 15, q = lane >> 4, j = lane, t0 = n * 64;
    unsigned char* ws = p.ws;
    bf16_t* y = (bf16_t*)(ws + WS_H); bf16_t* PB = (bf16_t*)(ws + WS_PB);
    const bf16_t* LW = (const bf16_t*)(ws + WS_LRUW);
    float* Aprod = (float*)(ws + WS_AP); float* Hend = (float*)(ws + WS_HE);
    const float* lam = p.in[10] + (size_t)(l * 2 + DIR) * 512 + 64 * h; const float* b_a = p.in[7] + (size_t)(l * 2 + DIR) * 512 + 64 * h; const float* b_x = p.in[9] + (size_t)(l * 2 + DIR) * 512 + 64 * h;
    const bf16_t* LWa = LW + ((size_t)(DIR * 2 + 0) * 8 + h) * 4096 + c * 64 + 8 * q; const bf16_t* LWx = LW + ((size_t)(DIR * 2 + 1) * 8 + h) * 4096 + c * 64 + 8 * q;
    bf16x8 wa[4][2], wx[4][2]; f32x4 sp4[4], ba4[4], bx4[4];
#pragma unroll
    for (int nf = 0; nf < 4; ++nf) {
#pragma unroll
        for (int ks = 0; ks < 2; ++ks) { wa[nf][ks] = *(const bf16x8*)(LWa + nf * 1024 + 32 * ks); wx[nf][ks] = *(const bf16x8*)(LWx + nf * 1024 + 32 * ks); }
        const f32x4 lam4 = *(const f32x4*)(lam + 16 * nf + 4 * q); ba4[nf] = *(const f32x4*)(b_a + 16 * nf + 4 * q); bx4[nf] = *(const f32x4*)(b_x + 16 * nf + 4 * q);
#pragma unroll
        for (int r = 0; r < 4; ++r) { const float e = __expf(-lam4[r]); const float l1p = e < 0.05f ? e * (1.0f - e * (0.5f - e * (0.33333334f - e * 0.25f))) : __logf(1.0f + e); sp4[nf][r] = -8.0f * l1p; }
    }
    float hcar = 0.f, P = 1.f;
#pragma unroll 1
    for (int g = 0; g < 4; ++g) {
        const int mi = DIR == 0 ? g : 3 - g;
        bf16_t hfp[16];
        if (DIR == 1) {
#pragma unroll
            for (int s = 0; s < 16; ++s) hfp[s] = y[(size_t)(t0 + 16 * mi + s) * D + 64 * h + j];
        }
        bf16x8 xf[2];
#pragma unroll
        for (int ks = 0; ks < 2; ++ks) xf[ks] = *(const LAS bf16x8*)(XC + (16 * mi + c) * 520 + 64 * h + 32 * ks + 8 * q);
        f32x4 za[4], zx[4];
#pragma unroll
        for (int nf = 0; nf < 4; ++nf) { za[nf] = (f32x4){0.f, 0.f, 0.f, 0.f}; zx[nf] = za[nf];
            za[nf] = mfma16(wa[nf][0], xf[0], za[nf]); za[nf] = mfma16(wa[nf][1], xf[1], za[nf]);
            zx[nf] = mfma16(wx[nf][0], xf[0], zx[nf]); zx[nf] = mfma16(wx[nf][1], xf[1], zx[nf]); }
#pragma unroll
        for (int nf = 0; nf < 4; ++nf) {
            const int jo = 16 * nf + 4 * q;
            const bf16x4 xc4 = *(const LAS bf16x4*)(XC + (16 * mi + c) * 520 + 64 * h + jo);
            const f32x4 zav = za[nf] + ba4[nf], zxv = zx[nf] + bx4[nf];
            f32x4 av, uv;
#pragma unroll
            for (int r = 0; r < 4; ++r) {
                const float ra = sigmoidf_(zav[r]), ix = sigmoidf_(zxv[r]);
                const float la = ra * sp4[nf][r];
                av[r] = __expf(la);
                const float x2 = 2.0f * la;
                const float om = -x2 * (1.0f + x2 * (0.5f + x2 * (0.16666667f + x2 * (0.041666668f + x2 * (0.0083333338f + x2 * (0.0013888889f + x2 * 0.0001984127f))))));
                uv[r] = bf2f((bf16_t)xc4[r]) * ix * __builtin_amdgcn_sqrtf(fmaxf(om, 0.f));
            }
            *(LAS f32x4*)(STA + c * 68 + jo) = av; *(LAS f32x4*)(STU + c * 68 + jo) = uv;
        }
        LDS_FENCE();
        float aa[16], uu[16];
#pragma unroll
        for (int s = 0; s < 16; ++s) { aa[s] = STA[s * 68 + j]; uu[s] = STU[s * 68 + j]; }
        LDS_FENCE();
#pragma unroll
        for (int s = 0; s < 16; ++s) {
            const int tl = DIR == 0 ? s : 15 - s;
            hcar = aa[tl] * hcar + uu[tl]; P *= aa[tl];
            const size_t row = (size_t)(t0 + 16 * mi + tl);
            if (DIR == 0) { const unsigned w = cvtpk(hcar, P); y[row * D + 64 * h + j] = (bf16_t)(w & 0xffffu); y[row * D + 512 + 64 * h + j] = (bf16_t)(w >> 16); }
            else { const unsigned w = cvtpk(bf2f(hfp[tl]) + hcar, P); y[row * D + 64 * h + j] = (bf16_t)(w & 0xffffu); PB[row * 512 + 64 * h + j] = (bf16_t)(w >> 16); }
        }
    }
    Aprod[(size_t)(DIR * NCH + n) * 512 + 64 * h + j] = P; Hend[(size_t)(DIR * NCH + n) * 512 + 64 * h + j] = hcar;
}

template <int MODE> __device__ void mixer_lru(const Params& p, int l, int n, LAS unsigned char* lds) {
    const int tid = otid(), lane = tid & 63, wave = tid >> 6;
    unsigned char* ws = p.ws;
    const bf16_t* proj = (const bf16_t*)(ws + WS_PROJ); bf16_t* y = (bf16_t*)(ws + WS_H);
    LAS bf16_t* XC = (LAS bf16_t*)lds;
    const int t0 = n * 64;
    if (MODE == 0) {
        LAS float* STA = (LAS float*)(lds + 66560 + wave * 8704);
        LAS float* STU = STA + 16 * 68;
        {
            const int ch = tid;
            const float cw0 = p.in[4][(size_t)(l * 4 + 0) * 512 + ch], cw1 = p.in[4][(size_t)(l * 4 + 1) * 512 + ch], cw2 = p.in[4][(size_t)(l * 4 + 2) * 512 + ch], cw3 = p.in[4][(size_t)(l * 4 + 3) * 512 + ch];
            const float cb = p.in[5][(size_t)l * 512 + ch];
            bf16_t xs[67];
#pragma unroll
            for (int i = 0; i < 67; ++i) { const int s_ = t0 - 2 + i; const int sc = s_ < 0 ? 0 : (s_ >= S ? S - 1 : s_); const bf16_t v = proj[(size_t)sc * DINP + ch]; xs[i] = s_ == sc ? v : (bf16_t)0; }
#pragma unroll
            for (int t = 0; t < 64; ++t) { const float xc = cb + cw0 * bf2f(xs[t]) + cw1 * bf2f(xs[t + 1]) + cw2 * bf2f(xs[t + 2]) + cw3 * bf2f(xs[t + 3]); XC[t * 520 + ch] = f2bf(xc); }
        }
        __syncthreads();
        lru_dir<0>(p, l, n, wave, lane, XC, STA, STU);
        lru_dir<1>(p, l, n, wave, lane, XC, STA, STU);
        __syncthreads();
    } else {
        const bf16_t* PB = (const bf16_t*)(ws + WS_PB); const float* carry = (const float*)(ws + WS_CA);
        const int ch0 = 8 * lane;
        const float* cfp = carry + (size_t)(0 * NCH + n) * 512 + ch0; const float* cbp = carry + (size_t)(1 * NCH + n) * 512 + ch0; const float* gnp = p.in[11] + (size_t)l * 512 + ch0;
        const f32x4 cf0 = *(const f32x4*)cfp, cf1 = *(const f32x4*)(cfp + 4), cb0 = *(const f32x4*)cbp, cb1 = *(const f32x4*)(cbp + 4), g0 = *(const f32x4*)gnp, g1 = *(const f32x4*)(gnp + 4);
        const float cf[8] = {cf0[0], cf0[1], cf0[2], cf0[3], cf1[0], cf1[1], cf1[2], cf1[3]}, cb[8] = {cb0[0], cb0[1], cb0[2], cb0[3], cb1[0], cb1[1], cb1[2], cb1[3]};
        const float gg[8] = {g0[0], g0[1], g0[2], g0[3], g1[0], g1[1], g1[2], g1[3]};
        {
            bf16x8 h0[8], pf[8], pb[8], gt[8];
#pragma unroll
            for (int i = 0; i < 8; ++i) { const size_t row = (size_t)(t0 + wave * 8 + i);
                h0[i] = *(const bf16x8*)(y + row * D + ch0); pf[i] = *(const bf16x8*)(y + row * D + 512 + ch0); pb[i] = *(const bf16x8*)(PB + row * 512 + ch0); gt[i] = *(const bf16x8*)(proj + row * DINP + 512 + ch0); }
#pragma unroll
            for (int i = 0; i < 8; ++i) { const size_t row = (size_t)(t0 + wave * 8 + i);
                float v[8]; float ss = 0.f;
#pragma unroll
                for (int k = 0; k < 8; ++k) { v[k] = (bf2f((bf16_t)h0[i][k]) + bf2f((bf16_t)pf[i][k]) * cf[k] + bf2f((bf16_t)pb[i][k]) * cb[k]) * geluf_(bf2f((bf16_t)gt[i][k])); ss += v[k] * v[k]; }
#pragma unroll
                for (int o = 32; o >= 1; o >>= 1) ss += __shfl_xor(ss, o);
                const float rs = rsqrtf(ss * (1.0f / 512.0f) + EPS);
                *(u32x4*)(y + row * D + ch0) = (u32x4){cvtpk(v[0] * rs * gg[0], v[1] * rs * gg[1]), cvtpk(v[2] * rs * gg[2], v[3] * rs * gg[3]), cvtpk(v[4] * rs * gg[4], v[5] * rs * gg[5]), cvtpk(v[6] * rs * gg[6], v[7] * rs * gg[7])}; }
        }
        __syncthreads();
    }
}

__device__ __forceinline__ bf16x8 pack8(const f32x4 a, const f32x4 b) {
    const u32x4 w = (u32x4){cvtpk(a[0], a[1]), cvtpk(a[2], a[3]), cvtpk(b[0], b[1]), cvtpk(b[2], b[3])}; return __builtin_bit_cast(bf16x8, w); }
#define SIGC(ef, c) (32 * ((ef) >> 1) + 8 * ((c) >> 2) + 4 * ((ef) & 1) + ((c) & 3))
#define SLOT(ks, q, jj) (32 * (ks) + 16 * ((jj) >> 2) + 4 * (q) + ((jj) & 3))

template <int MODE> __device__ void mixer_gla(const Params& p, int l, int n, LAS unsigned char* lds) {
    const int tid = otid(), lane = tid & 63, wave = tid >> 6, c = lane & 15, q = lane >> 4;
    const int h = wave >> 1, vh = wave & 1;
    unsigned char* ws = p.ws;
    const bf16_t* proj = (const bf16_t*)(ws + WS_PROJ); bf16_t* y = (bf16_t*)(ws + WS_H); const bf16_t* GW = (const bf16_t*)(ws + WS_GW);
    bf16_t* uT = (bf16_t*)(ws + WS_M); const bf16_t* spT = (const bf16_t*)(ws + WS_M + (size_t)S * D * 2); float* dec = (float*)(ws + WS_DEC);
    LAS bf16_t* VTw = (LAS bf16_t*)(lds + 66560 + wave * 9216);
    LAS float* SSQ = (LAS float*)(lds + 66560 + 8 * 9216);
    const int t0 = n * 64;
    const f32x4 zero4 = (f32x4){0.f, 0.f, 0.f, 0.f};
    {
        bf16x8 vn[4][2], identv[2];
#pragma unroll
        for (int tt = 0; tt < 4; ++tt)
#pragma unroll
            for (int kv = 0; kv < 2; ++kv) vn[tt][kv] = *(const bf16x8*)(proj + (size_t)(t0 + 16 * tt + c) * DINP + 1536 + 128 * h + 64 * vh + 32 * kv + 8 * q);
#pragma unroll
        for (int e1 = 0; e1 < 2; ++e1)
#pragma unroll
            for (int jj = 0; jj < 8; ++jj) identv[e1][jj] = (8 * q + jj == 16 * e1 + c) ? (short)0x3F80 : (short)0;
#pragma unroll
        for (int vf = 0; vf < 4; ++vf)
#pragma unroll
            for (int tt = 0; tt < 4; ++tt) { const f32x4 d = mfma16(vn[tt][vf >> 1], identv[vf & 1], zero4);
                *(LAS u32x2*)(VTw + (16 * vf + c) * 72 + 16 * tt + 4 * q) = (u32x2){cvtpk(d[0], d[1]), cvtpk(d[2], d[3])}; }
    }
    LDS_FENCE();
    f32x4 acc[4][4];
#pragma unroll
    for (int a = 0; a < 4; ++a)
#pragma unroll
        for (int b = 0; b < 4; ++b) acc[a][b] = zero4;
#pragma unroll 1
    for (int dir = 0; dir < 2; ++dir) {
        bf16x8 laop[4][2]; float tot[4];
        {
            bf16x8 lrf[4], gwf[4]; float bgv[4];
#pragma unroll
            for (int tt = 0; tt < 4; ++tt) { lrf[tt] = (bf16x8){0, 0, 0, 0, 0, 0, 0, 0}; if (q < 2) lrf[tt] = *(const bf16x8*)(proj + (size_t)(t0 + 16 * tt + c) * DINP + 2560 + dir * 16 + 8 * q); }
#pragma unroll
            for (int ef = 0; ef < 4; ++ef) { gwf[ef] = *(const bf16x8*)(GW + (size_t)(dir * 256 + 64 * h + SIGC(ef, c)) * 32 + 8 * q); bgv[ef] = p.in[13][(size_t)(l * 2 + dir) * 256 + 64 * h + SIGC(ef, c)]; }
#pragma unroll
            for (int ef = 0; ef < 4; ++ef) { tot[ef] = 0.f;
#pragma unroll
                for (int ks = 0; ks < 2; ++ks) { f32x4 la2[2];
#pragma unroll
                    for (int t2 = 0; t2 < 2; ++t2) { const f32x4 z = mfma16(lrf[2 * ks + t2], gwf[ef], zero4);
#pragma unroll
                        for (int r = 0; r < 4; ++r) { const float zz = z[r] + bgv[ef]; const float la = (fminf(zz, 0.f) - __logf(1.0f + __expf(-fabsf(zz)))) * (1.0f / 16.0f); la2[t2][r] = la; tot[ef] += la; } }
                    laop[ef][ks] = pack8(la2[0], la2[1]); __builtin_amdgcn_sched_barrier(0); } }
        }
        if (MODE == 1) {
            bf16x8 QEop[4][2], KEop[4][2];
            bf16x8 qn[4][2], kn1[4][2];
#pragma unroll
            for (int tj = 0; tj < 4; ++tj)
#pragma unroll
                for (int ks = 0; ks < 2; ++ks) { const bf16_t* rp = proj + (size_t)(t0 + 16 * tj + c) * DINP + 64 * h + 32 * ks + 8 * q; qn[tj][ks] = *(const bf16x8*)(rp + 1024); kn1[tj][ks] = *(const bf16x8*)(rp + 1280); }
            __builtin_amdgcn_sched_barrier(0);
#pragma unroll
            for (int tj = 0; tj < 4; ++tj) {
                const int t = 16 * tj + c;
                bf16x8 mk[2];
#pragma unroll
                for (int ks = 0; ks < 2; ++ks)
#pragma unroll
                    for (int jj = 0; jj < 8; ++jj) { const int sidx = SLOT(ks, q, jj); const bool on = dir == 0 ? sidx <= t : sidx >= t; mk[ks][jj] = on ? (short)0x3F80 : (short)0; }
#pragma unroll
                for (int ks2 = 0; ks2 < 2; ++ks2) { f32x4 qe2[2], ke2[2];
#pragma unroll
                    for (int e2 = 0; e2 < 2; ++e2) { const int ef = 2 * ks2 + e2;
                        f32x4 b = mfma16(laop[ef][0], mk[0], zero4); b = mfma16(laop[ef][1], mk[1], b);
#pragma unroll
                        for (int r = 0; r < 4; ++r) { qe2[e2][r] = bf2f((bf16_t)qn[tj][ks2][4 * e2 + r]) * 0.125f * __expf(b[r]); ke2[e2][r] = bf2f((bf16_t)kn1[tj][ks2][4 * e2 + r]) * __expf(-b[r]); } }
                    QEop[tj][ks2] = pack8(qe2[0], qe2[1]); KEop[tj][ks2] = pack8(ke2[0], ke2[1]); }
                __builtin_amdgcn_sched_barrier(0);
            }
            const bf16_t* SP = spT + ((size_t)(dir * NCH + n) * 4 + h) * 8192 + (size_t)(64 * vh) * 64;
            bf16x8 spf[4][2];
#pragma unroll
            for (int vf = 0; vf < 4; ++vf)
#pragma unroll
                for (int ks = 0; ks < 2; ++ks) spf[vf][ks] = *(const bf16x8*)(SP + (16 * vf + c) * 64 + 32 * ks + 8 * q);
            __builtin_amdgcn_sched_barrier(0);
            bf16x8 Pop[4][2];
#pragma unroll
            for (int ti = 0; ti < 4; ++ti)
#pragma unroll
                for (int ksp = 0; ksp < 2; ++ksp) { f32x4 pm[2];
#pragma unroll
                    for (int j2 = 0; j2 < 2; ++j2) { const int tjj = 2 * ksp + j2;
                        f32x4 sc = mfma16(KEop[tjj][0], QEop[ti][0], zero4); sc = mfma16(KEop[tjj][1], QEop[ti][1], sc);
#pragma unroll
                        for (int r = 0; r < 4; ++r) { const int j = 16 * tjj + 4 * q + r, i = 16 * ti + c; const bool keep = dir == 0 ? j <= i : j >= i; pm[j2][r] = keep ? sc[r] : 0.f; } }
                    Pop[ti][ksp] = pack8(pm[0], pm[1]); __builtin_amdgcn_sched_barrier(0); }
#pragma unroll
            for (int vf = 0; vf < 4; ++vf)
#pragma unroll
                for (int ks = 0; ks < 2; ++ks) {
                    const u32x2 v0 = *(const LAS u32x2*)(VTw + (16 * vf + c) * 72 + 32 * ks + 4 * q), v1 = *(const LAS u32x2*)(VTw + (16 * vf + c) * 72 + 32 * ks + 16 + 4 * q);
                    const bf16x8 vtf = __builtin_bit_cast(bf16x8, (u32x4){v0.x, v0.y, v1.x, v1.y});
#pragma unroll
                    for (int ti = 0; ti < 4; ++ti) { acc[vf][ti] = mfma16(vtf, Pop[ti][ks], acc[vf][ti]); acc[vf][ti] = mfma16(spf[vf][ks], QEop[ti][ks], acc[vf][ti]); }
                    if (ks == 1 && (vf & 1)) __builtin_amdgcn_sched_barrier(0);
                }
        } else {
#pragma unroll
            for (int ef = 0; ef < 4; ++ef) { float tt = tot[ef]; tt += __shfl_xor(tt, 16); tt += __shfl_xor(tt, 32);
                if (vh == 0 && q == 0) dec[((size_t)(dir * NCH + n) * 4 + h) * 64 + SIGC(ef, c)] = __expf(tt); }
            bf16x8 kn[4][2];
#pragma unroll
            for (int tj = 0; tj < 4; ++tj)
#pragma unroll
                for (int ks = 0; ks < 2; ++ks) kn[tj][ks] = *(const bf16x8*)(proj + (size_t)(t0 + 16 * tj + c) * DINP + 1280 + 64 * h + 32 * ks + 8 * q);
            bf16x8 ident[2];
#pragma unroll
            for (int e1 = 0; e1 < 2; ++e1)
#pragma unroll
                for (int jj = 0; jj < 8; ++jj) ident[e1][jj] = (8 * q + jj == 8 * (c >> 2) + 4 * e1 + (c & 3)) ? (short)0x3F80 : (short)0;
            bf16x8 kdop[4][2];
#pragma unroll
            for (int ks = 0; ks < 2; ++ks) {
                bf16x8 mk[2][2];
#pragma unroll
                for (int t2 = 0; t2 < 2; ++t2)
#pragma unroll
                    for (int k2 = 0; k2 < 2; ++k2)
#pragma unroll
                        for (int jj = 0; jj < 8; ++jj) { const int tp = 16 * (2 * ks + t2) + c, sidx = SLOT(k2, q, jj); const bool on = dir == 0 ? sidx > tp : sidx < tp; mk[t2][k2][jj] = on ? (short)0x3F80 : (short)0; }
#pragma unroll
                for (int ef = 0; ef < 4; ++ef) { f32x4 kd2[2];
#pragma unroll
                    for (int t2 = 0; t2 < 2; ++t2) { const int tj = 2 * ks + t2;
                        f32x4 E = mfma16(mk[t2][0], laop[ef][0], zero4); E = mfma16(mk[t2][1], laop[ef][1], E);
                        const f32x4 kR = mfma16(kn[tj][ef >> 1], ident[ef & 1], zero4);
#pragma unroll
                        for (int r = 0; r < 4; ++r) kd2[t2][r] = kR[r] * __expf(E[r]); }
                    kdop[ef][ks] = pack8(kd2[0], kd2[1]); __builtin_amdgcn_sched_barrier(0); }
            }
            bf16_t* U = uT + ((size_t)(dir * NCH + n) * 4 + h) * 8192 + (size_t)(64 * vh) * 64;
#pragma unroll
            for (int vf = 0; vf < 4; ++vf) { bf16x8 vtf[2];
#pragma unroll
                for (int ks = 0; ks < 2; ++ks) { const u32x2 v0 = *(const LAS u32x2*)(VTw + (16 * vf + c) * 72 + 32 * ks + 4 * q), v1 = *(const LAS u32x2*)(VTw + (16 * vf + c) * 72 + 32 * ks + 16 + 4 * q);
                    vtf[ks] = __builtin_bit_cast(bf16x8, (u32x4){v0.x, v0.y, v1.x, v1.y}); }
#pragma unroll
                for (int ef = 0; ef < 4; ++ef) { f32x4 u = mfma16(kdop[ef][0], vtf[0], zero4); u = mfma16(kdop[ef][1], vtf[1], u);
                    *(u32x2*)(U + (16 * vf + c) * 64 + 32 * (ef >> 1) + 8 * q + 4 * (ef & 1)) = (u32x2){cvtpk(u[0], u[1]), cvtpk(u[2], u[3])}; } }
        }
    }
    if (MODE == 1) {
        bf16x4 ggp[4][4];
#pragma unroll
        for (int ti = 0; ti < 4; ++ti)
#pragma unroll
            for (int vf = 0; vf < 4; ++vf) ggp[ti][vf] = *(const bf16x4*)(proj + (size_t)(t0 + 16 * ti + c) * DINP + 2048 + 128 * h + 64 * vh + 16 * vf + 4 * q);
#pragma unroll
        for (int ti = 0; ti < 4; ++ti) { float ss = 0.f;
#pragma unroll
            for (int vf = 0; vf < 4; ++vf) ss += acc[vf][ti][0] * acc[vf][ti][0] + acc[vf][ti][1] * acc[vf][ti][1] + acc[vf][ti][2] * acc[vf][ti][2] + acc[vf][ti][3] * acc[vf][ti][3];
            ss += __shfl_xor(ss, 16); ss += __shfl_xor(ss, 32);
            if (q == 0) SSQ[(h * 64 + 16 * ti + c) * 2 + vh] = ss; }
        __syncthreads();
        const float* gn = p.in[14] + (size_t)l * 128;
#pragma unroll
        for (int ti = 0; ti < 4; ++ti) { const int t = 16 * ti + c; const float rs = rsqrtf((SSQ[(h * 64 + t) * 2] + SSQ[(h * 64 + t) * 2 + 1]) * (1.0f / 128.0f) + EPS);
#pragma unroll
            for (int vf = 0; vf < 4; ++vf) { const int v = 64 * vh + 16 * vf + 4 * q; const f32x4 g4 = *(const f32x4*)(gn + v);
                float o[4];
#pragma unroll
                for (int r = 0; r < 4; ++r) o[r] = acc[vf][ti][r] * rs * g4[r] * siluf_(bf2f((bf16_t)ggp[ti][vf][r]));
                *(u32x2*)(y + (size_t)(t0 + t) * D + 512 + 128 * h + v) = (u32x2){cvtpk(o[0], o[1]), cvtpk(o[2], o[3])}; } }
    }
    __syncthreads();
}

__device__ void phase_scan(const Params& p) {
    unsigned char* ws = p.ws; const int tid = otid();
    if (tid < 256) {
        const bf16_t* __restrict__ uT = (const bf16_t*)(ws + WS_M); bf16_t* __restrict__ spT = (bf16_t*)(ws + WS_M + (size_t)S * D * 2); const float* __restrict__ dec = (const float*)(ws + WS_DEC);
        for (int gid = obid() * 256 + tid; gid < 65536; gid += gridDim.x * 256) {
            const int dir = gid >> 15, rem = gid & 32767, h = rem >> 13, vd = rem & 8191, d = vd & 63;
            float s = 0.f;
            const long step = dir ? -1 : 1; const int nfirst = dir ? NCH - 1 : 0;
            const bf16_t* up = uT + ((size_t)(dir * NCH + nfirst) * 4 + h) * 8192 + vd; bf16_t* sp = spT + ((size_t)(dir * NCH + nfirst) * 4 + h) * 8192 + vd;
            const float* dp = dec + ((size_t)(dir * NCH + nfirst) * 4 + h) * 64 + d;
#pragma unroll 1
            for (int st = 0; st < NCH; st += 64) {
                bf16_t ub[64]; float db[64];
#pragma unroll
                for (int i = 0; i < 64; ++i) { ub[i] = up[(long)(st + i) * step * 32768]; db[i] = dp[(long)(st + i) * step * 256]; }
#pragma unroll
                for (int i = 0; i < 64; ++i) { sp[(long)(st + i) * step * 32768] = f2bf(s); s = db[i] * s + bf2f(ub[i]); }
            }
        }
    } else if (tid < 384 && obid() < 8) {
        const float* __restrict__ Aprod = (const float*)(ws + WS_AP); const float* __restrict__ Hend = (const float*)(ws + WS_HE); float* __restrict__ carry = (float*)(ws + WS_CA);
        const int gid = obid() * 128 + (tid - 256); const int dir = gid >> 9, ch = gid & 511;
        float hc = 0.f;
        const long step = dir ? -1 : 1; const size_t base = (size_t)(dir * NCH + (dir ? NCH - 1 : 0)) * 512 + ch;
#pragma unroll 1
        for (int st = 0; st < NCH; st += 64) {
            float ab[64], hb[64];
#pragma unroll
            for (int i = 0; i < 64; ++i) { ab[i] = Aprod[base + (long)(st + i) * step * 512]; hb[i] = Hend[base + (long)(st + i) * step * 512]; }
#pragma unroll
            for (int i = 0; i < 64; ++i) { carry[base + (long)(st + i) * step * 512] = hc; hc = ab[i] * hc + hb[i]; }
        }
    }
}

#define XB_TMO      128
#define XB_XCNT(j)  (256  + 64 * (j))
#define XB_XSUB(j)  (1280 + 64 * (j))
#define XB_XGEN(j)  (2304 + 64 * (j))
#define XB_TOP      3328
#define XB_TOPGEN   3392
#define XCD_BAR_WORDS 3456
#define XB_SPIN_CAP (1u << 18)

__device__ __forceinline__ unsigned xb_ld(unsigned* p)              { return __hip_atomic_load(p, __ATOMIC_RELAXED, __HIP_MEMORY_SCOPE_AGENT); }
__device__ __forceinline__ unsigned xb_add(unsigned* p, unsigned v) { return __hip_atomic_fetch_add(p, v, __ATOMIC_RELAXED, __HIP_MEMORY_SCOPE_AGENT); }
__device__ __forceinline__ unsigned xb_xcc_id() { return (unsigned)__builtin_amdgcn_s_getreg((3 << 11) | 20) & 0xFu; }
#define XB_SPIN(cond, bar) do { unsigned _sp = 0; while (cond) { __builtin_amdgcn_s_sleep(1); \
    if ((++_sp & 255u) == 0u) { if (xb_ld(&(bar)[XB_TMO])) break; if (_sp > XB_SPIN_CAP) { atomicAdd(&(bar)[XB_TMO], 1u); break; } } } } while (0)

struct XcdBarrier {
    unsigned* bar; unsigned x;
    volatile LAS unsigned* st;
};

__device__ __forceinline__ XcdBarrier xcd_barrier_post(unsigned* bar, volatile LAS unsigned* st) {
    XcdBarrier b; b.bar = bar; b.x = xb_xcc_id(); b.st = st;
    if (threadIdx.x == 0) (void)xb_add(&bar[XB_XCNT(b.x)], 1u);
    return b;
}
__device__ __forceinline__ void xcd_barrier_complete(unsigned* bar, unsigned x, unsigned& nloc, unsigned& nx) {
    const unsigned G = gridDim.x * gridDim.y * gridDim.z;
    unsigned sum, cnt, mine, sp = 0u;
    for (;;) {
        sum = 0u; cnt = 0u; mine = 0u;
#pragma unroll
        for (unsigned j = 0; j < 16; ++j) { const unsigned c = xb_ld(&bar[XB_XCNT(j)]); sum += c; cnt += (c > 0u) ? 1u : 0u; mine = (j == x) ? c : mine; }
        if (sum == G) break;
        __builtin_amdgcn_s_sleep(1);
        if ((++sp & 255u) == 0u) { if (xb_ld(&bar[XB_TMO])) break; if (sp > XB_SPIN_CAP) { atomicAdd(&bar[XB_TMO], 1u); break; } }
    }
    nloc = mine > 0u ? mine : 1u; nx = cnt > 0u ? cnt : 1u;
}

__device__ __forceinline__ void xcd_barrier(const XcdBarrier& b) {
    asm volatile("s_waitcnt vmcnt(0)" ::: "memory");
    __syncthreads();
    if (threadIdx.x == 0) {
        unsigned* bar = b.bar;
        __builtin_amdgcn_s_waitcnt(0);
        unsigned nloc = b.st[0], nx = b.st[1];
        if (nloc == 0u) { xcd_barrier_complete(bar, b.x, nloc, nx); b.st[0] = nloc; b.st[1] = nx; }
        const unsigned old = xb_add(&bar[XB_XSUB(b.x)], 1u);
        const unsigned gen = old / nloc;
        if (old + 1u == (gen + 1u) * nloc) {
            __builtin_amdgcn_fence(__ATOMIC_RELEASE, "agent");
            asm volatile("s_waitcnt vmcnt(0)" ::: "memory");
            const unsigned og = xb_add(&bar[XB_TOP], 1u);
            const unsigned tg = og / nx;
            if (og + 1u == (tg + 1u) * nx) xb_add(&bar[XB_TOPGEN], 1u);
            else XB_SPIN(xb_ld(&bar[XB_TOPGEN]) == tg, bar);
            __builtin_amdgcn_fence(__ATOMIC_ACQUIRE, "agent");
            xb_add(&bar[XB_XGEN(b.x)], 1u);
            asm volatile("s_waitcnt vmcnt(0)" ::: "memory");
        } else {
            XB_SPIN(xb_ld(&bar[XB_XGEN(b.x)]) == gen, bar);
            __builtin_amdgcn_fence(__ATOMIC_ACQUIRE, "agent");
            asm volatile("s_waitcnt vmcnt(0)" ::: "memory");
        }
    }
    __syncthreads();
}

__global__ void __launch_bounds__(NTHR, 2) mk_fwd(Params p) {
    extern __shared__ __attribute__((aligned(16))) unsigned char lds_raw[];
    LAS unsigned char* lds = (LAS unsigned char*)lds_raw;
    unsigned char* ws = p.ws;
    bf16_t* WinT = (bf16_t*)(ws + WS_WIN); bf16_t* WoutT = (bf16_t*)(ws + WS_WOUT); bf16_t* WguT = (bf16_t*)(ws + WS_WGU); bf16_t* WdT = (bf16_t*)(ws + WS_WD);
    bf16_t* Hb = (bf16_t*)(ws + WS_H); bf16_t* PROJ = (bf16_t*)(ws + WS_PROJ); float* Mb = (float*)(ws + WS_M);
    const float* xin = p.in[0]; float* out = p.out;
    volatile LAS unsigned* bst = (volatile LAS unsigned*)(lds + LDS_BYTES - 16);
    if (threadIdx.x == 0) { bst[0] = 0u; bst[1] = 0u; }
    __syncthreads();
    XcdBarrier bar = xcd_barrier_post((unsigned*)(ws + WS_CTL), bst);
    for (int ph = p.ph_lo; ph < p.ph_hi; ++ph) {
        if (ph == p.ph_lo + 1) cg::this_grid().sync();
        else if (ph > p.ph_lo) xcd_barrier(bar);
        if (ph == 9 * NL) { phase_rowprep(out, (const bf16_t*)Mb, p.in[17] + (size_t)(NL - 1) * D, out, nullptr, nullptr); continue; }
        const int l = ph / 9, s = ph % 9;
        switch (s) {
        case 0: phase_weights(p, l, lds);
                if (l == 0) phase_rowprep(xin, nullptr, nullptr, nullptr, p.in[1], Hb);
                else phase_rowprep(out, (const bf16_t*)Mb, p.in[17] + (size_t)(l - 1) * D, out, p.in[1] + (size_t)l * D, Hb);
                break;
        case 1: gemm_fast(lds, Hb, WinT, S, DINP, D, EpiB16{PROJ, DINP}); break;
        case 2: for (int n = obid(); n < NCH; n += gridDim.x) mixer_lru<0>(p, l, n, lds);
                for (int n = obid(); n < NCH; n += gridDim.x) mixer_gla<0>(p, l, n, lds); break;
        case 3: phase_scan(p); break;
        case 4: for (int n = obid(); n < NCH; n += gridDim.x) mixer_lru<1>(p, l, n, lds);
                for (int n = obid(); n < NCH; n += gridDim.x) mixer_gla<1>(p, l, n, lds); break;
        case 5: gemm_fast(lds, Hb, WoutT, S, D, D, EpiB16{(bf16_t*)Mb, D}); break;
        case 6: phase_rowprep(l == 0 ? xin : out, (const bf16_t*)Mb, p.in[2] + (size_t)l * D, out, p.in[16] + (size_t)l * D, Hb); break;
        case 7: gemm_fast(lds, Hb, WguT, S, 2 * DFF, D, EpiSwiglu{PROJ, DFF}); break;
        case 8: gemm_fast(lds, PROJ, WdT, S, D, DFF, EpiB16{(bf16_t*)Mb, D}); break;
        }
    }
}

extern "C" void kernel_launch(void* const* d_in, const int* in_sizes, int n_in, void* d_out, int out_size, void* d_ws, size_t ws_size, hipStream_t stream) {
    static int grid = 0;
    if (grid == 0) {
        if (n_in != 21 || out_size != S * D || ws_size < WS_END) { fprintf(stderr, "kernel_launch: unexpected shapes: n_in %d out %d ws %zu (need %zu)\n", n_in, out_size, ws_size, (size_t)WS_END); grid = -1; return; }
        int dev = 0, cus = 0, per_cu = 0;
        (void)hipGetDevice(&dev); (void)hipDeviceGetAttribute(&cus, hipDeviceAttributeMultiprocessorCount, dev);
        if (hipFuncSetAttribute((const void*)mk_fwd, hipFuncAttributeMaxDynamicSharedMemorySize, LDS_BYTES) != hipSuccess) { fprintf(stderr, "kernel_launch: hipFuncSetAttribute failed\n"); grid = -1; return; }
        if (hipOccupancyMaxActiveBlocksPerMultiprocessor(&per_cu, (const void*)mk_fwd, NTHR, LDS_BYTES) != hipSuccess || per_cu < 1) { fprintf(stderr, "kernel_launch: occupancy query says %d\n", per_cu); per_cu = 1; }
        (void)hipGetLastError();
        grid = cus;
    }
    if (grid < 0) return;
    Params p{};
    for (int i = 0; i < 21; ++i) p.in[i] = (const float*)d_in[i];
    p.out = (float*)d_out; p.ws = (unsigned char*)d_ws;
    (void)hipMemsetAsync((unsigned char*)d_ws + WS_CTL, 0, 16384, stream);
#if ONE_LAUNCH
    p.ph_lo = 0; p.ph_hi = 9 * NL + 1;
    void* args[] = {&p};
    hipError_t e = hipLaunchCooperativeKernel((const void*)mk_fwd, dim3(grid), dim3(NTHR), args, LDS_BYTES, stream);
    if (e != hipSuccess) fprintf(stderr, "cooperative launch failed: %s (grid %d)\n", hipGetErrorString(e), grid);
#else
    for (int ph = 0; ph < 9 * NL + 1; ++ph) { p.ph_lo = ph; p.ph_hi = ph + 1; hipLaunchKernelGGL(mk_fwd, dim3(grid), dim3(NTHR), LDS_BYTES, stream, p); }
#endif
}
```
